# Optimizing an MI355X kernel written in HIP

```python
import math
import jax, jax.numpy as jnp
from jax import lax
import numpy as np

D_MODEL = 1024
BATCH = 4
SEQ = 4096
DEPTH = 1

CONV_WIDTH = 512
CONV_KERNEL = 31
N_HEADS = 8
HEAD_DIM = 64
ATTN_WIDTH = N_HEADS * HEAD_DIM
IDX_HEADS = 8
IDX_DIM = 64
TOPK_MAX = 256
Q_BLOCK = 128
ROPE_THETA = 10000.0
N_GROUPS = 4
EXPERTS_PER_GROUP = 4
N_EXPERTS = N_GROUPS * EXPERTS_PER_GROUP
TOP_K_EXPERTS = 2
D_EXPERT = 256
EPS = 1e-6
IN_SIZES = (2 * CONV_WIDTH, ATTN_WIDTH, ATTN_WIDTH, ATTN_WIDTH,
            IDX_HEADS * IDX_DIM, IDX_DIM, IDX_HEADS, D_MODEL, D_MODEL)
IN_COLS = sum(IN_SIZES)

kernel_name = "hybrid_conv_dsa_hmoe_block"


def rms_norm(x, g):
    xf = x.astype(jnp.float32)
    y = xf * lax.rsqrt(jnp.mean(xf * xf, axis=-1, keepdims=True) + EPS)
    return (y * g.astype(jnp.float32)).astype(x.dtype)


def rope_tables(positions, dim, dtype):
    inv = 1.0 / (ROPE_THETA ** (jnp.arange(0, dim, 2, dtype=jnp.float32) / dim))
    ang = positions.astype(jnp.float32)[..., None] * inv
    return jnp.cos(ang).astype(dtype), jnp.sin(ang).astype(dtype)


def apply_rope(x, cos, sin):
    x1, x2 = jnp.split(x, 2, axis=-1)
    return jnp.concatenate([x1 * cos - x2 * sin, x2 * cos + x1 * sin], axis=-1)


def conformer_conv(u, w_dw, b_dw, ln_g, ln_b, w_out):
    a, b = jnp.split(u, 2, axis=-1)
    g = a * jax.nn.sigmoid(b)
    c = lax.conv_general_dilated(g, w_dw.astype(g.dtype), window_strides=(1,),
                                 padding=[(CONV_KERNEL - 1, 0)],
                                 dimension_numbers=('NWC', 'WIO', 'NWC'),
                                 feature_group_count=CONV_WIDTH) + b_dw
    cf = c.astype(jnp.float32)
    mu = jnp.mean(cf, axis=-1, keepdims=True)
    var = jnp.mean(jnp.square(cf - mu), axis=-1, keepdims=True)
    n = ((cf - mu) * lax.rsqrt(var + EPS) * ln_g + ln_b).astype(u.dtype)
    return jax.nn.silu(n) @ w_out


def dsa_attention(q, k, v, qi, ki, wi):
    B, S = q.shape[0], q.shape[1]
    n_blocks = S // Q_BLOCK
    topk = min(TOPK_MAX, S // 4)
    key_pos = jnp.arange(S)
    scale = HEAD_DIM ** -0.5

    def block(i):
        start = i * Q_BLOCK
        qb = lax.dynamic_slice_in_dim(q, start, Q_BLOCK, axis=1)
        qib = lax.dynamic_slice_in_dim(qi, start, Q_BLOCK, axis=1)
        wib = lax.dynamic_slice_in_dim(wi, start, Q_BLOCK, axis=1)
        t = start + jnp.arange(Q_BLOCK)
        causal = key_pos[None, :] <= t[:, None]
        rel = jax.nn.relu(jnp.einsum('bqhd,bsd->bqhs', qib, ki))
        scores = jnp.einsum('bqhs,bqh->bqs', rel, wib).astype(jnp.float32)
        scores = jnp.where(causal[None], scores, -jnp.inf)
        _, idx = lax.top_k(scores, topk)
        valid = idx <= t[None, :, None]
        k_sel = jax.vmap(lambda kb, ib: kb[ib])(k, idx)
        v_sel = jax.vmap(lambda vb, ib: vb[ib])(v, idx)
        logits = jnp.einsum('bqhd,bqkhd->bqhk', qb, k_sel).astype(jnp.float32) * scale
        logits = jnp.where(valid[:, :, None, :], logits, -jnp.inf)
        p = jax.nn.softmax(logits, axis=-1).astype(v.dtype)
        return jnp.einsum('bqhk,bqkhd->bqhd', p, v_sel)

    out = lax.map(block, jnp.arange(n_blocks))
    return jnp.transpose(out, (1, 0, 2, 3, 4)).reshape(B, S, N_HEADS * HEAD_DIM)


def hier_moe(h, w_rg, b_rg, w_re, b_re, w_gate, w_up, w_down):
    B, S, D = h.shape
    hf = h.reshape(-1, D)
    T = hf.shape[0]
    g_prob = jax.nn.softmax((hf @ w_rg + b_rg).astype(jnp.float32), axis=-1)
    p_g, gi = lax.top_k(g_prob, 1)
    e_logits = (jnp.einsum('td,dge->tge', hf, w_re) + b_re).astype(jnp.float32)
    e_sel = jnp.take_along_axis(e_logits, gi[:, :, None], axis=1)[:, 0]
    p_e, ei = lax.top_k(jax.nn.softmax(e_sel, axis=-1), TOP_K_EXPERTS)
    p_e = p_e / jnp.sum(p_e, axis=-1, keepdims=True)
    comb = p_g * p_e
    eid = gi * EXPERTS_PER_GROUP + ei
    gate_w = jnp.zeros((T, N_EXPERTS), jnp.float32).at[jnp.arange(T)[:, None], eid].add(comb)
    gate_w = gate_w.astype(h.dtype)
    hid = jax.nn.silu(jnp.einsum('td,edf->tef', hf, w_gate)) * jnp.einsum('td,edf->tef', hf, w_up)
    hid = hid * gate_w[:, :, None]
    y = jnp.einsum('tef,efd->td', hid, w_down)
    return y.reshape(B, S, D)


def setup_inputs(seed: int = 0) -> dict:
    key = jax.random.key(seed)
    ks = jax.random.split(key, 24)
    f32 = jnp.float32
    nrm = lambda k, shape, fan_in: jax.random.normal(k, shape, f32) * (fan_in ** -0.5)
    L = DEPTH
    return {
        "x": jax.random.normal(ks[0], (BATCH, SEQ, D_MODEL), f32),
        "positions": jnp.broadcast_to(jnp.arange(SEQ, dtype=jnp.int32), (BATCH, SEQ)),
        "g_mix": 1.0 + 0.02 * jax.random.normal(ks[1], (L, D_MODEL), f32),
        "w_in": nrm(ks[2], (L, D_MODEL, IN_COLS), D_MODEL),
        "w_dw": nrm(ks[3], (L, CONV_KERNEL, 1, CONV_WIDTH), CONV_KERNEL),
        "b_dw": 0.02 * jax.random.normal(ks[4], (L, CONV_WIDTH), f32),
        "ln_g": 1.0 + 0.02 * jax.random.normal(ks[5], (L, CONV_WIDTH), f32),
        "ln_b": 0.02 * jax.random.normal(ks[6], (L, CONV_WIDTH), f32),
        "w_conv_out": nrm(ks[7], (L, CONV_WIDTH, D_MODEL), CONV_WIDTH),
        "w_attn_out": nrm(ks[8], (L, ATTN_WIDTH, D_MODEL), ATTN_WIDTH),
        "w_o": nrm(ks[9], (L, D_MODEL, D_MODEL), D_MODEL),
        "g_ffn": 1.0 + 0.02 * jax.random.normal(ks[10], (L, D_MODEL), f32),
        "w_rg": nrm(ks[11], (L, D_MODEL, N_GROUPS), D_MODEL),
        "b_rg": 0.01 * jax.random.normal(ks[12], (L, N_GROUPS), f32),
        "w_re": nrm(ks[13], (L, D_MODEL, N_GROUPS, EXPERTS_PER_GROUP), D_MODEL),
        "b_re": 0.01 * jax.random.normal(ks[14], (L, N_GROUPS, EXPERTS_PER_GROUP), f32),
        "w_gate": nrm(ks[15], (L, N_EXPERTS, D_MODEL, D_EXPERT), D_MODEL),
        "w_up": nrm(ks[16], (L, N_EXPERTS, D_MODEL, D_EXPERT), D_MODEL),
        "w_down": nrm(ks[17], (L, N_EXPERTS, D_EXPERT, D_MODEL), D_EXPERT),
        "g_final": 1.0 + 0.02 * jax.random.normal(ks[18], (D_MODEL,), f32),
    }


def reference(x, positions, g_mix, w_in, w_dw, b_dw, ln_g, ln_b, w_conv_out, w_attn_out,
              w_o, g_ffn, w_rg, b_rg, w_re, b_re, w_gate, w_up, w_down, g_final):
    B, S, _ = x.shape
    cos, sin = rope_tables(positions, HEAD_DIM, x.dtype)
    cos_h, sin_h = cos[:, :, None, :], sin[:, :, None, :]
    idx_scale = (IDX_HEADS ** -0.5) * (IDX_DIM ** -0.5)
    split_pts = np.cumsum(IN_SIZES)[:-1].tolist()
    for l in range(DEPTH):
        h = rms_norm(x, g_mix[l])
        z = h @ w_in[l]
        u_conv, q, k, v, qi, ki, wi, gc, ga = jnp.split(z, split_pts, axis=-1)
        q = apply_rope(q.reshape(B, S, N_HEADS, HEAD_DIM), cos_h, sin_h)
        k = apply_rope(k.reshape(B, S, N_HEADS, HEAD_DIM), cos_h, sin_h)
        v = v.reshape(B, S, N_HEADS, HEAD_DIM)
        qi = apply_rope(qi.reshape(B, S, IDX_HEADS, IDX_DIM), cos_h, sin_h)
        ki = apply_rope(ki, cos, sin)
        wi = wi * idx_scale
        y_conv = conformer_conv(u_conv, w_dw[l], b_dw[l], ln_g[l], ln_b[l], w_conv_out[l])
        y_attn = dsa_attention(q, k, v, qi, ki, wi) @ w_attn_out[l]
        m = jax.nn.sigmoid(gc) * y_conv + jax.nn.sigmoid(ga) * y_attn
        x = x + m @ w_o[l]
        h2 = rms_norm(x, g_ffn[l])
        x = x + hier_moe(h2, w_rg[l], b_rg[l], w_re[l], b_re[l], w_gate[l], w_up[l], w_down[l])
    return rms_norm(x, g_final)
```

```cpp
#include <hip/hip_runtime.h>
#include <stdint.h>

typedef unsigned short us;

constexpr int D = 1024, NB = 4, S = 4096, T = NB * S;
constexpr int TOPK = 256;
constexpr float EPS = 1e-6f;
constexpr int OFF_U = 0, OFF_Q = 1024, OFF_K = 1536, OFF_V = 2048, OFF_QI = 2560, OFF_KI = 3072, OFF_WI = 3136,
              OFF_GC = 3144, OFF_GA = 4168, INC = 5192;

__device__ __forceinline__ us f2bf(float f) {
  unsigned u = __float_as_uint(f);
  u += 0x7FFFu + ((u >> 16) & 1u);
  return (us)(u >> 16);
}
__device__ __forceinline__ float bf2f(us h) { return __uint_as_float(((unsigned)h) << 16); }
__device__ __forceinline__ float sigmoidf_(float x) { return 1.0f / (1.0f + expf(-x)); }

__device__ __forceinline__ float block_sum256(float v, float* red) {
  for (int o = 32; o > 0; o >>= 1) v += __shfl_xor(v, o);
  int w = threadIdx.x >> 6;
  __syncthreads();
  if ((threadIdx.x & 63) == 0) red[w] = v;
  __syncthreads();
  float r = red[0] + red[1] + red[2] + red[3];
  return r;
}

__global__ __launch_bounds__(256) void k_rmsnorm(const float* __restrict__ x, const float* __restrict__ g, us* __restrict__ out) {
  __shared__ float red[4];
  int t = blockIdx.x;
  const float* xr = x + (size_t)t * D;
  float v[4];
  float ss = 0.f;
#pragma unroll
  for (int i = 0; i < 4; i++) { v[i] = xr[threadIdx.x + 256 * i]; ss += v[i] * v[i]; }
  ss = block_sum256(ss, red);
  float r = 1.0f / sqrtf(ss * (1.0f / D) + EPS);
#pragma unroll
  for (int i = 0; i < 4; i++) out[(size_t)t * D + threadIdx.x + 256 * i] = f2bf(v[i] * r * g[threadIdx.x + 256 * i]);
}

__global__ void k_rope_table(const int* __restrict__ pos, float* __restrict__ ct, float* __restrict__ st) {
  int i = blockIdx.x * blockDim.x + threadIdx.x;
  if (i >= T * 32) return;
  int t = i >> 5, d = i & 31;
  float inv = 1.0f / powf(10000.0f, (float)(2 * d) / 64.0f);
  float ang = (float)pos[t] * inv;
  ct[i] = cosf(ang);
  st[i] = sinf(ang);
}

__global__ __launch_bounds__(256) void k_gemm_naive(const us* __restrict__ A, int lda, const float* __restrict__ Bm, int ldb,
                                                    float* __restrict__ C, int ldc, int M, int N, int K,
                                                    const float* __restrict__ R, int ldr) {
  __shared__ float As[16][65];
  __shared__ float Bs[16][65];
  int tx = threadIdx.x & 15, ty = threadIdx.x >> 4;
  int m0 = blockIdx.y * 64, n0 = blockIdx.x * 64;
  float acc[4][4];
#pragma unroll
  for (int i = 0; i < 4; i++)
#pragma unroll
    for (int j = 0; j < 4; j++) acc[i][j] = 0.f;
  for (int k0 = 0; k0 < K; k0 += 16) {
    for (int i = threadIdx.x; i < 1024; i += 256) {
      int m = i >> 4, k = i & 15;
      As[k][m] = (m0 + m < M) ? bf2f(A[(size_t)(m0 + m) * lda + k0 + k]) : 0.f;
    }
    for (int i = threadIdx.x; i < 1024; i += 256) {
      int k = i >> 6, n = i & 63;
      Bs[k][n] = (n0 + n < N) ? Bm[(size_t)(k0 + k) * ldb + n0 + n] : 0.f;
    }
    __syncthreads();
#pragma unroll
    for (int k = 0; k < 16; k++) {
      float a[4], b[4];
#pragma unroll
      for (int i = 0; i < 4; i++) { a[i] = As[k][ty * 4 + i]; b[i] = Bs[k][tx * 4 + i]; }
#pragma unroll
      for (int i = 0; i < 4; i++)
#pragma unroll
        for (int j = 0; j < 4; j++) acc[i][j] += a[i] * b[j];
    }
    __syncthreads();
  }
#pragma unroll
  for (int i = 0; i < 4; i++)
#pragma unroll
    for (int j = 0; j < 4; j++) {
      int m = m0 + ty * 4 + i, n = n0 + tx * 4 + j;
      if (m < M && n < N) {
        float v = acc[i][j];
        if (R) v += R[(size_t)m * ldr + n];
        C[(size_t)m * ldc + n] = v;
      }
    }
}

__global__ void k_ep_glu(const float* __restrict__ z, us* __restrict__ G) {
  int i = blockIdx.x * blockDim.x + threadIdx.x;
  int t = i >> 9, c = i & 511;
  float a = z[(size_t)t * 1024 + c], b = z[(size_t)t * 1024 + 512 + c];
  G[i] = f2bf(a * sigmoidf_(b));
}
__global__ void k_ep_rope(const float* __restrict__ z, const float* __restrict__ ct, const float* __restrict__ st,
                          us* __restrict__ out, int nh) {
  int i = blockIdx.x * blockDim.x + threadIdx.x;
  if (i >= T * nh * 32) return;
  int d = i & 31, h = (i >> 5) % nh, t = i / (32 * nh);
  float x1 = z[(size_t)t * 1024 + h * 64 + d], x2 = z[(size_t)t * 1024 + h * 64 + 32 + d];
  float c = ct[t * 32 + d], s = st[t * 32 + d];
  out[(size_t)t * (nh * 64) + h * 64 + d] = f2bf(x1 * c - x2 * s);
  out[(size_t)t * (nh * 64) + h * 64 + 32 + d] = f2bf(x2 * c + x1 * s);
}
__global__ void k_ep_copy(const float* __restrict__ z, us* __restrict__ out, int n, int act) {
  int i = blockIdx.x * blockDim.x + threadIdx.x;
  if (i >= T * n) return;
  int t = i / n, c = i % n;
  float v = z[(size_t)t * 1024 + c];
  if (act) v = sigmoidf_(v);
  out[i] = f2bf(v);
}
__global__ void k_ep_wi(const float* __restrict__ z, float* __restrict__ WI) {
  int i = blockIdx.x * blockDim.x + threadIdx.x;
  if (i >= T * 8) return;
  int t = i >> 3, c = i & 7;
  WI[i] = z[(size_t)t * 1024 + 64 + c] * 0.04419417382415922f;
}

__global__ __launch_bounds__(256) void k_conv(const us* __restrict__ G, const float* __restrict__ w_dw, const float* __restrict__ b_dw,
                                              const float* __restrict__ ln_g, const float* __restrict__ ln_b, us* __restrict__ NA) {
  __shared__ float red[4];
  int t = blockIdx.x, tt = t % S;
  float c[2];
#pragma unroll
  for (int i = 0; i < 2; i++) {
    int ch = threadIdx.x + 256 * i;
    float a = b_dw[ch];
    for (int j = 0; j < 31; j++) {
      int sp = tt - 30 + j;
      if (sp >= 0) a += w_dw[j * 512 + ch] * bf2f(G[(size_t)(t - 30 + j) * 512 + ch]);
    }
    c[i] = a;
  }
  float mu = block_sum256(c[0] + c[1], red) * (1.0f / 512);
  float d0 = c[0] - mu, d1 = c[1] - mu;
  float var = block_sum256(d0 * d0 + d1 * d1, red) * (1.0f / 512);
  float r = 1.0f / sqrtf(var + EPS);
#pragma unroll
  for (int i = 0; i < 2; i++) {
    int ch = threadIdx.x + 256 * i;
    float n = (c[i] - mu) * r * ln_g[ch] + ln_b[ch];
    NA[(size_t)t * 512 + ch] = f2bf(n * sigmoidf_(n));
  }
}

__device__ __forceinline__ unsigned fkey(float f) {
  unsigned u = __float_as_uint(f);
  return (u & 0x80000000u) ? ~u : (u | 0x80000000u);
}
__global__ __launch_bounds__(256) void k_attn_naive(const us* __restrict__ Q, const us* __restrict__ K, const us* __restrict__ V,
                                                    const us* __restrict__ QI, const us* __restrict__ KI, const float* __restrict__ WI,
                                                    us* __restrict__ AO) {
  __shared__ float sc[4096];
  __shared__ float qis[512];
  __shared__ float qs[512];
  __shared__ float wis[8];
  __shared__ int sel[256];
  __shared__ unsigned cnt;
  __shared__ int scan[256];
  __shared__ float pbuf[4][256];
  const int t = blockIdx.x, b = t / S, tt = t % S, N = tt + 1, tid = threadIdx.x;
  for (int i = tid; i < 512; i += 256) { qis[i] = bf2f(QI[(size_t)t * 512 + i]); qs[i] = bf2f(Q[(size_t)t * 512 + i]); }
  if (tid < 8) wis[tid] = WI[t * 8 + tid];
  __syncthreads();
  for (int s = tid; s < N; s += 256) {
    const us* kr = KI + (size_t)(b * S + s) * 64;
    float tot = 0.f;
    for (int h = 0; h < 8; h++) {
      float dot = 0.f;
      for (int d = 0; d < 64; d++) dot += qis[h * 64 + d] * bf2f(kr[d]);
      tot += wis[h] * fmaxf(dot, 0.f);
    }
    sc[s] = tot;
  }
  __syncthreads();
  int nsel;
  if (N <= TOPK) {
    for (int s = tid; s < N; s += 256) sel[s] = s;
    nsel = N;
  } else {
    unsigned prefix = 0;
    for (int bit = 31; bit >= 0; --bit) {
      unsigned cand = prefix | (1u << bit);
      if (tid == 0) cnt = 0;
      __syncthreads();
      unsigned c = 0;
      for (int s = tid; s < N; s += 256) c += (fkey(sc[s]) >= cand) ? 1u : 0u;
      atomicAdd(&cnt, c);
      __syncthreads();
      if (cnt >= (unsigned)TOPK) prefix = cand;
      __syncthreads();
    }
    const unsigned tau = prefix;
    if (tid == 0) cnt = 0;
    __syncthreads();
    {
      unsigned c = 0;
      for (int s = tid; s < N; s += 256) c += (fkey(sc[s]) > tau) ? 1u : 0u;
      atomicAdd(&cnt, c);
    }
    __syncthreads();
    const int need = TOPK - (int)cnt;
    unsigned flags = 0;
    int lc = 0;
    for (int e = 0; e < 16; e++) {
      int s = tid * 16 + e;
      if (s < N) {
        unsigned k = fkey(sc[s]);
        bool pick = k > tau;
        if (k == tau) {
          int rank = 0;
          for (int s2 = 0; s2 < s; s2++) rank += (fkey(sc[s2]) == tau) ? 1 : 0;
          pick = rank < need;
        }
        if (pick) { flags |= (1u << e); lc++; }
      }
    }
    scan[tid] = lc;
    __syncthreads();
    int base = 0;
    for (int i = 0; i < tid; i++) base += scan[i];
    for (int e = 0; e < 16; e++)
      if (flags & (1u << e)) { if (base < 256) sel[base] = tid * 16 + e; base++; }
    nsel = TOPK;
  }
  __syncthreads();
  const int w = tid >> 6, lane = tid & 63;
  for (int hh = 0; hh < 2; hh++) {
    const int h = w * 2 + hh;
    float lg[4];
    float mx = -INFINITY;
#pragma unroll
    for (int i = 0; i < 4; i++) {
      int j = lane + 64 * i;
      lg[i] = -INFINITY;
      if (j < nsel) {
        const us* kr = K + (size_t)(b * S + sel[j]) * 512 + h * 64;
        float dot = 0.f;
        for (int d = 0; d < 64; d++) dot += qs[h * 64 + d] * bf2f(kr[d]);
        lg[i] = dot * 0.125f;
      }
      mx = fmaxf(mx, lg[i]);
    }
    for (int o = 32; o > 0; o >>= 1) mx = fmaxf(mx, __shfl_xor(mx, o));
    float sum = 0.f;
#pragma unroll
    for (int i = 0; i < 4; i++) {
      int j = lane + 64 * i;
      float p = (j < nsel) ? expf(lg[i] - mx) : 0.f;
      pbuf[w][j] = p;
      sum += p;
    }
    for (int o = 32; o > 0; o >>= 1) sum += __shfl_xor(sum, o);
    __syncthreads();
    float o_ = 0.f;
    for (int j = 0; j < nsel; j++) o_ += pbuf[w][j] * bf2f(V[(size_t)(b * S + sel[j]) * 512 + h * 64 + lane]);
    AO[(size_t)t * 512 + h * 64 + lane] = f2bf(o_ / sum);
    __syncthreads();
  }
}

__global__ void k_gate(const float* __restrict__ y1, const float* __restrict__ y2, const us* __restrict__ GC, const us* __restrict__ GA,
                       us* __restrict__ M1) {
  size_t i = (size_t)blockIdx.x * blockDim.x + threadIdx.x;
  M1[i] = f2bf(bf2f(GC[i]) * y1[i] + bf2f(GA[i]) * y2[i]);
}

__global__ __launch_bounds__(256) void k_moe_naive(float* __restrict__ x1io, const float* __restrict__ g_ffn, const float* __restrict__ w_rg,
                                                   const float* __restrict__ b_rg, const float* __restrict__ w_re, const float* __restrict__ b_re,
                                                   const float* __restrict__ w_gate, const float* __restrict__ w_up,
                                                   const float* __restrict__ w_down, const float* __restrict__ g_final) {
  __shared__ float xs[1024];
  __shared__ float hs[1024];
  __shared__ float hid[256];
  __shared__ float lg[20];
  __shared__ float pe[4];
  __shared__ float red[4];
  __shared__ int eid[2];
  __shared__ float comb[2];
  const int t = blockIdx.x, tid = threadIdx.x, w = tid >> 6, lane = tid & 63;
  float* xr = x1io + (size_t)t * D;
  float ss = 0.f;
  for (int i = tid; i < D; i += 256) { float v = xr[i]; xs[i] = v; ss += v * v; }
  ss = block_sum256(ss, red);
  float r = 1.0f / sqrtf(ss * (1.0f / D) + EPS);
  for (int i = tid; i < D; i += 256) hs[i] = xs[i] * r * g_ffn[i];
  __syncthreads();
  for (int o = w; o < 20; o += 4) {
    float a = 0.f;
    for (int d = lane; d < D; d += 64) a += hs[d] * (o < 4 ? w_rg[d * 4 + o] : w_re[d * 16 + (o - 4)]);
    for (int k = 32; k > 0; k >>= 1) a += __shfl_xor(a, k);
    if (lane == 0) lg[o] = a + (o < 4 ? b_rg[o] : b_re[o - 4]);
  }
  __syncthreads();
  if (tid == 0) {
    float m = fmaxf(fmaxf(lg[0], lg[1]), fmaxf(lg[2], lg[3]));
    float se = 0.f;
    for (int i = 0; i < 4; i++) { float ev = expf(lg[i] - m); pe[i] = ev; se += ev; }
    int gi = 0;
    float best = pe[0];
    for (int i = 1; i < 4; i++) { float ev = pe[i]; if (ev > best) { best = ev; gi = i; } }
    float pg = best / se;
    float m2 = fmaxf(fmaxf(lg[4 + gi * 4], lg[5 + gi * 4]), fmaxf(lg[6 + gi * 4], lg[7 + gi * 4]));
    float sf = 0.f;
    for (int i = 0; i < 4; i++) { float fv = expf(lg[4 + gi * 4 + i] - m2); pe[i] = fv; sf += fv; }
    int e0 = 0;
    float b0 = pe[0];
    for (int i = 1; i < 4; i++) { float fv = pe[i]; if (fv > b0) { b0 = fv; e0 = i; } }
    int e1 = -1;
    float b1 = -1.f;
    for (int i = 0; i < 4; i++) { float fv = pe[i]; if (i != e0 && fv > b1) { b1 = fv; e1 = i; } }
    float p0 = b0 / sf, p1 = b1 / sf;
    float sp = p0 + p1;
    eid[0] = gi * 4 + e0; eid[1] = gi * 4 + e1;
    comb[0] = pg * (p0 / sp); comb[1] = pg * (p1 / sp);
  }
  __syncthreads();
  float y[4] = {0.f, 0.f, 0.f, 0.f};
  for (int k = 0; k < 2; k++) {
    const int e = eid[k];
    const float* wg = w_gate + (size_t)e * D * 256;
    const float* wu = w_up + (size_t)e * D * 256;
    float ga = 0.f, ua = 0.f;
    for (int d = 0; d < D; d++) { float h = hs[d]; ga += h * wg[(size_t)d * 256 + tid]; ua += h * wu[(size_t)d * 256 + tid]; }
    __syncthreads();
    hid[tid] = ga * sigmoidf_(ga) * ua * comb[k];
    __syncthreads();
    const float* wd = w_down + (size_t)e * 256 * D;
    for (int j = 0; j < 256; j++) {
      float hv = hid[j];
#pragma unroll
      for (int i = 0; i < 4; i++) y[i] += hv * wd[(size_t)j * D + tid + 256 * i];
    }
  }
  float v[4];
  float s2 = 0.f;
#pragma unroll
  for (int i = 0; i < 4; i++) { v[i] = xs[tid + 256 * i] + y[i]; s2 += v[i] * v[i]; }
  s2 = block_sum256(s2, red);
  float r2 = 1.0f / sqrtf(s2 * (1.0f / D) + EPS);
#pragma unroll
  for (int i = 0; i < 4; i++) xr[tid + 256 * i] = v[i] * r2 * g_final[tid + 256 * i];
}

extern "C" void kernel_launch(void* const* d_in, const int* in_sizes, int n_in, void* d_out, int out_size, void* d_ws, size_t ws_size,
                              hipStream_t stream) {
  const float* x = (const float*)d_in[0];
  const int* pos = (const int*)d_in[1];
  const float* g_mix = (const float*)d_in[2];
  const float* w_in = (const float*)d_in[3];
  const float* w_dw = (const float*)d_in[4];
  const float* b_dw = (const float*)d_in[5];
  const float* ln_g = (const float*)d_in[6];
  const float* ln_b = (const float*)d_in[7];
  const float* w_co = (const float*)d_in[8];
  const float* w_ao = (const float*)d_in[9];
  const float* w_o = (const float*)d_in[10];
  const float* g_ffn = (const float*)d_in[11];
  const float* w_rg = (const float*)d_in[12];
  const float* b_rg = (const float*)d_in[13];
  const float* w_re = (const float*)d_in[14];
  const float* b_re = (const float*)d_in[15];
  const float* w_gate = (const float*)d_in[16];
  const float* w_up = (const float*)d_in[17];
  const float* w_down = (const float*)d_in[18];
  const float* g_final = (const float*)d_in[19];
  float* out = (float*)d_out;

  char* ws = (char*)d_ws;
  size_t off = 0;
  auto take = [&](size_t bytes) { char* p = ws + off; off += (bytes + 255) & ~(size_t)255; return p; };
  const size_t MB = 1 << 20;
  us* Hb = (us*)take(32 * MB);
  char* big = take(80 * MB);
  us* G = (us*)big;
  us* Qb = (us*)(big + 16 * MB);
  us* Kb = (us*)(big + 32 * MB);
  us* Vb = (us*)(big + 48 * MB);
  us* QIb = (us*)(big + 64 * MB);
  float* Y1 = (float*)big;
  us* KIb = (us*)take(2 * MB);
  float* WIb = (float*)take(T * 8 * 4);
  us* GCb = (us*)take(32 * MB);
  us* GAb = (us*)take(32 * MB);
  us* NAb = (us*)take(16 * MB);
  us* AOb = (us*)take(16 * MB);
  us* M1b = (us*)take(32 * MB);
  float* CT = (float*)take(2 * MB);
  float* ST = (float*)take(2 * MB);
  float* ZT = out;

  k_rmsnorm<<<T, 256, 0, stream>>>(x, g_mix, Hb);
  k_rope_table<<<T * 32 / 256, 256, 0, stream>>>(pos, CT, ST);
  auto gemm = [&](const us* A, int lda, const float* Bm, int ldb, float* C, int ldc, int M, int N, int K, const float* R, int ldr) {
    dim3 grid((N + 63) / 64, (M + 63) / 64);
    k_gemm_naive<<<grid, 256, 0, stream>>>(A, lda, Bm, ldb, C, ldc, M, N, K, R, ldr);
  };
  gemm(Hb, D, w_in + OFF_U, INC, ZT, 1024, T, 1024, D, nullptr, 0);
  k_ep_glu<<<T * 512 / 256, 256, 0, stream>>>(ZT, G);
  gemm(Hb, D, w_in + OFF_Q, INC, ZT, 1024, T, 512, D, nullptr, 0);
  k_ep_rope<<<T * 8 * 32 / 256, 256, 0, stream>>>(ZT, CT, ST, Qb, 8);
  gemm(Hb, D, w_in + OFF_K, INC, ZT, 1024, T, 512, D, nullptr, 0);
  k_ep_rope<<<T * 8 * 32 / 256, 256, 0, stream>>>(ZT, CT, ST, Kb, 8);
  gemm(Hb, D, w_in + OFF_V, INC, ZT, 1024, T, 512, D, nullptr, 0);
  k_ep_copy<<<T * 512 / 256, 256, 0, stream>>>(ZT, Vb, 512, 0);
  gemm(Hb, D, w_in + OFF_QI, INC, ZT, 1024, T, 512, D, nullptr, 0);
  k_ep_rope<<<T * 8 * 32 / 256, 256, 0, stream>>>(ZT, CT, ST, QIb, 8);
  gemm(Hb, D, w_in + OFF_KI, INC, ZT, 1024, T, 72, D, nullptr, 0);
  k_ep_rope<<<T * 1 * 32 / 256, 256, 0, stream>>>(ZT, CT, ST, KIb, 1);
  k_ep_wi<<<T * 8 / 256, 256, 0, stream>>>(ZT, WIb);
  gemm(Hb, D, w_in + OFF_GC, INC, ZT, 1024, T, 1024, D, nullptr, 0);
  k_ep_copy<<<T * 1024 / 256, 256, 0, stream>>>(ZT, GCb, 1024, 1);
  gemm(Hb, D, w_in + OFF_GA, INC, ZT, 1024, T, 1024, D, nullptr, 0);
  k_ep_copy<<<T * 1024 / 256, 256, 0, stream>>>(ZT, GAb, 1024, 1);

  k_conv<<<T, 256, 0, stream>>>(G, w_dw, b_dw, ln_g, ln_b, NAb);
  k_attn_naive<<<T, 256, 0, stream>>>(Qb, Kb, Vb, QIb, KIb, WIb, AOb);

  gemm(NAb, 512, w_co, D, Y1, 1024, T, 1024, 512, nullptr, 0);
  gemm(AOb, 512, w_ao, D, ZT, 1024, T, 1024, 512, nullptr, 0);
  k_gate<<<T * 1024 / 256, 256, 0, stream>>>(Y1, ZT, GCb, GAb, M1b);
  gemm(M1b, D, w_o, D, out, 1024, T, 1024, D, x, 1024);
  k_moe_naive<<<T, 256, 0, stream>>>(out, g_ffn, w_rg, b_rg, w_re, b_re, w_gate, w_up, w_down, g_final);
}
```

```cpp
#include <hip/hip_runtime.h>
#include <hip/hip_bf16.h>
#include <stdint.h>
#include <cstdio>

typedef unsigned short us;

constexpr int D = 1024, NB = 4, S = 4096, T = NB * S;
constexpr int TOPK = 256;
constexpr float EPS = 1e-6f;
constexpr int OFF_U = 0, OFF_Q = 1024, OFF_K = 1536, OFF_V = 2048, OFF_QI = 2560, OFF_KI = 3072, OFF_WI = 3136,
              OFF_GC = 3144, OFF_GA = 4168, INC = 5192;
constexpr int NIN = 5376;
constexpr float QSCALE = 0.125f * 1.4426950408889634f;
constexpr float IDX_SCALE = 0.04419417382415922f;

__device__ __forceinline__ us f2bf_(float f) {
  unsigned u = __float_as_uint(f);
  u += 0x7FFFu + ((u >> 16) & 1u);
  return (us)(u >> 16);
}
__device__ __forceinline__ float bf2f(us h) { return __uint_as_float(((unsigned)h) << 16); }
__device__ __forceinline__ float sigmoidf_(float x) { return 1.0f / (1.0f + expf(-x)); }
__device__ __forceinline__ float fsigmoid(float x) { return __builtin_amdgcn_rcpf(1.0f + __builtin_amdgcn_exp2f(-1.4426950408889634f * x)); }

namespace pg8 {
#define PG8_LAS __attribute__((address_space(3)))
typedef unsigned short bf16_t;
typedef short bf16x8 __attribute__((ext_vector_type(8)));
typedef float f32x4 __attribute__((ext_vector_type(4)));
typedef unsigned u32x4 __attribute__((ext_vector_type(4)));
constexpr int BM = 256, BK = 64, HALF = 128, HTB = HALF * BK * 2  , STAGE_BYTES = 8 * HTB, NXCD = 8, WGM = 8;

__host__ __device__ __forceinline__ int lds_byte(int r, int c) { const int st = (r >> 4) * 2 + (c >> 5), rr = r & 15, cc = c & 31, ob = rr * 64 + cc * 2; return st * 1024 + (ob ^ (((ob >> 9) & 1) << 5)); }
__host__ __device__ __forceinline__ void stage_rc(int b, int& R, int& C) { const int st = b / 1024, sb = b % 1024, swz = sb ^ (((sb >> 9) & 1) << 5); R = (st >> 1) * 16 + swz / 64; C = (st & 1) * 32 + (swz % 64) / 2; }
__host__ __device__ __forceinline__ int perm32(int rho) { const int n = rho >> 4, i = rho & 15; return 8 * (i >> 2) + 4 * n + (i & 3); }

struct Unit { int pm, pn, sel; };
struct Gemm { const bf16_t* A; const bf16_t* Bt; int M, N, K; };

struct StaticOrder {
    int nM, nN, nwg, G, c;
    __host__ __device__ void init(int M, int N, int G_, int c_) { nM = M / BM; nN = N / BM; nwg = nM * nN; G = G_; c = c_; }
    __host__ __device__ bool next(int i, Unit& u) const {
        const long L = (long)i * G + c; if (L >= nwg) return false;
        int wgid = (int)L; { const int q = nwg / NXCD, r = nwg % NXCD, xcd = wgid % NXCD, off = wgid / NXCD; wgid = (xcd < r ? xcd * (q + 1) : r * (q + 1) + (xcd - r) * q) + off; }
        const int nig = WGM * nN, gid = wgid / nig, fm = gid * WGM, gsz = (nM - fm) < WGM ? (nM - fm) : WGM;
        u.pm = fm + ((wgid % nig) % gsz); u.pn = (wgid % nig) / gsz; u.sel = 0; return true;
    }
    __device__ __forceinline__ void a_ready(const Unit&) const {}
    __device__ __forceinline__ void done(const Unit&) const {}
};

__device__ __forceinline__ unsigned cvt_pk_bf16(float lo, float hi) { unsigned r; asm volatile("v_cvt_pk_bf16_f32 %0, %1, %2" : "=v"(r) : "v"(lo), "v"(hi)); return r; }
typedef float f32x2 __attribute__((ext_vector_type(2)));
__device__ __forceinline__ f32x2 gelu_pk(f32x2 v) {
    const f32x2 av = __builtin_elementwise_abs(v), d = av * 0.2316418882f + 1.0f;
    f32x2 t; t.x = __builtin_amdgcn_rcpf(d.x); t.y = __builtin_amdgcn_rcpf(d.y);
    f32x2 q = t * 0.5307027145f + (-0.7265760135f); q = q * t + 0.7107068705f; q = q * t + (-0.142248368f); q = q * t + 0.127414796f; q = q * t;
    const f32x2 s = (v * v) * (-0.72134752044f);
    f32x2 e; e.x = __builtin_amdgcn_exp2f(s.x); e.y = __builtin_amdgcn_exp2f(s.y);
    const f32x2 m = v * (q * e), r = v - m;
    f32x2 o; o.x = v.x < 0.f ? m.x : r.x; o.y = v.y < 0.f ? m.y : r.y; return o;
}

template <int ACT  > struct EpiBf16 {
    static constexpr bool PERM = true, AFTER_DRAIN = false, CHAIN = false; static_assert(ACT == 0 || ACT == 1, "EpiBf16: ACT is 0 (none) or 1 (gelu_pk)");
    bf16_t* O; int ldc; const float* bias; int split_cols; size_t split_stride; float scale0;
    __device__ __forceinline__ void operator()(const f32x4 (&acc)[2][2][4][2], const Unit& u, int wr, int wc, int fr, int fq) const {
        const int row0 = u.pm * BM + wr * 64 + fr; int colt = u.pn * BM; bf16_t* base = O;
        float sc = 1.f; if (split_cols) { const int t = colt / split_cols; base += (size_t)t * split_stride; colt -= t * split_cols; if (t == 0) sc = scale0; }
        const int col0 = colt + wc * 32 + 8 * fq, bcol0 = u.pn * BM + wc * 32 + 8 * fq;
        f32x4 bv[2][2];
#pragma unroll
        for (int bj = 0; bj < 2; ++bj)
#pragma unroll
            for (int n = 0; n < 2; ++n) bv[bj][n] = bias ? *(const f32x4*)(bias + bcol0 + bj * HALF + 4 * n) : (f32x4){0.f, 0.f, 0.f, 0.f};
#pragma unroll
        for (int ai = 0; ai < 2; ++ai)
#pragma unroll
            for (int m = 0; m < 4; ++m) { bf16_t* rowp = base + (size_t)(row0 + ai * HALF + m * 16) * ldc + col0;
#pragma unroll
                for (int bj = 0; bj < 2; ++bj) { f32x4 v0 = acc[ai][bj][m][0] + bv[bj][0], v1 = acc[ai][bj][m][1] + bv[bj][1];
                    if (ACT == 1) { f32x2 a = gelu_pk((f32x2){v0[0], v0[1]}), b = gelu_pk((f32x2){v0[2], v0[3]}), c = gelu_pk((f32x2){v1[0], v1[1]}), d = gelu_pk((f32x2){v1[2], v1[3]});
                        v0 = (f32x4){a.x, a.y, b.x, b.y}; v1 = (f32x4){c.x, c.y, d.x, d.y}; }
                    v0 = v0 * sc; v1 = v1 * sc; u32x4 w; w.x = cvt_pk_bf16(v0[0], v0[1]); w.y = cvt_pk_bf16(v0[2], v0[3]); w.z = cvt_pk_bf16(v1[0], v1[1]); w.w = cvt_pk_bf16(v1[2], v1[3]);
                    *(u32x4*)(rowp + bj * HALF) = w; } }
    }
};

struct PanelStats {
    unsigned* xbuf;
    unsigned* cnt;
    unsigned* tmo;
    int ntn; float eps;
    unsigned code;
    __device__ __forceinline__ bool run(const f32x4 (&v)[2][2][4][2], const Unit& u, int wr, int wc, int fr, int fq, PG8_LAS unsigned char* lds, int wid, int lane) const {
        typedef float f32x2v __attribute__((ext_vector_type(2)));
        PG8_LAS f32x2v* P = (PG8_LAS f32x2v*)lds;
        PG8_LAS f32x2v* S = (PG8_LAS f32x2v*)(lds + 8192);
        PG8_LAS unsigned* flag = (PG8_LAS unsigned*)(lds + 8192 + 2048);
#pragma unroll
        for (int ai = 0; ai < 2; ++ai)
#pragma unroll
            for (int m = 0; m < 4; ++m) {
                float s = 0.f;
#pragma unroll
                for (int bj = 0; bj < 2; ++bj)
#pragma unroll
                    for (int n = 0; n < 2; ++n) { const f32x4 x = v[ai][bj][m][n]; s += (x[0] + x[1]) + (x[2] + x[3]); }
                s += __shfl_xor(s, 16); s += __shfl_xor(s, 32);
                const float mw = s * (1.0f / 64.0f); float q = 0.f;
#pragma unroll
                for (int bj = 0; bj < 2; ++bj)
#pragma unroll
                    for (int n = 0; n < 2; ++n) { const f32x4 d = v[ai][bj][m][n] - mw; q += (d[0] * d[0] + d[1] * d[1]) + (d[2] * d[2] + d[3] * d[3]); }
                q += __shfl_xor(q, 16); q += __shfl_xor(q, 32);
                if (fq == 0) P[(ai * HALF + wr * 64 + m * 16 + fr) * 4 + wc] = (f32x2v){mw, q};
            }
        asm volatile("s_waitcnt lgkmcnt(0)" ::: "memory"); __builtin_amdgcn_s_barrier(); asm volatile("" ::: "memory");
#if defined(BROKEN_EXCHANGE_NO_WAIT)
#warning BROKEN CONTROL BUILD: the row-statistics exchange does not wait; results are wrong by design
        if (blockIdx.x >= 64) { const long long t0_ = clock64(); while (clock64() - t0_ < 60000) __builtin_amdgcn_s_sleep(8); }
#endif
        const int row = wid * 32 + (lane & 31);
        if (lane < 32) {
            const f32x2v a = P[row * 4 + 0], b = P[row * 4 + 1], c = P[row * 4 + 2], d = P[row * 4 + 3];
            const float mt = (a.x + b.x + c.x + d.x) * 0.25f;
            const float da = a.x - mt, db = b.x - mt, dc = c.x - mt, dd = d.x - mt;
            const float m2 = (a.y + b.y) + (c.y + d.y) + 64.0f * ((da * da + db * db) + (dc * dc + dd * dd));
            unsigned long long* slot = (unsigned long long*)xbuf + ((size_t)(u.pm * BM + row) * 4 + u.pn);
            __hip_atomic_store(slot, ((unsigned long long)__float_as_uint(m2) << 32) | __float_as_uint(mt), __ATOMIC_RELAXED, __HIP_MEMORY_SCOPE_AGENT);
        }
        asm volatile("s_waitcnt vmcnt(0)" ::: "memory");
        if (lane == 0) __hip_atomic_fetch_add(cnt + 64 * u.pm, 1u, __ATOMIC_RELAXED, __HIP_MEMORY_SCOPE_AGENT);
        if (wid == 0) {
            bool dead = false; const unsigned long long t0 = __builtin_amdgcn_s_memrealtime(); const unsigned want = 8u * (unsigned)ntn;
            for (;;) {
#if defined(BROKEN_EXCHANGE_NO_WAIT)
                break;
#endif
                if ((unsigned)__builtin_amdgcn_readfirstlane(__hip_atomic_load(cnt + 64 * u.pm, __ATOMIC_RELAXED, __HIP_MEMORY_SCOPE_AGENT)) >= want) break;
                if (__builtin_amdgcn_s_memrealtime() - t0 > 2000000ull) {
                    if (lane == 0) { unsigned expect = 0u; __hip_atomic_compare_exchange_strong(tmo + 1, &expect, code | (unsigned)(u.pm & 0xff), __ATOMIC_RELAXED, __ATOMIC_RELAXED, __HIP_MEMORY_SCOPE_AGENT);
                                     __hip_atomic_store(tmo, 1u, __ATOMIC_RELAXED, __HIP_MEMORY_SCOPE_AGENT); }
                    dead = true; break; }
                __builtin_amdgcn_s_sleep(2);
            }
            __builtin_amdgcn_fence(__ATOMIC_ACQUIRE, "agent");
            if (lane == 0) flag[0] = dead ? 1u : 0u;
        }
        asm volatile("s_waitcnt vmcnt(0) lgkmcnt(0)" ::: "memory"); __builtin_amdgcn_s_barrier(); asm volatile("" ::: "memory");
        const bool bad = flag[0] != 0u;
        if (lane < 32) {
            const unsigned long long* slot = (const unsigned long long*)xbuf + (size_t)(u.pm * BM + row) * 4; float mt[4], m2[4]; float ms = 0.f;
#pragma unroll
            for (int t = 0; t < 4; ++t) { if (t < ntn) { const unsigned long long w = __hip_atomic_load(slot + t, __ATOMIC_RELAXED, __HIP_MEMORY_SCOPE_AGENT); mt[t] = __uint_as_float((unsigned)w); m2[t] = __uint_as_float((unsigned)(w >> 32)); } else { mt[t] = 0.f; m2[t] = 0.f; } ms += mt[t]; }
            const float mean = ms / (float)ntn; float q = 0.f;
#pragma unroll
            for (int t = 0; t < 4; ++t) if (t < ntn) { const float dm = mt[t] - mean; q += m2[t] + 256.0f * dm * dm; }
            S[row] = (f32x2v){mean, 1.0f / sqrtf(q / (256.0f * (float)ntn) + eps)};
        }
        asm volatile("s_waitcnt lgkmcnt(0)" ::: "memory"); __builtin_amdgcn_s_barrier(); asm volatile("" ::: "memory");
        return bad;
    }
};
struct EpiLnRes {
    static constexpr bool PERM = false, AFTER_DRAIN = true, CHAIN = false;
    const float* base; float* out; int ldc; const float* bias; PanelStats st; unsigned poison;
    __device__ __forceinline__ void fused(f32x4 (&acc)[2][2][4][2], const Unit& u, int wr, int wc, int fr, int fq, PG8_LAS unsigned char* lds, int wid, int lane) const {
        typedef float f32x2v __attribute__((ext_vector_type(2)));
        const PG8_LAS f32x2v* S = (const PG8_LAS f32x2v*)(lds + 8192);
        const int col0 = u.pn * BM + wc * 32 + 4 * fq;
#pragma unroll
        for (int bj = 0; bj < 2; ++bj)
#pragma unroll
            for (int n = 0; n < 2; ++n) { const f32x4 bv = bias ? *(const f32x4*)(bias + col0 + bj * HALF + n * 16) : (f32x4){0.f, 0.f, 0.f, 0.f};
#pragma unroll
                for (int ai = 0; ai < 2; ++ai)
#pragma unroll
                    for (int m = 0; m < 4; ++m) acc[ai][bj][m][n] += bv; }
        f32x4 pre[4][2][2];
#pragma unroll
        for (int m = 0; m < 4; ++m) { const size_t off = (size_t)(u.pm * BM + wr * 64 + m * 16 + fr) * ldc + col0;
#pragma unroll
            for (int bj = 0; bj < 2; ++bj)
#pragma unroll
                for (int n = 0; n < 2; ++n) pre[m][bj][n] = *(const f32x4*)(base + off + bj * HALF + n * 16); }
        const bool bad = st.run(acc, u, wr, wc, fr, fq, lds, wid, lane) || poison != 0u;
        const float qnan = __builtin_nanf("");
#pragma unroll
        for (int ai = 0; ai < 2; ++ai)
#pragma unroll
            for (int m = 0; m < 4; ++m) { const int r = ai * HALF + wr * 64 + m * 16 + fr; const f32x2v sr = S[r]; const size_t off = (size_t)(u.pm * BM + r) * ldc + col0;
#pragma unroll
                for (int bj = 0; bj < 2; ++bj)
#pragma unroll
                    for (int n = 0; n < 2; ++n) { const f32x4 bs = ai == 0 ? pre[m][bj][n] : *(const f32x4*)(base + off + bj * HALF + n * 16); f32x4 o = bs + (acc[ai][bj][m][n] - sr.x) * sr.y;
                        if (bad) o = (f32x4){qnan, qnan, qnan, qnan}; *(f32x4*)(out + off + bj * HALF + n * 16) = o; }
                if (m & 1) asm volatile("" ::: "memory"); }
    }
};
struct EpiLnResLn {
    static constexpr bool PERM = false, AFTER_DRAIN = true, CHAIN = false;
    const float* base; float* out; bf16_t* xn; int ldc; const float* bias; PanelStats st1, st2; unsigned poison;
    __device__ __forceinline__ void fused(f32x4 (&acc)[2][2][4][2], const Unit& u, int wr, int wc, int fr, int fq, PG8_LAS unsigned char* lds, int wid, int lane) const {
        typedef float f32x2v __attribute__((ext_vector_type(2))); typedef unsigned u32x2v __attribute__((ext_vector_type(2)));
        const PG8_LAS f32x2v* S = (const PG8_LAS f32x2v*)(lds + 8192);
        const int col0 = u.pn * BM + wc * 32 + 4 * fq;
#pragma unroll
        for (int bj = 0; bj < 2; ++bj)
#pragma unroll
            for (int n = 0; n < 2; ++n) { const f32x4 bv = bias ? *(const f32x4*)(bias + col0 + bj * HALF + n * 16) : (f32x4){0.f, 0.f, 0.f, 0.f};
#pragma unroll
                for (int ai = 0; ai < 2; ++ai)
#pragma unroll
                    for (int m = 0; m < 4; ++m) acc[ai][bj][m][n] += bv; }
        bool bad = st1.run(acc, u, wr, wc, fr, fq, lds, wid, lane) || poison != 0u;
        const float qnan = __builtin_nanf("");
#pragma unroll
        for (int ai = 0; ai < 2; ++ai)
#pragma unroll
            for (int m = 0; m < 4; ++m) { const int r = ai * HALF + wr * 64 + m * 16 + fr; const f32x2v sr = S[r]; const size_t off = (size_t)(u.pm * BM + r) * ldc + col0;
#pragma unroll
                for (int bj = 0; bj < 2; ++bj)
#pragma unroll
                    for (int n = 0; n < 2; ++n) { const f32x4 bs = *(const f32x4*)(base + off + bj * HALF + n * 16); acc[ai][bj][m][n] = bs + (acc[ai][bj][m][n] - sr.x) * sr.y; }
                asm volatile("" : "+v"(acc[ai][0][m][0]), "+v"(acc[ai][0][m][1]), "+v"(acc[ai][1][m][0]), "+v"(acc[ai][1][m][1]));
                if (m & 1) asm volatile("" ::: "memory"); }
        const bool bad1 = bad;
        bad = st2.run(acc, u, wr, wc, fr, fq, lds, wid, lane) || bad;
#pragma unroll
        for (int ai = 0; ai < 2; ++ai)
#pragma unroll
            for (int m = 0; m < 4; ++m) { const int r = ai * HALF + wr * 64 + m * 16 + fr; const f32x2v sr = S[r]; const size_t off = (size_t)(u.pm * BM + r) * ldc + col0;
#pragma unroll
                for (int bj = 0; bj < 2; ++bj)
#pragma unroll
                    for (int n = 0; n < 2; ++n) { const f32x4 x1 = acc[ai][bj][m][n]; *(f32x4*)(out + off + bj * HALF + n * 16) = bad1 ? (f32x4){qnan, qnan, qnan, qnan} : x1;
                        const f32x4 o = (x1 - sr.x) * sr.y; u32x2v w; w.x = cvt_pk_bf16(o[0], o[1]); w.y = cvt_pk_bf16(o[2], o[3]);
                        if (bad) { w.x = 0x7fc07fc0u; w.y = 0x7fc07fc0u; } *(u32x2v*)(xn + off + bj * HALF + n * 16) = w; }
                asm volatile("" ::: "memory"); }
    }
};

template <class Epi, class Sched, bool ALIGN_EPI = false, bool SP2 = false>
__device__ __forceinline__ void gemm_phase(PG8_LAS unsigned char* lds, const Gemm g, const Sched& S, const Epi& E, const Gemm g1 = Gemm{nullptr, nullptr, 0, 0, 0}) {
    const int tid = threadIdx.x, wid = __builtin_amdgcn_readfirstlane(tid >> 6), lane = tid & 63, wr = wid >> 2, wc = wid & 3, fr = lane & 15, fq = lane >> 4;
    const int K = g.K, nt = K / BK;
    unsigned voffA[2], voffB[2];
#pragma unroll
    for (int i = 0; i < 2; ++i) { int R, C; stage_rc(tid * 16 + i * 8192, R, C); const int Rb = Epi::PERM ? ((R & ~31) + perm32(R & 31)) : R;
        voffA[i] = (unsigned)(R * K + C) * 2u; voffB[i] = (unsigned)(Rb * K + C) * 2u; }
    const size_t kstep = (size_t)(BK * 2);
    const size_t hstep = (size_t)HALF * K * 2;
    const size_t tstep = 2 * hstep;
    const unsigned ldsw = (unsigned)wid * 1024u;
    const int aoff = lds_byte(wr * 64 + fr, fq * 8), boff = lds_byte(wc * 32 + fr, fq * 8);
#define PG8_SA(b, h) (((b) * 2 + (h)) * HTB)
#define PG8_SB(b, h) ((4 + (b) * 2 + (h)) * HTB)
#define PG8_STAGE(bufoff, gbase, voff) do { _Pragma("unroll") for (int _i = 0; _i < 2; ++_i) \
        __builtin_amdgcn_global_load_lds((const unsigned*)((const char*)(gbase) + (voff)[_i]), (PG8_LAS unsigned*)(lds + (bufoff) + ldsw + _i * 8192), 16, 0, 0); } while (0)
#define PG8_LDA(dst, b, h) do { _Pragma("unroll") for (int m = 0; m < 4; ++m) _Pragma("unroll") for (int k = 0; k < 2; ++k) dst[m][k] = *(const PG8_LAS bf16x8*)(lds + PG8_SA(b, h) + aoff + m * 2048 + k * 1024); } while (0)
#define PG8_LDB(dst, b, h) do { _Pragma("unroll") for (int n = 0; n < 2; ++n) _Pragma("unroll") for (int k = 0; k < 2; ++k) dst[n][k] = *(const PG8_LAS bf16x8*)(lds + PG8_SB(b, h) + boff + n * 2048 + k * 1024); } while (0)
#define PG8_MMA(ai, bj, At, Bt) do { __builtin_amdgcn_s_setprio(1); _Pragma("unroll") for (int m = 0; m < 4; ++m) _Pragma("unroll") for (int n = 0; n < 2; ++n) _Pragma("unroll") for (int k = 0; k < 2; ++k) \
        acc[ai][bj][m][n] = __builtin_amdgcn_mfma_f32_16x16x32_bf16(Bt[n][k], At[m][k], acc[ai][bj][m][n], 0, 0, 0); __builtin_amdgcn_s_setprio(0); } while (0)
#define PG8_WAIT_V(n) asm volatile("s_waitcnt vmcnt(" #n ")" ::: "memory")
#define PG8_WAIT_L(n) asm volatile("s_waitcnt lgkmcnt(" #n ")" ::: "memory")
#define PG8_BAR __builtin_amdgcn_s_barrier()
#define PG8_SCHED __builtin_amdgcn_sched_barrier(0)
    Unit cur, nxt; int ui = 0;
    if (!S.next(0, cur)) return;
    f32x4 acc[2][2][4][2];
#pragma unroll
    for (int a = 0; a < 2; ++a)
#pragma unroll
        for (int b = 0; b < 2; ++b)
#pragma unroll
            for (int m = 0; m < 4; ++m)
#pragma unroll
                for (int n = 0; n < 2; ++n) acc[a][b][m][n] = (f32x4){0.f, 0.f, 0.f, 0.f};
    bf16x8 At[4][2], B0[2][2], B1[2][2];
    const char* cA = (const char*)(cur.sel ? g1.A : g.A) + (size_t)cur.pm * tstep; const char* cB = (const char*)(cur.sel ? g1.Bt : g.Bt) + (size_t)cur.pn * tstep;
    S.a_ready(cur);
    if constexpr (SP2) {
        PG8_STAGE(PG8_SB(0, 0), cB, voffB); PG8_STAGE(PG8_SB(0, 1), cB + hstep, voffB); PG8_STAGE(PG8_SA(0, 0), cA, voffA); PG8_STAGE(PG8_SA(0, 1), cA + hstep, voffA);
        if (wr == 1) PG8_BAR;
        PG8_WAIT_V(2); PG8_BAR;
        PG8_STAGE(PG8_SB(1, 0), cB + kstep, voffB); PG8_STAGE(PG8_SA(1, 0), cA + kstep, voffA); PG8_STAGE(PG8_SB(1, 1), cB + hstep + kstep, voffB);
        PG8_WAIT_V(6); PG8_BAR;
    } else {
        PG8_STAGE(PG8_SB(0, 0), cB, voffB); PG8_STAGE(PG8_SA(0, 0), cA, voffA); PG8_STAGE(PG8_SB(0, 1), cB + hstep, voffB); PG8_STAGE(PG8_SA(0, 1), cA + hstep, voffA);
        if (wr == 1) PG8_BAR;
        PG8_WAIT_V(4); PG8_BAR;
        PG8_STAGE(PG8_SB(1, 0), cB + kstep, voffB); PG8_STAGE(PG8_SA(1, 0), cA + kstep, voffA); PG8_STAGE(PG8_SB(1, 1), cB + hstep + kstep, voffB);
        PG8_WAIT_V(6); PG8_BAR;
    }
    for (;;) {
        const bool has_next = S.next(ui + 1, nxt);
        const char* nA = has_next ? (const char*)(nxt.sel ? g1.A : g.A) + (size_t)nxt.pm * tstep : cA; const char* nB = has_next ? (const char*)(nxt.sel ? g1.Bt : g.Bt) + (size_t)nxt.pn * tstep : cB;
        for (int t = 0; t < nt; t += 2) {
            const bool last = (t == nt - 2);
            const char* a1 = cA + (size_t)(t + 1) * kstep;
            const char* a2 = last ? nA : cA + (size_t)(t + 2) * kstep; const char* b2 = last ? nB : cB + (size_t)(t + 2) * kstep;
            const char* a3 = a2 + kstep; const char* b3 = b2 + kstep;
            if (last && has_next) S.a_ready(nxt);
            if constexpr (SP2) {
            PG8_LDB(B0, 0, 0); PG8_LDB(B1, 0, 1); PG8_SCHED; PG8_LDA(At, 0, 0); PG8_STAGE(PG8_SA(1, 1), a1 + hstep, voffA);
            PG8_WAIT_V(8); PG8_WAIT_L(0); PG8_BAR; PG8_MMA(0, 0, At, B0); PG8_MMA(0, 1, At, B1); PG8_BAR; PG8_SCHED;
            PG8_LDA(At, 0, 1); PG8_STAGE(PG8_SB(0, 0), b2, voffB); PG8_STAGE(PG8_SB(0, 1), b2 + hstep, voffB); PG8_STAGE(PG8_SA(0, 0), a2, voffA);
            PG8_WAIT_V(8); PG8_WAIT_L(0); PG8_BAR; PG8_MMA(1, 0, At, B0); PG8_MMA(1, 1, At, B1); PG8_BAR; PG8_SCHED;
            PG8_LDB(B0, 1, 0); PG8_LDB(B1, 1, 1); PG8_SCHED; PG8_LDA(At, 1, 0); PG8_STAGE(PG8_SA(0, 1), a2 + hstep, voffA);
            PG8_WAIT_V(8); PG8_WAIT_L(0); PG8_BAR; PG8_MMA(0, 0, At, B0); PG8_MMA(0, 1, At, B1); PG8_BAR; PG8_SCHED;
            PG8_LDA(At, 1, 1); PG8_STAGE(PG8_SB(1, 0), b3, voffB); PG8_STAGE(PG8_SB(1, 1), b3 + hstep, voffB); PG8_STAGE(PG8_SA(1, 0), a3, voffA);
            PG8_WAIT_V(8); PG8_WAIT_L(0); PG8_BAR; PG8_MMA(1, 0, At, B0); PG8_MMA(1, 1, At, B1); PG8_BAR; PG8_SCHED;
            } else {
            PG8_LDB(B0, 0, 0); PG8_SCHED; PG8_LDA(At, 0, 0); PG8_STAGE(PG8_SA(1, 1), a1 + hstep, voffA);
            PG8_WAIT_L(8); PG8_BAR; PG8_WAIT_L(0); PG8_MMA(0, 0, At, B0); PG8_BAR; PG8_SCHED;
            PG8_LDB(B1, 0, 1); PG8_STAGE(PG8_SB(0, 0), b2, voffB);
            PG8_BAR; PG8_WAIT_L(0); PG8_MMA(0, 1, At, B1); PG8_BAR;
            PG8_LDA(At, 0, 1); PG8_STAGE(PG8_SA(0, 0), a2, voffA);
            PG8_BAR; PG8_WAIT_L(0); PG8_MMA(1, 0, At, B0); PG8_BAR; PG8_SCHED;
            PG8_STAGE(PG8_SB(0, 1), b2 + hstep, voffB);
            PG8_WAIT_V(6); PG8_BAR; PG8_MMA(1, 1, At, B1); PG8_BAR;
            PG8_LDB(B0, 1, 0); PG8_SCHED; PG8_LDA(At, 1, 0); PG8_STAGE(PG8_SA(0, 1), a2 + hstep, voffA);
            PG8_WAIT_L(8); PG8_BAR; PG8_WAIT_L(0); PG8_MMA(0, 0, At, B0); PG8_BAR; PG8_SCHED;
            PG8_LDB(B1, 1, 1); PG8_STAGE(PG8_SB(1, 0), b3, voffB);
            PG8_BAR; PG8_WAIT_L(0); PG8_MMA(0, 1, At, B1); PG8_BAR;
            PG8_LDA(At, 1, 1); PG8_STAGE(PG8_SA(1, 0), a3, voffA);
            PG8_BAR; PG8_WAIT_L(0); PG8_MMA(1, 0, At, B0); PG8_BAR; PG8_SCHED;
            PG8_STAGE(PG8_SB(1, 1), b3 + hstep, voffB);
            PG8_WAIT_V(6); PG8_BAR; PG8_MMA(1, 1, At, B1); PG8_BAR;
            }
        }
        if constexpr (ALIGN_EPI) { if (wr == 0) PG8_BAR; }
        bool keep_acc = false;
        if constexpr (Epi::CHAIN) { keep_acc = E.chain(acc, cur, wr, wc, fr, fq); }
        if constexpr (!Epi::AFTER_DRAIN) { if (!keep_acc) { E(acc, cur, wr, wc, fr, fq); } S.done(cur); }
        if (!has_next) break;
        if (!keep_acc) {
#pragma unroll
        for (int a = 0; a < 2; ++a)
#pragma unroll
            for (int b = 0; b < 2; ++b)
#pragma unroll
                for (int m = 0; m < 4; ++m)
#pragma unroll
                    for (int n = 0; n < 2; ++n) acc[a][b][m][n] = (f32x4){0.f, 0.f, 0.f, 0.f};
        }
        cur = nxt; cA = nA; cB = nB; ++ui;
        if constexpr (ALIGN_EPI) { if (wr == 1) PG8_BAR; }
    }
    PG8_WAIT_V(0);
    if constexpr (!ALIGN_EPI) { if (wr == 0) PG8_BAR; }
    PG8_BAR;
    if constexpr (Epi::AFTER_DRAIN) { E.fused(acc, cur, wr, wc, fr, fq, lds, wid, lane); S.done(cur); }
#undef PG8_SA
#undef PG8_SB
#undef PG8_STAGE
#undef PG8_LDA
#undef PG8_LDB
#undef PG8_MMA
#undef PG8_WAIT_V
#undef PG8_WAIT_L
#undef PG8_BAR
#undef PG8_SCHED
}
}

#define GAS __attribute__((address_space(1)))
#define LAS __attribute__((address_space(3)))
typedef unsigned v4u __attribute__((ext_vector_type(4)));
typedef float f32x4 __attribute__((ext_vector_type(4)));
typedef short bf16x8 __attribute__((ext_vector_type(8)));
typedef GAS unsigned gu32;
typedef GAS unsigned long long gu64;
#define RLX_AGENT __ATOMIC_RELAXED, __HIP_MEMORY_SCOPE_AGENT
#define LDS_WAIT() asm volatile("s_waitcnt lgkmcnt(0)" ::: "memory")
#define VM_WAIT() asm volatile("s_waitcnt vmcnt(0)" ::: "memory")
__device__ __forceinline__ unsigned f2bf(float f) { unsigned u = __builtin_bit_cast(unsigned, f); return (u + 0x7fffu + ((u >> 16) & 1u)) >> 16; }
__device__ __forceinline__ unsigned pk2(float lo, float hi) { return f2bf(lo) | (f2bf(hi) << 16); }
__device__ __forceinline__ float wave_sum(float v) {
#pragma unroll
  for (int o = 1; o < 64; o <<= 1) v += __shfl_xor(v, o);
  return v;
}
__device__ __forceinline__ float wave_sum_dpp(float v) {
  v += __builtin_bit_cast(float, __builtin_amdgcn_update_dpp(0, __builtin_bit_cast(int, v), 0xB1, 0xF, 0xF, true));
  v += __builtin_bit_cast(float, __builtin_amdgcn_update_dpp(0, __builtin_bit_cast(int, v), 0x4E, 0xF, 0xF, true));
  v += __builtin_bit_cast(float, __builtin_amdgcn_update_dpp(0, __builtin_bit_cast(int, v), 0x141, 0xF, 0xF, true));
  v += __builtin_bit_cast(float, __builtin_amdgcn_update_dpp(0, __builtin_bit_cast(int, v), 0x140, 0xF, 0xF, true));
  v += __builtin_bit_cast(float, __builtin_amdgcn_update_dpp(0, __builtin_bit_cast(int, v), 0x142, 0xA, 0xF, true));
  v += __builtin_bit_cast(float, __builtin_amdgcn_update_dpp(0, __builtin_bit_cast(int, v), 0x143, 0xC, 0xF, true));
  return __builtin_bit_cast(float, __builtin_amdgcn_readlane(__builtin_bit_cast(int, v), 63));
}

#define XB_TMO      128
#define XB_XCNT(j)  (256  + 64 * (j))
#define XB_XSUB(j)  (1280 + 64 * (j))
#define XB_XGEN(j)  (2304 + 64 * (j))
#define XB_TOP      3328
#define XB_TOPGEN   3392
#define XCD_BAR_WORDS 3456
#define XB_SPIN_CAP (1u << 18)

__device__ __forceinline__ unsigned xb_ld(unsigned* p)              { return __hip_atomic_load(p, __ATOMIC_RELAXED, __HIP_MEMORY_SCOPE_AGENT); }
__device__ __forceinline__ unsigned xb_add(unsigned* p, unsigned v) { return __hip_atomic_fetch_add(p, v, __ATOMIC_RELAXED, __HIP_MEMORY_SCOPE_AGENT); }
__device__ __forceinline__ unsigned xb_xcc_id() { return (unsigned)__builtin_amdgcn_s_getreg((3 << 11) | 20) & 0xFu; }
#define XB_SPIN(cond, bar) do { unsigned _sp = 0; while (cond) { __builtin_amdgcn_s_sleep(1); \
    if ((++_sp & 255u) == 0u) { if (xb_ld(&(bar)[XB_TMO])) break; if (_sp > XB_SPIN_CAP) { atomicAdd(&(bar)[XB_TMO], 1u); break; } } } } while (0)

struct XcdBarrier {
    unsigned* bar; unsigned x;
    volatile LAS unsigned* st;
};

__device__ __forceinline__ XcdBarrier xcd_barrier_post(unsigned* bar, volatile LAS unsigned* st) {
    XcdBarrier b; b.bar = bar; b.x = xb_xcc_id(); b.st = st;
    if (threadIdx.x == 0) (void)xb_add(&bar[XB_XCNT(b.x)], 1u);
    return b;
}
__device__ __forceinline__ void xcd_barrier_complete(unsigned* bar, unsigned x, unsigned& nloc, unsigned& nx) {
    const unsigned G = gridDim.x * gridDim.y * gridDim.z;
    unsigned sum, cnt, mine, sp = 0u;
    for (;;) {
        sum = 0u; cnt = 0u; mine = 0u;
#pragma unroll
        for (unsigned j = 0; j < 16; ++j) { const unsigned c = xb_ld(&bar[XB_XCNT(j)]); sum += c; cnt += (c > 0u) ? 1u : 0u; mine = (j == x) ? c : mine; }
        if (sum == G) break;
        __builtin_amdgcn_s_sleep(1);
        if ((++sp & 255u) == 0u) { if (xb_ld(&bar[XB_TMO])) break; if (sp > XB_SPIN_CAP) { atomicAdd(&bar[XB_TMO], 1u); break; } }
    }
    nloc = mine > 0u ? mine : 1u; nx = cnt > 0u ? cnt : 1u;
}

__device__ __forceinline__ void xcd_barrier(const XcdBarrier& b) {
    asm volatile("s_waitcnt vmcnt(0)" ::: "memory");
    __syncthreads();
    if (threadIdx.x == 0) {
        unsigned* bar = b.bar;
        __builtin_amdgcn_s_waitcnt(0);
        unsigned nloc = b.st[0], nx = b.st[1];
        if (nloc == 0u) { xcd_barrier_complete(bar, b.x, nloc, nx); b.st[0] = nloc; b.st[1] = nx; }
        const unsigned old = xb_add(&bar[XB_XSUB(b.x)], 1u);
        const unsigned gen = old / nloc;
        if (old + 1u == (gen + 1u) * nloc) {
            __builtin_amdgcn_fence(__ATOMIC_RELEASE, "agent");
            asm volatile("s_waitcnt vmcnt(0)" ::: "memory");
            const unsigned og = xb_add(&bar[XB_TOP], 1u);
            const unsigned tg = og / nx;
            if (og + 1u == (tg + 1u) * nx) xb_add(&bar[XB_TOPGEN], 1u);
            else XB_SPIN(xb_ld(&bar[XB_TOPGEN]) == tg, bar);
            __builtin_amdgcn_fence(__ATOMIC_ACQUIRE, "agent");
            xb_add(&bar[XB_XGEN(b.x)], 1u);
            asm volatile("s_waitcnt vmcnt(0)" ::: "memory");
        } else {
            XB_SPIN(xb_ld(&bar[XB_XGEN(b.x)]) == gen, bar);
            __builtin_amdgcn_fence(__ATOMIC_ACQUIRE, "agent");
            asm volatile("s_waitcnt vmcnt(0)" ::: "memory");
        }
    }
    __syncthreads();
}


namespace sg {
typedef float f32x16 __attribute__((ext_vector_type(16)));
constexpr int BM = 128, BN = 256, BK = 64, RS = 144;
constexpr int A_BYTES = BM * RS;
__device__ __forceinline__ int crow(int r, int hi) { return (r & 3) + 8 * (r >> 2) + 4 * hi; }
template <class Epi>
__device__ __forceinline__ void tile(LAS unsigned char* lds, const us* const (&ap)[2], const us* bf0, const us* bf1, int K, const Epi& E, int tid) {
  const int lane = tid & 63, wave = __builtin_amdgcn_readfirstlane(tid >> 6), wm = wave >> 2, wn = wave & 3;
  const int r32 = lane & 31, hi = lane >> 5;
  f32x16 acc[2][2];
#pragma unroll
  for (int a = 0; a < 2; ++a)
#pragma unroll
    for (int b = 0; b < 2; ++b)
#pragma unroll
      for (int r = 0; r < 16; ++r) acc[a][b][r] = 0.f;
  v4u ra0[2], ra1[2];
  bf16x8 bq[2][4];
  unsigned wa[2];
#pragma unroll
  for (int i = 0; i < 2; ++i) { const int c = tid + 512 * i; wa[i] = (unsigned)((c >> 3) * RS + (c & 7) * 16); }
  const unsigned aoff = (unsigned)((wm * 64 + r32) * RS + hi * 16);
  const int nk = K / BK;
#define SG_LOADA(RA, kt_) do { const int kc_ = (kt_) < nk ? (kt_) : nk - 1; \
    _Pragma("unroll") for (int i = 0; i < 2; ++i) RA[i] = *(const v4u*)(ap[i] + kc_ * BK); } while (0)
#define SG_LOADB1(ks, kt_) do { const int kc_ = (kt_) < nk ? (kt_) : nk - 1; \
    bq[0][ks] = *(const bf16x8*)(bf0 + (size_t)(kc_ * 4 + (ks)) * 512); bq[1][ks] = *(const bf16x8*)(bf1 + (size_t)(kc_ * 4 + (ks)) * 512); } while (0)
#define SG_WRITEA(RA, bufoff) do { \
    _Pragma("unroll") for (int i = 0; i < 2; ++i) *(LAS v4u*)(lds + (bufoff) + wa[i]) = RA[i]; } while (0)
#define SG_COMPUTE(bufoff, ktn_) do { \
    _Pragma("unroll") for (int ks = 0; ks < 4; ++ks) { \
      bf16x8 af[2]; \
      _Pragma("unroll") for (int m = 0; m < 2; ++m) af[m] = *(const LAS bf16x8*)(lds + (bufoff) + aoff + m * 32 * RS + ks * 32); \
      _Pragma("unroll") for (int h = 0; h < 2; ++h) \
        _Pragma("unroll") for (int m = 0; m < 2; ++m) acc[h][m] = __builtin_amdgcn_mfma_f32_32x32x16_bf16(bq[h][ks], af[m], acc[h][m], 0, 0, 0); \
      SG_LOADB1(ks, ktn_); } } while (0)
  SG_LOADA(ra0, 0);
#pragma unroll
  for (int ks = 0; ks < 4; ++ks) SG_LOADB1(ks, 0);
  SG_LOADA(ra1, 1);
  SG_WRITEA(ra0, 0);
  __syncthreads();
  for (int kt = 0; kt < nk; kt += 2) {
    SG_LOADA(ra0, kt + 2);
    SG_COMPUTE(0, kt + 1);
    SG_WRITEA(ra1, A_BYTES);
    __syncthreads();
    SG_LOADA(ra1, kt + 3);
    SG_COMPUTE(A_BYTES, kt + 2);
    SG_WRITEA(ra0, 0);
    __syncthreads();
  }
#undef SG_LOADA
#undef SG_LOADB1
#undef SG_WRITEA
#undef SG_COMPUTE
  E(acc, wm, wn, r32, hi);
}
template <class Epi>
__device__ __forceinline__ void tile_wide(LAS unsigned char* lds, const us* const (&ap)[2], const us* bf0, const us* bf1, int K, const Epi& E, int tid) {
  const int lane = tid & 63, wave = __builtin_amdgcn_readfirstlane(tid >> 6);
  const int r32 = lane & 31, hi = lane >> 5;
  f32x16 acc[2][4];
#pragma unroll
  for (int a = 0; a < 2; ++a)
#pragma unroll
    for (int b = 0; b < 4; ++b)
#pragma unroll
      for (int r = 0; r < 16; ++r) acc[a][b][r] = 0.f;
  v4u ra0[2];
  bf16x8 bq[2][4];
  unsigned wa[2];
#pragma unroll
  for (int i = 0; i < 2; ++i) { const int c = tid + 512 * i; wa[i] = (unsigned)((c >> 3) * RS + (c & 7) * 16); }
  const unsigned aoff = (unsigned)(r32 * RS + hi * 16);
  const int nk = K / BK;
#define SGW_LOADA(RA, kt_) do { const int kc_ = (kt_) < nk ? (kt_) : nk - 1; \
    _Pragma("unroll") for (int i = 0; i < 2; ++i) RA[i] = *(const v4u*)(ap[i] + kc_ * BK); } while (0)
#define SGW_LOADB1(ks, kt_) do { const int kc_ = (kt_) < nk ? (kt_) : nk - 1; \
    bq[0][ks] = *(const bf16x8*)(bf0 + (size_t)(kc_ * 4 + (ks)) * 512); bq[1][ks] = *(const bf16x8*)(bf1 + (size_t)(kc_ * 4 + (ks)) * 512); } while (0)
#define SGW_WRITEA(RA, bufoff) do { \
    _Pragma("unroll") for (int i = 0; i < 2; ++i) *(LAS v4u*)(lds + (bufoff) + wa[i]) = RA[i]; } while (0)
#define SGW_LDA(dst, bufoff, ks) do { _Pragma("unroll") for (int m = 0; m < 4; ++m) dst[m] = *(const LAS bf16x8*)(lds + (bufoff) + aoff + m * 32 * RS + (ks) * 32); } while (0)
#define SGW_MMA(afr, ks, ktn_) do { \
      _Pragma("unroll") for (int h = 0; h < 2; ++h) \
        _Pragma("unroll") for (int m = 0; m < 4; ++m) acc[h][m] = __builtin_amdgcn_mfma_f32_32x32x16_bf16(bq[h][ks], afr[m], acc[h][m], 0, 0, 0); \
      SGW_LOADB1(ks, ktn_); __builtin_amdgcn_sched_barrier(0); } while (0)
#define SGW_COMPUTE(bufoff, ktn_) do { bf16x8 afA[4], afB[4]; \
    SGW_LDA(afA, bufoff, 0); \
    SGW_LDA(afB, bufoff, 1); SGW_MMA(afA, 0, ktn_); \
    SGW_LDA(afA, bufoff, 2); SGW_MMA(afB, 1, ktn_); \
    SGW_LDA(afB, bufoff, 3); SGW_MMA(afA, 2, ktn_); \
    SGW_MMA(afB, 3, ktn_); } while (0)
  SGW_LOADA(ra0, 0);
#pragma unroll
  for (int ks = 0; ks < 4; ++ks) SGW_LOADB1(ks, 0);
  SGW_WRITEA(ra0, 0);
  __syncthreads();
  for (int kt = 0; kt < nk; kt += 2) {
    SGW_LOADA(ra0, kt + 1); __builtin_amdgcn_sched_barrier(0);
    SGW_COMPUTE(0, kt + 1);
    SGW_WRITEA(ra0, A_BYTES);
    __syncthreads();
    SGW_LOADA(ra0, kt + 2); __builtin_amdgcn_sched_barrier(0);
    SGW_COMPUTE(A_BYTES, kt + 2);
    SGW_WRITEA(ra0, 0);
    __syncthreads();
  }
#undef SGW_LOADA
#undef SGW_LOADB1
#undef SGW_WRITEA
#undef SGW_COMPUTE
#undef SGW_LDA
#undef SGW_MMA
  E(acc, wave, r32, hi);
}
constexpr int ARS = 528;
template <class Epi>
__device__ __forceinline__ void tile_resident(LAS unsigned char* lds, const us* bf0, const us* bf1, const Epi& E, int tid) {
  const int lane = tid & 63, wave = __builtin_amdgcn_readfirstlane(tid >> 6), wm = wave >> 2, wn = wave & 3;
  const int r32 = lane & 31, hi = lane >> 5;
  f32x16 acc[2][2];
#pragma unroll
  for (int a = 0; a < 2; ++a)
#pragma unroll
    for (int b = 0; b < 2; ++b)
#pragma unroll
      for (int r = 0; r < 16; ++r) acc[a][b][r] = 0.f;
  bf16x8 bq[2][4];
  const unsigned aoff = (unsigned)((wm * 64 + r32) * ARS + hi * 16);
#define SGR_LOADB1(ks, kc_) do { bq[0][ks] = *(const bf16x8*)(bf0 + (size_t)((kc_) * 4 + (ks)) * 512); bq[1][ks] = *(const bf16x8*)(bf1 + (size_t)((kc_) * 4 + (ks)) * 512); } while (0)
#pragma unroll
  for (int ks = 0; ks < 4; ++ks) SGR_LOADB1(ks, 0);
  bf16x8 afA[2], afB[2];
#define SGR_LDA(dst, st_) do { _Pragma("unroll") for (int m = 0; m < 2; ++m) dst[m] = *(const LAS bf16x8*)(lds + aoff + m * 32 * ARS + (st_) * 32); } while (0)
#define SGR_MMA(afr, st_) do { \
      _Pragma("unroll") for (int h = 0; h < 2; ++h) \
        _Pragma("unroll") for (int m = 0; m < 2; ++m) acc[h][m] = __builtin_amdgcn_mfma_f32_32x32x16_bf16(bq[h][(st_) & 3], afr[m], acc[h][m], 0, 0, 0); \
      if ((st_) < 12) SGR_LOADB1((st_) & 3, ((st_) >> 2) + 1); \
      __builtin_amdgcn_sched_barrier(0); } while (0)
  SGR_LDA(afA, 0);
#pragma unroll
  for (int st = 0; st < 16; st += 2) {
    SGR_LDA(afB, st + 1); SGR_MMA(afA, st);
    if (st + 2 < 16) SGR_LDA(afA, st + 2);
    SGR_MMA(afB, st + 1);
  }
#undef SGR_LDA
#undef SGR_MMA
#undef SGR_LOADB1
  E(acc, wm, wn, r32, hi);
}
}

constexpr size_t MiB = 1u << 20;
constexpr size_t WS_CTL = 0, CTL_ZERO_BYTES = 64 * 1024;
constexpr int CW_BAR = 1024;
constexpr size_t WS_WIN = 1 * MiB;
constexpr size_t WS_WCO = 12 * MiB;
constexpr size_t WS_WAO = 13 * MiB;
constexpr size_t WS_WO = 14 * MiB;
constexpr size_t WS_CT = 16 * MiB, WS_ST = 18 * MiB;
constexpr size_t WS_KI = 20 * MiB;
constexpr size_t WS_WI = 22 * MiB;
constexpr size_t WS_HB = 24 * MiB;
constexpr size_t WS_G = 56 * MiB;
constexpr size_t WS_QI = 72 * MiB, WS_K = 88 * MiB, WS_V = 104 * MiB, WS_Q = 120 * MiB;
constexpr size_t WS_GC = 136 * MiB, WS_GA = 168 * MiB;
constexpr size_t WS_NA = 200 * MiB, WS_AO = 216 * MiB;
constexpr size_t WS_M1 = 56 * MiB;
constexpr int CW_ATTN = 512;
constexpr size_t WS_Y1 = 88 * MiB;
constexpr size_t WS_END = 232 * MiB;

constexpr int LDS_BYTES = 147456;
constexpr int MISC_OFF = LDS_BYTES - 256;

constexpr bool AMP_ON = false;
struct Args {
  const float* in[20];
  float* out;
  unsigned char* ws;
  int ph_lo, ph_hi, li, dup;
};
enum { PH_PREP = 0, PH_INPROJ = 1, PH_CONV = 2, PH_TOPK = 3, PH_ATTN = 4, PH_MIX = 5, PH_WO = 6, PH_ROUTE = 7, PH_MOE1 = 8, PH_MOE2 = 9, PH_FINAL = 10, PH_END = 11 };

constexpr int CW_M1 = 576, CW_X1 = 640;
template <bool ACCUM> struct EpiGate {
  static constexpr bool PERM = true, AFTER_DRAIN = false, CHAIN = false;
  const us* gate; us* M1;
  __device__ __forceinline__ void operator()(const pg8::f32x4 (&acc)[2][2][4][2], const pg8::Unit& u, int wr, int wc, int fr, int fq) const {
    const int row0 = u.pm * 256 + wr * 64 + fr, col0 = u.pn * 256 + wc * 32 + 8 * fq;
#pragma unroll
    for (int ai = 0; ai < 2; ++ai)
#pragma unroll
      for (int mh = 0; mh < 2; ++mh) {
        v4u gw[2][2], pw[2][2];
#pragma unroll
        for (int mm = 0; mm < 2; ++mm)
#pragma unroll
          for (int bj = 0; bj < 2; ++bj) {
            const size_t off = (size_t)(row0 + ai * 128 + (2 * mh + mm) * 16) * 1024 + col0 + bj * 128;
            gw[mm][bj] = *(const v4u*)(gate + off);
            if (ACCUM) pw[mm][bj] = *(const v4u*)(M1 + off);
          }
        __builtin_amdgcn_sched_barrier(0);
#pragma unroll
        for (int mm = 0; mm < 2; ++mm)
#pragma unroll
          for (int bj = 0; bj < 2; ++bj) {
            const int m = 2 * mh + mm;
            const size_t off = (size_t)(row0 + ai * 128 + m * 16) * 1024 + col0 + bj * 128;
            const v4u g = gw[mm][bj];
            const f32x4 v0 = acc[ai][bj][m][0], v1 = acc[ai][bj][m][1];
            float o[8];
            o[0] = __uint_as_float(g.x << 16) * v0[0]; o[1] = __uint_as_float(g.x & 0xffff0000u) * v0[1];
            o[2] = __uint_as_float(g.y << 16) * v0[2]; o[3] = __uint_as_float(g.y & 0xffff0000u) * v0[3];
            o[4] = __uint_as_float(g.z << 16) * v1[0]; o[5] = __uint_as_float(g.z & 0xffff0000u) * v1[1];
            o[6] = __uint_as_float(g.w << 16) * v1[2]; o[7] = __uint_as_float(g.w & 0xffff0000u) * v1[3];
            if (ACCUM) {
              const v4u p = pw[mm][bj];
              o[0] += __uint_as_float(p.x << 16); o[1] += __uint_as_float(p.x & 0xffff0000u);
              o[2] += __uint_as_float(p.y << 16); o[3] += __uint_as_float(p.y & 0xffff0000u);
              o[4] += __uint_as_float(p.z << 16); o[5] += __uint_as_float(p.z & 0xffff0000u);
              o[6] += __uint_as_float(p.w << 16); o[7] += __uint_as_float(p.w & 0xffff0000u);
            }
            v4u w; w.x = pk2(o[0], o[1]); w.y = pk2(o[2], o[3]); w.z = pk2(o[4], o[5]); w.w = pk2(o[6], o[7]);
            *(v4u*)(M1 + off) = w;
          }
        __builtin_amdgcn_sched_barrier(0);
      }
  }
};
struct DualOrder : pg8::StaticOrder {
  const unsigned* ready;
  __device__ bool next(int i, pg8::Unit& u) const { if (i >= 2) return false; const bool ok = pg8::StaticOrder::next(0, u); u.sel = i; return ok; }
  __device__ __forceinline__ void a_ready(const pg8::Unit& u) const {
    if (u.sel == 0) return;
    if (threadIdx.x < 64) {
      unsigned sp = 0;
      while ((unsigned)__builtin_amdgcn_readfirstlane(__hip_atomic_load(ready + u.pm, __ATOMIC_RELAXED, __HIP_MEMORY_SCOPE_AGENT)) < 8u) { __builtin_amdgcn_s_sleep(2); if (++sp > (1u << 22)) break; }
      __builtin_amdgcn_fence(__ATOMIC_ACQUIRE, "agent");
      asm volatile("s_waitcnt vmcnt(0)" ::: "memory");
    }
    asm volatile("" ::: "memory"); __builtin_amdgcn_s_barrier(); asm volatile("" ::: "memory");
  }
};
struct EpiGate2 {
  static constexpr bool PERM = true, AFTER_DRAIN = false, CHAIN = true;
  const us *gc, *ga; us* M1;
  __device__ __forceinline__ bool chain(pg8::f32x4 (&acc)[2][2][4][2], const pg8::Unit& u, int wr, int wc, int fr, int fq) const {
    if (u.sel != 0) return false;
    const int row0 = u.pm * 256 + wr * 64 + fr, col0 = u.pn * 256 + wc * 32 + 8 * fq;
#pragma unroll
    for (int ai = 0; ai < 2; ++ai)
#pragma unroll
      for (int mh = 0; mh < 2; ++mh) {
        v4u gw[2][2], hw[2][2];
#pragma unroll
        for (int mm = 0; mm < 2; ++mm)
#pragma unroll
          for (int bj = 0; bj < 2; ++bj) {
            const size_t off = (size_t)(row0 + ai * 128 + (2 * mh + mm) * 16) * 1024 + col0 + bj * 128;
            gw[mm][bj] = *(const v4u*)(gc + off); hw[mm][bj] = *(const v4u*)(ga + off);
          }
        __builtin_amdgcn_sched_barrier(0);
#pragma unroll
        for (int mm = 0; mm < 2; ++mm)
#pragma unroll
          for (int bj = 0; bj < 2; ++bj) {
            const int m = 2 * mh + mm;
            const v4u g = gw[mm][bj], h = hw[mm][bj];
            f32x4& v0 = acc[ai][bj][m][0]; f32x4& v1 = acc[ai][bj][m][1];
            v0[0] *= __uint_as_float(g.x << 16) * __builtin_amdgcn_rcpf(__uint_as_float(h.x << 16)); v0[1] *= __uint_as_float(g.x & 0xffff0000u) * __builtin_amdgcn_rcpf(__uint_as_float(h.x & 0xffff0000u));
            v0[2] *= __uint_as_float(g.y << 16) * __builtin_amdgcn_rcpf(__uint_as_float(h.y << 16)); v0[3] *= __uint_as_float(g.y & 0xffff0000u) * __builtin_amdgcn_rcpf(__uint_as_float(h.y & 0xffff0000u));
            v1[0] *= __uint_as_float(g.z << 16) * __builtin_amdgcn_rcpf(__uint_as_float(h.z << 16)); v1[1] *= __uint_as_float(g.z & 0xffff0000u) * __builtin_amdgcn_rcpf(__uint_as_float(h.z & 0xffff0000u));
            v1[2] *= __uint_as_float(g.w << 16) * __builtin_amdgcn_rcpf(__uint_as_float(h.w << 16)); v1[3] *= __uint_as_float(g.w & 0xffff0000u) * __builtin_amdgcn_rcpf(__uint_as_float(h.w & 0xffff0000u));
          }
        __builtin_amdgcn_sched_barrier(0);
      }
    return true;
  }
  __device__ __forceinline__ void operator()(const pg8::f32x4 (&acc)[2][2][4][2], const pg8::Unit& u, int wr, int wc, int fr, int fq) const {
    EpiGate<false> E; E.gate = ga; E.M1 = M1; E(acc, u, wr, wc, fr, fq);
  }
};
struct EpiRes {
  static constexpr bool PERM = false, AFTER_DRAIN = false, CHAIN = false;
  const float* base; float* out;
  __device__ __forceinline__ void operator()(const pg8::f32x4 (&acc)[2][2][4][2], const pg8::Unit& u, int wr, int wc, int fr, int fq) const {
    const int row0 = u.pm * 256 + wr * 64 + fr, col0 = u.pn * 256 + wc * 32 + 4 * fq;
#pragma unroll
    for (int ai = 0; ai < 2; ++ai)
#pragma unroll
      for (int mh = 0; mh < 2; ++mh) {
        f32x4 b[2][2][2];
#pragma unroll
        for (int mm = 0; mm < 2; ++mm)
#pragma unroll
          for (int bj = 0; bj < 2; ++bj)
#pragma unroll
            for (int n = 0; n < 2; ++n) b[mm][bj][n] = *(const f32x4*)(base + (size_t)(row0 + ai * 128 + (2 * mh + mm) * 16) * 1024 + col0 + bj * 128 + n * 16);
        __builtin_amdgcn_sched_barrier(0);
#pragma unroll
        for (int mm = 0; mm < 2; ++mm)
#pragma unroll
          for (int bj = 0; bj < 2; ++bj)
#pragma unroll
            for (int n = 0; n < 2; ++n)
              *(f32x4*)(out + (size_t)(row0 + ai * 128 + (2 * mh + mm) * 16) * 1024 + col0 + bj * 128 + n * 16) = b[mm][bj][n] + acc[ai][bj][2 * mh + mm][n];
        __builtin_amdgcn_sched_barrier(0);
      }
  }
};

__device__ __forceinline__ void p0_transpose_item(const float* __restrict__ W, int ldw, int k0, int n_src, us* __restrict__ WT, int ldt, int dst_row0,
                                                  LAS float* scr, int lane) {
  if (n_src >= 0) {
#pragma unroll 8
    for (int i = 0; i < 32; ++i) { const int kk = 2 * i + (lane >> 5); scr[kk * 33 + (lane & 31)] = W[(size_t)(k0 + kk) * ldw + n_src + (lane & 31)]; }
  } else {
#pragma unroll 8
    for (int i = 0; i < 32; ++i) { const int kk = 2 * i + (lane >> 5); scr[kk * 33 + (lane & 31)] = 0.f; }
  }
  LDS_WAIT(); asm volatile("" ::: "memory");
  const int c = lane & 7;
#pragma unroll
  for (int j = 0; j < 4; ++j) {
    const int n = (lane >> 3) + 8 * j;
    const LAS float* s = scr + (8 * c) * 33 + n;
    v4u o;
    o.x = pk2(s[0 * 33], s[1 * 33]); o.y = pk2(s[2 * 33], s[3 * 33]); o.z = pk2(s[4 * 33], s[5 * 33]); o.w = pk2(s[6 * 33], s[7 * 33]);
    *(v4u*)(WT + (size_t)(dst_row0 + n) * ldt + k0 + 8 * c) = o;
  }
  LDS_WAIT(); asm volatile("" ::: "memory");
}
__device__ __forceinline__ void p0_transpose_item_fm(const float* __restrict__ W, int ldw, int k0, int n_src, us* __restrict__ WT, int K, int g,
                                                     LAS float* scr, int lane) {
#pragma unroll 8
  for (int i = 0; i < 32; ++i) { const int kk = 2 * i + (lane >> 5); scr[kk * 33 + (lane & 31)] = W[(size_t)(k0 + kk) * ldw + n_src + (lane & 31)]; }
  LDS_WAIT(); asm volatile("" ::: "memory");
  const int c = lane & 7;
#pragma unroll
  for (int j = 0; j < 4; ++j) {
    const int n = (lane >> 3) + 8 * j;
    const LAS float* s = scr + (8 * c) * 33 + n;
    v4u o;
    o.x = pk2(s[0 * 33], s[1 * 33]); o.y = pk2(s[2 * 33], s[3 * 33]); o.z = pk2(s[4 * 33], s[5 * 33]); o.w = pk2(s[6 * 33], s[7 * 33]);
    *(v4u*)(WT + ((((size_t)g * (K >> 4) + (k0 >> 4) + (c >> 1)) * 2 + (c & 1)) * 32 + n) * 8) = o;
  }
  LDS_WAIT(); asm volatile("" ::: "memory");
}
__device__ __forceinline__ int inproj_src(int g) {
  const int pn = g >> 3, bj = (g >> 2) & 1, wc = g & 3;
  if (pn < 4) return (bj ? 512 : 0) + pn * 128 + wc * 32;
  if (pn < 12) { const int type = (pn - 4) >> 1, head = ((pn - 4) & 1) * 4 + wc; return OFF_Q + type * 512 + head * 64 + bj * 32; }
  if (pn < 20) return (pn < 16 ? OFF_GC : OFF_GA) + ((pn - 12) & 3) * 256 + bj * 128 + wc * 32;
  if (wc == 0) return OFF_KI + bj * 32;
  if (wc == 1 && bj == 0) return OFF_WI;
  return -1;
}
__device__ __forceinline__ void rms_row_to_bf16(const float* __restrict__ xrow, const float* __restrict__ g, us* __restrict__ orow, int lane) {
  const f32x4* xr = (const f32x4*)xrow + lane;
  f32x4 v[4]; float s = 0.f;
#pragma unroll
  for (int j = 0; j < 4; ++j) { v[j] = xr[64 * j]; s += (v[j].x * v[j].x + v[j].y * v[j].y) + (v[j].z * v[j].z + v[j].w * v[j].w); }
  const float rstd = 1.0f / sqrtf(wave_sum(s) * (1.0f / D) + EPS);
#pragma unroll
  for (int j = 0; j < 4; ++j) {
    const f32x4 gg = ((const f32x4*)g)[lane + 64 * j];
    unsigned long long o = (unsigned long long)pk2(v[j].x * rstd * gg.x, v[j].y * rstd * gg.y) |
                           ((unsigned long long)pk2(v[j].z * rstd * gg.z, v[j].w * rstd * gg.w) << 32);
    ((unsigned long long*)orow)[lane + 64 * j] = o;
  }
}

__device__ __forceinline__ void rms_rows4_to_bf16(const float* __restrict__ x0, const float* __restrict__ g, us* __restrict__ o0, int lane) {
  f32x4 v[4][4];
#pragma unroll
  for (int r = 0; r < 4; ++r)
#pragma unroll
    for (int j = 0; j < 4; ++j) v[r][j] = ((const f32x4*)(x0 + (size_t)r * D))[lane + 64 * j];
  __builtin_amdgcn_sched_barrier(0);
#pragma unroll
  for (int r = 0; r < 4; ++r) {
    float s = 0.f;
#pragma unroll
    for (int j = 0; j < 4; ++j) s += (v[r][j].x * v[r][j].x + v[r][j].y * v[r][j].y) + (v[r][j].z * v[r][j].z + v[r][j].w * v[r][j].w);
    const float rstd = 1.0f / sqrtf(wave_sum_dpp(s) * (1.0f / D) + EPS);
#pragma unroll
    for (int j = 0; j < 4; ++j) {
      const f32x4 gg = ((const f32x4*)g)[lane + 64 * j];
      unsigned long long o = (unsigned long long)pk2(v[r][j].x * rstd * gg.x, v[r][j].y * rstd * gg.y) |
                             ((unsigned long long)pk2(v[r][j].z * rstd * gg.z, v[r][j].w * rstd * gg.w) << 32);
      ((unsigned long long*)(o0 + (size_t)r * D))[lane + 64 * j] = o;
    }
  }
}

constexpr int CW_DEP = 104;
constexpr unsigned DEP_TARGET = 7u * 64u * 8u;
constexpr int CW_TQ = 100;
struct InProjOrder : pg8::StaticOrder {
  unsigned* dep;
  __device__ __forceinline__ static int perm(int r) { return r == 0 ? 20 : (r < 3 ? r + 9 : (r < 13 ? r - 3 : r - 1)); }
  __device__ __forceinline__ static bool is_dep(int pn) { return pn < 4 || pn == 10 || pn == 11 || pn == 20; }
  __device__ bool next(int i, pg8::Unit& u) const { const bool ok = pg8::StaticOrder::next(i, u); u.pn = perm(u.pn); return ok; }
  __device__ __forceinline__ void done(const pg8::Unit& u) const {
    if (is_dep(u.pn)) {
      asm volatile("s_waitcnt vmcnt(0)" ::: "memory");
      if ((threadIdx.x & 63) == 0) __hip_atomic_fetch_add(dep, 1u, __ATOMIC_RELAXED, __HIP_MEMORY_SCOPE_AGENT);
    }
  }
};
__device__ __forceinline__ void st16_wt_g(void* ptr, v4u v) { asm volatile("global_store_dwordx4 %0, %1, off sc1\n\ts_nop 1" :: "v"(ptr), "v"(v) : "memory"); }

struct EpiInProj {
  static constexpr bool PERM = true, AFTER_DRAIN = false, CHAIN = false;
  us *G, *Q, *K, *V, *QI, *KI, *GC, *GA; float* WI; const float *CT, *ST;
  __device__ __forceinline__ void operator()(const pg8::f32x4 (&acc)[2][2][4][2], const pg8::Unit& u, int wr, int wc, int fr, int fq) const {
    const int pn = u.pn;
    const int row0 = u.pm * 256 + wr * 64 + fr;
    if (pn < 4) {
#pragma unroll
      for (int ai = 0; ai < 2; ++ai)
#pragma unroll
        for (int m = 0; m < 4; ++m) {
          const int row = row0 + ai * 128 + m * 16;
          const f32x4 a0 = acc[ai][0][m][0], a1 = acc[ai][0][m][1], b0 = acc[ai][1][m][0], b1 = acc[ai][1][m][1];
          v4u w;
          w.x = pk2(a0[0] * fsigmoid(b0[0]), a0[1] * fsigmoid(b0[1])); w.y = pk2(a0[2] * fsigmoid(b0[2]), a0[3] * fsigmoid(b0[3]));
          w.z = pk2(a1[0] * fsigmoid(b1[0]), a1[1] * fsigmoid(b1[1])); w.w = pk2(a1[2] * fsigmoid(b1[2]), a1[3] * fsigmoid(b1[3]));
          st16_wt_g(G + (size_t)row * 512 + pn * 128 + wc * 32 + 8 * fq, w);
        }
    } else if (pn < 12) {
      const int type = (pn - 4) >> 1, head = ((pn - 4) & 1) * 4 + wc;
      us* dst = type == 0 ? Q : (type == 1 ? K : (type == 2 ? V : QI));
      const float sc = type == 0 ? QSCALE : 1.0f;
#pragma unroll
      for (int ai = 0; ai < 2; ++ai)
#pragma unroll
        for (int m = 0; m < 4; ++m) {
          const int row = row0 + ai * 128 + m * 16;
          const f32x4 x10 = acc[ai][0][m][0], x11 = acc[ai][0][m][1], x20 = acc[ai][1][m][0], x21 = acc[ai][1][m][1];
          f32x4 o10, o11, o20, o21;
          if (type == 2) { o10 = x10; o11 = x11; o20 = x20; o21 = x21; }
          else {
            const f32x4 c0 = *(const f32x4*)(CT + (size_t)row * 32 + 8 * fq), c1 = *(const f32x4*)(CT + (size_t)row * 32 + 8 * fq + 4);
            const f32x4 s0 = *(const f32x4*)(ST + (size_t)row * 32 + 8 * fq), s1 = *(const f32x4*)(ST + (size_t)row * 32 + 8 * fq + 4);
            o10 = (x10 * c0 - x20 * s0) * sc; o11 = (x11 * c1 - x21 * s1) * sc;
            o20 = (x20 * c0 + x10 * s0) * sc; o21 = (x21 * c1 + x11 * s1) * sc;
          }
          v4u w1, w2;
          w1.x = pk2(o10[0], o10[1]); w1.y = pk2(o10[2], o10[3]); w1.z = pk2(o11[0], o11[1]); w1.w = pk2(o11[2], o11[3]);
          w2.x = pk2(o20[0], o20[1]); w2.y = pk2(o20[2], o20[3]); w2.z = pk2(o21[0], o21[1]); w2.w = pk2(o21[2], o21[3]);
          us* p = dst + (size_t)row * 512 + head * 64 + 8 * fq;
          if (type == 3) { st16_wt_g(p, w1); st16_wt_g(p + 32, w2); } else { *(v4u*)p = w1; *(v4u*)(p + 32) = w2; }
        }
    } else if (pn < 20) {
      us* dst = pn < 16 ? GC : GA;
      const int cb = ((pn - 12) & 3) * 256 + wc * 32 + 8 * fq;
#pragma unroll
      for (int ai = 0; ai < 2; ++ai)
#pragma unroll
        for (int m = 0; m < 4; ++m) {
          const int row = row0 + ai * 128 + m * 16;
#pragma unroll
          for (int bj = 0; bj < 2; ++bj) {
            const f32x4 v0 = acc[ai][bj][m][0], v1 = acc[ai][bj][m][1];
            v4u w;
            const float lo_ = pn < 16 ? 0.f : 1e-30f;
            w.x = pk2(fmaxf(fsigmoid(v0[0]), lo_), fmaxf(fsigmoid(v0[1]), lo_)); w.y = pk2(fmaxf(fsigmoid(v0[2]), lo_), fmaxf(fsigmoid(v0[3]), lo_));
            w.z = pk2(fmaxf(fsigmoid(v1[0]), lo_), fmaxf(fsigmoid(v1[1]), lo_)); w.w = pk2(fmaxf(fsigmoid(v1[2]), lo_), fmaxf(fsigmoid(v1[3]), lo_));
            *(v4u*)(dst + (size_t)row * 1024 + cb + bj * 128) = w;
          }
        }
    } else {
      if (wc == 0) {
#pragma unroll
        for (int ai = 0; ai < 2; ++ai)
#pragma unroll
          for (int m = 0; m < 4; ++m) {
            const int row = row0 + ai * 128 + m * 16;
            const f32x4 x10 = acc[ai][0][m][0], x11 = acc[ai][0][m][1], x20 = acc[ai][1][m][0], x21 = acc[ai][1][m][1];
            const f32x4 c0 = *(const f32x4*)(CT + (size_t)row * 32 + 8 * fq), c1 = *(const f32x4*)(CT + (size_t)row * 32 + 8 * fq + 4);
            const f32x4 s0 = *(const f32x4*)(ST + (size_t)row * 32 + 8 * fq), s1 = *(const f32x4*)(ST + (size_t)row * 32 + 8 * fq + 4);
            const f32x4 o10 = x10 * c0 - x20 * s0, o11 = x11 * c1 - x21 * s1, o20 = x20 * c0 + x10 * s0, o21 = x21 * c1 + x11 * s1;
            v4u w1, w2;
            w1.x = pk2(o10[0], o10[1]); w1.y = pk2(o10[2], o10[3]); w1.z = pk2(o11[0], o11[1]); w1.w = pk2(o11[2], o11[3]);
            w2.x = pk2(o20[0], o20[1]); w2.y = pk2(o20[2], o20[3]); w2.z = pk2(o21[0], o21[1]); w2.w = pk2(o21[2], o21[3]);
            us* p = KI + ((size_t)(row >> 5) * 8 * 32 + (row & 31)) * 8;
            st16_wt_g(p + (size_t)fq * 256, w1); st16_wt_g(p + (size_t)(4 + fq) * 256, w2);
          }
      } else if (wc == 1 && fq == 0) {
#pragma unroll
        for (int ai = 0; ai < 2; ++ai)
#pragma unroll
          for (int m = 0; m < 4; ++m) {
            const int row = row0 + ai * 128 + m * 16;
            const f32x4 wa_ = acc[ai][0][m][0] * IDX_SCALE, wb_ = acc[ai][0][m][1] * IDX_SCALE;
            st16_wt_g(WI + (size_t)row * 8, (v4u){__float_as_uint(wa_[0]), __float_as_uint(wa_[1]), __float_as_uint(wa_[2]), __float_as_uint(wa_[3])});
            st16_wt_g(WI + (size_t)row * 8 + 4, (v4u){__float_as_uint(wb_[0]), __float_as_uint(wb_[1]), __float_as_uint(wb_[2]), __float_as_uint(wb_[3])});
          }
      }
    }
  }
};


constexpr size_t WS_WGU = 232 * MiB;
constexpr size_t WS_WD = 248 * MiB;
constexpr size_t WS_H2 = WS_HB;
constexpr size_t WS_YS = 72 * MiB;
constexpr size_t WS_HID = 136 * MiB;
constexpr size_t WS_LIST = 160 * MiB;
constexpr size_t WS_COMB = 162 * MiB;
constexpr int CW_CNT = 64;
constexpr int LIST_CAP = 16384;

__device__ __forceinline__ void moe_offsets(const unsigned* cnt, int (&rb_start)[17], int (&row_off)[17]) {
  int a = 0, b = 0;
#pragma unroll
  for (int e = 0; e < 16; ++e) { rb_start[e] = a; row_off[e] = b; const int n = (int)__hip_atomic_load(cnt + e, RLX_AGENT); const int nb = (n + 127) >> 7; a += nb; b += nb * 128; }
  rb_start[16] = a; row_off[16] = b;
}

__device__ __forceinline__ void route_phase(LAS unsigned char* lds, unsigned char* ws, float* x1, const float* g_ffn, const float* w_rg, const float* b_rg,
                                            const float* w_re, const float* b_re, int tid, int lane, int wave, int mode) {
  LAS float* Wr = (LAS float*)lds;
  LAS int* cnt_l = (LAS int*)(lds + 81920);
  LAS int* base_l = cnt_l + 16;
  LAS int* tok_e = base_l + 16;
  LAS int* tok_p = tok_e + 128;
  unsigned* cnt = (unsigned*)(ws + WS_CTL) + CW_CNT;
  int* LIST = (int*)(ws + WS_LIST);
  float* COMB = (float*)(ws + WS_COMB);
  us* H2 = (us*)(ws + WS_H2);
  for (int i = tid; i < 1024 * 4; i += 512) { const int d = i >> 2, o = i & 3; Wr[o * 1024 + d] = w_rg[i]; }
  for (int i = tid; i < 1024 * 16; i += 512) { const int d = i >> 4, o = i & 15; Wr[(4 + o) * 1024 + d] = w_re[i]; }
  if (tid < 16) cnt_l[tid] = 0;
  __syncthreads();
  LAS float* lgs = (LAS float*)(tok_p + 128);
  if (mode & 2) return;
  const int t0 = blockIdx.x * 64 + wave * 8;
#pragma unroll 1
  for (int tb = 0; tb < 4; ++tb) {
    f32x4 v[2][4];
#pragma unroll
    for (int tk = 0; tk < 2; ++tk) {
      const f32x4* xr = (const f32x4*)(x1 + (size_t)(t0 + tb * 2 + tk) * D) + lane;
#pragma unroll
      for (int j = 0; j < 4; ++j) v[tk][j] = xr[64 * j];
    }
#pragma unroll
    for (int tk = 0; tk < 2; ++tk) {
      float s = 0.f;
#pragma unroll
      for (int j = 0; j < 4; ++j) s += (v[tk][j].x * v[tk][j].x + v[tk][j].y * v[tk][j].y) + (v[tk][j].z * v[tk][j].z + v[tk][j].w * v[tk][j].w);
      const float rstd = 1.0f / sqrtf(wave_sum_dpp(s) * (1.0f / D) + EPS);
#pragma unroll
      for (int j = 0; j < 4; ++j) {
        const f32x4 gg = ((const f32x4*)g_ffn)[lane + 64 * j];
        v[tk][j] = v[tk][j] * rstd * gg;
        unsigned long long o = (unsigned long long)pk2(v[tk][j].x, v[tk][j].y) | ((unsigned long long)pk2(v[tk][j].z, v[tk][j].w) << 32);
        ((unsigned long long*)(H2 + (size_t)(t0 + tb * 2 + tk) * D))[lane + 64 * j] = o;
      }
    }
    typedef float f32x2r __attribute__((ext_vector_type(2)));
    float gl[2][4];
#pragma unroll
    for (int o = 0; o < 4; ++o) {
      f32x2r p0 = {0.f, 0.f}, p1 = {0.f, 0.f};
#pragma unroll
      for (int j = 0; j < 4; ++j) {
        const f32x4 w = *(const LAS f32x4*)(Wr + o * 1024 + 4 * lane + 256 * j);
        const f32x2r wl = {w.x, w.y}, wh = {w.z, w.w};
        p0 = __builtin_elementwise_fma((f32x2r){v[0][j].x, v[0][j].y}, wl, p0); p0 = __builtin_elementwise_fma((f32x2r){v[0][j].z, v[0][j].w}, wh, p0);
        p1 = __builtin_elementwise_fma((f32x2r){v[1][j].x, v[1][j].y}, wl, p1); p1 = __builtin_elementwise_fma((f32x2r){v[1][j].z, v[1][j].w}, wh, p1);
      }
      gl[0][o] = wave_sum_dpp(p0.x + p0.y) + b_rg[o]; gl[1][o] = wave_sum_dpp(p1.x + p1.y) + b_rg[o];
    }
#pragma unroll
    for (int tk = 0; tk < 2; ++tk) {
      const int t = t0 + tb * 2 + tk;
      const float g0 = gl[tk][0], g1 = gl[tk][1], g2 = gl[tk][2], g3 = gl[tk][3];
      int gi = 0; float gm = g0;
      if (g1 > gm) { gm = g1; gi = 1; }
      if (g2 > gm) { gm = g2; gi = 2; }
      if (g3 > gm) { gm = g3; gi = 3; }
      gi = __builtin_amdgcn_readfirstlane(gi);
      const float pg = 1.0f / (expf(g0 - gm) + expf(g1 - gm) + expf(g2 - gm) + expf(g3 - gm));
      float el[4];
#pragma unroll
      for (int oe = 0; oe < 4; ++oe) {
        f32x2r p = {0.f, 0.f};
#pragma unroll
        for (int j = 0; j < 4; ++j) {
          const f32x4 w = *(const LAS f32x4*)(Wr + (4 + gi * 4 + oe) * 1024 + 4 * lane + 256 * j);
          p = __builtin_elementwise_fma((f32x2r){v[tk][j].x, v[tk][j].y}, (f32x2r){w.x, w.y}, p); p = __builtin_elementwise_fma((f32x2r){v[tk][j].z, v[tk][j].w}, (f32x2r){w.z, w.w}, p);
        }
        el[oe] = wave_sum_dpp(p.x + p.y) + b_re[gi * 4 + oe];
      }
      const float e0 = el[0], e1 = el[1], e2 = el[2], e3 = el[3];
      int i0 = 0; float m0 = e0;
      if (e1 > m0) { m0 = e1; i0 = 1; }
      if (e2 > m0) { m0 = e2; i0 = 2; }
      if (e3 > m0) { m0 = e3; i0 = 3; }
      int i1 = -1; float m1 = -INFINITY;
      if (i0 != 0 && e0 > m1) { m1 = e0; i1 = 0; }
      if (i0 != 1 && e1 > m1) { m1 = e1; i1 = 1; }
      if (i0 != 2 && e2 > m1) { m1 = e2; i1 = 2; }
      if (i0 != 3 && e3 > m1) { m1 = e3; i1 = 3; }
      const float r = expf(m1 - m0);
      const float c0 = pg / (1.0f + r), c1 = pg * r / (1.0f + r);
      if (lane == 0) {
        const int ea = gi * 4 + i0, eb = gi * 4 + i1;
        const int li = wave * 8 + tb * 2 + tk;
        tok_e[li * 2] = ea; tok_e[li * 2 + 1] = eb;
        tok_p[li * 2] = atomicAdd((int*)(cnt_l + ea), 1);
        tok_p[li * 2 + 1] = atomicAdd((int*)(cnt_l + eb), 1);
        COMB[t * 2] = c0; COMB[t * 2 + 1] = c1;
      }
      asm volatile("" ::: "memory");
    }
  }
  __syncthreads();
  if (mode & 1) return;
  if (tid < 16) base_l[tid] = (int)__hip_atomic_fetch_add(cnt + tid, (unsigned)cnt_l[tid], RLX_AGENT);
  __syncthreads();
  if (tid < 128) {
    const int e = tok_e[tid], p = base_l[e] + tok_p[tid];
    LIST[e * LIST_CAP + p] = (blockIdx.x * 64 + (tid >> 1)) * 2 + (tid & 1);
  }
}

constexpr int SG_EPI_STAGE = 9216;
__device__ __forceinline__ void st16_wt(us* p, v4u v) { asm volatile("global_store_dwordx4 %0, %1, off sc1\n\ts_nop 1" :: "v"(p), "v"(v) : "memory"); }
struct EpiMoe1 {
  us* HID; int hid_row0, nvalid; LAS unsigned char* stage;
  __device__ __forceinline__ void operator()(const sg::f32x16 (&acc)[2][4], int wave, int r32, int hi) const {
    const int lane = r32 + 32 * hi;
    LAS unsigned char* st = stage + wave * SG_EPI_STAGE;
#pragma unroll
    for (int m = 0; m < 4; ++m)
#pragma unroll
      for (int q = 0; q < 4; ++q) {
        float h[4];
#pragma unroll
        for (int i = 0; i < 4; ++i) { const float g = acc[0][m][4 * q + i], u = acc[1][m][4 * q + i]; h[i] = g * fsigmoid(g) * u; }
        *(LAS unsigned long long*)(st + (m * 32 + r32) * 72 + (8 * q + 4 * hi) * 2) = (unsigned long long)pk2(h[0], h[1]) | ((unsigned long long)pk2(h[2], h[3]) << 32);
      }
    LDS_WAIT();
#pragma unroll
    for (int i = 0; i < 8; ++i) {
      const int rr = i * 16 + (lane >> 2), c = lane & 3;
      const unsigned long long lo = *(const LAS unsigned long long*)(st + rr * 72 + c * 16), hi2 = *(const LAS unsigned long long*)(st + rr * 72 + c * 16 + 8);
      const v4u v = (v4u){(unsigned)lo, (unsigned)(lo >> 32), (unsigned)hi2, (unsigned)(hi2 >> 32)};
      if (rr < nvalid) st16_wt(HID + (size_t)(hid_row0 + rr) * 256 + wave * 32 + c * 8, v);
      asm volatile("" ::: "memory");
    }
    LDS_WAIT();
  }
};
struct EpiMoe2 {
  us* YS; const LAS int* slots; int ct, nvalid; LAS unsigned char* stage;
  __device__ __forceinline__ void operator()(const sg::f32x16 (&acc)[2][2], int wm, int wn, int r32, int hi) const {
    const int lane = r32 + 32 * hi;
    LAS unsigned char* st = stage + (wm * 4 + wn) * SG_EPI_STAGE;
#pragma unroll
    for (int m = 0; m < 2; ++m) {
#pragma unroll
      for (int h = 0; h < 2; ++h)
#pragma unroll
        for (int q = 0; q < 4; ++q)
          *(LAS unsigned long long*)(st + r32 * 144 + (h * 32 + 8 * q + 4 * hi) * 2) =
              (unsigned long long)pk2(acc[h][m][4 * q], acc[h][m][4 * q + 1]) | ((unsigned long long)pk2(acc[h][m][4 * q + 2], acc[h][m][4 * q + 3]) << 32);
      LDS_WAIT();
#pragma unroll
      for (int i = 0; i < 4; ++i) {
        const int rr = i * 8 + (lane >> 3), c = lane & 7, grow = wm * 64 + m * 32 + rr;
        const v4u v = *(const LAS v4u*)(st + rr * 144 + c * 16);
        if (grow < nvalid) { const int slot = slots[grow]; *(v4u*)(YS + (size_t)slot * 1024 + ct * 256 + (c >> 2) * 128 + wn * 32 + (c & 3) * 8) = v; }
        asm volatile("" ::: "memory");
      }
      LDS_WAIT();
    }
  }
};

constexpr int CW_Q = 96;
constexpr int CW_READY = 128;
constexpr int MOE_SLOTS = LDS_BYTES - 1024;
constexpr int MOE_TAB = LDS_BYTES - 512;
constexpr int MOE_STG1 = 40960, MOE_STG2 = 67584;
template <int PART> __device__ __forceinline__ void moe_phase(LAS unsigned char* lds, unsigned char* ws, volatile LAS unsigned* MISC, int tid0, int mode) {
  int tid = tid0;
  unsigned* ctl = (unsigned*)(ws + WS_CTL);
  const unsigned* cnt = ctl + CW_CNT;
  LAS int* tab = (LAS int*)(lds + MOE_TAB);
  if (tid == 0) {
    int a = 0, b = 0;
    for (int e = 0; e < 16; ++e) { tab[e] = a; tab[17 + e] = b; const int n = (int)__hip_atomic_load(cnt + e, RLX_AGENT); tab[34 + e] = n; const int nb = (n + 127) >> 7; a += nb; b += nb * 128; }
    tab[16] = a; tab[33] = b;
  }
  __syncthreads();
  const int nrb = __builtin_amdgcn_readfirstlane(tab[16]);
  const int* LIST = (const int*)(ws + WS_LIST);
  const us* H2 = (const us*)(ws + WS_H2);
  const us* WguT = (const us*)(ws + WS_WGU);
  const us* WdT = (const us*)(ws + WS_WD);
  us* HID = (us*)(ws + WS_HID);
  const int wave_ = __builtin_amdgcn_readfirstlane(tid0 >> 6);
  unsigned long long tp_acc = 0ull, tp_0 = 0ull; const int tprobe = AMP_ON ? mode >> 8 : 0;
  if (tprobe == 3) tp_0 = __builtin_amdgcn_s_memrealtime();
  for (;;) {
    if (wave_ == 0) {   const int lane_ = tid0 & 63;
      unsigned v_ = 0u;
      if (lane_ == 0) v_ = __hip_atomic_fetch_add(ctl + CW_Q + (PART == 2 ? 1 : 0), 1u, RLX_AGENT) + (PART == 2 ? (unsigned)nrb : 0u);
      MISC[16] = (unsigned)__builtin_amdgcn_readfirstlane((int)v_);
    }
    __syncthreads();
    asm volatile("" : "+v"(tid));
    const int lane_ = tid & 63, wn_ = (tid >> 6) & 3;
    const int q = __builtin_amdgcn_readfirstlane((int)MISC[16]);
    if (q >= (PART == 1 ? 1 : 3) * nrb) break;
    const bool down = q >= nrb;
    if (tprobe == (down ? 2 : 1)) tp_0 = __builtin_amdgcn_s_memrealtime();
    const int rb = down ? (q - nrb) >> 1 : q;
    int e = 0;
#pragma unroll
    for (int k = 1; k < 16; ++k) if (rb >= tab[k]) e = k;
    const int n_e = tab[34 + e], row0 = tab[17 + e];
    const int r0 = (rb - tab[e]) * 128, nvalid = min(128, n_e - r0);
    if (!down) {
      const us* ap[2];
#pragma unroll
      for (int i = 0; i < 2; ++i) { const int c = tid + 512 * i; int r = c >> 3; if (r >= nvalid) r = 0; const int tok = LIST[e * LIST_CAP + r0 + r] >> 1; ap[i] = H2 + (size_t)tok * D + (c & 7) * 8; }
      const us* bf0 = WguT + ((size_t)(e * 16 + (wave_ >> 2) * 8 + (wave_ & 3)) * 64 * 2 + (lane_ >> 5)) * 256 + (lane_ & 31) * 8;
      const us* bf1 = bf0 + (size_t)4 * 64 * 512;
      EpiMoe1 E; E.HID = HID; E.hid_row0 = row0 + r0; E.nvalid = nvalid; E.stage = lds + MOE_STG1;
      sg::tile_wide(lds, ap, bf0, bf1, 1024, E, tid);
      asm volatile("s_waitcnt vmcnt(0)" ::: "memory");
      __syncthreads();
      if (wave_ == 1) { if (lane_ == 0) __hip_atomic_fetch_add(ctl + CW_READY + rb, 1u, RLX_AGENT); }
    } else {
      if (PART == 0 && wave_ == 2) { if (lane_ == 0) {
        unsigned sp = 0;
        while (__hip_atomic_load(ctl + CW_READY + rb, RLX_AGENT) < 1u) { __builtin_amdgcn_s_sleep(2); if (++sp > (1u << 22)) break; }
        __builtin_amdgcn_fence(__ATOMIC_ACQUIRE, "agent");
        asm volatile("s_waitcnt vmcnt(0)" ::: "memory");
      } }
      __syncthreads();
      if (tid < 128) ((LAS int*)(lds + MOE_SLOTS))[tid] = LIST[e * LIST_CAP + r0 + (tid < nvalid ? tid : 0)];
      {
        const us* hrow = HID + (size_t)(row0 + r0) * 256;
#pragma unroll
        for (int i = 0; i < 8; ++i) { const int c = tid + 512 * i; const int r = c >> 5, ch = c & 31;
          const v4u v = *(const v4u*)(hrow + (size_t)r * 256 + ch * 8);
          *(LAS v4u*)(lds + r * sg::ARS + ch * 16) = v; }
      }
      __syncthreads();
#pragma unroll 1
      for (int ct = 2 * ((q - nrb) & 1); ct < 2 * ((q - nrb) & 1) + 2; ++ct) {
        const us* bf0 = WdT + ((size_t)(e * 32 + ct * 8 + wn_) * 16 * 2 + (lane_ >> 5)) * 256 + (lane_ & 31) * 8;
        const us* bf1 = bf0 + (size_t)4 * 16 * 512;
        EpiMoe2 E; E.YS = (us*)(ws + WS_YS); E.slots = (const LAS int*)(lds + MOE_SLOTS); E.ct = ct; E.nvalid = nvalid; E.stage = lds + MOE_STG2;
        sg::tile_resident(lds, bf0, bf1, E, tid);
      }
      __syncthreads();
    }
    if (tprobe == (down ? 2 : 1)) tp_acc += __builtin_amdgcn_s_memrealtime() - tp_0;
  }
  if (tprobe == 3) tp_acc = __builtin_amdgcn_s_memrealtime() - tp_0;
  if (tprobe && blockIdx.x == 0) { const unsigned long long t1 = __builtin_amdgcn_s_memrealtime(); while (__builtin_amdgcn_s_memrealtime() - t1 < 9ull * tp_acc) __builtin_amdgcn_s_sleep(8); }
}
__device__ __forceinline__ void final_phase(unsigned char* ws, float* x1, const float* g_final, int lane, int wave, int mode) {
  const us* YS = (const us*)(ws + WS_YS);
  const float* COMB = (const float*)(ws + WS_COMB);
  for (int t = blockIdx.x * 8 + wave; t < T; t += gridDim.x * 8) {
    f32x4* xr = (f32x4*)(x1 + (size_t)t * D) + lane;
    const float c0 = COMB[t * 2], c1 = COMB[t * 2 + 1];
    const unsigned long long* y0 = (const unsigned long long*)(YS + (size_t)(2 * t) * D) + lane;
    const unsigned long long* y1 = (const unsigned long long*)(YS + (size_t)(2 * t + 1) * D) + lane;
    f32x4 v[4]; float s = 0.f;
#pragma unroll
    for (int j = 0; j < 4; ++j) {
      v[j] = xr[64 * j];
      const unsigned long long a = y0[64 * j], b = y1[64 * j];
      v[j].x += c0 * __uint_as_float((unsigned)a << 16) + c1 * __uint_as_float((unsigned)b << 16);
      v[j].y += c0 * __uint_as_float((unsigned)a & 0xffff0000u) + c1 * __uint_as_float((unsigned)b & 0xffff0000u);
      v[j].z += c0 * __uint_as_float((unsigned)(a >> 32) << 16) + c1 * __uint_as_float((unsigned)(b >> 32) << 16);
      v[j].w += c0 * __uint_as_float((unsigned)(a >> 32) & 0xffff0000u) + c1 * __uint_as_float((unsigned)(b >> 32) & 0xffff0000u);
      s += (v[j].x * v[j].x + v[j].y * v[j].y) + (v[j].z * v[j].z + v[j].w * v[j].w);
    }
    const float rstd = 1.0f / sqrtf(wave_sum(s) * (1.0f / D) + EPS);
    f32x4* orow = (mode & 1) ? (f32x4*)((float*)(ws + WS_G) + (size_t)(t & 4095) * D) + lane : xr;
#pragma unroll
    for (int j = 0; j < 4; ++j) { const f32x4 gg = ((const f32x4*)g_final)[lane + 64 * j]; orow[64 * j] = v[j] * rstd * gg; }
  }
}

__device__ __forceinline__ void conv_phase(LAS unsigned char* lds, unsigned char* ws, const float* __restrict__ w_dw, const float* __restrict__ b_dw,
                                           const float* __restrict__ ln_g, const float* __restrict__ ln_b, int tid, int lane, int wave,
                                           volatile LAS unsigned* MISC, unsigned* qhead) {
  const us* G = (const us*)(ws + WS_G);
  us* NA = (us*)(ws + WS_NA);
  LAS us* gl = (LAS us*)lds;
  LAS float* ctile = (LAS float*)(lds + 63488);
  float w[31];
#pragma unroll
  for (int j = 0; j < 31; ++j) w[j] = w_dw[j * 512 + tid];
  const float bias = b_dw[tid];
  const int wave_u = __builtin_amdgcn_readfirstlane(wave);
  for (;;) {
    if (wave_u == 0) {
      unsigned v_ = 0u;
      if (lane == 0) v_ = __hip_atomic_fetch_add(qhead, 1u, __ATOMIC_RELAXED, __HIP_MEMORY_SCOPE_AGENT);
      MISC[21] = (unsigned)__builtin_amdgcn_readfirstlane((int)v_);
    }
    __syncthreads();
    const int tile = __builtin_amdgcn_readfirstlane((int)MISC[21]);
    if (tile >= T / 32) break;
    const int t0 = tile * 32, tt0 = t0 & (S - 1);
    for (int c = tid; c < 62 * 64; c += 512) {
      const int r = c >> 6, ch = c & 63;
      v4u v = (v4u){0u, 0u, 0u, 0u};
      if (tt0 - 30 + r >= 0) v = *(const v4u*)(G + (size_t)(t0 - 30 + r) * 512 + ch * 8);
      *(LAS v4u*)(gl + r * 512 + ch * 8) = v;
    }
    __syncthreads();
#pragma unroll 1
    for (int p = 0; p < 4; ++p) {
      float acc[8];
#pragma unroll
      for (int o = 0; o < 8; ++o) acc[o] = bias;
#pragma unroll
      for (int rr = 0; rr < 38; ++rr) {
        const float gv = __uint_as_float(((unsigned)gl[(p * 8 + rr) * 512 + tid]) << 16);
#pragma unroll
        for (int o = 0; o < 8; ++o) { const int j = rr - o; if (j >= 0 && j < 31) acc[o] += w[j] * gv; }
      }
#pragma unroll
      for (int o = 0; o < 8; ++o) ctile[(p * 8 + o) * 512 + tid] = acc[o];
    }
    __syncthreads();
#pragma unroll
    for (int q = 0; q < 4; ++q) {
      const int tok = wave * 4 + q;
      const f32x4 a = *(const LAS f32x4*)(ctile + tok * 512 + 4 * lane), b = *(const LAS f32x4*)(ctile + tok * 512 + 256 + 4 * lane);
      const float mu = wave_sum((a.x + a.y) + (a.z + a.w) + (b.x + b.y) + (b.z + b.w)) * (1.0f / 512);
      const f32x4 da = a - mu, db = b - mu;
      const float var = wave_sum((da.x * da.x + da.y * da.y) + (da.z * da.z + da.w * da.w) + (db.x * db.x + db.y * db.y) + (db.z * db.z + db.w * db.w)) * (1.0f / 512);
      const float rs = 1.0f / sqrtf(var + EPS);
      const f32x4 ga = *(const f32x4*)(ln_g + 4 * lane), gb = *(const f32x4*)(ln_g + 256 + 4 * lane);
      const f32x4 ba = *(const f32x4*)(ln_b + 4 * lane), bb = *(const f32x4*)(ln_b + 256 + 4 * lane);
      f32x4 na = da * rs * ga + ba, nb = db * rs * gb + bb;
      na.x *= fsigmoid(na.x); na.y *= fsigmoid(na.y); na.z *= fsigmoid(na.z); na.w *= fsigmoid(na.w);
      nb.x *= fsigmoid(nb.x); nb.y *= fsigmoid(nb.y); nb.z *= fsigmoid(nb.z); nb.w *= fsigmoid(nb.w);
      us* dst = NA + (size_t)(t0 + tok) * 512;
      *(unsigned long long*)(dst + 4 * lane) = (unsigned long long)pk2(na.x, na.y) | ((unsigned long long)pk2(na.z, na.w) << 32);
      *(unsigned long long*)(dst + 256 + 4 * lane) = (unsigned long long)pk2(nb.x, nb.y) | ((unsigned long long)pk2(nb.z, nb.w) << 32);
    }
  }
}

constexpr size_t WS_MW = WS_HB;
__device__ __forceinline__ unsigned pk_sub_sat_u16(unsigned a, unsigned b) { unsigned r; asm("v_pk_sub_u16 %0, %1, %2 clamp" : "=v"(r) : "v"(a), "v"(b)); return r; }
__device__ __forceinline__ unsigned pk_min_u16(unsigned a, unsigned b) { unsigned r; asm("v_pk_min_u16 %0, %1, %2" : "=v"(r) : "v"(a), "v"(b)); return r; }
__device__ __forceinline__ unsigned pk_add_u16(unsigned a, unsigned b) { unsigned r; asm("v_pk_add_u16 %0, %1, %2" : "=v"(r) : "v"(a), "v"(b)); return r; }
__device__ __forceinline__ int wave_isum(int v) {
#pragma unroll
  for (int o = 1; o < 64; o <<= 1) v += __shfl_xor(v, o);
  return v;
}
__device__ __forceinline__ unsigned f16key(float sc) {
  sc += 0.0f;
  const _Float16 h = (_Float16)sc;
  const unsigned b = (unsigned)__builtin_bit_cast(unsigned short, h);
  const unsigned m = (unsigned)((int)(b << 16) >> 31);
  return (b ^ (m | 0x8000u)) & 0xFFFFu;
}
__device__ __forceinline__ int wave_isum_dpp(int v) {
  v += __builtin_amdgcn_update_dpp(0, v, 0xB1, 0xF, 0xF, true);
  v += __builtin_amdgcn_update_dpp(0, v, 0x4E, 0xF, 0xF, true);
  v += __builtin_amdgcn_update_dpp(0, v, 0x141, 0xF, 0xF, true);
  v += __builtin_amdgcn_update_dpp(0, v, 0x140, 0xF, 0xF, true);
  v += __builtin_amdgcn_update_dpp(0, v, 0x142, 0xA, 0xF, true);
  v += __builtin_amdgcn_update_dpp(0, v, 0x143, 0xC, 0xF, true);
  return __builtin_amdgcn_readlane(v, 63);
}
__device__ __forceinline__ void tk_count4(unsigned& acc, const v4u k, unsigned cm1p, unsigned one2) {
  unsigned t0, t1, t2, t3;
  asm("v_pk_sub_u16 %1, %5, %9 clamp\n\tv_pk_sub_u16 %2, %6, %9 clamp\n\tv_pk_sub_u16 %3, %7, %9 clamp\n\tv_pk_sub_u16 %4, %8, %9 clamp\n\t"
      "v_pk_min_u16 %1, %1, %10\n\tv_pk_min_u16 %2, %2, %10\n\tv_pk_min_u16 %3, %3, %10\n\tv_pk_min_u16 %4, %4, %10\n\t"
      "v_pk_add_u16 %1, %1, %2\n\tv_pk_add_u16 %3, %3, %4\n\tv_pk_add_u16 %0, %0, %1\n\tv_pk_add_u16 %0, %0, %3"
      : "+v"(acc), "=&v"(t0), "=&v"(t1), "=&v"(t2), "=&v"(t3)
      : "v"(k.x), "v"(k.y), "v"(k.z), "v"(k.w), "v"(cm1p), "v"(one2));
}
template <int NQ> __device__ __forceinline__ int tk_count(const v4u (&kq)[NQ], unsigned cm1p, unsigned one2) {
  unsigned a0 = 0u, a1 = 0u;
#pragma unroll
  for (int q = 0; q < NQ; ++q) { if (q & 1) tk_count4(a1, kq[q], cm1p, one2); else tk_count4(a0, kq[q], cm1p, one2); }
  const unsigned a = a0 + a1;
  return wave_isum_dpp((int)((a & 0xffffu) + (a >> 16)));
}
template <int NQ> __device__ __forceinline__ void tk_select(const LAS us* KEYS, const LAS unsigned* HIST, unsigned char* MWB, int T0, int N_unit, int nkw, int wave, int lane) {
  const unsigned one2 = 0x00010001u;
#pragma unroll 1
  for (int jj = 0; jj < 2; ++jj) {
    const int j = 2 * wave + jj;
    v4u kq[NQ];
#pragma unroll
    for (int q = 0; q < NQ; ++q) {
      const int ci = lane + 64 * q;
      kq[q] = (v4u){0u, 0u, 0u, 0u};
      if (ci * 8 < N_unit) kq[q] = *(const LAS v4u*)(KEYS + j * 4096 + ci * 8);
    }
    unsigned prefix = 0u; int cge = 0, bit0 = 15;
    {
      const unsigned h01 = HIST[j * 128 + 2 * lane], h23 = HIST[j * 128 + 2 * lane + 1];
      const int c0 = (int)(h01 & 0xffffu), c1 = (int)(h01 >> 16), c2 = (int)(h23 & 0xffffu), c3 = (int)(h23 >> 16);
      const int t4 = (c0 + c1) + (c2 + c3);
      int p = t4;
      p += __builtin_amdgcn_update_dpp(0, p, 0x111, 0xF, 0xF, true);
      p += __builtin_amdgcn_update_dpp(0, p, 0x112, 0xF, 0xF, true);
      p += __builtin_amdgcn_update_dpp(0, p, 0x114, 0xF, 0xF, true);
      p += __builtin_amdgcn_update_dpp(0, p, 0x118, 0xF, 0xF, true);
      p += __builtin_amdgcn_update_dpp(0, p, 0x142, 0xA, 0xF, true);
      p += __builtin_amdgcn_update_dpp(0, p, 0x143, 0xC, 0xF, true);
      const int total = __builtin_amdgcn_readlane(p, 63);
      const int suf = total - p + t4;
      const unsigned long long okm = __ballot(suf >= TOPK);
      if (okm != 0ull) {
        const int ls = 63 - __builtin_clzll(okm);
        const int above = __builtin_amdgcn_readlane(suf - t4, ls);
        const int d3 = __builtin_amdgcn_readlane(c3, ls), d2 = __builtin_amdgcn_readlane(c2, ls), d1 = __builtin_amdgcn_readlane(c1, ls), d0 = __builtin_amdgcn_readlane(c0, ls);
        int bsel, cnt_ge;
        if (above + d3 >= TOPK) { bsel = 3; cnt_ge = above + d3; }
        else if (above + d3 + d2 >= TOPK) { bsel = 2; cnt_ge = above + d3 + d2; }
        else if (above + d3 + d2 + d1 >= TOPK) { bsel = 1; cnt_ge = above + d3 + d2 + d1; }
        else { bsel = 0; cnt_ge = above + d3 + d2 + d1 + d0; }
        prefix = (unsigned)(4 * ls + bsel) << 8; cge = cnt_ge; bit0 = 7;
      }
    }
#pragma unroll 1
    for (int bit = bit0; bit >= 0; --bit) {
      const unsigned cand = prefix | (1u << bit), cm1 = cand - 1u, cp = cm1 | (cm1 << 16);
      const int cnt = tk_count<NQ>(kq, cp, one2);
      if (cnt >= TOPK) { prefix = cand; cge = cnt; }
    }
    const unsigned tau = prefix, tp = tau | (tau << 16);
    unsigned char* mrow = MWB + (size_t)(T0 + j) * 512;
#define TK_STORE(q_, f0, f1, f2, f3) do { const unsigned by_ = ((f0) & 1u) | (((f0) >> 16) << 1) | (((f1) & 1u) << 2) | (((f1) >> 16) << 3) | (((f2) & 1u) << 4) | (((f2) >> 16) << 5) | \
        (((f3) & 1u) << 6) | (((f3) >> 16) << 7); const int ci_ = lane + 64 * (q_); if (ci_ * 8 < nkw) mrow[ci_] = (unsigned char)by_; } while (0)
    if (tau == 0u) {
#pragma unroll
      for (int q = 0; q < NQ; ++q) {
        TK_STORE(q, pk_min_u16(kq[q].x, one2), pk_min_u16(kq[q].y, one2), pk_min_u16(kq[q].z, one2), pk_min_u16(kq[q].w, one2)); }
    } else if (cge == TOPK) {
      const unsigned cm1 = tau - 1u, cp = cm1 | (cm1 << 16);
#pragma unroll
      for (int q = 0; q < NQ; ++q) {
        TK_STORE(q, pk_min_u16(pk_sub_sat_u16(kq[q].x, cp), one2), pk_min_u16(pk_sub_sat_u16(kq[q].y, cp), one2),
                 pk_min_u16(pk_sub_sat_u16(kq[q].z, cp), one2), pk_min_u16(pk_sub_sat_u16(kq[q].w, cp), one2)); }
    } else {
      const int cgt = tk_count<NQ>(kq, tp, one2);
      const int need = TOPK - cgt;
      int base = 0;
#pragma unroll
      for (int q = 0; q < NQ; ++q) {
        unsigned gt[4], eq[4];
        gt[0] = pk_min_u16(pk_sub_sat_u16(kq[q].x, tp), one2); gt[1] = pk_min_u16(pk_sub_sat_u16(kq[q].y, tp), one2);
        gt[2] = pk_min_u16(pk_sub_sat_u16(kq[q].z, tp), one2); gt[3] = pk_min_u16(pk_sub_sat_u16(kq[q].w, tp), one2);
        eq[0] = pk_min_u16(kq[q].x ^ tp, one2) ^ one2; eq[1] = pk_min_u16(kq[q].y ^ tp, one2) ^ one2;
        eq[2] = pk_min_u16(kq[q].z ^ tp, one2) ^ one2; eq[3] = pk_min_u16(kq[q].w ^ tp, one2) ^ one2;
        const unsigned es = (eq[0] + eq[1]) + (eq[2] + eq[3]);
        const int ecnt = (int)((es & 0xffffu) + (es >> 16));
        if (__ballot(ecnt != 0) != 0ull) {
          int pre = 0, tot = 0;
#pragma unroll
          for (int bb = 0; bb < 4; ++bb) {
            const unsigned long long bal = __ballot((ecnt >> bb) & 1);
            pre += (int)__builtin_amdgcn_mbcnt_hi((unsigned)(bal >> 32), __builtin_amdgcn_mbcnt_lo((unsigned)bal, 0u)) << bb;
            tot += __popcll(bal) << bb;
          }
          int rk = base + pre;
#pragma unroll
          for (int d = 0; d < 4; ++d) {
            const unsigned e_lo = eq[d] & 1u, e_hi = eq[d] >> 16;
            const unsigned s_lo = (e_lo && rk < need) ? 1u : 0u; rk += (int)e_lo;
            const unsigned s_hi = (e_hi && rk < need) ? 1u : 0u; rk += (int)e_hi;
            gt[d] |= s_lo | (s_hi << 16);
          }
          base += tot;
        }
        TK_STORE(q, gt[0], gt[1], gt[2], gt[3]);
      }
    }
#undef TK_STORE
  }
}

__device__ __forceinline__ void topk_phase(LAS unsigned char* lds, unsigned char* ws, int tid0, int mode, unsigned long long& amp_acc,
                                           volatile LAS unsigned* MISC, int mword, unsigned* qhead, int nunits, int blk_hi) {
  const int ampk = AMP_ON ? (mode >> 16) & 15 : 0;
  typedef float f32x16 __attribute__((ext_vector_type(16)));
  const us* QI = (const us*)(ws + WS_QI);
  const us* KI = (const us*)(ws + WS_KI);
  const float* WI = (const float*)(ws + WS_WI);
  unsigned char* MWB = (unsigned char*)(ws + WS_MW);
  LAS us* KEYS = (LAS us*)lds;
  LAS unsigned* HIST = (LAS unsigned*)(lds + 131072);
  const int wave_u = __builtin_amdgcn_readfirstlane(tid0 >> 6);
  int tid = tid0;
  for (;;) {
    if (wave_u == 0) {
      unsigned v_ = 0u;
      if ((tid0 & 63) == 0) v_ = __hip_atomic_fetch_add(qhead, 1u, __ATOMIC_RELAXED, __HIP_MEMORY_SCOPE_AGENT);
      MISC[mword] = (unsigned)__builtin_amdgcn_readfirstlane((int)v_);
    }
    __syncthreads();
    const int u = __builtin_amdgcn_readfirstlane((int)MISC[mword]);
    if (u >= nunits) break;
    asm volatile("" : "+v"(tid));
    const int lane = tid & 63, wave = tid >> 6;
    const int r = lane & 31, hh = lane >> 5;
    const int a_tok = ((r >> 3) >> 1) + 2 * ((r >> 2) & 1), a_head = (r & 3) + 4 * ((r >> 3) & 1);
    const int rp = wave & 1, kg = wave >> 1;
    const int b = u & 3, blk = blk_hi - (u >> 2);
    const int tt0 = blk * 16, T0 = b * S + tt0, tmax = tt0 + 15, nkt = (tmax >> 5) + 1;
    ((LAS v4u*)HIST)[tid] = (v4u){0u, 0u, 0u, 0u};
    __syncthreads();
    const unsigned long long ta_ = AMP_ON ? __builtin_amdgcn_s_memrealtime() : 0ull;
    if (!(mode & 2)) {
      bf16x8 afr[2][4];
#pragma unroll
      for (int mt = 0; mt < 2; ++mt)
#pragma unroll
        for (int ks = 0; ks < 4; ++ks) afr[mt][ks] = *(const bf16x8*)(QI + (size_t)(T0 + 8 * rp + 4 * mt + a_tok) * 512 + a_head * 64 + 16 * ks + 8 * hh);
      float wv[2][16];
#pragma unroll
      for (int mt = 0; mt < 2; ++mt)
#pragma unroll
        for (int tl = 0; tl < 2; ++tl) {
          const float* wp = WI + (size_t)(T0 + 8 * rp + 4 * mt + tl + 2 * hh) * 8;
          const f32x4 w0 = *(const f32x4*)wp, w1 = *(const f32x4*)(wp + 4);
          wv[mt][8 * tl + 0] = w0.x; wv[mt][8 * tl + 1] = w0.y; wv[mt][8 * tl + 2] = w0.z; wv[mt][8 * tl + 3] = w0.w;
          wv[mt][8 * tl + 4] = w1.x; wv[mt][8 * tl + 5] = w1.y; wv[mt][8 * tl + 6] = w1.z; wv[mt][8 * tl + 7] = w1.w;
        }
      const us* kbase = KI + ((size_t)(b * (S / 32)) * 8 * 32 + hh * 32 + r) * 8;
      bf16x8 bA[4], bB[4];
      const int klast = nkt - 1;
#define TK_LOADB(dst, kt_) do { const int kc_ = (kt_) < klast ? (kt_) : klast; _Pragma("unroll") for (int ks = 0; ks < 4; ++ks) dst[ks] = *(const bf16x8*)(kbase + (size_t)kc_ * 2048 + 512 * ks); } while (0)
#define TK_TILE(bfr, kt_) do { \
        f32x16 acc[2]; \
        _Pragma("unroll") for (int mt = 0; mt < 2; ++mt) { \
          _Pragma("unroll") for (int i = 0; i < 16; ++i) acc[mt][i] = 0.f; \
          _Pragma("unroll") for (int ks = 0; ks < 4; ++ks) acc[mt] = __builtin_amdgcn_mfma_f32_32x32x16_bf16(afr[mt][ks], bfr[ks], acc[mt], 0, 0, 0); } \
        const int s = (kt_) * 32 + r; \
        _Pragma("unroll") for (int mt = 0; mt < 2; ++mt) \
          _Pragma("unroll") for (int tl = 0; tl < 2; ++tl) { \
            float sc = 0.f; \
            _Pragma("unroll") for (int h8 = 0; h8 < 8; ++h8) { const float rl_ = __int_as_float(max(__float_as_int(acc[mt][8 * tl + h8]), 0));   \
              asm("v_fmac_f32_e32 %0, %1, %2" : "+v"(sc) : "v"(wv[mt][8 * tl + h8]), "v"(rl_)); }     \
            const int tokl = 8 * rp + 4 * mt + tl + 2 * hh; \
            const unsigned key = (s <= tt0 + tokl) ? f16key(sc) : 0u; \
            KEYS[tokl * 4096 + s] = (us)key; \
            if (key) __hip_atomic_fetch_add(HIST + tokl * 128 + (key >> 9), 1u << ((key >> 4) & 16u), __ATOMIC_RELAXED, __HIP_MEMORY_SCOPE_WORKGROUP);     \
          } } while (0)
      if (kg < nkt) {
        TK_LOADB(bA, kg);
        for (int kt = kg; kt < nkt; kt += 4) {
          TK_LOADB(bB, kt + 4);
          TK_TILE(bA, kt);
#pragma unroll
          for (int ks = 0; ks < 4; ++ks) bA[ks] = bB[ks];
        }
      }
#undef TK_LOADB
#undef TK_TILE
    }
    __syncthreads();
    const unsigned long long tb_ = AMP_ON ? __builtin_amdgcn_s_memrealtime() : 0ull;
    if (ampk == 2) amp_acc += tb_ - ta_;
    {
      const int N_unit = nkt * 32;
      const int nkw = ((tt0 >> 8) + 1) * 256;
      const int nq = (nkw + 511) >> 9;
      if (mode & 1) continue;
      switch (nq) {
        case 1: tk_select<1>(KEYS, HIST, MWB, T0, N_unit, nkw, wave, lane); break;
        case 2: tk_select<2>(KEYS, HIST, MWB, T0, N_unit, nkw, wave, lane); break;
        case 3: tk_select<3>(KEYS, HIST, MWB, T0, N_unit, nkw, wave, lane); break;
        case 4: tk_select<4>(KEYS, HIST, MWB, T0, N_unit, nkw, wave, lane); break;
        case 5: tk_select<5>(KEYS, HIST, MWB, T0, N_unit, nkw, wave, lane); break;
        case 6: tk_select<6>(KEYS, HIST, MWB, T0, N_unit, nkw, wave, lane); break;
        case 7: tk_select<7>(KEYS, HIST, MWB, T0, N_unit, nkw, wave, lane); break;
        default: tk_select<8>(KEYS, HIST, MWB, T0, N_unit, nkw, wave, lane); break;
      }
      if (ampk == 3) amp_acc += __builtin_amdgcn_s_memrealtime() - tb_;
    }
  }
}

namespace attn_body {
using bf16=__hip_bfloat16;
using bf16x8=__attribute__((ext_vector_type(8)))short;
using s16x4=__attribute__((ext_vector_type(4)))short;
using f32x16=__attribute__((ext_vector_type(16)))float;
using u32x4=__attribute__((ext_vector_type(4)))unsigned;
constexpr int BATCH=4,NHEAD=8,SEQ=4096,D=64,DM=NHEAD*D;
constexpr int NW=8,QBLK=32,QB=QBLK*NW,KVBLK=64,NQB=SEQ/QB;
constexpr int ATTN_PITCH=DM, ATTN_UNIT_ROWS=QB;
__device__ __forceinline__ int crow(int r,int hi){return (r&3)+8*(r>>2)+4*hi;}
#define SBAR() __builtin_amdgcn_sched_barrier(0)
__device__ __forceinline__ void cmask(f32x16&p0,f32x16&p1,int jb,int qrel,int hi){
  const float NEG=-INFINITY; int kb=64*jb+4*hi;
  #pragma unroll
  for(int r=0;r<16;++r){int kv=kb+(r&3)+8*(r>>2); if(kv>qrel)p0[r]=NEG; if(kv+32>qrel)p1[r]=NEG;}
}

constexpr int NSLOT=3, SLOTB=8192;
constexpr int LDS_K=0, LDS_V=NSLOT*SLOTB, LDS_WS=2*NSLOT*SLOTB, LDS_OST=LDS_WS+NW*64*4, LDS_MK=LDS_OST+NW*4096, LDS_BYTES=LDS_MK+NW*2048;
constexpr float C2=0.125f*1.4426950408889634f;
__device__ __forceinline__ void glds16(const void*gsrc,unsigned lds_dst){unsigned keep;
  asm volatile("s_mov_b32 %0, m0\n\ts_mov_b32 m0, %2\n\ts_nop 0\n\tglobal_load_lds_dwordx4 %1, off\n\ts_mov_b32 m0, %0":"=&s"(keep):"v"(gsrc),"s"(lds_dst):"memory");}
__device__ __forceinline__ float max3f(float a,float b,float c){float r;asm("v_max3_f32 %0, %1, %2, %3":"=v"(r):"v"(a),"v"(b),"v"(c));return r;}
__device__ __forceinline__ float max2f(float a,float b){float r;asm("v_max_f32_e32 %0, %1, %2":"=v"(r):"v"(a),"v"(b));return r;}
__device__ __forceinline__ float fadd_s(float a,float b){float r;asm("v_add_f32_e32 %0, %1, %2":"=v"(r):"v"(a),"v"(b));return r;}
__device__ __forceinline__ float fsub_s(float a,float b){float r;asm("v_sub_f32_e32 %0, %1, %2":"=v"(r):"v"(a),"v"(b));return r;}
typedef float f32x2_t __attribute__((ext_vector_type(2))); typedef __bf16 bf16x2_t __attribute__((ext_vector_type(2)));
__device__ __forceinline__ unsigned cvtpk_s(float lo,float hi){f32x2_t v={lo,hi};bf16x2_t b=__builtin_convertvector(v,bf16x2_t);return __builtin_bit_cast(unsigned,b);}
#define WAIT_BAR(N) asm volatile("s_waitcnt vmcnt(" #N ") lgkmcnt(0)\n\ts_barrier":::"memory")

__device__ __forceinline__ void qkt(f32x16&p0,f32x16&p1,const char*Kslot,const bf16x8*qr,const f32x16&negm,int r32,int hi){
  const char*kb=Kslot+hi*1024+r32*16;
  #pragma unroll
  for(int d0=0;d0<4;++d0){
    const bf16x8 b0=*reinterpret_cast<const bf16x8*>(kb+d0*2048);
    const bf16x8 b1=*reinterpret_cast<const bf16x8*>(kb+d0*2048+512);
    if(d0==0){p0=__builtin_amdgcn_mfma_f32_32x32x16_bf16(b0,qr[0],negm,0,0,0);p1=__builtin_amdgcn_mfma_f32_32x32x16_bf16(b1,qr[0],negm,0,0,0);}
    else{p0=__builtin_amdgcn_mfma_f32_32x32x16_bf16(b0,qr[d0],p0,0,0,0);p1=__builtin_amdgcn_mfma_f32_32x32x16_bf16(b1,qr[d0],p1,0,0,0);}}
}
typedef __attribute__((address_space(3))) const char* lds_cptr;
typedef short v4i16_t __attribute__((ext_vector_type(4)));
__device__ __forceinline__ void kload8(bf16x8*kf,lds_cptr kp){
  kf[0]=*(const __attribute__((address_space(3))) bf16x8*)(kp);      kf[1]=*(const __attribute__((address_space(3))) bf16x8*)(kp+512);
  kf[2]=*(const __attribute__((address_space(3))) bf16x8*)(kp+2048); kf[3]=*(const __attribute__((address_space(3))) bf16x8*)(kp+2560);
  kf[4]=*(const __attribute__((address_space(3))) bf16x8*)(kp+4096); kf[5]=*(const __attribute__((address_space(3))) bf16x8*)(kp+4608);
  kf[6]=*(const __attribute__((address_space(3))) bf16x8*)(kp+6144); kf[7]=*(const __attribute__((address_space(3))) bf16x8*)(kp+6656);
}
__device__ __forceinline__ void kload2(bf16x8*kf,lds_cptr kp,int j){ kf[2*j]=*(const __attribute__((address_space(3))) bf16x8*)(kp+j*2048); kf[2*j+1]=*(const __attribute__((address_space(3))) bf16x8*)(kp+j*2048+512); }
__device__ __forceinline__ s16x4 vtr(lds_cptr p){ return __builtin_bit_cast(s16x4,__builtin_amdgcn_ds_read_tr16_b64_v4i16((__attribute__((address_space(3))) v4i16_t*)p)); }
__device__ __forceinline__ float rowmax(const f32x16&p0,const f32x16&p1){
  float a=max3f(p0[0],p0[1],p1[0]),b=max3f(p0[2],p0[3],p1[1]);a=max3f(a,p1[2],p1[3]);
  #pragma unroll
  for(int r=4;r<16;r+=4){a=max3f(a,p0[r],p0[r+1]);b=max3f(b,p0[r+2],p0[r+3]);a=max3f(a,p1[r],p1[r+1]);b=max3f(b,p1[r+2],p1[r+3]);}
  const float m=max2f(a,b);
  auto rr=__builtin_amdgcn_permlane32_swap(__float_as_uint(m),__float_as_uint(m),false,false);
  return max2f(__uint_as_float(rr[0]),__uint_as_float(rr[1]));
}
__device__ __forceinline__ void pv(f32x16*o,int vb,bf16x8 pa0,bf16x8 pa1,bf16x8 pa2,bf16x8 pa3){
  #pragma unroll
  for(int d0=0;d0<2;++d0){s16x4 lo[4],hi[4];
    #pragma unroll
    for(int ks=0;ks<4;++ks){
      asm volatile("ds_read_b64_tr_b16 %0,%1 offset:%c2":"=&v"(lo[ks]):"v"(vb),"i"(d0*4096+ks*1024):"memory");
      asm volatile("ds_read_b64_tr_b16 %0,%1 offset:%c2":"=&v"(hi[ks]):"v"(vb),"i"(d0*4096+ks*1024+512):"memory");}
    asm volatile("s_waitcnt lgkmcnt(0)":::"memory");SBAR();
    #define PK(k) (bf16x8){lo[k][0],lo[k][1],lo[k][2],lo[k][3],hi[k][0],hi[k][1],hi[k][2],hi[k][3]}
    o[d0]=__builtin_amdgcn_mfma_f32_32x32x16_bf16(pa0,PK(0),o[d0],0,0,0);
    o[d0]=__builtin_amdgcn_mfma_f32_32x32x16_bf16(pa1,PK(1),o[d0],0,0,0);
    o[d0]=__builtin_amdgcn_mfma_f32_32x32x16_bf16(pa2,PK(2),o[d0],0,0,0);
    o[d0]=__builtin_amdgcn_mfma_f32_32x32x16_bf16(pa3,PK(3),o[d0],0,0,0);
    #undef PK
  }
}

#ifndef ATTN_STORE16
#define ATTN_STORE16(p,v) asm volatile("global_store_dwordx4 %0, %1, off sc1\n\ts_nop 1"::"v"(p),"v"(v):"memory")
#endif
template<int THRL> __device__ __forceinline__ void attn_unit(int b,int h,int qb,const bf16*Q,const bf16*__restrict__ K,const bf16*__restrict__ V,bf16*O,const unsigned char*MW,unsigned*done,char*shm){
  const int tid=threadIdx.x,lane=tid&63,r32=lane&31,hi=lane>>5; const int wid=__builtin_amdgcn_readfirstlane(tid>>6);
  const long rowbase=(long)b*SEQ; const int q0=qb*QB;
  const bf16*Qw=Q+(rowbase+q0+wid*QBLK)*DM+h*D;
  const bf16*Kh=K+rowbase*DM+h*D,*Vh=V+rowbase*DM+h*D;
  const unsigned lds0=(unsigned)(uintptr_t)shm;
  float*wsf=(float*)(shm+LDS_WS)+wid*64;
  const bf16*ksrc=Kh+(long)lane*DM+wid*8;
  const bf16*vsrc=Vh+(long)(16*(wid&3)+(lane>>2))*DM+(wid>>2)*32+(lane&3)*8;
  const unsigned kdst=lds0+LDS_K+wid*1024, vdst=lds0+LDS_V+wid*1024;
  #define DMA_K(t,slot) glds16(ksrc+(long)(t)*KVBLK*DM,(unsigned)__builtin_amdgcn_readfirstlane(kdst+(slot)))
  #define DMA_V(t,slot) glds16(vsrc+(long)(t)*KVBLK*DM,(unsigned)__builtin_amdgcn_readfirstlane(vdst+(slot)))
  const int vb0=(int)(lds0+LDS_V)+((lane>>4)&1)*32+(lane&3)*8+(4*hi+((lane&15)>>2))*64;
  const char*Kbase=shm+LDS_K; bf16x8 kf[8];
  const lds_cptr shm3=(lds_cptr)shm; const lds_cptr kp0=shm3+LDS_K+hi*1024+r32*16; const lds_cptr vp0=shm3+LDS_V+((lane>>4)&1)*32+(lane&3)*8+(4*hi+((lane&15)>>2))*64;
  const int NT=(q0+QB)/KVBLK;
  const unsigned char*msrc=MW+((size_t)(rowbase+q0+wid*QBLK+(lane>>1)))*512+(lane&1)*16;
  const unsigned mdst=lds0+LDS_MK+wid*2048;
  #define MDMA(g) glds16(msrc+(g)*32,(unsigned)__builtin_amdgcn_readfirstlane(mdst+((g)&1)*1024))
  const lds_cptr mkp=(lds_cptr)shm+LDS_MK+wid*2048+r32*32;
  #define MWORD(t) (*(const __attribute__((address_space(3))) unsigned long long*)(mkp+(((t)>>2)&1)*1024+(((t)>>1)&1)*16+((t)&1)*8))
  #define MAPPLY(X,B,w) do{ X[B]=__uint_as_float(__float_as_uint(X[B])&(unsigned)__builtin_amdgcn_sbfe((int)(w),((B)&3)+8*((B)>>2),1)); }while(0)
  MDMA(0); if(q0+QB>4*KVBLK){MDMA(1);}
  DMA_K(0,0);DMA_V(0,0);DMA_K(1,SLOTB);
  bf16x8 qr[4];
  #pragma unroll
  for(int d0=0;d0<4;++d0)qr[d0]=*reinterpret_cast<const bf16x8*>(&Qw[(long)r32*DM+d0*16+hi*8]);
  float mhat=0.f,l_reg=0.f;f32x16 o[2];o[0]=f32x16{};o[1]=f32x16{};f32x16 negm=f32x16{};asm volatile("":"+v"(negm));
  const int qrel=wid*QBLK+r32;
  #define CMASK(P0,P1,t) do{int jb_=(t)-(NT-4); if(jb_>=0)cmask(P0,P1,jb_,qrel,hi);}while(0)
  bool resc=false;
  #define START(P0,P1) do{ const float rm=rowmax(P0,P1); resc=false; \
    { const float dl=rm; mhat=fadd_s(mhat,dl); \
      _Pragma("unroll") for(int r=0;r<16;++r){P0[r]=fsub_s(P0[r],dl);P1[r]=fsub_s(P1[r],dl);} \
      _Pragma("unroll") for(int r=0;r<16;++r)negm[r]=-mhat; asm volatile("":"+v"(negm)); } \
    _Pragma("unroll") for(int r=0;r<16;++r)P0[r]=__builtin_amdgcn_exp2f(P0[r]); }while(0)
  #define RESC() do{ if(resc){ asm volatile("s_waitcnt lgkmcnt(0)":::"memory"); \
      _Pragma("unroll") for(int d_=0;d_<2;++d_) _Pragma("unroll") for(int r=0;r<16;++r)o[d_][r]*=wsf[crow(r,hi)]; } }while(0)
  f32x16 pA0,pA1,pB0,pB1;
  int sl_prev=0,sl_cur=0,sl_next=SLOTB;
  #define ROT() do{sl_prev=sl_cur;sl_cur=sl_next;sl_next=(sl_next==(NSLOT-1)*SLOTB)?0:sl_next+SLOTB;}while(0)
  DMA_K(2,2*SLOTB);
  WAIT_BAR(3);
  qkt(pA0,pA1,Kbase,qr,negm,r32,hi);asm volatile("s_nop 15\n\ts_nop 7":"+v"(pA0),"+v"(pA1));
  START(pA0,pA1);
  _Pragma("unroll") for(int r=0;r<16;++r)pA1[r]=__builtin_amdgcn_exp2f(pA1[r]);
  { const unsigned long long mw_=MWORD(0); const unsigned wl_=(unsigned)mw_>>(4*hi), wh_=(unsigned)(mw_>>32)>>(4*hi);
    _Pragma("unroll") for(int r=0;r<16;++r){ MAPPLY(pA0,r,wl_); MAPPLY(pA1,r,wh_); } }
  WAIT_BAR(0);
  DMA_K(3,0);DMA_V(1,SLOTB);
  ROT();
  kload8(kf,kp0+sl_cur);
  WAIT_BAR(2);
  s16x4 vlo[8],vhi[8]; u32x4 pw0,pw1,pw2,pw3;
  #define PKW(P,B) cvtpk_s(P[B],P[B+1])
  #define PAF(k) __builtin_bit_cast(bf16x8,pw##k)
  #define VFR(i) (bf16x8){vlo[i][0],vlo[i][1],vlo[i][2],vlo[i][3],vhi[i][0],vhi[i][1],vhi[i][2],vhi[i][3]}
  #define PIN(x) asm volatile("":"+v"(x))
  #define MX3(a,b,c) __builtin_fmaxf(__builtin_fmaxf((a),(b)),(c))
  #define GAPA(MF,A0,A1,A2,A3,W0,W1,PW) do{ MF; sacc+=A0; sacc+=A1; sacc+=A2; sacc+=A3; PIN(sacc); W0; W1; PIN(PW); SBAR(); }while(0)
  #define EX(v) __builtin_amdgcn_exp2f(v)
  #define GAPB(MF,X,B,w) do{ MF; X[B]=EX(X[B]); X[B+1]=EX(X[B+1]); X[B+2]=EX(X[B+2]); X[B+3]=EX(X[B+3]); MAPPLY(X,B,w); MAPPLY(X,B+1,w); MAPPLY(X,B+2,w); MAPPLY(X,B+3,w); PIN(X); SBAR(); }while(0)
  #define VRD(i) do{ vlo[i]=vtr(vp_+(((i)>>2)*4096+((i)&3)*1024)); vhi[i]=vtr(vp_+(((i)>>2)*4096+((i)&3)*1024+512)); }while(0)
  #define KRD(G,j) do{ if(G){ kload2(kf,kp0+sl_next,j); SBAR(); } }while(0)
  #define STEP(C0,C1,P0,P1,t,GK,GV,GL) do{ SBAR(); \
    const lds_cptr vp_=vp0+sl_prev; \
    VRD(0); SBAR(); float sacc=(P0[0]+P0[1]); \
    GAPA(C0=__builtin_amdgcn_mfma_f32_32x32x16_bf16(kf[0],qr[0],negm,0,0,0), P0[2],P0[3],P0[4],P0[5],     pw0[0]=PKW(P0,0), pw0[1]=PKW(P0,2), pw0); \
    VRD(4); SBAR(); GAPA(C1=__builtin_amdgcn_mfma_f32_32x32x16_bf16(kf[1],qr[0],negm,0,0,0), P0[6],P0[7],P0[8],P0[9],     pw0[2]=PKW(P0,4), pw0[3]=PKW(P0,6), pw0); \
    VRD(1); SBAR(); GAPA(C0=__builtin_amdgcn_mfma_f32_32x32x16_bf16(kf[2],qr[1],C0,0,0,0),   P0[10],P0[11],P0[12],P0[13], pw1[0]=PKW(P0,8), pw1[1]=PKW(P0,10), pw1); \
    VRD(5); SBAR(); GAPA(C1=__builtin_amdgcn_mfma_f32_32x32x16_bf16(kf[3],qr[1],C1,0,0,0),   P0[14],P0[15],P1[0],P1[1],   pw1[2]=PKW(P0,12),pw1[3]=PKW(P0,14), pw1); \
    VRD(2); SBAR(); GAPA(C0=__builtin_amdgcn_mfma_f32_32x32x16_bf16(kf[4],qr[2],C0,0,0,0),   P1[2],P1[3],P1[4],P1[5],     pw2[0]=PKW(P1,0), pw2[1]=PKW(P1,2), pw2); \
    VRD(6); SBAR(); GAPA(C1=__builtin_amdgcn_mfma_f32_32x32x16_bf16(kf[5],qr[2],C1,0,0,0),   P1[6],P1[7],P1[8],P1[9],     pw2[2]=PKW(P1,4), pw2[3]=PKW(P1,6), pw2); \
    VRD(3); SBAR(); GAPA(C0=__builtin_amdgcn_mfma_f32_32x32x16_bf16(kf[6],qr[3],C0,0,0,0),   P1[10],P1[11],P1[12],P1[13], pw3[0]=PKW(P1,8), pw3[1]=PKW(P1,10), pw3); \
    VRD(7); SBAR(); GAPA(C1=__builtin_amdgcn_mfma_f32_32x32x16_bf16(kf[7],qr[3],C1,0,0,0),   P1[14],P1[15],0.f,0.f,       pw3[2]=PKW(P1,12),pw3[3]=PKW(P1,14), pw3); \
    l_reg+=sacc; \
    if((((t)&3)==0)&&((t)+4<NT)){MDMA(((t)>>2)+1);} \
    if(GK){DMA_K((t)+3,sl_cur);} if(GV){DMA_V((t)+1,sl_next);} \
    const unsigned long long mw_=MWORD(t); const unsigned wl_=(unsigned)mw_>>(4*hi), wh_=(unsigned)(mw_>>32)>>(4*hi); \
    { float a=MX3(C0[0],C0[1],C1[0]),b=MX3(C0[2],C0[3],C1[1]); a=MX3(a,C1[2],C1[3]); \
      _Pragma("unroll") for(int r=4;r<16;r+=4){a=MX3(a,C0[r],C0[r+1]);b=MX3(b,C0[r+2],C0[r+3]);a=MX3(a,C1[r],C1[r+1]);b=MX3(b,C1[r+2],C1[r+3]);} \
      float rm=__builtin_fmaxf(a,b); { auto rr=__builtin_amdgcn_permlane32_swap(__float_as_uint(rm),__float_as_uint(rm),false,false); rm=__builtin_fmaxf(__uint_as_float(rr[0]),__uint_as_float(rr[1])); } \
      resc=false; \
      if(__builtin_expect(__any(rm>(float)THRL),0)){ const float dl=__builtin_fmaxf(rm,0.f); mhat+=dl; \
        _Pragma("unroll") for(int r=0;r<16;++r){C0[r]-=dl;C1[r]-=dl;} \
        _Pragma("unroll") for(int r=0;r<16;++r)negm[r]=-mhat; asm volatile("":"+v"(negm)); \
        const float f=__builtin_amdgcn_exp2f(-dl); l_reg*=f; if(hi==0)wsf[r32]=f; resc=true; } } \
    SBAR(); \
    GAPB(o[0]=__builtin_amdgcn_mfma_f32_32x32x16_bf16(PAF(0),VFR(0),o[0],0,0,0), C0,0,wl_); \
    GAPB(o[1]=__builtin_amdgcn_mfma_f32_32x32x16_bf16(PAF(0),VFR(4),o[1],0,0,0), C0,4,wl_); \
    KRD(GL,0); GAPB(o[0]=__builtin_amdgcn_mfma_f32_32x32x16_bf16(PAF(1),VFR(1),o[0],0,0,0), C0,8,wl_); \
    KRD(GL,1); GAPB(o[1]=__builtin_amdgcn_mfma_f32_32x32x16_bf16(PAF(1),VFR(5),o[1],0,0,0), C0,12,wl_); \
    KRD(GL,2); GAPB(o[0]=__builtin_amdgcn_mfma_f32_32x32x16_bf16(PAF(2),VFR(2),o[0],0,0,0), C1,0,wh_); \
    KRD(GL,3); GAPB(o[1]=__builtin_amdgcn_mfma_f32_32x32x16_bf16(PAF(2),VFR(6),o[1],0,0,0), C1,4,wh_); \
    GAPB(o[0]=__builtin_amdgcn_mfma_f32_32x32x16_bf16(PAF(3),VFR(3),o[0],0,0,0), C1,8,wh_); \
    GAPB(o[1]=__builtin_amdgcn_mfma_f32_32x32x16_bf16(PAF(3),VFR(7),o[1],0,0,0), C1,12,wh_); \
    }while(0)
  int t=1;
  #undef CMASK
  #define CMASK(P0,P1,t) do{}while(0)
  for(;t+5<NT;t+=2){
    STEP(pB0,pB1,pA0,pA1,t,true,true,true);     WAIT_BAR(2); RESC(); ROT();
    STEP(pA0,pA1,pB0,pB1,t+1,true,true,true);   WAIT_BAR(2); RESC(); ROT();
  }
  #undef CMASK
  #define CMASK(P0,P1,t) do{int jb_=(t)-(NT-4); if(jb_>=0)cmask(P0,P1,jb_,qrel,hi);}while(0)
  #define ENDW(tt) do{ if((tt)+3<NT){WAIT_BAR(2);} else if((tt)+2<NT){WAIT_BAR(1);} else {WAIT_BAR(0);} }while(0)
  for(;t+1<NT;t+=2){
    STEP(pB0,pB1,pA0,pA1,t,(t+3<NT),(t+1<NT),(t+1<NT));       ENDW(t);   RESC(); ROT();
    STEP(pA0,pA1,pB0,pB1,t+1,(t+4<NT),(t+2<NT),(t+2<NT));     ENDW(t+1); RESC(); ROT();
  }
  STEP(pB0,pB1,pA0,pA1,NT-1,false,false,false); RESC();
  { float sacc=pB0[0]+pB0[1]; _Pragma("unroll") for(int r=2;r<16;++r)sacc+=pB0[r]; _Pragma("unroll") for(int r=0;r<16;++r)sacc+=pB1[r]; l_reg+=sacc;
    pw0=(u32x4){PKW(pB0,0),PKW(pB0,2),PKW(pB0,4),PKW(pB0,6)};pw1=(u32x4){PKW(pB0,8),PKW(pB0,10),PKW(pB0,12),PKW(pB0,14)};pw2=(u32x4){PKW(pB1,0),PKW(pB1,2),PKW(pB1,4),PKW(pB1,6)};pw3=(u32x4){PKW(pB1,8),PKW(pB1,10),PKW(pB1,12),PKW(pB1,14)};
    SBAR(); pv(o,vb0+sl_cur,PAF(0),PAF(1),PAF(2),PAF(3)); }
  #undef PKW
  #undef PAF
  #undef VFR
  #undef PIN
  #undef MX3
  #undef GAPA
  #undef GAPB
  #undef EX
  #undef VRD
  #undef KRD
  #undef STEP
  #undef ENDW
  {auto rr=__builtin_amdgcn_permlane32_swap(__float_as_uint(l_reg),__float_as_uint(l_reg),false,false);l_reg=__uint_as_float(rr[0])+__uint_as_float(rr[1]);}
  if(hi==0)wsf[32+r32]=l_reg;asm volatile("s_waitcnt lgkmcnt(0)":::"memory");
  float rli[16];
  #pragma unroll
  for(int r=0;r<16;++r)rli[r]=__builtin_amdgcn_rcpf(wsf[32+crow(r,hi)]);
  bf16*Ow=O+(rowbase+q0+wid*QBLK)*DM+h*D;
  { bf16*stg=(bf16*)(shm+LDS_OST)+wid*2048;
    #pragma unroll
    for(int r=0;r<16;++r){const int orow=crow(r,hi);
      #pragma unroll
      for(int d0=0;d0<2;++d0)stg[orow*64+d0*32+r32]=__float2bfloat16(o[d0][r]*rli[r]);}
    asm volatile("s_waitcnt lgkmcnt(0)":::"memory");
    #pragma unroll
    for(int i=0;i<4;++i){const int row=i*8+(lane>>3),ch=lane&7; const u32x4 v=*(const u32x4*)(stg+row*64+ch*8); ATTN_STORE16(Ow+(long)row*DM+ch*8,v);} }
  asm volatile("s_waitcnt vmcnt(0) lgkmcnt(0)\n\ts_barrier":::"memory");
  if(wid==1){ if(lane==0) __hip_atomic_fetch_add(done+b*16+qb,1u,__ATOMIC_RELAXED,__HIP_MEMORY_SCOPE_AGENT); }
  #undef DMA_K
  #undef DMA_V
  #undef CMASK
  #undef MDMA
  #undef MWORD
  #undef MAPPLY
  #undef START
  #undef RESC
  #undef ROT
}
constexpr int ATTN_LDS_BYTES=LDS_BYTES;
struct AttnTensors { const bf16* Q; const bf16* K; const bf16* V; bf16* O; const unsigned char* MW; unsigned* done; };
template<int THRL=8> __device__ __forceinline__ void attn_phase(char*lds,const AttnTensors&T,int grid,int block){
  for(int v0=block;v0<256;v0+=grid){
    const int vcu=(grid==256)?((v0%8)*32+v0/8):v0; const int bh=vcu>>3,s=vcu&7;
    attn_unit<THRL>(bh/NHEAD,bh%NHEAD,s,T.Q,T.K,T.V,T.O,T.MW,T.done,lds);
    attn_unit<THRL>(bh/NHEAD,bh%NHEAD,15-s,T.Q,T.K,T.V,T.O,T.MW,T.done,lds);
  }
}
#undef SBAR
#undef WAIT_BAR
}

__global__ void __launch_bounds__(512, 2) mk_fwd(Args args) {
  extern __shared__ __attribute__((aligned(16))) unsigned char lds_raw[];
  LAS unsigned char* lds = (LAS unsigned char*)lds_raw;
  volatile LAS unsigned* MISC = (volatile LAS unsigned*)(lds + MISC_OFF);
  const int tid = threadIdx.x, lane = tid & 63;
  const int wave = __builtin_amdgcn_readfirstlane(tid >> 6);
  const int G_ = gridDim.x;
  unsigned char* ws = args.ws;
  if (tid < 32) MISC[tid] = 0u;
  __syncthreads();
  XcdBarrier bar = xcd_barrier_post((unsigned*)(ws + WS_CTL) + CW_BAR + args.li * XCD_BAR_WORDS, MISC + 8);
  const int lo = args.ph_lo, hi = args.ph_hi;
#define IN(k) (lo <= (k) && (k) < hi)
  unsigned long long amp_acc = 0ull, t_lastexit = AMP_ON ? __builtin_amdgcn_s_memrealtime() : 0ull;
#define SEAM(k) do { if (IN(k) && (k) + 1 < hi) { if (!AMP_ON) { xcd_barrier(bar); } else { const unsigned long long tb_ = __builtin_amdgcn_s_memrealtime(); xcd_barrier(bar); const unsigned long long te_ = __builtin_amdgcn_s_memrealtime(); \
    if (((args.dup >> 16) & 15) == 1) amp_acc += te_ - tb_; \
    if (((args.dup >> 16) & 15) == 14 && (((unsigned)args.dup >> 28) & 15u) == (unsigned)(k)) amp_acc += te_ - t_lastexit; t_lastexit = te_; } } } while (0)

#define PHASE_IDS() int tid_p = tid; asm volatile("" : "+v"(tid_p)); const int lane_p = tid_p & 63; const int wave_p = __builtin_amdgcn_readfirstlane(tid_p >> 6)
#define AMP_T0() const unsigned long long tph_ = AMP_ON ? __builtin_amdgcn_s_memrealtime() : 0ull
#define AMP_T1(k) do { if (AMP_ON && ((args.dup >> 16) & 15) == 15 && (((unsigned)args.dup >> 28) & 15u) == (unsigned)(k)) amp_acc += __builtin_amdgcn_s_memrealtime() - tph_; } while (0)
  const float* x = args.in[0];
  const int* pos = (const int*)args.in[1];
  const float* g_mix = args.in[2];
  const float* w_in = args.in[3];
  us* WinT = (us*)(ws + WS_WIN); us* WcoT = (us*)(ws + WS_WCO); us* WaoT = (us*)(ws + WS_WAO); us* WoT = (us*)(ws + WS_WO);
  float* CT = (float*)(ws + WS_CT); float* ST = (float*)(ws + WS_ST);
  us* Hb = (us*)(ws + WS_HB);

  { AMP_T0(); if (IN(PH_PREP)) {
    LAS float* scr = (LAS float*)(lds + wave * 16384);
    const int gw = blockIdx.x * 8 + wave, NGW = G_ * 8;
    constexpr int I_IN = 16 * 168, I_CO = 8 * 32, I_AO = 8 * 32, I_O = 16 * 32;
    constexpr int NITEMS = I_IN + I_CO + I_AO + I_O;
    for (int it = gw; it < NITEMS; it += NGW) {
      int r = it;
      if (r < I_IN) { const int g = r % 168, kb = r / 168; p0_transpose_item(w_in, INC, 64 * kb, inproj_src(g), WinT, 1024, 32 * g, scr, lane); continue; }
      r -= I_IN;
      if (r < I_CO) { const int nb = r % 32, kb = r / 32; p0_transpose_item(args.in[8], 1024, 64 * kb, 32 * nb, WcoT, 512, 32 * nb, scr, lane); continue; }
      r -= I_CO;
      if (r < I_AO) { const int nb = r % 32, kb = r / 32; p0_transpose_item(args.in[9], 1024, 64 * kb, 32 * nb, WaoT, 512, 32 * nb, scr, lane); continue; }
      r -= I_AO;
      { const int nb = r % 32, kb = r / 32; p0_transpose_item(args.in[10], 1024, 64 * kb, 32 * nb, WoT, 1024, 32 * nb, scr, lane); }
    }
    for (int row = gw * 4; row < T; row += NGW * 4) rms_rows4_to_bf16(x + (size_t)row * D, g_mix, Hb + (size_t)row * D, lane);
    for (int i = blockIdx.x * 512 + tid; i < T * 32; i += G_ * 512) {
      const int t = i >> 5, d = i & 31;
      const float inv = 1.0f / powf(10000.0f, (float)(2 * d) / 64.0f);
      const float ang = (float)pos[t] * inv;
      const float n_ = rintf(ang * 0.15915494309189535f);
      float rr = __builtin_fmaf(-n_, 6.28125f, ang); rr = __builtin_fmaf(-n_, 1.9353071795864769e-3f, rr);
      const float rev = rr * 0.15915494309189535f;
      CT[i] = __builtin_amdgcn_cosf(rev); ST[i] = __builtin_amdgcn_sinf(rev);
    }
  }
  AMP_T1(PH_PREP); }
  SEAM(PH_PREP);
  { AMP_T0(); if (IN(PH_INPROJ)) {
    pg8::Gemm g{Hb, WinT, T, NIN, D};
    InProjOrder So; So.init(T, NIN, G_, (int)blockIdx.x); So.dep = (unsigned*)(ws + WS_CTL) + CW_DEP;
    EpiInProj E;
    E.G = (us*)(ws + WS_G); E.Q = (us*)(ws + WS_Q); E.K = (us*)(ws + WS_K); E.V = (us*)(ws + WS_V); E.QI = (us*)(ws + WS_QI);
    E.KI = (us*)(ws + WS_KI); E.GC = (us*)(ws + WS_GC); E.GA = (us*)(ws + WS_GA); E.WI = (float*)(ws + WS_WI); E.CT = CT; E.ST = ST;
    pg8::gemm_phase<EpiInProj, InProjOrder, true, true>(lds, g, So, E);
    {
      const int nwg_ = (T / 256) * (NIN / 256); int n6 = nwg_ - 5 * G_; n6 = n6 < 0 ? 0 : (n6 > G_ ? G_ : n6);
      const bool all_ = (n6 == 0 || n6 == G_);
      const bool six = !all_ && (int)blockIdx.x < n6;
      const int nfree = all_ ? G_ : G_ - n6, myidx = all_ ? (int)blockIdx.x : (int)blockIdx.x - n6;
      if (!six && nfree > 0) {
        LAS float* scr = (LAS float*)(lds + wave * 16384);
        constexpr int I_GU = 16 * 16 * 16, I_DN = 16 * 4 * 32;
        for (int it = myidx * 8 + wave; it < I_GU + I_DN; it += nfree * 8) {
          int r = it;
      if (r < I_GU) {
        const int g16 = r & 15, kb = (r >> 4) & 15, e = r >> 8; const int ct = g16 >> 3, half = (g16 >> 2) & 1, q = g16 & 3;
        p0_transpose_item_fm((half ? args.in[17] : args.in[16]) + (size_t)e * 1024 * 256, 256, 64 * kb, 128 * ct + 32 * q, (us*)(ws + WS_WGU), 1024,
                             e * 16 + ct * 8 + half * 4 + q, scr, lane);
        continue; }
      r -= I_GU;
      { const int g = r & 31, kb = (r >> 5) & 3, e = r >> 7;
        p0_transpose_item_fm(args.in[18] + (size_t)e * 256 * 1024, 1024, 64 * kb, 32 * g, (us*)(ws + WS_WD), 256, e * 32 + g, scr, lane); }
        }
      }
    }
  }
  AMP_T1(PH_INPROJ); }
  { AMP_T0(); if (IN(PH_TOPK)) { PHASE_IDS();
    unsigned* ctl_ = (unsigned*)(ws + WS_CTL);
    if (threadIdx.x < 64) {
      unsigned sp = 0;
      while ((unsigned)__builtin_amdgcn_readfirstlane(__hip_atomic_load(ctl_ + CW_DEP, __ATOMIC_RELAXED, __HIP_MEMORY_SCOPE_AGENT)) < DEP_TARGET) { __builtin_amdgcn_s_sleep(2); if (++sp > (1u << 22)) break; }
      __builtin_amdgcn_fence(__ATOMIC_ACQUIRE, "agent");
      asm volatile("s_waitcnt vmcnt(0)" ::: "memory");
    }
    __syncthreads();
    topk_phase(lds, ws, tid_p, args.dup, amp_acc, MISC, 20, ctl_ + CW_TQ, 768, 255);
    conv_phase(lds, ws, args.in[4], args.in[5], args.in[6], args.in[7], tid_p, lane_p, wave_p, MISC, ctl_ + CW_TQ + 1);
    topk_phase(lds, ws, tid_p, args.dup, amp_acc, MISC, 22, ctl_ + CW_TQ + 2, 256, 63);
  }
  AMP_T1(PH_TOPK); }
  SEAM(PH_TOPK);
  { AMP_T0(); if (IN(PH_ATTN)) {
    attn_body::AttnTensors Tn{(const attn_body::bf16*)(ws + WS_Q), (const attn_body::bf16*)(ws + WS_K), (const attn_body::bf16*)(ws + WS_V),
                              (attn_body::bf16*)(ws + WS_AO), (const unsigned char*)(ws + WS_MW), (unsigned*)(ws + WS_CTL) + CW_ATTN};
    attn_body::attn_phase<8>((char*)lds_raw, Tn, G_, (int)blockIdx.x);
  }
  AMP_T1(PH_ATTN); }
  { AMP_T0(); if (IN(PH_MIX)) {
    us* M1 = (us*)(ws + WS_M1);
    DualOrder So; So.init(T, 1024, G_, (int)blockIdx.x); So.ready = (const unsigned*)(ws + WS_CTL) + CW_ATTN;
    pg8::Gemm g0{(const us*)(ws + WS_NA), WcoT, T, 1024, 512}, g1{(const us*)(ws + WS_AO), WaoT, T, 1024, 512};
    EpiGate2 E; E.gc = (const us*)(ws + WS_GC); E.ga = (const us*)(ws + WS_GA); E.M1 = M1;
    pg8::gemm_phase<EpiGate2, DualOrder, true, true>(lds, g0, So, E, g1);
  }
  AMP_T1(PH_MIX); }
  SEAM(PH_MIX);
  { AMP_T0(); if (IN(PH_WO)) {
    pg8::Gemm g{(const us*)(ws + WS_M1), WoT, T, 1024, 1024};
    pg8::StaticOrder So; So.init(T, 1024, G_, (int)blockIdx.x);
    EpiRes E; E.base = x; E.out = args.out;
    pg8::gemm_phase<EpiRes, pg8::StaticOrder, true, true>(lds, g, So, E);
  }
  AMP_T1(PH_WO); }
  SEAM(PH_WO);
  const unsigned long long tr0_ = AMP_ON ? __builtin_amdgcn_s_memrealtime() : 0ull;
  if (IN(PH_ROUTE)) { PHASE_IDS(); route_phase(lds, ws, args.out, args.in[11], args.in[12], args.in[13], args.in[14], args.in[15], tid_p, lane_p, wave_p, args.dup); }
  if (AMP_ON && ((args.dup >> 16) & 15) == 4) amp_acc += __builtin_amdgcn_s_memrealtime() - tr0_;
  SEAM(PH_ROUTE);
  { AMP_T0(); if (IN(PH_MOE1)) { PHASE_IDS(); moe_phase<0>(lds, ws, MISC, tid_p, args.dup); }
  AMP_T1(PH_MOE1); }
  SEAM(PH_MOE1);
  if (AMP_ON && ((args.dup >> 16) & 15) == 5) { for (int i_ = 0; i_ < 10; ++i_) xcd_barrier(bar); }
  { AMP_T0(); if (IN(PH_FINAL)) { PHASE_IDS(); final_phase(ws, args.out, args.in[19], lane_p, wave_p, args.dup); }
  AMP_T1(PH_FINAL); }
  if (AMP_ON && ((args.dup >> 16) & 15) && (int)blockIdx.x == ((args.dup >> 20) & 255)) { const unsigned long long t1 = __builtin_amdgcn_s_memrealtime(); while (__builtin_amdgcn_s_memrealtime() - t1 < 9ull * amp_acc) __builtin_amdgcn_s_sleep(8); }
}

constexpr int SHIP_MODE = 0;
constexpr int PROBE_MODE = 0;
constexpr int PROBE_K = -1;
extern "C" void kernel_launch(void* const* d_in, const int* in_sizes, int n_in, void* d_out, int out_size, void* d_ws, size_t ws_size,
                              hipStream_t stream) {
  static int grid = 0;
  if (grid == 0) {
    int dev = 0, cus = 0, per_cu = 0;
    hipGetDevice(&dev);
    hipDeviceGetAttribute(&cus, hipDeviceAttributeMultiprocessorCount, dev);
    hipFuncSetAttribute((const void*)mk_fwd, hipFuncAttributeMaxDynamicSharedMemorySize, LDS_BYTES);
    hipOccupancyMaxActiveBlocksPerMultiprocessor(&per_cu, (const void*)mk_fwd, 512, LDS_BYTES);
    if (per_cu < 1) { fprintf(stderr, "kernel_launch: occupancy query says %d blocks/CU\n", per_cu); per_cu = 1; }
    grid = cus;
  }
  hipMemsetAsync((char*)d_ws + WS_CTL, 0, CTL_ZERO_BYTES, stream);
  Args a{};
  for (int i = 0; i < 20; ++i) a.in[i] = (const float*)d_in[i];
  a.out = (float*)d_out; a.ws = (unsigned char*)d_ws;
  auto launch = [&](int lo, int hi, int li, int mode = 0) {
    a.ph_lo = lo; a.ph_hi = hi; a.li = li; a.dup = mode;
    void* kargs[] = {&a};
    hipError_t e = hipLaunchCooperativeKernel((const void*)mk_fwd, dim3(grid), dim3(512), kargs, LDS_BYTES, stream);
    if (e != hipSuccess) fprintf(stderr, "cooperative launch failed: %s (grid %d)\n", hipGetErrorString(e), grid);
  };
  if (PROBE_K == -1) launch(PH_PREP, PH_END, 0, SHIP_MODE);
  else if (PROBE_K == -2) { launch(PH_PREP, PH_ATTN, 0); launch(PH_ATTN, PH_MIX, 1); launch(PH_MIX, PH_END, 2); }
  else { int li = 0; if (PROBE_K > 0) launch(PH_PREP, PROBE_K, li++); launch(PROBE_K, PROBE_K + 1, li++, PROBE_MODE); if (PROBE_K == PH_MOE1) hipMemsetAsync((char*)d_ws + WS_CTL + 96 * 4, 0, (512 - 96) * 4, stream); launch(PROBE_K, PROBE_K + 1, li++); if (PROBE_K + 1 < PH_END) launch(PROBE_K + 1, PH_END, li++); }

}
```

```cpp
#include <hip/hip_runtime.h>
#include <hip/hip_bf16.h>
#include <stdint.h>
#include <cstdio>

typedef unsigned short us;

constexpr int D = 1024, NB = 4, S = 4096, T = NB * S;
constexpr int TOPK = 256;
constexpr float EPS = 1e-6f;
constexpr int OFF_U = 0, OFF_Q = 1024, OFF_K = 1536, OFF_V = 2048, OFF_QI = 2560, OFF_KI = 3072, OFF_WI = 3136,
              OFF_GC = 3144, OFF_GA = 4168, INC = 5192;
constexpr int NIN = 5376;
constexpr float QSCALE = 0.125f * 1.4426950408889634f;
constexpr float IDX_SCALE = 0.04419417382415922f;

__device__ __forceinline__ us f2bf_(float f) {
  unsigned u = __float_as_uint(f);
  u += 0x7FFFu + ((u >> 16) & 1u);
  return (us)(u >> 16);
}
__device__ __forceinline__ float bf2f(us h) { return __uint_as_float(((unsigned)h) << 16); }
__device__ __forceinline__ float sigmoidf_(float x) { return 1.0f / (1.0f + expf(-x)); }
__device__ __forceinline__ float fsigmoid(float x) { return __builtin_amdgcn_rcpf(1.0f + __builtin_amdgcn_exp2f(-1.4426950408889634f * x)); }

namespace pg8 {
#define PG8_LAS __attribute__((address_space(3)))
typedef unsigned short bf16_t;
typedef short bf16x8 __attribute__((ext_vector_type(8)));
typedef float f32x4 __attribute__((ext_vector_type(4)));
typedef unsigned u32x4 __attribute__((ext_vector_type(4)));
constexpr int BM = 256, BK = 64, HALF = 128, HTB = HALF * BK * 2  , STAGE_BYTES = 8 * HTB, NXCD = 8, WGM = 8;

__host__ __device__ __forceinline__ int lds_byte(int r, int c) { const int st = (r >> 4) * 2 + (c >> 5), rr = r & 15, cc = c & 31, ob = rr * 64 + cc * 2; return st * 1024 + (ob ^ (((ob >> 9) & 1) << 5)); }
__host__ __device__ __forceinline__ void stage_rc(int b, int& R, int& C) { const int st = b / 1024, sb = b % 1024, swz = sb ^ (((sb >> 9) & 1) << 5); R = (st >> 1) * 16 + swz / 64; C = (st & 1) * 32 + (swz % 64) / 2; }
__host__ __device__ __forceinline__ int perm32(int rho) { const int n = rho >> 4, i = rho & 15; return 8 * (i >> 2) + 4 * n + (i & 3); }

struct Unit { int pm, pn, sel; };
struct Gemm { const bf16_t* A; const bf16_t* Bt; int M, N, K; };

struct StaticOrder {
    int nM, nN, nwg, G, c;
    __host__ __device__ void init(int M, int N, int G_, int c_) { nM = M / BM; nN = N / BM; nwg = nM * nN; G = G_; c = c_; }
    __host__ __device__ bool next(int i, Unit& u) const {
        const long L = (long)i * G + c; if (L >= nwg) return false;
        int wgid = (int)L; { const int q = nwg / NXCD, r = nwg % NXCD, xcd = wgid % NXCD, off = wgid / NXCD; wgid = (xcd < r ? xcd * (q + 1) : r * (q + 1) + (xcd - r) * q) + off; }
        const int nig = WGM * nN, gid = wgid / nig, fm = gid * WGM, gsz = (nM - fm) < WGM ? (nM - fm) : WGM;
        u.pm = fm + ((wgid % nig) % gsz); u.pn = (wgid % nig) / gsz; u.sel = 0; return true;
    }
    __device__ __forceinline__ void a_ready(const Unit&) const {}
    __device__ __forceinline__ void done(const Unit&) const {}
};

__device__ __forceinline__ unsigned cvt_pk_bf16(float lo, float hi) { unsigned r; asm volatile("v_cvt_pk_bf16_f32 %0, %1, %2" : "=v"(r) : "v"(lo), "v"(hi)); return r; }
typedef float f32x2 __attribute__((ext_vector_type(2)));
__device__ __forceinline__ f32x2 gelu_pk(f32x2 v) {
    const f32x2 av = __builtin_elementwise_abs(v), d = av * 0.2316418882f + 1.0f;
    f32x2 t; t.x = __builtin_amdgcn_rcpf(d.x); t.y = __builtin_amdgcn_rcpf(d.y);
    f32x2 q = t * 0.5307027145f + (-0.7265760135f); q = q * t + 0.7107068705f; q = q * t + (-0.142248368f); q = q * t + 0.127414796f; q = q * t;
    const f32x2 s = (v * v) * (-0.72134752044f);
    f32x2 e; e.x = __builtin_amdgcn_exp2f(s.x); e.y = __builtin_amdgcn_exp2f(s.y);
    const f32x2 m = v * (q * e), r = v - m;
    f32x2 o; o.x = v.x < 0.f ? m.x : r.x; o.y = v.y < 0.f ? m.y : r.y; return o;
}

template <int ACT  > struct EpiBf16 {
    static constexpr bool PERM = true, AFTER_DRAIN = false, CHAIN = false; static_assert(ACT == 0 || ACT == 1, "EpiBf16: ACT is 0 (none) or 1 (gelu_pk)");
    bf16_t* O; int ldc; const float* bias; int split_cols; size_t split_stride; float scale0;
    __device__ __forceinline__ void operator()(const f32x4 (&acc)[2][2][4][2], const Unit& u, int wr, int wc, int fr, int fq) const {
        const int row0 = u.pm * BM + wr * 64 + fr; int colt = u.pn * BM; bf16_t* base = O;
        float sc = 1.f; if (split_cols) { const int t = colt / split_cols; base += (size_t)t * split_stride; colt -= t * split_cols; if (t == 0) sc = scale0; }
        const int col0 = colt + wc * 32 + 8 * fq, bcol0 = u.pn * BM + wc * 32 + 8 * fq;
        f32x4 bv[2][2];
#pragma unroll
        for (int bj = 0; bj < 2; ++bj)
#pragma unroll
            for (int n = 0; n < 2; ++n) bv[bj][n] = bias ? *(const f32x4*)(bias + bcol0 + bj * HALF + 4 * n) : (f32x4){0.f, 0.f, 0.f, 0.f};
#pragma unroll
        for (int ai = 0; ai < 2; ++ai)
#pragma unroll
            for (int m = 0; m < 4; ++m) { bf16_t* rowp = base + (size_t)(row0 + ai * HALF + m * 16) * ldc + col0;
#pragma unroll
                for (int bj = 0; bj < 2; ++bj) { f32x4 v0 = acc[ai][bj][m][0] + bv[bj][0], v1 = acc[ai][bj][m][1] + bv[bj][1];
                    if (ACT == 1) { f32x2 a = gelu_pk((f32x2){v0[0], v0[1]}), b = gelu_pk((f32x2){v0[2], v0[3]}), c = gelu_pk((f32x2){v1[0], v1[1]}), d = gelu_pk((f32x2){v1[2], v1[3]});
                        v0 = (f32x4){a.x, a.y, b.x, b.y}; v1 = (f32x4){c.x, c.y, d.x, d.y}; }
                    v0 = v0 * sc; v1 = v1 * sc; u32x4 w; w.x = cvt_pk_bf16(v0[0], v0[1]); w.y = cvt_pk_bf16(v0[2], v0[3]); w.z = cvt_pk_bf16(v1[0], v1[1]); w.w = cvt_pk_bf16(v1[2], v1[3]);
                    *(u32x4*)(rowp + bj * HALF) = w; } }
    }
};

struct PanelStats {
    unsigned* xbuf;
    unsigned* cnt;
    unsigned* tmo;
    int ntn; float eps;
    unsigned code;
    __device__ __forceinline__ bool run(const f32x4 (&v)[2][2][4][2], const Unit& u, int wr, int wc, int fr, int fq, PG8_LAS unsigned char* lds, int wid, int lane) const {
        typedef float f32x2v __attribute__((ext_vector_type(2)));
        PG8_LAS f32x2v* P = (PG8_LAS f32x2v*)lds;
        PG8_LAS f32x2v* S = (PG8_LAS f32x2v*)(lds + 8192);
        PG8_LAS unsigned* flag = (PG8_LAS unsigned*)(lds + 8192 + 2048);
#pragma unroll
        for (int ai = 0; ai < 2; ++ai)
#pragma unroll
            for (int m = 0; m < 4; ++m) {
                float s = 0.f;
#pragma unroll
                for (int bj = 0; bj < 2; ++bj)
#pragma unroll
                    for (int n = 0; n < 2; ++n) { const f32x4 x = v[ai][bj][m][n]; s += (x[0] + x[1]) + (x[2] + x[3]); }
                s += __shfl_xor(s, 16); s += __shfl_xor(s, 32);
                const float mw = s * (1.0f / 64.0f); float q = 0.f;
#pragma unroll
                for (int bj = 0; bj < 2; ++bj)
#pragma unroll
                    for (int n = 0; n < 2; ++n) { const f32x4 d = v[ai][bj][m][n] - mw; q += (d[0] * d[0] + d[1] * d[1]) + (d[2] * d[2] + d[3] * d[3]); }
                q += __shfl_xor(q, 16); q += __shfl_xor(q, 32);
                if (fq == 0) P[(ai * HALF + wr * 64 + m * 16 + fr) * 4 + wc] = (f32x2v){mw, q};
            }
        asm volatile("s_waitcnt lgkmcnt(0)" ::: "memory"); __builtin_amdgcn_s_barrier(); asm volatile("" ::: "memory");
#if defined(BROKEN_EXCHANGE_NO_WAIT)
#warning BROKEN CONTROL BUILD: the row-statistics exchange does not wait; results are wrong by design
        if (blockIdx.x >= 64) { const long long t0_ = clock64(); while (clock64() - t0_ < 60000) __builtin_amdgcn_s_sleep(8); }
#endif
        const int row = wid * 32 + (lane & 31);
        if (lane < 32) {
            const f32x2v a = P[row * 4 + 0], b = P[row * 4 + 1], c = P[row * 4 + 2], d = P[row * 4 + 3];
            const float mt = (a.x + b.x + c.x + d.x) * 0.25f;
            const float da = a.x - mt, db = b.x - mt, dc = c.x - mt, dd = d.x - mt;
            const float m2 = (a.y + b.y) + (c.y + d.y) + 64.0f * ((da * da + db * db) + (dc * dc + dd * dd));
            unsigned long long* slot = (unsigned long long*)xbuf + ((size_t)(u.pm * BM + row) * 4 + u.pn);
            __hip_atomic_store(slot, ((unsigned long long)__float_as_uint(m2) << 32) | __float_as_uint(mt), __ATOMIC_RELAXED, __HIP_MEMORY_SCOPE_AGENT);
        }
        asm volatile("s_waitcnt vmcnt(0)" ::: "memory");
        if (lane == 0) __hip_atomic_fetch_add(cnt + 64 * u.pm, 1u, __ATOMIC_RELAXED, __HIP_MEMORY_SCOPE_AGENT);
        if (wid == 0) {
            bool dead = false; const unsigned long long t0 = __builtin_amdgcn_s_memrealtime(); const unsigned want = 8u * (unsigned)ntn;
            for (;;) {
#if defined(BROKEN_EXCHANGE_NO_WAIT)
                break;
#endif
                if ((unsigned)__builtin_amdgcn_readfirstlane(__hip_atomic_load(cnt + 64 * u.pm, __ATOMIC_RELAXED, __HIP_MEMORY_SCOPE_AGENT)) >= want) break;
                if (__builtin_amdgcn_s_memrealtime() - t0 > 2000000ull) {
                    if (lane == 0) { unsigned expect = 0u; __hip_atomic_compare_exchange_strong(tmo + 1, &expect, code | (unsigned)(u.pm & 0xff), __ATOMIC_RELAXED, __ATOMIC_RELAXED, __HIP_MEMORY_SCOPE_AGENT);
                                     __hip_atomic_store(tmo, 1u, __ATOMIC_RELAXED, __HIP_MEMORY_SCOPE_AGENT); }
                    dead = true; break; }
                __builtin_amdgcn_s_sleep(2);
            }
            __builtin_amdgcn_fence(__ATOMIC_ACQUIRE, "agent");
            if (lane == 0) flag[0] = dead ? 1u : 0u;
        }
        asm volatile("s_waitcnt vmcnt(0) lgkmcnt(0)" ::: "memory"); __builtin_amdgcn_s_barrier(); asm volatile("" ::: "memory");
        const bool bad = flag[0] != 0u;
        if (lane < 32) {
            const unsigned long long* slot = (const unsigned long long*)xbuf + (size_t)(u.pm * BM + row) * 4; float mt[4], m2[4]; float ms = 0.f;
#pragma unroll
            for (int t = 0; t < 4; ++t) { if (t < ntn) { const unsigned long long w = __hip_atomic_load(slot + t, __ATOMIC_RELAXED, __HIP_MEMORY_SCOPE_AGENT); mt[t] = __uint_as_float((unsigned)w); m2[t] = __uint_as_float((unsigned)(w >> 32)); } else { mt[t] = 0.f; m2[t] = 0.f; } ms += mt[t]; }
            const float mean = ms / (float)ntn; float q = 0.f;
#pragma unroll
            for (int t = 0; t < 4; ++t) if (t < ntn) { const float dm = mt[t] - mean; q += m2[t] + 256.0f * dm * dm; }
            S[row] = (f32x2v){mean, 1.0f / sqrtf(q / (256.0f * (float)ntn) + eps)};
        }
        asm volatile("s_waitcnt lgkmcnt(0)" ::: "memory"); __builtin_amdgcn_s_barrier(); asm volatile("" ::: "memory");
        return bad;
    }
};
struct EpiLnRes {
    static constexpr bool PERM = false, AFTER_DRAIN = true, CHAIN = false;
    const float* base; float* out; int ldc; const float* bias; PanelStats st; unsigned poison;
    __device__ __forceinline__ void fused(f32x4 (&acc)[2][2][4][2], const Unit& u, int wr, int wc, int fr, int fq, PG8_LAS unsigned char* lds, int wid, int lane) const {
        typedef float f32x2v __attribute__((ext_vector_type(2)));
        const PG8_LAS f32x2v* S = (const PG8_LAS f32x2v*)(lds + 8192);
        const int col0 = u.pn * BM + wc * 32 + 4 * fq;
#pragma unroll
        for (int bj = 0; bj < 2; ++bj)
#pragma unroll
            for (int n = 0; n < 2; ++n) { const f32x4 bv = bias ? *(const f32x4*)(bias + col0 + bj * HALF + n * 16) : (f32x4){0.f, 0.f, 0.f, 0.f};
#pragma unroll
                for (int ai = 0; ai < 2; ++ai)
#pragma unroll
                    for (int m = 0; m < 4; ++m) acc[ai][bj][m][n] += bv; }
        f32x4 pre[4][2][2];
#pragma unroll
        for (int m = 0; m < 4; ++m) { const size_t off = (size_t)(u.pm * BM + wr * 64 + m * 16 + fr) * ldc + col0;
#pragma unroll
            for (int bj = 0; bj < 2; ++bj)
#pragma unroll
                for (int n = 0; n < 2; ++n) pre[m][bj][n] = *(const f32x4*)(base + off + bj * HALF + n * 16); }
        const bool bad = st.run(acc, u, wr, wc, fr, fq, lds, wid, lane) || poison != 0u;
        const float qnan = __builtin_nanf("");
#pragma unroll
        for (int ai = 0; ai < 2; ++ai)
#pragma unroll
            for (int m = 0; m < 4; ++m) { const int r = ai * HALF + wr * 64 + m * 16 + fr; const f32x2v sr = S[r]; const size_t off = (size_t)(u.pm * BM + r) * ldc + col0;
#pragma unroll
                for (int bj = 0; bj < 2; ++bj)
#pragma unroll
                    for (int n = 0; n < 2; ++n) { const f32x4 bs = ai == 0 ? pre[m][bj][n] : *(const f32x4*)(base + off + bj * HALF + n * 16); f32x4 o = bs + (acc[ai][bj][m][n] - sr.x) * sr.y;
                        if (bad) o = (f32x4){qnan, qnan, qnan, qnan}; *(f32x4*)(out + off + bj * HALF + n * 16) = o; }
                if (m & 1) asm volatile("" ::: "memory"); }
    }
};
struct EpiLnResLn {
    static constexpr bool PERM = false, AFTER_DRAIN = true, CHAIN = false;
    const float* base; float* out; bf16_t* xn; int ldc; const float* bias; PanelStats st1, st2; unsigned poison;
    __device__ __forceinline__ void fused(f32x4 (&acc)[2][2][4][2], const Unit& u, int wr, int wc, int fr, int fq, PG8_LAS unsigned char* lds, int wid, int lane) const {
        typedef float f32x2v __attribute__((ext_vector_type(2))); typedef unsigned u32x2v __attribute__((ext_vector_type(2)));
        const PG8_LAS f32x2v* S = (const PG8_LAS f32x2v*)(lds + 8192);
        const int col0 = u.pn * BM + wc * 32 + 4 * fq;
#pragma unroll
        for (int bj = 0; bj < 2; ++bj)
#pragma unroll
            for (int n = 0; n < 2; ++n) { const f32x4 bv = bias ? *(const f32x4*)(bias + col0 + bj * HALF + n * 16) : (f32x4){0.f, 0.f, 0.f, 0.f};
#pragma unroll
                for (int ai = 0; ai < 2; ++ai)
#pragma unroll
                    for (int m = 0; m < 4; ++m) acc[ai][bj][m][n] += bv; }
        bool bad = st1.run(acc, u, wr, wc, fr, fq, lds, wid, lane) || poison != 0u;
        const float qnan = __builtin_nanf("");
#pragma unroll
        for (int ai = 0; ai < 2; ++ai)
#pragma unroll
            for (int m = 0; m < 4; ++m) { const int r = ai * HALF + wr * 64 + m * 16 + fr; const f32x2v sr = S[r]; const size_t off = (size_t)(u.pm * BM + r) * ldc + col0;
#pragma unroll
                for (int bj = 0; bj < 2; ++bj)
#pragma unroll
                    for (int n = 0; n < 2; ++n) { const f32x4 bs = *(const f32x4*)(base + off + bj * HALF + n * 16); acc[ai][bj][m][n] = bs + (acc[ai][bj][m][n] - sr.x) * sr.y; }
                asm volatile("" : "+v"(acc[ai][0][m][0]), "+v"(acc[ai][0][m][1]), "+v"(acc[ai][1][m][0]), "+v"(acc[ai][1][m][1]));
                if (m & 1) asm volatile("" ::: "memory"); }
        const bool bad1 = bad;
        bad = st2.run(acc, u, wr, wc, fr, fq, lds, wid, lane) || bad;
#pragma unroll
        for (int ai = 0; ai < 2; ++ai)
#pragma unroll
            for (int m = 0; m < 4; ++m) { const int r = ai * HALF + wr * 64 + m * 16 + fr; const f32x2v sr = S[r]; const size_t off = (size_t)(u.pm * BM + r) * ldc + col0;
#pragma unroll
                for (int bj = 0; bj < 2; ++bj)
#pragma unroll
                    for (int n = 0; n < 2; ++n) { const f32x4 x1 = acc[ai][bj][m][n]; *(f32x4*)(out + off + bj * HALF + n * 16) = bad1 ? (f32x4){qnan, qnan, qnan, qnan} : x1;
                        const f32x4 o = (x1 - sr.x) * sr.y; u32x2v w; w.x = cvt_pk_bf16(o[0], o[1]); w.y = cvt_pk_bf16(o[2], o[3]);
                        if (bad) { w.x = 0x7fc07fc0u; w.y = 0x7fc07fc0u; } *(u32x2v*)(xn + off + bj * HALF + n * 16) = w; }
                asm volatile("" ::: "memory"); }
    }
};

template <class Epi, class Sched, bool ALIGN_EPI = false, bool SP2 = false>
__device__ __forceinline__ void gemm_phase(PG8_LAS unsigned char* lds, const Gemm g, const Sched& S, const Epi& E, const Gemm g1 = Gemm{nullptr, nullptr, 0, 0, 0}) {
    const int tid = threadIdx.x, wid = __builtin_amdgcn_readfirstlane(tid >> 6), lane = tid & 63, wr = wid >> 2, wc = wid & 3, fr = lane & 15, fq = lane >> 4;
    const int K = g.K, nt = K / BK;
    unsigned voffA[2], voffB[2];
#pragma unroll
    for (int i = 0; i < 2; ++i) { int R, C; stage_rc(tid * 16 + i * 8192, R, C); const int Rb = Epi::PERM ? ((R & ~31) + perm32(R & 31)) : R;
        voffA[i] = (unsigned)(R * K + C) * 2u; voffB[i] = (unsigned)(Rb * K + C) * 2u; }
    const size_t kstep = (size_t)(BK * 2);
    const size_t hstep = (size_t)HALF * K * 2;
    const size_t tstep = 2 * hstep;
    const unsigned ldsw = (unsigned)wid * 1024u;
    const int aoff = lds_byte(wr * 64 + fr, fq * 8), boff = lds_byte(wc * 32 + fr, fq * 8);
#define PG8_SA(b, h) (((b) * 2 + (h)) * HTB)
#define PG8_SB(b, h) ((4 + (b) * 2 + (h)) * HTB)
#define PG8_STAGE(bufoff, gbase, voff) do { _Pragma("unroll") for (int _i = 0; _i < 2; ++_i) \
        __builtin_amdgcn_global_load_lds((const unsigned*)((const char*)(gbase) + (voff)[_i]), (PG8_LAS unsigned*)(lds + (bufoff) + ldsw + _i * 8192), 16, 0, 0); } while (0)
#define PG8_LDA(dst, b, h) do { _Pragma("unroll") for (int m = 0; m < 4; ++m) _Pragma("unroll") for (int k = 0; k < 2; ++k) dst[m][k] = *(const PG8_LAS bf16x8*)(lds + PG8_SA(b, h) + aoff + m * 2048 + k * 1024); } while (0)
#define PG8_LDB(dst, b, h) do { _Pragma("unroll") for (int n = 0; n < 2; ++n) _Pragma("unroll") for (int k = 0; k < 2; ++k) dst[n][k] = *(const PG8_LAS bf16x8*)(lds + PG8_SB(b, h) + boff + n * 2048 + k * 1024); } while (0)
#define PG8_MMA(ai, bj, At, Bt) do { __builtin_amdgcn_s_setprio(1); _Pragma("unroll") for (int m = 0; m < 4; ++m) _Pragma("unroll") for (int n = 0; n < 2; ++n) _Pragma("unroll") for (int k = 0; k < 2; ++k) \
        acc[ai][bj][m][n] = __builtin_amdgcn_mfma_f32_16x16x32_bf16(Bt[n][k], At[m][k], acc[ai][bj][m][n], 0, 0, 0); __builtin_amdgcn_s_setprio(0); } while (0)
#define PG8_WAIT_V(n) asm volatile("s_waitcnt vmcnt(" #n ")" ::: "memory")
#define PG8_WAIT_L(n) asm volatile("s_waitcnt lgkmcnt(" #n ")" ::: "memory")
#define PG8_BAR __builtin_amdgcn_s_barrier()
#define PG8_SCHED __builtin_amdgcn_sched_barrier(0)
    Unit cur, nxt; int ui = 0;
    if (!S.next(0, cur)) return;
    f32x4 acc[2][2][4][2];
#pragma unroll
    for (int a = 0; a < 2; ++a)
#pragma unroll
        for (int b = 0; b < 2; ++b)
#pragma unroll
            for (int m = 0; m < 4; ++m)
#pragma unroll
                for (int n = 0; n < 2; ++n) acc[a][b][m][n] = (f32x4){0.f, 0.f, 0.f, 0.f};
    bf16x8 At[4][2], B0[2][2], B1[2][2];
    const char* cA = (const char*)(cur.sel ? g1.A : g.A) + (size_t)cur.pm * tstep; const char* cB = (const char*)(cur.sel ? g1.Bt : g.Bt) + (size_t)cur.pn * tstep;
    S.a_ready(cur);
    if constexpr (SP2) {
        PG8_STAGE(PG8_SB(0, 0), cB, voffB); PG8_STAGE(PG8_SB(0, 1), cB + hstep, voffB); PG8_STAGE(PG8_SA(0, 0), cA, voffA); PG8_STAGE(PG8_SA(0, 1), cA + hstep, voffA);
        if (wr == 1) PG8_BAR;
        PG8_WAIT_V(2); PG8_BAR;
        PG8_STAGE(PG8_SB(1, 0), cB + kstep, voffB); PG8_STAGE(PG8_SA(1, 0), cA + kstep, voffA); PG8_STAGE(PG8_SB(1, 1), cB + hstep + kstep, voffB);
        PG8_WAIT_V(6); PG8_BAR;
    } else {
        PG8_STAGE(PG8_SB(0, 0), cB, voffB); PG8_STAGE(PG8_SA(0, 0), cA, voffA); PG8_STAGE(PG8_SB(0, 1), cB + hstep, voffB); PG8_STAGE(PG8_SA(0, 1), cA + hstep, voffA);
        if (wr == 1) PG8_BAR;
        PG8_WAIT_V(4); PG8_BAR;
        PG8_STAGE(PG8_SB(1, 0), cB + kstep, voffB); PG8_STAGE(PG8_SA(1, 0), cA + kstep, voffA); PG8_STAGE(PG8_SB(1, 1), cB + hstep + kstep, voffB);
        PG8_WAIT_V(6); PG8_BAR;
    }
    for (;;) {
        const bool has_next = S.next(ui + 1, nxt);
        const char* nA = has_next ? (const char*)(nxt.sel ? g1.A : g.A) + (size_t)nxt.pm * tstep : cA; const char* nB = has_next ? (const char*)(nxt.sel ? g1.Bt : g.Bt) + (size_t)nxt.pn * tstep : cB;
        for (int t = 0; t < nt; t += 2) {
            const bool last = (t == nt - 2);
            const char* a1 = cA + (size_t)(t + 1) * kstep;
            const char* a2 = last ? nA : cA + (size_t)(t + 2) * kstep; const char* b2 = last ? nB : cB + (size_t)(t + 2) * kstep;
            const char* a3 = a2 + kstep; const char* b3 = b2 + kstep;
            if (last && has_next) S.a_ready(nxt);
            if constexpr (SP2) {
            PG8_LDB(B0, 0, 0); PG8_LDB(B1, 0, 1); PG8_SCHED; PG8_LDA(At, 0, 0); PG8_STAGE(PG8_SA(1, 1), a1 + hstep, voffA);
            PG8_WAIT_V(8); PG8_WAIT_L(0); PG8_BAR; PG8_MMA(0, 0, At, B0); PG8_MMA(0, 1, At, B1); PG8_BAR; PG8_SCHED;
            PG8_LDA(At, 0, 1); PG8_STAGE(PG8_SB(0, 0), b2, voffB); PG8_STAGE(PG8_SB(0, 1), b2 + hstep, voffB); PG8_STAGE(PG8_SA(0, 0), a2, voffA);
            PG8_WAIT_V(8); PG8_WAIT_L(0); PG8_BAR; PG8_MMA(1, 0, At, B0); PG8_MMA(1, 1, At, B1); PG8_BAR; PG8_SCHED;
            PG8_LDB(B0, 1, 0); PG8_LDB(B1, 1, 1); PG8_SCHED; PG8_LDA(At, 1, 0); PG8_STAGE(PG8_SA(0, 1), a2 + hstep, voffA);
            PG8_WAIT_V(8); PG8_WAIT_L(0); PG8_BAR; PG8_MMA(0, 0, At, B0); PG8_MMA(0, 1, At, B1); PG8_BAR; PG8_SCHED;
            PG8_LDA(At, 1, 1); PG8_STAGE(PG8_SB(1, 0), b3, voffB); PG8_STAGE(PG8_SB(1, 1), b3 + hstep, voffB); PG8_STAGE(PG8_SA(1, 0), a3, voffA);
            PG8_WAIT_V(8); PG8_WAIT_L(0); PG8_BAR; PG8_MMA(1, 0, At, B0); PG8_MMA(1, 1, At, B1); PG8_BAR; PG8_SCHED;
            } else {
            PG8_LDB(B0, 0, 0); PG8_SCHED; PG8_LDA(At, 0, 0); PG8_STAGE(PG8_SA(1, 1), a1 + hstep, voffA);
            PG8_WAIT_L(8); PG8_BAR; PG8_WAIT_L(0); PG8_MMA(0, 0, At, B0); PG8_BAR; PG8_SCHED;
            PG8_LDB(B1, 0, 1); PG8_STAGE(PG8_SB(0, 0), b2, voffB);
            PG8_BAR; PG8_WAIT_L(0); PG8_MMA(0, 1, At, B1); PG8_BAR;
            PG8_LDA(At, 0, 1); PG8_STAGE(PG8_SA(0, 0), a2, voffA);
            PG8_BAR; PG8_WAIT_L(0); PG8_MMA(1, 0, At, B0); PG8_BAR; PG8_SCHED;
            PG8_STAGE(PG8_SB(0, 1), b2 + hstep, voffB);
            PG8_WAIT_V(6); PG8_BAR; PG8_MMA(1, 1, At, B1); PG8_BAR;
            PG8_LDB(B0, 1, 0); PG8_SCHED; PG8_LDA(At, 1, 0); PG8_STAGE(PG8_SA(0, 1), a2 + hstep, voffA);
            PG8_WAIT_L(8); PG8_BAR; PG8_WAIT_L(0); PG8_MMA(0, 0, At, B0); PG8_BAR; PG8_SCHED;
            PG8_LDB(B1, 1, 1); PG8_STAGE(PG8_SB(1, 0), b3, voffB);
            PG8_BAR; PG8_WAIT_L(0); PG8_MMA(0, 1, At, B1); PG8_BAR;
            PG8_LDA(At, 1, 1); PG8_STAGE(PG8_SA(1, 0), a3, voffA);
            PG8_BAR; PG8_WAIT_L(0); PG8_MMA(1, 0, At, B0); PG8_BAR; PG8_SCHED;
            PG8_STAGE(PG8_SB(1, 1), b3 + hstep, voffB);
            PG8_WAIT_V(6); PG8_BAR; PG8_MMA(1, 1, At, B1); PG8_BAR;
            }
        }
        if constexpr (ALIGN_EPI) { if (wr == 0) PG8_BAR; }
        bool keep_acc = false;
        if constexpr (Epi::CHAIN) { keep_acc = E.chain(acc, cur, wr, wc, fr, fq); }
        if constexpr (!Epi::AFTER_DRAIN) { if (!keep_acc) { E(acc, cur, wr, wc, fr, fq); } S.done(cur); }
        if (!has_next) break;
        if (!keep_acc) {
#pragma unroll
        for (int a = 0; a < 2; ++a)
#pragma unroll
            for (int b = 0; b < 2; ++b)
#pragma unroll
                for (int m = 0; m < 4; ++m)
#pragma unroll
                    for (int n = 0; n < 2; ++n) acc[a][b][m][n] = (f32x4){0.f, 0.f, 0.f, 0.f};
        }
        cur = nxt; cA = nA; cB = nB; ++ui;
        if constexpr (ALIGN_EPI) { if (wr == 1) PG8_BAR; }
    }
    PG8_WAIT_V(0);
    if constexpr (!ALIGN_EPI) { if (wr == 0) PG8_BAR; }
    PG8_BAR;
    if constexpr (Epi::AFTER_DRAIN) { E.fused(acc, cur, wr, wc, fr, fq, lds, wid, lane); S.done(cur); }
#undef PG8_SA
#undef PG8_SB
#undef PG8_STAGE
#undef PG8_LDA
#undef PG8_LDB
#undef PG8_MMA
#undef PG8_WAIT_V
#undef PG8_WAIT_L
#undef PG8_BAR
#undef PG8_SCHED
}
}

#define GAS __attribute__((address_space(1)))
#define LAS __attribute__((address_space(3)))
typedef unsigned v4u __attribute__((ext_vector_type(4)));
typedef float f32x4 __attribute__((ext_vector_type(4)));
typedef short bf16x8 __attribute__((ext_vector_type(8)));
typedef GAS unsigned gu32;
typedef GAS unsigned long long gu64;
#define RLX_AGENT __ATOMIC_RELAXED, __HIP_MEMORY_SCOPE_AGENT
#define LDS_WAIT() asm volatile("s_waitcnt lgkmcnt(0)" ::: "memory")
#define VM_WAIT() asm volatile("s_waitcnt vmcnt(0)" ::: "memory")
__device__ __forceinline__ unsigned f2bf(float f) { unsigned u = __builtin_bit_cast(unsigned, f); return (u + 0x7fffu + ((u >> 16) & 1u)) >> 16; }
__device__ __forceinline__ unsigned pk2(float lo, float hi) { return f2bf(lo) | (f2bf(hi) << 16); }
__device__ __forceinline__ float wave_sum(float v) {
#pragma unroll
  for (int o = 1; o < 64; o <<= 1) v += __shfl_xor(v, o);
  return v;
}
__device__ __forceinline__ float wave_sum_dpp(float v) {
  v += __builtin_bit_cast(float, __builtin_amdgcn_update_dpp(0, __builtin_bit_cast(int, v), 0xB1, 0xF, 0xF, true));
  v += __builtin_bit_cast(float, __builtin_amdgcn_update_dpp(0, __builtin_bit_cast(int, v), 0x4E, 0xF, 0xF, true));
  v += __builtin_bit_cast(float, __builtin_amdgcn_update_dpp(0, __builtin_bit_cast(int, v), 0x141, 0xF, 0xF, true));
  v += __builtin_bit_cast(float, __builtin_amdgcn_update_dpp(0, __builtin_bit_cast(int, v), 0x140, 0xF, 0xF, true));
  v += __builtin_bit_cast(float, __builtin_amdgcn_update_dpp(0, __builtin_bit_cast(int, v), 0x142, 0xA, 0xF, true));
  v += __builtin_bit_cast(float, __builtin_amdgcn_update_dpp(0, __builtin_bit_cast(int, v), 0x143, 0xC, 0xF, true));
  return __builtin_bit_cast(float, __builtin_amdgcn_readlane(__builtin_bit_cast(int, v), 63));
}

#define XB_TMO      128
#define XB_XCNT(j)  (256  + 64 * (j))
#define XB_XSUB(j)  (1280 + 64 * (j))
#define XB_XGEN(j)  (2304 + 64 * (j))
#define XB_TOP      3328
#define XB_TOPGEN   3392
#define XCD_BAR_WORDS 3456
#define XB_SPIN_CAP (1u << 18)

__device__ __forceinline__ unsigned xb_ld(unsigned* p)              { return __hip_atomic_load(p, __ATOMIC_RELAXED, __HIP_MEMORY_SCOPE_AGENT); }
__device__ __forceinline__ unsigned xb_add(unsigned* p, unsigned v) { return __hip_atomic_fetch_add(p, v, __ATOMIC_RELAXED, __HIP_MEMORY_SCOPE_AGENT); }
__device__ __forceinline__ unsigned xb_xcc_id() { return (unsigned)__builtin_amdgcn_s_getreg((3 << 11) | 20) & 0xFu; }
#define XB_SPIN(cond, bar) do { unsigned _sp = 0; while (cond) { __builtin_amdgcn_s_sleep(1); \
    if ((++_sp & 255u) == 0u) { if (xb_ld(&(bar)[XB_TMO])) break; if (_sp > XB_SPIN_CAP) { atomicAdd(&(bar)[XB_TMO], 1u); break; } } } } while (0)

struct XcdBarrier {
    unsigned* bar; unsigned x;
    volatile LAS unsigned* st;
};

__device__ __forceinline__ XcdBarrier xcd_barrier_post(unsigned* bar, volatile LAS unsigned* st) {
    XcdBarrier b; b.bar = bar; b.x = xb_xcc_id(); b.st = st;
    if (threadIdx.x == 0) (void)xb_add(&bar[XB_XCNT(b.x)], 1u);
    return b;
}
__device__ __forceinline__ void xcd_barrier_complete(unsigned* bar, unsigned x, unsigned& nloc, unsigned& nx) {
    const unsigned G = gridDim.x * gridDim.y * gridDim.z;
    unsigned sum, cnt, mine, sp = 0u;
    for (;;) {
        sum = 0u; cnt = 0u; mine = 0u;
#pragma unroll
        for (unsigned j = 0; j < 16; ++j) { const unsigned c = xb_ld(&bar[XB_XCNT(j)]); sum += c; cnt += (c > 0u) ? 1u : 0u; mine = (j == x) ? c : mine; }
        if (sum == G) break;
        __builtin_amdgcn_s_sleep(1);
        if ((++sp & 255u) == 0u) { if (xb_ld(&bar[XB_TMO])) break; if (sp > XB_SPIN_CAP) { atomicAdd(&bar[XB_TMO], 1u); break; } }
    }
    nloc = mine > 0u ? mine : 1u; nx = cnt > 0u ? cnt : 1u;
}

__device__ __forceinline__ void xcd_barrier(const XcdBarrier& b) {
    asm volatile("s_waitcnt vmcnt(0)" ::: "memory");
    __syncthreads();
    if (threadIdx.x == 0) {
        unsigned* bar = b.bar;
        __builtin_amdgcn_s_waitcnt(0);
        unsigned nloc = b.st[0], nx = b.st[1];
        if (nloc == 0u) { xcd_barrier_complete(bar, b.x, nloc, nx); b.st[0] = nloc; b.st[1] = nx; }
        const unsigned old = xb_add(&bar[XB_XSUB(b.x)], 1u);
        const unsigned gen = old / nloc;
        if (old + 1u == (gen + 1u) * nloc) {
            __builtin_amdgcn_fence(__ATOMIC_RELEASE, "agent");
            asm volatile("s_waitcnt vmcnt(0)" ::: "memory");
            const unsigned og = xb_add(&bar[XB_TOP], 1u);
            const unsigned tg = og / nx;
            if (og + 1u == (tg + 1u) * nx) xb_add(&bar[XB_TOPGEN], 1u);
            else XB_SPIN(xb_ld(&bar[XB_TOPGEN]) == tg, bar);
            __builtin_amdgcn_fence(__ATOMIC_ACQUIRE, "agent");
            xb_add(&bar[XB_XGEN(b.x)], 1u);
            asm volatile("s_waitcnt vmcnt(0)" ::: "memory");
        } else {
            XB_SPIN(xb_ld(&bar[XB_XGEN(b.x)]) == gen, bar);
            __builtin_amdgcn_fence(__ATOMIC_ACQUIRE, "agent");
            asm volatile("s_waitcnt vmcnt(0)" ::: "memory");
        }
    }
    __syncthreads();
}


namespace sg {
typedef float f32x16 __attribute__((ext_vector_type(16)));
constexpr int BM = 128, BN = 256, BK = 64, RS = 144;
constexpr int A_BYTES = BM * RS;
__device__ __forceinline__ int crow(int r, int hi) { return (r & 3) + 8 * (r >> 2) + 4 * hi; }
template <class Epi>
__device__ __forceinline__ void tile(LAS unsigned char* lds, const us* const (&ap)[2], const us* bf0, const us* bf1, int K, const Epi& E, int tid) {
  const int lane = tid & 63, wave = __builtin_amdgcn_readfirstlane(tid >> 6), wm = wave >> 2, wn = wave & 3;
  const int r32 = lane & 31, hi = lane >> 5;
  f32x16 acc[2][2];
#pragma unroll
  for (int a = 0; a < 2; ++a)
#pragma unroll
    for (int b = 0; b < 2; ++b)
#pragma unroll
      for (int r = 0; r < 16; ++r) acc[a][b][r] = 0.f;
  v4u ra0[2], ra1[2];
  bf16x8 bq[2][4];
  unsigned wa[2];
#pragma unroll
  for (int i = 0; i < 2; ++i) { const int c = tid + 512 * i; wa[i] = (unsigned)((c >> 3) * RS + (c & 7) * 16); }
  const unsigned aoff = (unsigned)((wm * 64 + r32) * RS + hi * 16);
  const int nk = K / BK;
#define SG_LOADA(RA, kt_) do { const int kc_ = (kt_) < nk ? (kt_) : nk - 1; \
    _Pragma("unroll") for (int i = 0; i < 2; ++i) RA[i] = *(const v4u*)(ap[i] + kc_ * BK); } while (0)
#define SG_LOADB1(ks, kt_) do { const int kc_ = (kt_) < nk ? (kt_) : nk - 1; \
    bq[0][ks] = *(const bf16x8*)(bf0 + (size_t)(kc_ * 4 + (ks)) * 512); bq[1][ks] = *(const bf16x8*)(bf1 + (size_t)(kc_ * 4 + (ks)) * 512); } while (0)
#define SG_WRITEA(RA, bufoff) do { \
    _Pragma("unroll") for (int i = 0; i < 2; ++i) *(LAS v4u*)(lds + (bufoff) + wa[i]) = RA[i]; } while (0)
#define SG_COMPUTE(bufoff, ktn_) do { \
    _Pragma("unroll") for (int ks = 0; ks < 4; ++ks) { \
      bf16x8 af[2]; \
      _Pragma("unroll") for (int m = 0; m < 2; ++m) af[m] = *(const LAS bf16x8*)(lds + (bufoff) + aoff + m * 32 * RS + ks * 32); \
      _Pragma("unroll") for (int h = 0; h < 2; ++h) \
        _Pragma("unroll") for (int m = 0; m < 2; ++m) acc[h][m] = __builtin_amdgcn_mfma_f32_32x32x16_bf16(bq[h][ks], af[m], acc[h][m], 0, 0, 0); \
      SG_LOADB1(ks, ktn_); } } while (0)
  SG_LOADA(ra0, 0);
#pragma unroll
  for (int ks = 0; ks < 4; ++ks) SG_LOADB1(ks, 0);
  SG_LOADA(ra1, 1);
  SG_WRITEA(ra0, 0);
  __syncthreads();
  for (int kt = 0; kt < nk; kt += 2) {
    SG_LOADA(ra0, kt + 2);
    SG_COMPUTE(0, kt + 1);
    SG_WRITEA(ra1, A_BYTES);
    __syncthreads();
    SG_LOADA(ra1, kt + 3);
    SG_COMPUTE(A_BYTES, kt + 2);
    SG_WRITEA(ra0, 0);
    __syncthreads();
  }
#undef SG_LOADA
#undef SG_LOADB1
#undef SG_WRITEA
#undef SG_COMPUTE
  E(acc, wm, wn, r32, hi);
}
template <class Epi>
__device__ __forceinline__ void tile_wide(LAS unsigned char* lds, const us* const (&ap)[2], const us* bf0, const us* bf1, int K, const Epi& E, int tid) {
  const int lane = tid & 63, wave = __builtin_amdgcn_readfirstlane(tid >> 6);
  const int r32 = lane & 31, hi = lane >> 5;
  f32x16 acc[2][4];
#pragma unroll
  for (int a = 0; a < 2; ++a)
#pragma unroll
    for (int b = 0; b < 4; ++b)
#pragma unroll
      for (int r = 0; r < 16; ++r) acc[a][b][r] = 0.f;
  v4u ra0[2];
  bf16x8 bq[2][4];
  unsigned wa[2];
#pragma unroll
  for (int i = 0; i < 2; ++i) { const int c = tid + 512 * i; wa[i] = (unsigned)((c >> 3) * RS + (c & 7) * 16); }
  const unsigned aoff = (unsigned)(r32 * RS + hi * 16);
  const int nk = K / BK;
#define SGW_LOADA(RA, kt_) do { const int kc_ = (kt_) < nk ? (kt_) : nk - 1; \
    _Pragma("unroll") for (int i = 0; i < 2; ++i) RA[i] = *(const v4u*)(ap[i] + kc_ * BK); } while (0)
#define SGW_LOADB1(ks, kt_) do { const int kc_ = (kt_) < nk ? (kt_) : nk - 1; \
    bq[0][ks] = *(const bf16x8*)(bf0 + (size_t)(kc_ * 4 + (ks)) * 512); bq[1][ks] = *(const bf16x8*)(bf1 + (size_t)(kc_ * 4 + (ks)) * 512); } while (0)
#define SGW_WRITEA(RA, bufoff) do { \
    _Pragma("unroll") for (int i = 0; i < 2; ++i) *(LAS v4u*)(lds + (bufoff) + wa[i]) = RA[i]; } while (0)
#define SGW_LDA(dst, bufoff, ks) do { _Pragma("unroll") for (int m = 0; m < 4; ++m) dst[m] = *(const LAS bf16x8*)(lds + (bufoff) + aoff + m * 32 * RS + (ks) * 32); } while (0)
#define SGW_MMA(afr, ks, ktn_) do { \
      _Pragma("unroll") for (int h = 0; h < 2; ++h) \
        _Pragma("unroll") for (int m = 0; m < 4; ++m) acc[h][m] = __builtin_amdgcn_mfma_f32_32x32x16_bf16(bq[h][ks], afr[m], acc[h][m], 0, 0, 0); \
      SGW_LOADB1(ks, ktn_); __builtin_amdgcn_sched_barrier(0); } while (0)
#define SGW_COMPUTE(bufoff, ktn_) do { bf16x8 afA[4], afB[4]; \
    SGW_LDA(afA, bufoff, 0); \
    SGW_LDA(afB, bufoff, 1); SGW_MMA(afA, 0, ktn_); \
    SGW_LDA(afA, bufoff, 2); SGW_MMA(afB, 1, ktn_); \
    SGW_LDA(afB, bufoff, 3); SGW_MMA(afA, 2, ktn_); \
    SGW_MMA(afB, 3, ktn_); } while (0)
  SGW_LOADA(ra0, 0);
#pragma unroll
  for (int ks = 0; ks < 4; ++ks) SGW_LOADB1(ks, 0);
  SGW_WRITEA(ra0, 0);
  __syncthreads();
  for (int kt = 0; kt < nk; kt += 2) {
    SGW_LOADA(ra0, kt + 1); __builtin_amdgcn_sched_barrier(0);
    SGW_COMPUTE(0, kt + 1);
    SGW_WRITEA(ra0, A_BYTES);
    __syncthreads();
    SGW_LOADA(ra0, kt + 2); __builtin_amdgcn_sched_barrier(0);
    SGW_COMPUTE(A_BYTES, kt + 2);
    SGW_WRITEA(ra0, 0);
    __syncthreads();
  }
#undef SGW_LOADA
#undef SGW_LOADB1
#undef SGW_WRITEA
#undef SGW_COMPUTE
#undef SGW_LDA
#undef SGW_MMA
  E(acc, wave, r32, hi);
}
constexpr int ARS = 528;
template <class Epi>
__device__ __forceinline__ void tile_resident(LAS unsigned char* lds, const us* bf0, const us* bf1, const Epi& E, int tid) {
  const int lane = tid & 63, wave = __builtin_amdgcn_readfirstlane(tid >> 6), wm = wave >> 2, wn = wave & 3;
  const int r32 = lane & 31, hi = lane >> 5;
  f32x16 acc[2][2];
#pragma unroll
  for (int a = 0; a < 2; ++a)
#pragma unroll
    for (int b = 0; b < 2; ++b)
#pragma unroll
      for (int r = 0; r < 16; ++r) acc[a][b][r] = 0.f;
  bf16x8 bq[2][4];
  const unsigned aoff = (unsigned)((wm * 64 + r32) * ARS + hi * 16);
#define SGR_LOADB1(ks, kc_) do { bq[0][ks] = *(const bf16x8*)(bf0 + (size_t)((kc_) * 4 + (ks)) * 512); bq[1][ks] = *(const bf16x8*)(bf1 + (size_t)((kc_) * 4 + (ks)) * 512); } while (0)
#pragma unroll
  for (int ks = 0; ks < 4; ++ks) SGR_LOADB1(ks, 0);
  bf16x8 afA[2], afB[2];
#define SGR_LDA(dst, st_) do { _Pragma("unroll") for (int m = 0; m < 2; ++m) dst[m] = *(const LAS bf16x8*)(lds + aoff + m * 32 * ARS + (st_) * 32); } while (0)
#define SGR_MMA(afr, st_) do { \
      _Pragma("unroll") for (int h = 0; h < 2; ++h) \
        _Pragma("unroll") for (int m = 0; m < 2; ++m) acc[h][m] = __builtin_amdgcn_mfma_f32_32x32x16_bf16(bq[h][(st_) & 3], afr[m], acc[h][m], 0, 0, 0); \
      if ((st_) < 12) SGR_LOADB1((st_) & 3, ((st_) >> 2) + 1); \
      __builtin_amdgcn_sched_barrier(0); } while (0)
  SGR_LDA(afA, 0);
#pragma unroll
  for (int st = 0; st < 16; st += 2) {
    SGR_LDA(afB, st + 1); SGR_MMA(afA, st);
    if (st + 2 < 16) SGR_LDA(afA, st + 2);
    SGR_MMA(afB, st + 1);
  }
#undef SGR_LDA
#undef SGR_MMA
#undef SGR_LOADB1
  E(acc, wm, wn, r32, hi);
}
}

constexpr size_t MiB = 1u << 20;
constexpr size_t WS_CTL = 0, CTL_ZERO_BYTES = 64 * 1024;
constexpr int CW_BAR = 1024;
constexpr size_t WS_WIN = 1 * MiB;
constexpr size_t WS_WCO = 12 * MiB;
constexpr size_t WS_WAO = 13 * MiB;
constexpr size_t WS_WO = 14 * MiB;
constexpr size_t WS_CT = 16 * MiB, WS_ST = 18 * MiB;
constexpr size_t WS_KI = 20 * MiB;
constexpr size_t WS_WI = 22 * MiB;
constexpr size_t WS_HB = 24 * MiB;
constexpr size_t WS_G = 56 * MiB;
constexpr size_t WS_QI = 72 * MiB, WS_K = 88 * MiB, WS_V = 104 * MiB, WS_Q = 120 * MiB;
constexpr size_t WS_GC = 136 * MiB, WS_GA = 168 * MiB;
constexpr size_t WS_NA = 200 * MiB, WS_AO = 216 * MiB;
constexpr size_t WS_M1 = 56 * MiB;
constexpr int CW_ATTN = 512;
constexpr size_t WS_Y1 = 88 * MiB;
constexpr size_t WS_X1B = 168 * MiB;
constexpr size_t WS_END = 232 * MiB;

constexpr int LDS_BYTES = 147456;
constexpr int MISC_OFF = LDS_BYTES - 256;

constexpr bool AMP_ON = false;
struct Args {
  const float* in[20];
  float* out;
  unsigned char* ws;
  int ph_lo, ph_hi, li, dup;
};
enum { PH_PREP = 0, PH_INPROJ = 1, PH_CONV = 2, PH_TOPK = 3, PH_ATTN = 4, PH_MIX = 5, PH_WO = 6, PH_ROUTE = 7, PH_MOE1 = 8, PH_MOE2 = 9, PH_FINAL = 10, PH_END = 11 };

constexpr int CW_M1 = 576, CW_X1 = 640;
template <bool ACCUM> struct EpiGate {
  static constexpr bool PERM = true, AFTER_DRAIN = false, CHAIN = false;
  const us* gate; us* M1;
  __device__ __forceinline__ void operator()(const pg8::f32x4 (&acc)[2][2][4][2], const pg8::Unit& u, int wr, int wc, int fr, int fq) const {
    const int row0 = u.pm * 256 + wr * 64 + fr, col0 = u.pn * 256 + wc * 32 + 8 * fq;
#pragma unroll
    for (int ai = 0; ai < 2; ++ai)
#pragma unroll
      for (int mh = 0; mh < 2; ++mh) {
        v4u gw[2][2], pw[2][2];
#pragma unroll
        for (int mm = 0; mm < 2; ++mm)
#pragma unroll
          for (int bj = 0; bj < 2; ++bj) {
            const size_t off = (size_t)(row0 + ai * 128 + (2 * mh + mm) * 16) * 1024 + col0 + bj * 128;
            gw[mm][bj] = *(const v4u*)(gate + off);
            if (ACCUM) pw[mm][bj] = *(const v4u*)(M1 + off);
          }
        __builtin_amdgcn_sched_barrier(0);
#pragma unroll
        for (int mm = 0; mm < 2; ++mm)
#pragma unroll
          for (int bj = 0; bj < 2; ++bj) {
            const int m = 2 * mh + mm;
            const size_t off = (size_t)(row0 + ai * 128 + m * 16) * 1024 + col0 + bj * 128;
            const v4u g = gw[mm][bj];
            const f32x4 v0 = acc[ai][bj][m][0], v1 = acc[ai][bj][m][1];
            float o[8];
            o[0] = __uint_as_float(g.x << 16) * v0[0]; o[1] = __uint_as_float(g.x & 0xffff0000u) * v0[1];
            o[2] = __uint_as_float(g.y << 16) * v0[2]; o[3] = __uint_as_float(g.y & 0xffff0000u) * v0[3];
            o[4] = __uint_as_float(g.z << 16) * v1[0]; o[5] = __uint_as_float(g.z & 0xffff0000u) * v1[1];
            o[6] = __uint_as_float(g.w << 16) * v1[2]; o[7] = __uint_as_float(g.w & 0xffff0000u) * v1[3];
            if (ACCUM) {
              const v4u p = pw[mm][bj];
              o[0] += __uint_as_float(p.x << 16); o[1] += __uint_as_float(p.x & 0xffff0000u);
              o[2] += __uint_as_float(p.y << 16); o[3] += __uint_as_float(p.y & 0xffff0000u);
              o[4] += __uint_as_float(p.z << 16); o[5] += __uint_as_float(p.z & 0xffff0000u);
              o[6] += __uint_as_float(p.w << 16); o[7] += __uint_as_float(p.w & 0xffff0000u);
            }
            v4u w; w.x = pk2(o[0], o[1]); w.y = pk2(o[2], o[3]); w.z = pk2(o[4], o[5]); w.w = pk2(o[6], o[7]);
            *(v4u*)(M1 + off) = w;
          }
        __builtin_amdgcn_sched_barrier(0);
      }
  }
};
struct DualOrder : pg8::StaticOrder {
  const unsigned* ready;
  __device__ bool next(int i, pg8::Unit& u) const { if (i >= 2) return false; const bool ok = pg8::StaticOrder::next(0, u); u.sel = i; return ok; }
  __device__ __forceinline__ void a_ready(const pg8::Unit& u) const {
    if (u.sel == 0) return;
    if (threadIdx.x < 64) {
      unsigned sp = 0;
      while ((unsigned)__builtin_amdgcn_readfirstlane(__hip_atomic_load(ready + u.pm, __ATOMIC_RELAXED, __HIP_MEMORY_SCOPE_AGENT)) < 8u) { __builtin_amdgcn_s_sleep(2); if (++sp > (1u << 22)) break; }
      __builtin_amdgcn_fence(__ATOMIC_ACQUIRE, "agent");
      asm volatile("s_waitcnt vmcnt(0)" ::: "memory");
    }
    asm volatile("" ::: "memory"); __builtin_amdgcn_s_barrier(); asm volatile("" ::: "memory");
  }
};
struct EpiGate2 {
  static constexpr bool PERM = true, AFTER_DRAIN = false, CHAIN = true;
  const us *gc, *ga; us* M1;
  __device__ __forceinline__ bool chain(pg8::f32x4 (&acc)[2][2][4][2], const pg8::Unit& u, int wr, int wc, int fr, int fq) const {
    if (u.sel != 0) return false;
    const int row0 = u.pm * 256 + wr * 64 + fr, col0 = u.pn * 256 + wc * 32 + 8 * fq;
#pragma unroll
    for (int ai = 0; ai < 2; ++ai)
#pragma unroll
      for (int mh = 0; mh < 2; ++mh) {
        v4u gw[2][2], hw[2][2];
#pragma unroll
        for (int mm = 0; mm < 2; ++mm)
#pragma unroll
          for (int bj = 0; bj < 2; ++bj) {
            const size_t off = (size_t)(row0 + ai * 128 + (2 * mh + mm) * 16) * 1024 + col0 + bj * 128;
            gw[mm][bj] = *(const v4u*)(gc + off); hw[mm][bj] = *(const v4u*)(ga + off);
          }
        __builtin_amdgcn_sched_barrier(0);
#pragma unroll
        for (int mm = 0; mm < 2; ++mm)
#pragma unroll
          for (int bj = 0; bj < 2; ++bj) {
            const int m = 2 * mh + mm;
            const v4u g = gw[mm][bj], h = hw[mm][bj];
            f32x4& v0 = acc[ai][bj][m][0]; f32x4& v1 = acc[ai][bj][m][1];
            v0[0] *= __uint_as_float(g.x << 16) * __builtin_amdgcn_rcpf(__uint_as_float(h.x << 16)); v0[1] *= __uint_as_float(g.x & 0xffff0000u) * __builtin_amdgcn_rcpf(__uint_as_float(h.x & 0xffff0000u));
            v0[2] *= __uint_as_float(g.y << 16) * __builtin_amdgcn_rcpf(__uint_as_float(h.y << 16)); v0[3] *= __uint_as_float(g.y & 0xffff0000u) * __builtin_amdgcn_rcpf(__uint_as_float(h.y & 0xffff0000u));
            v1[0] *= __uint_as_float(g.z << 16) * __builtin_amdgcn_rcpf(__uint_as_float(h.z << 16)); v1[1] *= __uint_as_float(g.z & 0xffff0000u) * __builtin_amdgcn_rcpf(__uint_as_float(h.z & 0xffff0000u));
            v1[2] *= __uint_as_float(g.w << 16) * __builtin_amdgcn_rcpf(__uint_as_float(h.w << 16)); v1[3] *= __uint_as_float(g.w & 0xffff0000u) * __builtin_amdgcn_rcpf(__uint_as_float(h.w & 0xffff0000u));
          }
        __builtin_amdgcn_sched_barrier(0);
      }
    return true;
  }
  __device__ __forceinline__ void operator()(const pg8::f32x4 (&acc)[2][2][4][2], const pg8::Unit& u, int wr, int wc, int fr, int fq) const {
    EpiGate<false> E; E.gate = ga; E.M1 = M1; E(acc, u, wr, wc, fr, fq);
  }
};
struct EpiRes {
  static constexpr bool PERM = true, AFTER_DRAIN = false, CHAIN = false;
  const float* base; us* x1b;
  __device__ __forceinline__ void operator()(const pg8::f32x4 (&acc)[2][2][4][2], const pg8::Unit& u, int wr, int wc, int fr, int fq) const {
    const int row0 = u.pm * 256 + wr * 64 + fr, col0 = u.pn * 256 + wc * 32 + 8 * fq;
#pragma unroll
    for (int ai = 0; ai < 2; ++ai)
#pragma unroll
      for (int mh = 0; mh < 2; ++mh) {
        f32x4 b[2][2][2];
#pragma unroll
        for (int mm = 0; mm < 2; ++mm)
#pragma unroll
          for (int bj = 0; bj < 2; ++bj)
#pragma unroll
            for (int n = 0; n < 2; ++n) b[mm][bj][n] = *(const f32x4*)(base + (size_t)(row0 + ai * 128 + (2 * mh + mm) * 16) * 1024 + col0 + bj * 128 + n * 4);
        __builtin_amdgcn_sched_barrier(0);
#pragma unroll
        for (int mm = 0; mm < 2; ++mm)
#pragma unroll
          for (int bj = 0; bj < 2; ++bj) {
            const f32x4 o0 = b[mm][bj][0] + acc[ai][bj][2 * mh + mm][0], o1 = b[mm][bj][1] + acc[ai][bj][2 * mh + mm][1];
            v4u w; w.x = pk2(o0[0], o0[1]); w.y = pk2(o0[2], o0[3]); w.z = pk2(o1[0], o1[1]); w.w = pk2(o1[2], o1[3]);
            *(v4u*)(x1b + (size_t)(row0 + ai * 128 + (2 * mh + mm) * 16) * 1024 + col0 + bj * 128) = w;
          }
        __builtin_amdgcn_sched_barrier(0);
      }
  }
};

__device__ __forceinline__ void p0_transpose_item(const float* __restrict__ W, int ldw, int k0, int n_src, us* __restrict__ WT, int ldt, int dst_row0,
                                                  LAS float* scr, int lane) {
  if (n_src >= 0) {
#pragma unroll 8
    for (int i = 0; i < 32; ++i) { const int kk = 2 * i + (lane >> 5); scr[kk * 33 + (lane & 31)] = W[(size_t)(k0 + kk) * ldw + n_src + (lane & 31)]; }
  } else {
#pragma unroll 8
    for (int i = 0; i < 32; ++i) { const int kk = 2 * i + (lane >> 5); scr[kk * 33 + (lane & 31)] = 0.f; }
  }
  LDS_WAIT(); asm volatile("" ::: "memory");
  const int c = lane & 7;
#pragma unroll
  for (int j = 0; j < 4; ++j) {
    const int n = (lane >> 3) + 8 * j;
    const LAS float* s = scr + (8 * c) * 33 + n;
    v4u o;
    o.x = pk2(s[0 * 33], s[1 * 33]); o.y = pk2(s[2 * 33], s[3 * 33]); o.z = pk2(s[4 * 33], s[5 * 33]); o.w = pk2(s[6 * 33], s[7 * 33]);
    *(v4u*)(WT + (size_t)(dst_row0 + n) * ldt + k0 + 8 * c) = o;
  }
  LDS_WAIT(); asm volatile("" ::: "memory");
}
__device__ __forceinline__ void p0_transpose_item_fm(const float* __restrict__ W, int ldw, int k0, int n_src, us* __restrict__ WT, int K, int g,
                                                     LAS float* scr, int lane) {
#pragma unroll 8
  for (int i = 0; i < 32; ++i) { const int kk = 2 * i + (lane >> 5); scr[kk * 33 + (lane & 31)] = W[(size_t)(k0 + kk) * ldw + n_src + (lane & 31)]; }
  LDS_WAIT(); asm volatile("" ::: "memory");
  const int c = lane & 7;
#pragma unroll
  for (int j = 0; j < 4; ++j) {
    const int n = (lane >> 3) + 8 * j;
    const LAS float* s = scr + (8 * c) * 33 + n;
    v4u o;
    o.x = pk2(s[0 * 33], s[1 * 33]); o.y = pk2(s[2 * 33], s[3 * 33]); o.z = pk2(s[4 * 33], s[5 * 33]); o.w = pk2(s[6 * 33], s[7 * 33]);
    *(v4u*)(WT + ((((size_t)g * (K >> 4) + (k0 >> 4) + (c >> 1)) * 2 + (c & 1)) * 32 + n) * 8) = o;
  }
  LDS_WAIT(); asm volatile("" ::: "memory");
}
__device__ __forceinline__ int inproj_src(int g) {
  const int pn = g >> 3, bj = (g >> 2) & 1, wc = g & 3;
  if (pn < 4) return (bj ? 512 : 0) + pn * 128 + wc * 32;
  if (pn < 12) { const int type = (pn - 4) >> 1, head = ((pn - 4) & 1) * 4 + wc; return OFF_Q + type * 512 + head * 64 + bj * 32; }
  if (pn < 20) return (pn < 16 ? OFF_GC : OFF_GA) + ((pn - 12) & 3) * 256 + bj * 128 + wc * 32;
  if (wc == 0) return OFF_KI + bj * 32;
  if (wc == 1 && bj == 0) return OFF_WI;
  return -1;
}
__device__ __forceinline__ void rms_row_to_bf16(const float* __restrict__ xrow, const float* __restrict__ g, us* __restrict__ orow, int lane) {
  const f32x4* xr = (const f32x4*)xrow + lane;
  f32x4 v[4]; float s = 0.f;
#pragma unroll
  for (int j = 0; j < 4; ++j) { v[j] = xr[64 * j]; s += (v[j].x * v[j].x + v[j].y * v[j].y) + (v[j].z * v[j].z + v[j].w * v[j].w); }
  const float rstd = 1.0f / sqrtf(wave_sum(s) * (1.0f / D) + EPS);
#pragma unroll
  for (int j = 0; j < 4; ++j) {
    const f32x4 gg = ((const f32x4*)g)[lane + 64 * j];
    unsigned long long o = (unsigned long long)pk2(v[j].x * rstd * gg.x, v[j].y * rstd * gg.y) |
                           ((unsigned long long)pk2(v[j].z * rstd * gg.z, v[j].w * rstd * gg.w) << 32);
    ((unsigned long long*)orow)[lane + 64 * j] = o;
  }
}

__device__ __forceinline__ void rms_rows4_to_bf16(const float* __restrict__ x0, const float* __restrict__ g, us* __restrict__ o0, int lane) {
  f32x4 v[4][4];
#pragma unroll
  for (int r = 0; r < 4; ++r)
#pragma unroll
    for (int j = 0; j < 4; ++j) v[r][j] = ((const f32x4*)(x0 + (size_t)r * D))[lane + 64 * j];
  __builtin_amdgcn_sched_barrier(0);
#pragma unroll
  for (int r = 0; r < 4; ++r) {
    float s = 0.f;
#pragma unroll
    for (int j = 0; j < 4; ++j) s += (v[r][j].x * v[r][j].x + v[r][j].y * v[r][j].y) + (v[r][j].z * v[r][j].z + v[r][j].w * v[r][j].w);
    const float rstd = 1.0f / sqrtf(wave_sum_dpp(s) * (1.0f / D) + EPS);
#pragma unroll
    for (int j = 0; j < 4; ++j) {
      const f32x4 gg = ((const f32x4*)g)[lane + 64 * j];
      unsigned long long o = (unsigned long long)pk2(v[r][j].x * rstd * gg.x, v[r][j].y * rstd * gg.y) |
                             ((unsigned long long)pk2(v[r][j].z * rstd * gg.z, v[r][j].w * rstd * gg.w) << 32);
      ((unsigned long long*)(o0 + (size_t)r * D))[lane + 64 * j] = o;
    }
  }
}

constexpr int CW_DEP = 104;
constexpr unsigned DEP_TARGET = 7u * 64u * 8u;
constexpr int CW_TQ = 100;
struct InProjOrder : pg8::StaticOrder {
  unsigned* dep;
  __device__ __forceinline__ static int perm(int r) { return r == 0 ? 20 : (r < 3 ? r + 9 : (r < 13 ? r - 3 : r - 1)); }
  __device__ __forceinline__ static bool is_dep(int pn) { return pn < 4 || pn == 10 || pn == 11 || pn == 20; }
  __device__ bool next(int i, pg8::Unit& u) const { const bool ok = pg8::StaticOrder::next(i, u); u.pn = perm(u.pn); return ok; }
  __device__ __forceinline__ void done(const pg8::Unit& u) const {
    if (is_dep(u.pn)) {
      asm volatile("s_waitcnt vmcnt(0)" ::: "memory");
      if ((threadIdx.x & 63) == 0) __hip_atomic_fetch_add(dep, 1u, __ATOMIC_RELAXED, __HIP_MEMORY_SCOPE_AGENT);
    }
  }
};
__device__ __forceinline__ void st16_wt_g(void* ptr, v4u v) { asm volatile("global_store_dwordx4 %0, %1, off sc1\n\ts_nop 1" :: "v"(ptr), "v"(v) : "memory"); }

struct EpiInProj {
  static constexpr bool PERM = true, AFTER_DRAIN = false, CHAIN = false;
  us *G, *Q, *K, *V, *QI, *KI, *GC, *GA; float* WI; const float *CT, *ST;
  __device__ __forceinline__ void operator()(const pg8::f32x4 (&acc)[2][2][4][2], const pg8::Unit& u, int wr, int wc, int fr, int fq) const {
    const int pn = u.pn;
    const int row0 = u.pm * 256 + wr * 64 + fr;
    if (pn < 4) {
#pragma unroll
      for (int ai = 0; ai < 2; ++ai)
#pragma unroll
        for (int m = 0; m < 4; ++m) {
          const int row = row0 + ai * 128 + m * 16;
          const f32x4 a0 = acc[ai][0][m][0], a1 = acc[ai][0][m][1], b0 = acc[ai][1][m][0], b1 = acc[ai][1][m][1];
          v4u w;
          w.x = pk2(a0[0] * fsigmoid(b0[0]), a0[1] * fsigmoid(b0[1])); w.y = pk2(a0[2] * fsigmoid(b0[2]), a0[3] * fsigmoid(b0[3]));
          w.z = pk2(a1[0] * fsigmoid(b1[0]), a1[1] * fsigmoid(b1[1])); w.w = pk2(a1[2] * fsigmoid(b1[2]), a1[3] * fsigmoid(b1[3]));
          st16_wt_g(G + (size_t)row * 512 + pn * 128 + wc * 32 + 8 * fq, w);
        }
    } else if (pn < 12) {
      const int type = (pn - 4) >> 1, head = ((pn - 4) & 1) * 4 + wc;
      us* dst = type == 0 ? Q : (type == 1 ? K : (type == 2 ? V : QI));
      const float sc = type == 0 ? QSCALE : 1.0f;
#pragma unroll
      for (int ai = 0; ai < 2; ++ai)
#pragma unroll
        for (int m = 0; m < 4; ++m) {
          const int row = row0 + ai * 128 + m * 16;
          const f32x4 x10 = acc[ai][0][m][0], x11 = acc[ai][0][m][1], x20 = acc[ai][1][m][0], x21 = acc[ai][1][m][1];
          f32x4 o10, o11, o20, o21;
          if (type == 2) { o10 = x10; o11 = x11; o20 = x20; o21 = x21; }
          else {
            const f32x4 c0 = *(const f32x4*)(CT + (size_t)row * 32 + 8 * fq), c1 = *(const f32x4*)(CT + (size_t)row * 32 + 8 * fq + 4);
            const f32x4 s0 = *(const f32x4*)(ST + (size_t)row * 32 + 8 * fq), s1 = *(const f32x4*)(ST + (size_t)row * 32 + 8 * fq + 4);
            o10 = (x10 * c0 - x20 * s0) * sc; o11 = (x11 * c1 - x21 * s1) * sc;
            o20 = (x20 * c0 + x10 * s0) * sc; o21 = (x21 * c1 + x11 * s1) * sc;
          }
          v4u w1, w2;
          w1.x = pk2(o10[0], o10[1]); w1.y = pk2(o10[2], o10[3]); w1.z = pk2(o11[0], o11[1]); w1.w = pk2(o11[2], o11[3]);
          w2.x = pk2(o20[0], o20[1]); w2.y = pk2(o20[2], o20[3]); w2.z = pk2(o21[0], o21[1]); w2.w = pk2(o21[2], o21[3]);
          us* p = dst + (size_t)row * 512 + head * 64 + 8 * fq;
          if (type == 3) { st16_wt_g(p, w1); st16_wt_g(p + 32, w2); } else { *(v4u*)p = w1; *(v4u*)(p + 32) = w2; }
        }
    } else if (pn < 20) {
      us* dst = pn < 16 ? GC : GA;
      const int cb = ((pn - 12) & 3) * 256 + wc * 32 + 8 * fq;
#pragma unroll
      for (int ai = 0; ai < 2; ++ai)
#pragma unroll
        for (int m = 0; m < 4; ++m) {
          const int row = row0 + ai * 128 + m * 16;
#pragma unroll
          for (int bj = 0; bj < 2; ++bj) {
            const f32x4 v0 = acc[ai][bj][m][0], v1 = acc[ai][bj][m][1];
            v4u w;
            const float lo_ = pn < 16 ? 0.f : 1e-30f;
            w.x = pk2(fmaxf(fsigmoid(v0[0]), lo_), fmaxf(fsigmoid(v0[1]), lo_)); w.y = pk2(fmaxf(fsigmoid(v0[2]), lo_), fmaxf(fsigmoid(v0[3]), lo_));
            w.z = pk2(fmaxf(fsigmoid(v1[0]), lo_), fmaxf(fsigmoid(v1[1]), lo_)); w.w = pk2(fmaxf(fsigmoid(v1[2]), lo_), fmaxf(fsigmoid(v1[3]), lo_));
            *(v4u*)(dst + (size_t)row * 1024 + cb + bj * 128) = w;
          }
        }
    } else {
      if (wc == 0) {
#pragma unroll
        for (int ai = 0; ai < 2; ++ai)
#pragma unroll
          for (int m = 0; m < 4; ++m) {
            const int row = row0 + ai * 128 + m * 16;
            const f32x4 x10 = acc[ai][0][m][0], x11 = acc[ai][0][m][1], x20 = acc[ai][1][m][0], x21 = acc[ai][1][m][1];
            const f32x4 c0 = *(const f32x4*)(CT + (size_t)row * 32 + 8 * fq), c1 = *(const f32x4*)(CT + (size_t)row * 32 + 8 * fq + 4);
            const f32x4 s0 = *(const f32x4*)(ST + (size_t)row * 32 + 8 * fq), s1 = *(const f32x4*)(ST + (size_t)row * 32 + 8 * fq + 4);
            const f32x4 o10 = x10 * c0 - x20 * s0, o11 = x11 * c1 - x21 * s1, o20 = x20 * c0 + x10 * s0, o21 = x21 * c1 + x11 * s1;
            v4u w1, w2;
            w1.x = pk2(o10[0], o10[1]); w1.y = pk2(o10[2], o10[3]); w1.z = pk2(o11[0], o11[1]); w1.w = pk2(o11[2], o11[3]);
            w2.x = pk2(o20[0], o20[1]); w2.y = pk2(o20[2], o20[3]); w2.z = pk2(o21[0], o21[1]); w2.w = pk2(o21[2], o21[3]);
            us* p = KI + ((size_t)(row >> 5) * 8 * 32 + (row & 31)) * 8;
            st16_wt_g(p + (size_t)fq * 256, w1); st16_wt_g(p + (size_t)(4 + fq) * 256, w2);
          }
      } else if (wc == 1 && fq == 0) {
#pragma unroll
        for (int ai = 0; ai < 2; ++ai)
#pragma unroll
          for (int m = 0; m < 4; ++m) {
            const int row = row0 + ai * 128 + m * 16;
            const f32x4 wa_ = acc[ai][0][m][0] * IDX_SCALE, wb_ = acc[ai][0][m][1] * IDX_SCALE;
            st16_wt_g(WI + (size_t)row * 8, (v4u){__float_as_uint(wa_[0]), __float_as_uint(wa_[1]), __float_as_uint(wa_[2]), __float_as_uint(wa_[3])});
            st16_wt_g(WI + (size_t)row * 8 + 4, (v4u){__float_as_uint(wb_[0]), __float_as_uint(wb_[1]), __float_as_uint(wb_[2]), __float_as_uint(wb_[3])});
          }
      }
    }
  }
};


constexpr size_t WS_WGU = 232 * MiB;
constexpr size_t WS_WD = 248 * MiB;
constexpr size_t WS_H2 = WS_HB;
constexpr size_t WS_YS = 72 * MiB;
constexpr size_t WS_HID = 136 * MiB;
constexpr size_t WS_LIST = 160 * MiB;
constexpr size_t WS_COMB = 162 * MiB;
constexpr int CW_CNT = 64;
constexpr int LIST_CAP = 16384;

__device__ __forceinline__ void moe_offsets(const unsigned* cnt, int (&rb_start)[17], int (&row_off)[17]) {
  int a = 0, b = 0;
#pragma unroll
  for (int e = 0; e < 16; ++e) { rb_start[e] = a; row_off[e] = b; const int n = (int)__hip_atomic_load(cnt + e, RLX_AGENT); const int nb = (n + 127) >> 7; a += nb; b += nb * 128; }
  rb_start[16] = a; row_off[16] = b;
}

__device__ __forceinline__ void route_phase(LAS unsigned char* lds, unsigned char* ws, const us* x1b, const float* g_ffn, const float* w_rg, const float* b_rg,
                                            const float* w_re, const float* b_re, int tid, int lane, int wave, int mode) {
  LAS float* Wr = (LAS float*)lds;
  LAS int* cnt_l = (LAS int*)(lds + 81920);
  LAS int* base_l = cnt_l + 16;
  LAS int* tok_e = base_l + 16;
  LAS int* tok_p = tok_e + 128;
  unsigned* cnt = (unsigned*)(ws + WS_CTL) + CW_CNT;
  int* LIST = (int*)(ws + WS_LIST);
  float* COMB = (float*)(ws + WS_COMB);
  us* H2 = (us*)(ws + WS_H2);
  for (int i = tid; i < 1024 * 4; i += 512) { const int d = i >> 2, o = i & 3; Wr[o * 1024 + d] = w_rg[i]; }
  for (int i = tid; i < 1024 * 16; i += 512) { const int d = i >> 4, o = i & 15; Wr[(4 + o) * 1024 + d] = w_re[i]; }
  if (tid < 16) cnt_l[tid] = 0;
  __syncthreads();
  LAS float* lgs = (LAS float*)(tok_p + 128);
  if (mode & 2) return;
  const int t0 = blockIdx.x * 64 + wave * 8;
  unsigned long long nx[2][4];
#pragma unroll
  for (int tk = 0; tk < 2; ++tk)
#pragma unroll
    for (int j = 0; j < 4; ++j) nx[tk][j] = ((const unsigned long long*)(x1b + (size_t)(t0 + tk) * D))[lane + 64 * j];
#pragma unroll 1
  for (int tb = 0; tb < 4; ++tb) {
    f32x4 v[2][4];
#pragma unroll
    for (int tk = 0; tk < 2; ++tk)
#pragma unroll
      for (int j = 0; j < 4; ++j) {
        const unsigned long long a = nx[tk][j];
        v[tk][j] = (f32x4){__uint_as_float((unsigned)a << 16), __uint_as_float((unsigned)a & 0xffff0000u), __uint_as_float((unsigned)(a >> 32) << 16), __uint_as_float((unsigned)(a >> 32) & 0xffff0000u)};
      }
    {
      const int tn = tb < 3 ? tb + 1 : 3;
#pragma unroll
      for (int tk = 0; tk < 2; ++tk)
#pragma unroll
        for (int j = 0; j < 4; ++j) nx[tk][j] = ((const unsigned long long*)(x1b + (size_t)(t0 + tn * 2 + tk) * D))[lane + 64 * j];
    }
#pragma unroll
    for (int tk = 0; tk < 2; ++tk) {
      float s = 0.f;
#pragma unroll
      for (int j = 0; j < 4; ++j) s += (v[tk][j].x * v[tk][j].x + v[tk][j].y * v[tk][j].y) + (v[tk][j].z * v[tk][j].z + v[tk][j].w * v[tk][j].w);
      const float rstd = 1.0f / sqrtf(wave_sum_dpp(s) * (1.0f / D) + EPS);
#pragma unroll
      for (int j = 0; j < 4; ++j) {
        const f32x4 gg = ((const f32x4*)g_ffn)[lane + 64 * j];
        v[tk][j] = v[tk][j] * rstd * gg;
        unsigned long long o = (unsigned long long)pk2(v[tk][j].x, v[tk][j].y) | ((unsigned long long)pk2(v[tk][j].z, v[tk][j].w) << 32);
        ((unsigned long long*)(H2 + (size_t)(t0 + tb * 2 + tk) * D))[lane + 64 * j] = o;
      }
    }
    typedef float f32x2r __attribute__((ext_vector_type(2)));
    float gl[2][4];
#pragma unroll
    for (int o = 0; o < 4; ++o) {
      f32x2r p0 = {0.f, 0.f}, p1 = {0.f, 0.f};
#pragma unroll
      for (int j = 0; j < 4; ++j) {
        const f32x4 w = *(const LAS f32x4*)(Wr + o * 1024 + 4 * lane + 256 * j);
        const f32x2r wl = {w.x, w.y}, wh = {w.z, w.w};
        p0 = __builtin_elementwise_fma((f32x2r){v[0][j].x, v[0][j].y}, wl, p0); p0 = __builtin_elementwise_fma((f32x2r){v[0][j].z, v[0][j].w}, wh, p0);
        p1 = __builtin_elementwise_fma((f32x2r){v[1][j].x, v[1][j].y}, wl, p1); p1 = __builtin_elementwise_fma((f32x2r){v[1][j].z, v[1][j].w}, wh, p1);
      }
      gl[0][o] = wave_sum_dpp(p0.x + p0.y) + b_rg[o]; gl[1][o] = wave_sum_dpp(p1.x + p1.y) + b_rg[o];
    }
#pragma unroll
    for (int tk = 0; tk < 2; ++tk) {
      const int t = t0 + tb * 2 + tk;
      const float g0 = gl[tk][0], g1 = gl[tk][1], g2 = gl[tk][2], g3 = gl[tk][3];
      int gi = 0; float gm = g0;
      if (g1 > gm) { gm = g1; gi = 1; }
      if (g2 > gm) { gm = g2; gi = 2; }
      if (g3 > gm) { gm = g3; gi = 3; }
      gi = __builtin_amdgcn_readfirstlane(gi);
      const float pg = 1.0f / (expf(g0 - gm) + expf(g1 - gm) + expf(g2 - gm) + expf(g3 - gm));
      float el[4];
#pragma unroll
      for (int oe = 0; oe < 4; ++oe) {
        f32x2r p = {0.f, 0.f};
#pragma unroll
        for (int j = 0; j < 4; ++j) {
          const f32x4 w = *(const LAS f32x4*)(Wr + (4 + gi * 4 + oe) * 1024 + 4 * lane + 256 * j);
          p = __builtin_elementwise_fma((f32x2r){v[tk][j].x, v[tk][j].y}, (f32x2r){w.x, w.y}, p); p = __builtin_elementwise_fma((f32x2r){v[tk][j].z, v[tk][j].w}, (f32x2r){w.z, w.w}, p);
        }
        el[oe] = wave_sum_dpp(p.x + p.y) + b_re[gi * 4 + oe];
      }
      const float e0 = el[0], e1 = el[1], e2 = el[2], e3 = el[3];
      int i0 = 0; float m0 = e0;
      if (e1 > m0) { m0 = e1; i0 = 1; }
      if (e2 > m0) { m0 = e2; i0 = 2; }
      if (e3 > m0) { m0 = e3; i0 = 3; }
      int i1 = -1; float m1 = -INFINITY;
      if (i0 != 0 && e0 > m1) { m1 = e0; i1 = 0; }
      if (i0 != 1 && e1 > m1) { m1 = e1; i1 = 1; }
      if (i0 != 2 && e2 > m1) { m1 = e2; i1 = 2; }
      if (i0 != 3 && e3 > m1) { m1 = e3; i1 = 3; }
      const float r = expf(m1 - m0);
      const float c0 = pg / (1.0f + r), c1 = pg * r / (1.0f + r);
      if (lane == 0) {
        const int ea = gi * 4 + i0, eb = gi * 4 + i1;
        const int li = wave * 8 + tb * 2 + tk;
        tok_e[li * 2] = ea; tok_e[li * 2 + 1] = eb;
        tok_p[li * 2] = atomicAdd((int*)(cnt_l + ea), 1);
        tok_p[li * 2 + 1] = atomicAdd((int*)(cnt_l + eb), 1);
        COMB[t * 2] = c0; COMB[t * 2 + 1] = c1;
      }
      asm volatile("" ::: "memory");
    }
  }
  __syncthreads();
  if (mode & 1) return;
  if (tid < 16) base_l[tid] = (int)__hip_atomic_fetch_add(cnt + tid, (unsigned)cnt_l[tid], RLX_AGENT);
  __syncthreads();
  if (tid < 128) {
    const int e = tok_e[tid], p = base_l[e] + tok_p[tid];
    LIST[e * LIST_CAP + p] = (blockIdx.x * 64 + (tid >> 1)) * 2 + (tid & 1);
  }
}

constexpr int SG_EPI_STAGE = 9216;
__device__ __forceinline__ void st16_wt(us* p, v4u v) { asm volatile("global_store_dwordx4 %0, %1, off sc1\n\ts_nop 1" :: "v"(p), "v"(v) : "memory"); }
struct EpiMoe1 {
  us* HID; int hid_row0, nvalid; LAS unsigned char* stage;
  __device__ __forceinline__ void operator()(const sg::f32x16 (&acc)[2][4], int wave, int r32, int hi) const {
    const int lane = r32 + 32 * hi;
    LAS unsigned char* st = stage + wave * SG_EPI_STAGE;
#pragma unroll
    for (int m = 0; m < 4; ++m)
#pragma unroll
      for (int q = 0; q < 4; ++q) {
        float h[4];
#pragma unroll
        for (int i = 0; i < 4; ++i) { const float g = acc[0][m][4 * q + i], u = acc[1][m][4 * q + i]; h[i] = g * fsigmoid(g) * u; }
        *(LAS unsigned long long*)(st + (m * 32 + r32) * 72 + (8 * q + 4 * hi) * 2) = (unsigned long long)pk2(h[0], h[1]) | ((unsigned long long)pk2(h[2], h[3]) << 32);
      }
    LDS_WAIT();
#pragma unroll
    for (int i = 0; i < 8; ++i) {
      const int rr = i * 16 + (lane >> 2), c = lane & 3;
      const unsigned long long lo = *(const LAS unsigned long long*)(st + rr * 72 + c * 16), hi2 = *(const LAS unsigned long long*)(st + rr * 72 + c * 16 + 8);
      const v4u v = (v4u){(unsigned)lo, (unsigned)(lo >> 32), (unsigned)hi2, (unsigned)(hi2 >> 32)};
      if (rr < nvalid) st16_wt(HID + (size_t)(hid_row0 + rr) * 256 + wave * 32 + c * 8, v);
      asm volatile("" ::: "memory");
    }
    LDS_WAIT();
  }
};
struct EpiMoe2 {
  us* YS; const LAS int* slots; int ct, nvalid; LAS unsigned char* stage;
  __device__ __forceinline__ void operator()(const sg::f32x16 (&acc)[2][2], int wm, int wn, int r32, int hi) const {
    const int lane = r32 + 32 * hi;
    LAS unsigned char* st = stage + (wm * 4 + wn) * SG_EPI_STAGE;
#pragma unroll
    for (int m = 0; m < 2; ++m) {
#pragma unroll
      for (int h = 0; h < 2; ++h)
#pragma unroll
        for (int q = 0; q < 4; ++q)
          *(LAS unsigned long long*)(st + r32 * 144 + (h * 32 + 8 * q + 4 * hi) * 2) =
              (unsigned long long)pk2(acc[h][m][4 * q], acc[h][m][4 * q + 1]) | ((unsigned long long)pk2(acc[h][m][4 * q + 2], acc[h][m][4 * q + 3]) << 32);
      LDS_WAIT();
#pragma unroll
      for (int i = 0; i < 4; ++i) {
        const int rr = i * 8 + (lane >> 3), c = lane & 7, grow = wm * 64 + m * 32 + rr;
        const v4u v = *(const LAS v4u*)(st + rr * 144 + c * 16);
        if (grow < nvalid) { const int slot = slots[grow]; *(v4u*)(YS + (size_t)slot * 1024 + ct * 256 + (c >> 2) * 128 + wn * 32 + (c & 3) * 8) = v; }
        asm volatile("" ::: "memory");
      }
      LDS_WAIT();
    }
  }
};

constexpr int CW_Q = 96;
constexpr int CW_READY = 128;
constexpr int MOE_SLOTS = LDS_BYTES - 1024;
constexpr int MOE_TAB = LDS_BYTES - 512;
constexpr int MOE_STG1 = 40960, MOE_STG2 = 67584;
template <int PART> __device__ __forceinline__ void moe_phase(LAS unsigned char* lds, unsigned char* ws, volatile LAS unsigned* MISC, int tid0, int mode) {
  int tid = tid0;
  unsigned* ctl = (unsigned*)(ws + WS_CTL);
  const unsigned* cnt = ctl + CW_CNT;
  LAS int* tab = (LAS int*)(lds + MOE_TAB);
  if (tid == 0) {
    int a = 0, b = 0;
    for (int e = 0; e < 16; ++e) { tab[e] = a; tab[17 + e] = b; const int n = (int)__hip_atomic_load(cnt + e, RLX_AGENT); tab[34 + e] = n; const int nb = (n + 127) >> 7; a += nb; b += nb * 128; }
    tab[16] = a; tab[33] = b;
  }
  __syncthreads();
  const int nrb = __builtin_amdgcn_readfirstlane(tab[16]);
  const int* LIST = (const int*)(ws + WS_LIST);
  const us* H2 = (const us*)(ws + WS_H2);
  const us* WguT = (const us*)(ws + WS_WGU);
  const us* WdT = (const us*)(ws + WS_WD);
  us* HID = (us*)(ws + WS_HID);
  const int wave_ = __builtin_amdgcn_readfirstlane(tid0 >> 6);
  unsigned long long tp_acc = 0ull, tp_0 = 0ull; const int tprobe = AMP_ON ? mode >> 8 : 0;
  if (tprobe == 3) tp_0 = __builtin_amdgcn_s_memrealtime();
  for (;;) {
    if (wave_ == 0) {   const int lane_ = tid0 & 63;
      unsigned v_ = 0u;
      if (lane_ == 0) v_ = __hip_atomic_fetch_add(ctl + CW_Q + (PART == 2 ? 1 : 0), 1u, RLX_AGENT) + (PART == 2 ? (unsigned)nrb : 0u);
      MISC[16] = (unsigned)__builtin_amdgcn_readfirstlane((int)v_);
    }
    __syncthreads();
    asm volatile("" : "+v"(tid));
    const int lane_ = tid & 63, wn_ = (tid >> 6) & 3;
    const int q = __builtin_amdgcn_readfirstlane((int)MISC[16]);
    if (q >= (PART == 1 ? 1 : 3) * nrb) break;
    const bool down = q >= nrb;
    if (tprobe == (down ? 2 : 1)) tp_0 = __builtin_amdgcn_s_memrealtime();
    const int rb = down ? (q - nrb) >> 1 : q;
    int e = 0;
#pragma unroll
    for (int k = 1; k < 16; ++k) if (rb >= tab[k]) e = k;
    const int n_e = tab[34 + e], row0 = tab[17 + e];
    const int r0 = (rb - tab[e]) * 128, nvalid = min(128, n_e - r0);
    if (!down) {
      const us* ap[2];
#pragma unroll
      for (int i = 0; i < 2; ++i) { const int c = tid + 512 * i; int r = c >> 3; if (r >= nvalid) r = 0; const int tok = LIST[e * LIST_CAP + r0 + r] >> 1; ap[i] = H2 + (size_t)tok * D + (c & 7) * 8; }
      const us* bf0 = WguT + ((size_t)(e * 16 + (wave_ >> 2) * 8 + (wave_ & 3)) * 64 * 2 + (lane_ >> 5)) * 256 + (lane_ & 31) * 8;
      const us* bf1 = bf0 + (size_t)4 * 64 * 512;
      EpiMoe1 E; E.HID = HID; E.hid_row0 = row0 + r0; E.nvalid = nvalid; E.stage = lds + MOE_STG1;
      sg::tile_wide(lds, ap, bf0, bf1, 1024, E, tid);
      asm volatile("s_waitcnt vmcnt(0)" ::: "memory");
      __syncthreads();
      if (wave_ == 1) { if (lane_ == 0) __hip_atomic_fetch_add(ctl + CW_READY + rb, 1u, RLX_AGENT); }
    } else {
      if (PART == 0 && wave_ == 2) { if (lane_ == 0) {
        unsigned sp = 0;
        while (__hip_atomic_load(ctl + CW_READY + rb, RLX_AGENT) < 1u) { __builtin_amdgcn_s_sleep(2); if (++sp > (1u << 22)) break; }
        __builtin_amdgcn_fence(__ATOMIC_ACQUIRE, "agent");
        asm volatile("s_waitcnt vmcnt(0)" ::: "memory");
      } }
      __syncthreads();
      if (tid < 128) ((LAS int*)(lds + MOE_SLOTS))[tid] = LIST[e * LIST_CAP + r0 + (tid < nvalid ? tid : 0)];
      {
        const us* hrow = HID + (size_t)(row0 + r0) * 256;
#pragma unroll
        for (int i = 0; i < 8; ++i) { const int c = tid + 512 * i; const int r = c >> 5, ch = c & 31;
          const v4u v = *(const v4u*)(hrow + (size_t)r * 256 + ch * 8);
          *(LAS v4u*)(lds + r * sg::ARS + ch * 16) = v; }
      }
      __syncthreads();
#pragma unroll 1
      for (int ct = 2 * ((q - nrb) & 1); ct < 2 * ((q - nrb) & 1) + 2; ++ct) {
        const us* bf0 = WdT + ((size_t)(e * 32 + ct * 8 + wn_) * 16 * 2 + (lane_ >> 5)) * 256 + (lane_ & 31) * 8;
        const us* bf1 = bf0 + (size_t)4 * 16 * 512;
        EpiMoe2 E; E.YS = (us*)(ws + WS_YS); E.slots = (const LAS int*)(lds + MOE_SLOTS); E.ct = ct; E.nvalid = nvalid; E.stage = lds + MOE_STG2;
        sg::tile_resident(lds, bf0, bf1, E, tid);
      }
      __syncthreads();
    }
    if (tprobe == (down ? 2 : 1)) tp_acc += __builtin_amdgcn_s_memrealtime() - tp_0;
  }
  if (tprobe == 3) tp_acc = __builtin_amdgcn_s_memrealtime() - tp_0;
  if (tprobe && blockIdx.x == 0) { const unsigned long long t1 = __builtin_amdgcn_s_memrealtime(); while (__builtin_amdgcn_s_memrealtime() - t1 < 9ull * tp_acc) __builtin_amdgcn_s_sleep(8); }
}
__device__ __forceinline__ void final_phase(unsigned char* ws, const us* x1b, float* out, const float* g_final, int lane, int wave, int mode) {
  const us* YS = (const us*)(ws + WS_YS);
  const float* COMB = (const float*)(ws + WS_COMB);
  for (int t = blockIdx.x * 8 + wave; t < T; t += gridDim.x * 8) {
    const unsigned long long* xr = (const unsigned long long*)(x1b + (size_t)t * D) + lane;
    const float c0 = COMB[t * 2], c1 = COMB[t * 2 + 1];
    const unsigned long long* y0 = (const unsigned long long*)(YS + (size_t)(2 * t) * D) + lane;
    const unsigned long long* y1 = (const unsigned long long*)(YS + (size_t)(2 * t + 1) * D) + lane;
    f32x4 v[4]; float s = 0.f;
#pragma unroll
    for (int j = 0; j < 4; ++j) {
      const unsigned long long xx = xr[64 * j];
      const unsigned long long a = y0[64 * j], b = y1[64 * j];
      v[j].x = __uint_as_float((unsigned)xx << 16) + (c0 * __uint_as_float((unsigned)a << 16) + c1 * __uint_as_float((unsigned)b << 16));
      v[j].y = __uint_as_float((unsigned)xx & 0xffff0000u) + (c0 * __uint_as_float((unsigned)a & 0xffff0000u) + c1 * __uint_as_float((unsigned)b & 0xffff0000u));
      v[j].z = __uint_as_float((unsigned)(xx >> 32) << 16) + (c0 * __uint_as_float((unsigned)(a >> 32) << 16) + c1 * __uint_as_float((unsigned)(b >> 32) << 16));
      v[j].w = __uint_as_float((unsigned)(xx >> 32) & 0xffff0000u) + (c0 * __uint_as_float((unsigned)(a >> 32) & 0xffff0000u) + c1 * __uint_as_float((unsigned)(b >> 32) & 0xffff0000u));
      s += (v[j].x * v[j].x + v[j].y * v[j].y) + (v[j].z * v[j].z + v[j].w * v[j].w);
    }
    const float rstd = 1.0f / sqrtf(wave_sum(s) * (1.0f / D) + EPS);
    f32x4* orow = (mode & 1) ? (f32x4*)((float*)(ws + WS_G) + (size_t)(t & 4095) * D) + lane : (f32x4*)(out + (size_t)t * D) + lane;
#pragma unroll
    for (int j = 0; j < 4; ++j) { const f32x4 gg = ((const f32x4*)g_final)[lane + 64 * j]; orow[64 * j] = v[j] * rstd * gg; }
  }
}

__device__ __forceinline__ void conv_phase(LAS unsigned char* lds, unsigned char* ws, const float* __restrict__ w_dw, const float* __restrict__ b_dw,
                                           const float* __restrict__ ln_g, const float* __restrict__ ln_b, int tid, int lane, int wave,
                                           volatile LAS unsigned* MISC, unsigned* qhead) {
  const us* G = (const us*)(ws + WS_G);
  us* NA = (us*)(ws + WS_NA);
  LAS us* gl = (LAS us*)lds;
  LAS float* ctile = (LAS float*)(lds + 63488);
  float w[31];
#pragma unroll
  for (int j = 0; j < 31; ++j) w[j] = w_dw[j * 512 + tid];
  const float bias = b_dw[tid];
  const int wave_u = __builtin_amdgcn_readfirstlane(wave);
  for (;;) {
    if (wave_u == 0) {
      unsigned v_ = 0u;
      if (lane == 0) v_ = __hip_atomic_fetch_add(qhead, 1u, __ATOMIC_RELAXED, __HIP_MEMORY_SCOPE_AGENT);
      MISC[21] = (unsigned)__builtin_amdgcn_readfirstlane((int)v_);
    }
    __syncthreads();
    const int tile = __builtin_amdgcn_readfirstlane((int)MISC[21]);
    if (tile >= T / 32) break;
    const int t0 = tile * 32, tt0 = t0 & (S - 1);
    for (int c = tid; c < 62 * 64; c += 512) {
      const int r = c >> 6, ch = c & 63;
      v4u v = (v4u){0u, 0u, 0u, 0u};
      if (tt0 - 30 + r >= 0) v = *(const v4u*)(G + (size_t)(t0 - 30 + r) * 512 + ch * 8);
      *(LAS v4u*)(gl + r * 512 + ch * 8) = v;
    }
    __syncthreads();
#pragma unroll 1
    for (int p = 0; p < 4; ++p) {
      float acc[8];
#pragma unroll
      for (int o = 0; o < 8; ++o) acc[o] = bias;
#pragma unroll
      for (int rr = 0; rr < 38; ++rr) {
        const float gv = __uint_as_float(((unsigned)gl[(p * 8 + rr) * 512 + tid]) << 16);
#pragma unroll
        for (int o = 0; o < 8; ++o) { const int j = rr - o; if (j >= 0 && j < 31) acc[o] += w[j] * gv; }
      }
#pragma unroll
      for (int o = 0; o < 8; ++o) ctile[(p * 8 + o) * 512 + tid] = acc[o];
    }
    __syncthreads();
#pragma unroll
    for (int q = 0; q < 4; ++q) {
      const int tok = wave * 4 + q;
      const f32x4 a = *(const LAS f32x4*)(ctile + tok * 512 + 4 * lane), b = *(const LAS f32x4*)(ctile + tok * 512 + 256 + 4 * lane);
      const float mu = wave_sum((a.x + a.y) + (a.z + a.w) + (b.x + b.y) + (b.z + b.w)) * (1.0f / 512);
      const f32x4 da = a - mu, db = b - mu;
      const float var = wave_sum((da.x * da.x + da.y * da.y) + (da.z * da.z + da.w * da.w) + (db.x * db.x + db.y * db.y) + (db.z * db.z + db.w * db.w)) * (1.0f / 512);
      const float rs = 1.0f / sqrtf(var + EPS);
      const f32x4 ga = *(const f32x4*)(ln_g + 4 * lane), gb = *(const f32x4*)(ln_g + 256 + 4 * lane);
      const f32x4 ba = *(const f32x4*)(ln_b + 4 * lane), bb = *(const f32x4*)(ln_b + 256 + 4 * lane);
      f32x4 na = da * rs * ga + ba, nb = db * rs * gb + bb;
      na.x *= fsigmoid(na.x); na.y *= fsigmoid(na.y); na.z *= fsigmoid(na.z); na.w *= fsigmoid(na.w);
      nb.x *= fsigmoid(nb.x); nb.y *= fsigmoid(nb.y); nb.z *= fsigmoid(nb.z); nb.w *= fsigmoid(nb.w);
      us* dst = NA + (size_t)(t0 + tok) * 512;
      *(unsigned long long*)(dst + 4 * lane) = (unsigned long long)pk2(na.x, na.y) | ((unsigned long long)pk2(na.z, na.w) << 32);
      *(unsigned long long*)(dst + 256 + 4 * lane) = (unsigned long long)pk2(nb.x, nb.y) | ((unsigned long long)pk2(nb.z, nb.w) << 32);
    }
  }
}

constexpr size_t WS_MW = WS_HB;
__device__ __forceinline__ unsigned pk_sub_sat_u16(unsigned a, unsigned b) { unsigned r; asm("v_pk_sub_u16 %0, %1, %2 clamp" : "=v"(r) : "v"(a), "v"(b)); return r; }
__device__ __forceinline__ unsigned pk_min_u16(unsigned a, unsigned b) { unsigned r; asm("v_pk_min_u16 %0, %1, %2" : "=v"(r) : "v"(a), "v"(b)); return r; }
__device__ __forceinline__ unsigned pk_add_u16(unsigned a, unsigned b) { unsigned r; asm("v_pk_add_u16 %0, %1, %2" : "=v"(r) : "v"(a), "v"(b)); return r; }
__device__ __forceinline__ int wave_isum(int v) {
#pragma unroll
  for (int o = 1; o < 64; o <<= 1) v += __shfl_xor(v, o);
  return v;
}
__device__ __forceinline__ unsigned f16key(float sc) {
  sc += 0.0f;
  const _Float16 h = (_Float16)sc;
  const unsigned b = (unsigned)__builtin_bit_cast(unsigned short, h);
  const unsigned m = (unsigned)((int)(b << 16) >> 31);
  return (b ^ (m | 0x8000u)) & 0xFFFFu;
}
__device__ __forceinline__ int wave_isum_dpp(int v) {
  v += __builtin_amdgcn_update_dpp(0, v, 0xB1, 0xF, 0xF, true);
  v += __builtin_amdgcn_update_dpp(0, v, 0x4E, 0xF, 0xF, true);
  v += __builtin_amdgcn_update_dpp(0, v, 0x141, 0xF, 0xF, true);
  v += __builtin_amdgcn_update_dpp(0, v, 0x140, 0xF, 0xF, true);
  v += __builtin_amdgcn_update_dpp(0, v, 0x142, 0xA, 0xF, true);
  v += __builtin_amdgcn_update_dpp(0, v, 0x143, 0xC, 0xF, true);
  return __builtin_amdgcn_readlane(v, 63);
}
__device__ __forceinline__ void tk_count4(unsigned& acc, const v4u k, unsigned cm1p, unsigned one2) {
  unsigned t0, t1, t2, t3;
  asm("v_pk_sub_u16 %1, %5, %9 clamp\n\tv_pk_sub_u16 %2, %6, %9 clamp\n\tv_pk_sub_u16 %3, %7, %9 clamp\n\tv_pk_sub_u16 %4, %8, %9 clamp\n\t"
      "v_pk_min_u16 %1, %1, %10\n\tv_pk_min_u16 %2, %2, %10\n\tv_pk_min_u16 %3, %3, %10\n\tv_pk_min_u16 %4, %4, %10\n\t"
      "v_pk_add_u16 %1, %1, %2\n\tv_pk_add_u16 %3, %3, %4\n\tv_pk_add_u16 %0, %0, %1\n\tv_pk_add_u16 %0, %0, %3"
      : "+v"(acc), "=&v"(t0), "=&v"(t1), "=&v"(t2), "=&v"(t3)
      : "v"(k.x), "v"(k.y), "v"(k.z), "v"(k.w), "v"(cm1p), "v"(one2));
}
template <int NQ> __device__ __forceinline__ int tk_count(const v4u (&kq)[NQ], unsigned cm1p, unsigned one2) {
  unsigned a0 = 0u, a1 = 0u;
#pragma unroll
  for (int q = 0; q < NQ; ++q) { if (q & 1) tk_count4(a1, kq[q], cm1p, one2); else tk_count4(a0, kq[q], cm1p, one2); }
  const unsigned a = a0 + a1;
  return wave_isum_dpp((int)((a & 0xffffu) + (a >> 16)));
}
template <int NQ> __device__ __forceinline__ void tk_select(const LAS us* KEYS, const LAS unsigned* HIST, unsigned char* MWB, int T0, int N_unit, int nkw, int wave, int lane) {
  const unsigned one2 = 0x00010001u;
#pragma unroll 1
  for (int jj = 0; jj < 2; ++jj) {
    const int j = 2 * wave + jj;
    v4u kq[NQ];
#pragma unroll
    for (int q = 0; q < NQ; ++q) {
      const int ci = lane + 64 * q;
      kq[q] = (v4u){0u, 0u, 0u, 0u};
      if (ci * 8 < N_unit) kq[q] = *(const LAS v4u*)(KEYS + j * 4096 + ci * 8);
    }
    unsigned prefix = 0u; int cge = 0, bit0 = 15;
    {
      const unsigned h01 = HIST[j * 128 + 2 * lane], h23 = HIST[j * 128 + 2 * lane + 1];
      const int c0 = (int)(h01 & 0xffffu), c1 = (int)(h01 >> 16), c2 = (int)(h23 & 0xffffu), c3 = (int)(h23 >> 16);
      const int t4 = (c0 + c1) + (c2 + c3);
      int p = t4;
      p += __builtin_amdgcn_update_dpp(0, p, 0x111, 0xF, 0xF, true);
      p += __builtin_amdgcn_update_dpp(0, p, 0x112, 0xF, 0xF, true);
      p += __builtin_amdgcn_update_dpp(0, p, 0x114, 0xF, 0xF, true);
      p += __builtin_amdgcn_update_dpp(0, p, 0x118, 0xF, 0xF, true);
      p += __builtin_amdgcn_update_dpp(0, p, 0x142, 0xA, 0xF, true);
      p += __builtin_amdgcn_update_dpp(0, p, 0x143, 0xC, 0xF, true);
      const int total = __builtin_amdgcn_readlane(p, 63);
      const int suf = total - p + t4;
      const unsigned long long okm = __ballot(suf >= TOPK);
      if (okm != 0ull) {
        const int ls = 63 - __builtin_clzll(okm);
        const int above = __builtin_amdgcn_readlane(suf - t4, ls);
        const int d3 = __builtin_amdgcn_readlane(c3, ls), d2 = __builtin_amdgcn_readlane(c2, ls), d1 = __builtin_amdgcn_readlane(c1, ls), d0 = __builtin_amdgcn_readlane(c0, ls);
        int bsel, cnt_ge;
        if (above + d3 >= TOPK) { bsel = 3; cnt_ge = above + d3; }
        else if (above + d3 + d2 >= TOPK) { bsel = 2; cnt_ge = above + d3 + d2; }
        else if (above + d3 + d2 + d1 >= TOPK) { bsel = 1; cnt_ge = above + d3 + d2 + d1; }
        else { bsel = 0; cnt_ge = above + d3 + d2 + d1 + d0; }
        prefix = (unsigned)(4 * ls + bsel) << 8; cge = cnt_ge; bit0 = 7;
      }
    }
#pragma unroll 1
    for (int bit = bit0; bit >= 0; --bit) {
      const unsigned cand = prefix | (1u << bit), cm1 = cand - 1u, cp = cm1 | (cm1 << 16);
      const int cnt = tk_count<NQ>(kq, cp, one2);
      if (cnt >= TOPK) { prefix = cand; cge = cnt; }
    }
    const unsigned tau = prefix, tp = tau | (tau << 16);
    unsigned char* mrow = MWB + (size_t)(T0 + j) * 512;
#define TK_STORE(q_, f0, f1, f2, f3) do { const unsigned by_ = ((f0) & 1u) | (((f0) >> 16) << 1) | (((f1) & 1u) << 2) | (((f1) >> 16) << 3) | (((f2) & 1u) << 4) | (((f2) >> 16) << 5) | \
        (((f3) & 1u) << 6) | (((f3) >> 16) << 7); const int ci_ = lane + 64 * (q_); if (ci_ * 8 < nkw) mrow[ci_] = (unsigned char)by_; } while (0)
    if (tau == 0u) {
#pragma unroll
      for (int q = 0; q < NQ; ++q) {
        TK_STORE(q, pk_min_u16(kq[q].x, one2), pk_min_u16(kq[q].y, one2), pk_min_u16(kq[q].z, one2), pk_min_u16(kq[q].w, one2)); }
    } else if (cge == TOPK) {
      const unsigned cm1 = tau - 1u, cp = cm1 | (cm1 << 16);
#pragma unroll
      for (int q = 0; q < NQ; ++q) {
        TK_STORE(q, pk_min_u16(pk_sub_sat_u16(kq[q].x, cp), one2), pk_min_u16(pk_sub_sat_u16(kq[q].y, cp), one2),
                 pk_min_u16(pk_sub_sat_u16(kq[q].z, cp), one2), pk_min_u16(pk_sub_sat_u16(kq[q].w, cp), one2)); }
    } else {
      const int cgt = tk_count<NQ>(kq, tp, one2);
      const int need = TOPK - cgt;
      int base = 0;
#pragma unroll
      for (int q = 0; q < NQ; ++q) {
        unsigned gt[4], eq[4];
        gt[0] = pk_min_u16(pk_sub_sat_u16(kq[q].x, tp), one2); gt[1] = pk_min_u16(pk_sub_sat_u16(kq[q].y, tp), one2);
        gt[2] = pk_min_u16(pk_sub_sat_u16(kq[q].z, tp), one2); gt[3] = pk_min_u16(pk_sub_sat_u16(kq[q].w, tp), one2);
        eq[0] = pk_min_u16(kq[q].x ^ tp, one2) ^ one2; eq[1] = pk_min_u16(kq[q].y ^ tp, one2) ^ one2;
        eq[2] = pk_min_u16(kq[q].z ^ tp, one2) ^ one2; eq[3] = pk_min_u16(kq[q].w ^ tp, one2) ^ one2;
        const unsigned es = (eq[0] + eq[1]) + (eq[2] + eq[3]);
        const int ecnt = (int)((es & 0xffffu) + (es >> 16));
        if (__ballot(ecnt != 0) != 0ull) {
          int pre = 0, tot = 0;
#pragma unroll
          for (int bb = 0; bb < 4; ++bb) {
            const unsigned long long bal = __ballot((ecnt >> bb) & 1);
            pre += (int)__builtin_amdgcn_mbcnt_hi((unsigned)(bal >> 32), __builtin_amdgcn_mbcnt_lo((unsigned)bal, 0u)) << bb;
            tot += __popcll(bal) << bb;
          }
          int rk = base + pre;
#pragma unroll
          for (int d = 0; d < 4; ++d) {
            const unsigned e_lo = eq[d] & 1u, e_hi = eq[d] >> 16;
            const unsigned s_lo = (e_lo && rk < need) ? 1u : 0u; rk += (int)e_lo;
            const unsigned s_hi = (e_hi && rk < need) ? 1u : 0u; rk += (int)e_hi;
            gt[d] |= s_lo | (s_hi << 16);
          }
          base += tot;
        }
        TK_STORE(q, gt[0], gt[1], gt[2], gt[3]);
      }
    }
#undef TK_STORE
  }
}

__device__ __forceinline__ void topk_phase(LAS unsigned char* lds, unsigned char* ws, int tid0, int mode, unsigned long long& amp_acc,
                                           volatile LAS unsigned* MISC, int mword, unsigned* qhead, int nunits, int blk_hi) {
  const int ampk = AMP_ON ? (mode >> 16) & 15 : 0;
  typedef float f32x16 __attribute__((ext_vector_type(16)));
  const us* QI = (const us*)(ws + WS_QI);
  const us* KI = (const us*)(ws + WS_KI);
  const float* WI = (const float*)(ws + WS_WI);
  unsigned char* MWB = (unsigned char*)(ws + WS_MW);
  LAS us* KEYS = (LAS us*)lds;
  LAS unsigned* HIST = (LAS unsigned*)(lds + 131072);
  const int wave_u = __builtin_amdgcn_readfirstlane(tid0 >> 6);
  int tid = tid0;
  for (;;) {
    if (wave_u == 0) {
      unsigned v_ = 0u;
      if ((tid0 & 63) == 0) v_ = __hip_atomic_fetch_add(qhead, 1u, __ATOMIC_RELAXED, __HIP_MEMORY_SCOPE_AGENT);
      MISC[mword] = (unsigned)__builtin_amdgcn_readfirstlane((int)v_);
    }
    __syncthreads();
    const int u = __builtin_amdgcn_readfirstlane((int)MISC[mword]);
    if (u >= nunits) break;
    asm volatile("" : "+v"(tid));
    const int lane = tid & 63, wave = tid >> 6;
    const int r = lane & 31, hh = lane >> 5;
    const int a_tok = ((r >> 3) >> 1) + 2 * ((r >> 2) & 1), a_head = (r & 3) + 4 * ((r >> 3) & 1);
    const int rp = wave & 1, kg = wave >> 1;
    const int b = u & 3, blk = blk_hi - (u >> 2);
    const int tt0 = blk * 16, T0 = b * S + tt0, tmax = tt0 + 15, nkt = (tmax >> 5) + 1;
    ((LAS v4u*)HIST)[tid] = (v4u){0u, 0u, 0u, 0u};
    __syncthreads();
    const unsigned long long ta_ = AMP_ON ? __builtin_amdgcn_s_memrealtime() : 0ull;
    if (!(mode & 2)) {
      bf16x8 afr[2][4];
#pragma unroll
      for (int mt = 0; mt < 2; ++mt)
#pragma unroll
        for (int ks = 0; ks < 4; ++ks) afr[mt][ks] = *(const bf16x8*)(QI + (size_t)(T0 + 8 * rp + 4 * mt + a_tok) * 512 + a_head * 64 + 16 * ks + 8 * hh);
      float wv[2][16];
#pragma unroll
      for (int mt = 0; mt < 2; ++mt)
#pragma unroll
        for (int tl = 0; tl < 2; ++tl) {
          const float* wp = WI + (size_t)(T0 + 8 * rp + 4 * mt + tl + 2 * hh) * 8;
          const f32x4 w0 = *(const f32x4*)wp, w1 = *(const f32x4*)(wp + 4);
          wv[mt][8 * tl + 0] = w0.x; wv[mt][8 * tl + 1] = w0.y; wv[mt][8 * tl + 2] = w0.z; wv[mt][8 * tl + 3] = w0.w;
          wv[mt][8 * tl + 4] = w1.x; wv[mt][8 * tl + 5] = w1.y; wv[mt][8 * tl + 6] = w1.z; wv[mt][8 * tl + 7] = w1.w;
        }
      const us* kbase = KI + ((size_t)(b * (S / 32)) * 8 * 32 + hh * 32 + r) * 8;
      bf16x8 bA[4], bB[4];
      const int klast = nkt - 1;
#define TK_LOADB(dst, kt_) do { const int kc_ = (kt_) < klast ? (kt_) : klast; _Pragma("unroll") for (int ks = 0; ks < 4; ++ks) dst[ks] = *(const bf16x8*)(kbase + (size_t)kc_ * 2048 + 512 * ks); } while (0)
#define TK_TILE(bfr, kt_) do { \
        f32x16 acc[2]; \
        _Pragma("unroll") for (int mt = 0; mt < 2; ++mt) { \
          _Pragma("unroll") for (int i = 0; i < 16; ++i) acc[mt][i] = 0.f; \
          _Pragma("unroll") for (int ks = 0; ks < 4; ++ks) acc[mt] = __builtin_amdgcn_mfma_f32_32x32x16_bf16(afr[mt][ks], bfr[ks], acc[mt], 0, 0, 0); } \
        const int s = (kt_) * 32 + r; \
        _Pragma("unroll") for (int mt = 0; mt < 2; ++mt) \
          _Pragma("unroll") for (int tl = 0; tl < 2; ++tl) { \
            float sc = 0.f; \
            _Pragma("unroll") for (int h8 = 0; h8 < 8; ++h8) { const float rl_ = __int_as_float(max(__float_as_int(acc[mt][8 * tl + h8]), 0));   \
              asm("v_fmac_f32_e32 %0, %1, %2" : "+v"(sc) : "v"(wv[mt][8 * tl + h8]), "v"(rl_)); }     \
            const int tokl = 8 * rp + 4 * mt + tl + 2 * hh; \
            const unsigned key = (s <= tt0 + tokl) ? f16key(sc) : 0u; \
            KEYS[tokl * 4096 + s] = (us)key; \
            if (key) __hip_atomic_fetch_add(HIST + tokl * 128 + (key >> 9), 1u << ((key >> 4) & 16u), __ATOMIC_RELAXED, __HIP_MEMORY_SCOPE_WORKGROUP);     \
          } } while (0)
      if (kg < nkt) {
        TK_LOADB(bA, kg);
        for (int kt = kg; kt < nkt; kt += 4) {
          TK_LOADB(bB, kt + 4);
          TK_TILE(bA, kt);
#pragma unroll
          for (int ks = 0; ks < 4; ++ks) bA[ks] = bB[ks];
        }
      }
#undef TK_LOADB
#undef TK_TILE
    }
    __syncthreads();
    const unsigned long long tb_ = AMP_ON ? __builtin_amdgcn_s_memrealtime() : 0ull;
    if (ampk == 2) amp_acc += tb_ - ta_;
    {
      const int N_unit = nkt * 32;
      const int nkw = ((tt0 >> 8) + 1) * 256;
      const int nq = (nkw + 511) >> 9;
      if (mode & 1) continue;
      switch (nq) {
        case 1: tk_select<1>(KEYS, HIST, MWB, T0, N_unit, nkw, wave, lane); break;
        case 2: tk_select<2>(KEYS, HIST, MWB, T0, N_unit, nkw, wave, lane); break;
        case 3: tk_select<3>(KEYS, HIST, MWB, T0, N_unit, nkw, wave, lane); break;
        case 4: tk_select<4>(KEYS, HIST, MWB, T0, N_unit, nkw, wave, lane); break;
        case 5: tk_select<5>(KEYS, HIST, MWB, T0, N_unit, nkw, wave, lane); break;
        case 6: tk_select<6>(KEYS, HIST, MWB, T0, N_unit, nkw, wave, lane); break;
        case 7: tk_select<7>(KEYS, HIST, MWB, T0, N_unit, nkw, wave, lane); break;
        default: tk_select<8>(KEYS, HIST, MWB, T0, N_unit, nkw, wave, lane); break;
      }
      if (ampk == 3) amp_acc += __builtin_amdgcn_s_memrealtime() - tb_;
    }
  }
}

namespace attn_body {
using bf16=__hip_bfloat16;
using bf16x8=__attribute__((ext_vector_type(8)))short;
using s16x4=__attribute__((ext_vector_type(4)))short;
using f32x16=__attribute__((ext_vector_type(16)))float;
using u32x4=__attribute__((ext_vector_type(4)))unsigned;
constexpr int BATCH=4,NHEAD=8,SEQ=4096,D=64,DM=NHEAD*D;
constexpr int NW=8,QBLK=32,QB=QBLK*NW,KVBLK=64,NQB=SEQ/QB;
constexpr int ATTN_PITCH=DM, ATTN_UNIT_ROWS=QB;
__device__ __forceinline__ int crow(int r,int hi){return (r&3)+8*(r>>2)+4*hi;}
#define SBAR() __builtin_amdgcn_sched_barrier(0)
__device__ __forceinline__ void cmask(f32x16&p0,f32x16&p1,int jb,int qrel,int hi){
  const float NEG=-INFINITY; int kb=64*jb+4*hi;
  #pragma unroll
  for(int r=0;r<16;++r){int kv=kb+(r&3)+8*(r>>2); if(kv>qrel)p0[r]=NEG; if(kv+32>qrel)p1[r]=NEG;}
}

constexpr int NSLOT=3, SLOTB=8192;
constexpr int LDS_K=0, LDS_V=NSLOT*SLOTB, LDS_WS=2*NSLOT*SLOTB, LDS_OST=LDS_WS+NW*64*4, LDS_MK=LDS_OST+NW*4096, LDS_BYTES=LDS_MK+NW*2048;
constexpr float C2=0.125f*1.4426950408889634f;
__device__ __forceinline__ void glds16(const void*gsrc,unsigned lds_dst){unsigned keep;
  asm volatile("s_mov_b32 %0, m0\n\ts_mov_b32 m0, %2\n\ts_nop 0\n\tglobal_load_lds_dwordx4 %1, off\n\ts_mov_b32 m0, %0":"=&s"(keep):"v"(gsrc),"s"(lds_dst):"memory");}
__device__ __forceinline__ float max3f(float a,float b,float c){float r;asm("v_max3_f32 %0, %1, %2, %3":"=v"(r):"v"(a),"v"(b),"v"(c));return r;}
__device__ __forceinline__ float max2f(float a,float b){float r;asm("v_max_f32_e32 %0, %1, %2":"=v"(r):"v"(a),"v"(b));return r;}
__device__ __forceinline__ float fadd_s(float a,float b){float r;asm("v_add_f32_e32 %0, %1, %2":"=v"(r):"v"(a),"v"(b));return r;}
__device__ __forceinline__ float fsub_s(float a,float b){float r;asm("v_sub_f32_e32 %0, %1, %2":"=v"(r):"v"(a),"v"(b));return r;}
typedef float f32x2_t __attribute__((ext_vector_type(2))); typedef __bf16 bf16x2_t __attribute__((ext_vector_type(2)));
__device__ __forceinline__ unsigned cvtpk_s(float lo,float hi){f32x2_t v={lo,hi};bf16x2_t b=__builtin_convertvector(v,bf16x2_t);return __builtin_bit_cast(unsigned,b);}
#define WAIT_BAR(N) asm volatile("s_waitcnt vmcnt(" #N ") lgkmcnt(0)\n\ts_barrier":::"memory")

__device__ __forceinline__ void qkt(f32x16&p0,f32x16&p1,const char*Kslot,const bf16x8*qr,const f32x16&negm,int r32,int hi){
  const char*kb=Kslot+hi*1024+r32*16;
  #pragma unroll
  for(int d0=0;d0<4;++d0){
    const bf16x8 b0=*reinterpret_cast<const bf16x8*>(kb+d0*2048);
    const bf16x8 b1=*reinterpret_cast<const bf16x8*>(kb+d0*2048+512);
    if(d0==0){p0=__builtin_amdgcn_mfma_f32_32x32x16_bf16(b0,qr[0],negm,0,0,0);p1=__builtin_amdgcn_mfma_f32_32x32x16_bf16(b1,qr[0],negm,0,0,0);}
    else{p0=__builtin_amdgcn_mfma_f32_32x32x16_bf16(b0,qr[d0],p0,0,0,0);p1=__builtin_amdgcn_mfma_f32_32x32x16_bf16(b1,qr[d0],p1,0,0,0);}}
}
typedef __attribute__((address_space(3))) const char* lds_cptr;
typedef short v4i16_t __attribute__((ext_vector_type(4)));
__device__ __forceinline__ void kload8(bf16x8*kf,lds_cptr kp){
  kf[0]=*(const __attribute__((address_space(3))) bf16x8*)(kp);      kf[1]=*(const __attribute__((address_space(3))) bf16x8*)(kp+512);
  kf[2]=*(const __attribute__((address_space(3))) bf16x8*)(kp+2048); kf[3]=*(const __attribute__((address_space(3))) bf16x8*)(kp+2560);
  kf[4]=*(const __attribute__((address_space(3))) bf16x8*)(kp+4096); kf[5]=*(const __attribute__((address_space(3))) bf16x8*)(kp+4608);
  kf[6]=*(const __attribute__((address_space(3))) bf16x8*)(kp+6144); kf[7]=*(const __attribute__((address_space(3))) bf16x8*)(kp+6656);
}
__device__ __forceinline__ void kload2(bf16x8*kf,lds_cptr kp,int j){ kf[2*j]=*(const __attribute__((address_space(3))) bf16x8*)(kp+j*2048); kf[2*j+1]=*(const __attribute__((address_space(3))) bf16x8*)(kp+j*2048+512); }
__device__ __forceinline__ s16x4 vtr(lds_cptr p){ return __builtin_bit_cast(s16x4,__builtin_amdgcn_ds_read_tr16_b64_v4i16((__attribute__((address_space(3))) v4i16_t*)p)); }
__device__ __forceinline__ float rowmax(const f32x16&p0,const f32x16&p1){
  float a=max3f(p0[0],p0[1],p1[0]),b=max3f(p0[2],p0[3],p1[1]);a=max3f(a,p1[2],p1[3]);
  #pragma unroll
  for(int r=4;r<16;r+=4){a=max3f(a,p0[r],p0[r+1]);b=max3f(b,p0[r+2],p0[r+3]);a=max3f(a,p1[r],p1[r+1]);b=max3f(b,p1[r+2],p1[r+3]);}
  const float m=max2f(a,b);
  auto rr=__builtin_amdgcn_permlane32_swap(__float_as_uint(m),__float_as_uint(m),false,false);
  return max2f(__uint_as_float(rr[0]),__uint_as_float(rr[1]));
}
__device__ __forceinline__ void pv(f32x16*o,int vb,bf16x8 pa0,bf16x8 pa1,bf16x8 pa2,bf16x8 pa3){
  #pragma unroll
  for(int d0=0;d0<2;++d0){s16x4 lo[4],hi[4];
    #pragma unroll
    for(int ks=0;ks<4;++ks){
      asm volatile("ds_read_b64_tr_b16 %0,%1 offset:%c2":"=&v"(lo[ks]):"v"(vb),"i"(d0*4096+ks*1024):"memory");
      asm volatile("ds_read_b64_tr_b16 %0,%1 offset:%c2":"=&v"(hi[ks]):"v"(vb),"i"(d0*4096+ks*1024+512):"memory");}
    asm volatile("s_waitcnt lgkmcnt(0)":::"memory");SBAR();
    #define PK(k) (bf16x8){lo[k][0],lo[k][1],lo[k][2],lo[k][3],hi[k][0],hi[k][1],hi[k][2],hi[k][3]}
    o[d0]=__builtin_amdgcn_mfma_f32_32x32x16_bf16(pa0,PK(0),o[d0],0,0,0);
    o[d0]=__builtin_amdgcn_mfma_f32_32x32x16_bf16(pa1,PK(1),o[d0],0,0,0);
    o[d0]=__builtin_amdgcn_mfma_f32_32x32x16_bf16(pa2,PK(2),o[d0],0,0,0);
    o[d0]=__builtin_amdgcn_mfma_f32_32x32x16_bf16(pa3,PK(3),o[d0],0,0,0);
    #undef PK
  }
}

#ifndef ATTN_STORE16
#define ATTN_STORE16(p,v) asm volatile("global_store_dwordx4 %0, %1, off sc1\n\ts_nop 1"::"v"(p),"v"(v):"memory")
#endif
template<int THRL> __device__ __forceinline__ void attn_unit(int b,int h,int qb,const bf16*Q,const bf16*__restrict__ K,const bf16*__restrict__ V,bf16*O,const unsigned char*MW,unsigned*done,char*shm){
  const int tid=threadIdx.x,lane=tid&63,r32=lane&31,hi=lane>>5; const int wid=__builtin_amdgcn_readfirstlane(tid>>6);
  const long rowbase=(long)b*SEQ; const int q0=qb*QB;
  const bf16*Qw=Q+(rowbase+q0+wid*QBLK)*DM+h*D;
  const bf16*Kh=K+rowbase*DM+h*D,*Vh=V+rowbase*DM+h*D;
  const unsigned lds0=(unsigned)(uintptr_t)shm;
  float*wsf=(float*)(shm+LDS_WS)+wid*64;
  const bf16*ksrc=Kh+(long)lane*DM+wid*8;
  const bf16*vsrc=Vh+(long)(16*(wid&3)+(lane>>2))*DM+(wid>>2)*32+(lane&3)*8;
  const unsigned kdst=lds0+LDS_K+wid*1024, vdst=lds0+LDS_V+wid*1024;
  #define DMA_K(t,slot) glds16(ksrc+(long)(t)*KVBLK*DM,(unsigned)__builtin_amdgcn_readfirstlane(kdst+(slot)))
  #define DMA_V(t,slot) glds16(vsrc+(long)(t)*KVBLK*DM,(unsigned)__builtin_amdgcn_readfirstlane(vdst+(slot)))
  const int vb0=(int)(lds0+LDS_V)+((lane>>4)&1)*32+(lane&3)*8+(4*hi+((lane&15)>>2))*64;
  const char*Kbase=shm+LDS_K; bf16x8 kf[8];
  const lds_cptr shm3=(lds_cptr)shm; const lds_cptr kp0=shm3+LDS_K+hi*1024+r32*16; const lds_cptr vp0=shm3+LDS_V+((lane>>4)&1)*32+(lane&3)*8+(4*hi+((lane&15)>>2))*64;
  const int NT=(q0+QB)/KVBLK;
  const unsigned char*msrc=MW+((size_t)(rowbase+q0+wid*QBLK+(lane>>1)))*512+(lane&1)*16;
  const unsigned mdst=lds0+LDS_MK+wid*2048;
  #define MDMA(g) glds16(msrc+(g)*32,(unsigned)__builtin_amdgcn_readfirstlane(mdst+((g)&1)*1024))
  const lds_cptr mkp=(lds_cptr)shm+LDS_MK+wid*2048+r32*32;
  #define MWORD(t) (*(const __attribute__((address_space(3))) unsigned long long*)(mkp+(((t)>>2)&1)*1024+(((t)>>1)&1)*16+((t)&1)*8))
  #define MAPPLY(X,B,w) do{ X[B]=__uint_as_float(__float_as_uint(X[B])&(unsigned)__builtin_amdgcn_sbfe((int)(w),((B)&3)+8*((B)>>2),1)); }while(0)
  MDMA(0); if(q0+QB>4*KVBLK){MDMA(1);}
  DMA_K(0,0);DMA_V(0,0);DMA_K(1,SLOTB);
  bf16x8 qr[4];
  #pragma unroll
  for(int d0=0;d0<4;++d0)qr[d0]=*reinterpret_cast<const bf16x8*>(&Qw[(long)r32*DM+d0*16+hi*8]);
  float mhat=0.f,l_reg=0.f;f32x16 o[2];o[0]=f32x16{};o[1]=f32x16{};f32x16 negm=f32x16{};asm volatile("":"+v"(negm));
  const int qrel=wid*QBLK+r32;
  #define CMASK(P0,P1,t) do{int jb_=(t)-(NT-4); if(jb_>=0)cmask(P0,P1,jb_,qrel,hi);}while(0)
  bool resc=false;
  #define START(P0,P1) do{ const float rm=rowmax(P0,P1); resc=false; \
    { const float dl=rm; mhat=fadd_s(mhat,dl); \
      _Pragma("unroll") for(int r=0;r<16;++r){P0[r]=fsub_s(P0[r],dl);P1[r]=fsub_s(P1[r],dl);} \
      _Pragma("unroll") for(int r=0;r<16;++r)negm[r]=-mhat; asm volatile("":"+v"(negm)); } \
    _Pragma("unroll") for(int r=0;r<16;++r)P0[r]=__builtin_amdgcn_exp2f(P0[r]); }while(0)
  #define RESC() do{ if(resc){ asm volatile("s_waitcnt lgkmcnt(0)":::"memory"); \
      _Pragma("unroll") for(int d_=0;d_<2;++d_) _Pragma("unroll") for(int r=0;r<16;++r)o[d_][r]*=wsf[crow(r,hi)]; } }while(0)
  f32x16 pA0,pA1,pB0,pB1;
  int sl_prev=0,sl_cur=0,sl_next=SLOTB;
  #define ROT() do{sl_prev=sl_cur;sl_cur=sl_next;sl_next=(sl_next==(NSLOT-1)*SLOTB)?0:sl_next+SLOTB;}while(0)
  DMA_K(2,2*SLOTB);
  WAIT_BAR(3);
  qkt(pA0,pA1,Kbase,qr,negm,r32,hi);asm volatile("s_nop 15\n\ts_nop 7":"+v"(pA0),"+v"(pA1));
  START(pA0,pA1);
  _Pragma("unroll") for(int r=0;r<16;++r)pA1[r]=__builtin_amdgcn_exp2f(pA1[r]);
  { const unsigned long long mw_=MWORD(0); const unsigned wl_=(unsigned)mw_>>(4*hi), wh_=(unsigned)(mw_>>32)>>(4*hi);
    _Pragma("unroll") for(int r=0;r<16;++r){ MAPPLY(pA0,r,wl_); MAPPLY(pA1,r,wh_); } }
  WAIT_BAR(0);
  DMA_K(3,0);DMA_V(1,SLOTB);
  ROT();
  kload8(kf,kp0+sl_cur);
  WAIT_BAR(2);
  s16x4 vlo[8],vhi[8]; u32x4 pw0,pw1,pw2,pw3;
  #define PKW(P,B) cvtpk_s(P[B],P[B+1])
  #define PAF(k) __builtin_bit_cast(bf16x8,pw##k)
  #define VFR(i) (bf16x8){vlo[i][0],vlo[i][1],vlo[i][2],vlo[i][3],vhi[i][0],vhi[i][1],vhi[i][2],vhi[i][3]}
  #define PIN(x) asm volatile("":"+v"(x))
  #define MX3(a,b,c) __builtin_fmaxf(__builtin_fmaxf((a),(b)),(c))
  #define GAPA(MF,A0,A1,A2,A3,W0,W1,PW) do{ MF; sacc+=A0; sacc+=A1; sacc+=A2; sacc+=A3; PIN(sacc); W0; W1; PIN(PW); SBAR(); }while(0)
  #define EX(v) __builtin_amdgcn_exp2f(v)
  #define GAPB(MF,X,B,w) do{ MF; X[B]=EX(X[B]); X[B+1]=EX(X[B+1]); X[B+2]=EX(X[B+2]); X[B+3]=EX(X[B+3]); MAPPLY(X,B,w); MAPPLY(X,B+1,w); MAPPLY(X,B+2,w); MAPPLY(X,B+3,w); PIN(X); SBAR(); }while(0)
  #define VRD(i) do{ vlo[i]=vtr(vp_+(((i)>>2)*4096+((i)&3)*1024)); vhi[i]=vtr(vp_+(((i)>>2)*4096+((i)&3)*1024+512)); }while(0)
  #define KRD(G,j) do{ if(G){ kload2(kf,kp0+sl_next,j); SBAR(); } }while(0)
  #define STEP(C0,C1,P0,P1,t,GK,GV,GL) do{ SBAR(); \
    const lds_cptr vp_=vp0+sl_prev; \
    VRD(0); SBAR(); float sacc=(P0[0]+P0[1]); \
    GAPA(C0=__builtin_amdgcn_mfma_f32_32x32x16_bf16(kf[0],qr[0],negm,0,0,0), P0[2],P0[3],P0[4],P0[5],     pw0[0]=PKW(P0,0), pw0[1]=PKW(P0,2), pw0); \
    VRD(4); SBAR(); GAPA(C1=__builtin_amdgcn_mfma_f32_32x32x16_bf16(kf[1],qr[0],negm,0,0,0), P0[6],P0[7],P0[8],P0[9],     pw0[2]=PKW(P0,4), pw0[3]=PKW(P0,6), pw0); \
    VRD(1); SBAR(); GAPA(C0=__builtin_amdgcn_mfma_f32_32x32x16_bf16(kf[2],qr[1],C0,0,0,0),   P0[10],P0[11],P0[12],P0[13], pw1[0]=PKW(P0,8), pw1[1]=PKW(P0,10), pw1); \
    VRD(5); SBAR(); GAPA(C1=__builtin_amdgcn_mfma_f32_32x32x16_bf16(kf[3],qr[1],C1,0,0,0),   P0[14],P0[15],P1[0],P1[1],   pw1[2]=PKW(P0,12),pw1[3]=PKW(P0,14), pw1); \
    VRD(2); SBAR(); GAPA(C0=__builtin_amdgcn_mfma_f32_32x32x16_bf16(kf[4],qr[2],C0,0,0,0),   P1[2],P1[3],P1[4],P1[5],     pw2[0]=PKW(P1,0), pw2[1]=PKW(P1,2), pw2); \
    VRD(6); SBAR(); GAPA(C1=__builtin_amdgcn_mfma_f32_32x32x16_bf16(kf[5],qr[2],C1,0,0,0),   P1[6],P1[7],P1[8],P1[9],     pw2[2]=PKW(P1,4), pw2[3]=PKW(P1,6), pw2); \
    VRD(3); SBAR(); GAPA(C0=__builtin_amdgcn_mfma_f32_32x32x16_bf16(kf[6],qr[3],C0,0,0,0),   P1[10],P1[11],P1[12],P1[13], pw3[0]=PKW(P1,8), pw3[1]=PKW(P1,10), pw3); \
    VRD(7); SBAR(); GAPA(C1=__builtin_amdgcn_mfma_f32_32x32x16_bf16(kf[7],qr[3],C1,0,0,0),   P1[14],P1[15],0.f,0.f,       pw3[2]=PKW(P1,12),pw3[3]=PKW(P1,14), pw3); \
    l_reg+=sacc; \
    if((((t)&3)==0)&&((t)+4<NT)){MDMA(((t)>>2)+1);} \
    if(GK){DMA_K((t)+3,sl_cur);} if(GV){DMA_V((t)+1,sl_next);} \
    const unsigned long long mw_=MWORD(t); const unsigned wl_=(unsigned)mw_>>(4*hi), wh_=(unsigned)(mw_>>32)>>(4*hi); \
    { float a=MX3(C0[0],C0[1],C1[0]),b=MX3(C0[2],C0[3],C1[1]); a=MX3(a,C1[2],C1[3]); \
      _Pragma("unroll") for(int r=4;r<16;r+=4){a=MX3(a,C0[r],C0[r+1]);b=MX3(b,C0[r+2],C0[r+3]);a=MX3(a,C1[r],C1[r+1]);b=MX3(b,C1[r+2],C1[r+3]);} \
      float rm=__builtin_fmaxf(a,b); { auto rr=__builtin_amdgcn_permlane32_swap(__float_as_uint(rm),__float_as_uint(rm),false,false); rm=__builtin_fmaxf(__uint_as_float(rr[0]),__uint_as_float(rr[1])); } \
      resc=false; \
      if(__builtin_expect(__any(rm>(float)THRL),0)){ const float dl=__builtin_fmaxf(rm,0.f); mhat+=dl; \
        _Pragma("unroll") for(int r=0;r<16;++r){C0[r]-=dl;C1[r]-=dl;} \
        _Pragma("unroll") for(int r=0;r<16;++r)negm[r]=-mhat; asm volatile("":"+v"(negm)); \
        const float f=__builtin_amdgcn_exp2f(-dl); l_reg*=f; if(hi==0)wsf[r32]=f; resc=true; } } \
    SBAR(); \
    GAPB(o[0]=__builtin_amdgcn_mfma_f32_32x32x16_bf16(PAF(0),VFR(0),o[0],0,0,0), C0,0,wl_); \
    GAPB(o[1]=__builtin_amdgcn_mfma_f32_32x32x16_bf16(PAF(0),VFR(4),o[1],0,0,0), C0,4,wl_); \
    KRD(GL,0); GAPB(o[0]=__builtin_amdgcn_mfma_f32_32x32x16_bf16(PAF(1),VFR(1),o[0],0,0,0), C0,8,wl_); \
    KRD(GL,1); GAPB(o[1]=__builtin_amdgcn_mfma_f32_32x32x16_bf16(PAF(1),VFR(5),o[1],0,0,0), C0,12,wl_); \
    KRD(GL,2); GAPB(o[0]=__builtin_amdgcn_mfma_f32_32x32x16_bf16(PAF(2),VFR(2),o[0],0,0,0), C1,0,wh_); \
    KRD(GL,3); GAPB(o[1]=__builtin_amdgcn_mfma_f32_32x32x16_bf16(PAF(2),VFR(6),o[1],0,0,0), C1,4,wh_); \
    GAPB(o[0]=__builtin_amdgcn_mfma_f32_32x32x16_bf16(PAF(3),VFR(3),o[0],0,0,0), C1,8,wh_); \
    GAPB(o[1]=__builtin_amdgcn_mfma_f32_32x32x16_bf16(PAF(3),VFR(7),o[1],0,0,0), C1,12,wh_); \
    }while(0)
  int t=1;
  #undef CMASK
  #define CMASK(P0,P1,t) do{}while(0)
  for(;t+5<NT;t+=2){
    STEP(pB0,pB1,pA0,pA1,t,true,true,true);     WAIT_BAR(2); RESC(); ROT();
    STEP(pA0,pA1,pB0,pB1,t+1,true,true,true);   WAIT_BAR(2); RESC(); ROT();
  }
  #undef CMASK
  #define CMASK(P0,P1,t) do{int jb_=(t)-(NT-4); if(jb_>=0)cmask(P0,P1,jb_,qrel,hi);}while(0)
  #define ENDW(tt) do{ if((tt)+3<NT){WAIT_BAR(2);} else if((tt)+2<NT){WAIT_BAR(1);} else {WAIT_BAR(0);} }while(0)
  for(;t+1<NT;t+=2){
    STEP(pB0,pB1,pA0,pA1,t,(t+3<NT),(t+1<NT),(t+1<NT));       ENDW(t);   RESC(); ROT();
    STEP(pA0,pA1,pB0,pB1,t+1,(t+4<NT),(t+2<NT),(t+2<NT));     ENDW(t+1); RESC(); ROT();
  }
  STEP(pB0,pB1,pA0,pA1,NT-1,false,false,false); RESC();
  { float sacc=pB0[0]+pB0[1]; _Pragma("unroll") for(int r=2;r<16;++r)sacc+=pB0[r]; _Pragma("unroll") for(int r=0;r<16;++r)sacc+=pB1[r]; l_reg+=sacc;
    pw0=(u32x4){PKW(pB0,0),PKW(pB0,2),PKW(pB0,4),PKW(pB0,6)};pw1=(u32x4){PKW(pB0,8),PKW(pB0,10),PKW(pB0,12),PKW(pB0,14)};pw2=(u32x4){PKW(pB1,0),PKW(pB1,2),PKW(pB1,4),PKW(pB1,6)};pw3=(u32x4){PKW(pB1,8),PKW(pB1,10),PKW(pB1,12),PKW(pB1,14)};
    SBAR(); pv(o,vb0+sl_cur,PAF(0),PAF(1),PAF(2),PAF(3)); }
  #undef PKW
  #undef PAF
  #undef VFR
  #undef PIN
  #undef MX3
  #undef GAPA
  #undef GAPB
  #undef EX
  #undef VRD
  #undef KRD
  #undef STEP
  #undef ENDW
  {auto rr=__builtin_amdgcn_permlane32_swap(__float_as_uint(l_reg),__float_as_uint(l_reg),false,false);l_reg=__uint_as_float(rr[0])+__uint_as_float(rr[1]);}
  if(hi==0)wsf[32+r32]=l_reg;asm volatile("s_waitcnt lgkmcnt(0)":::"memory");
  float rli[16];
  #pragma unroll
  for(int r=0;r<16;++r)rli[r]=__builtin_amdgcn_rcpf(wsf[32+crow(r,hi)]);
  bf16*Ow=O+(rowbase+q0+wid*QBLK)*DM+h*D;
  { bf16*stg=(bf16*)(shm+LDS_OST)+wid*2048;
    #pragma unroll
    for(int r=0;r<16;++r){const int orow=crow(r,hi);
      #pragma unroll
      for(int d0=0;d0<2;++d0)stg[orow*64+d0*32+r32]=__float2bfloat16(o[d0][r]*rli[r]);}
    asm volatile("s_waitcnt lgkmcnt(0)":::"memory");
    #pragma unroll
    for(int i=0;i<4;++i){const int row=i*8+(lane>>3),ch=lane&7; const u32x4 v=*(const u32x4*)(stg+row*64+ch*8); ATTN_STORE16(Ow+(long)row*DM+ch*8,v);} }
  asm volatile("s_waitcnt vmcnt(0) lgkmcnt(0)\n\ts_barrier":::"memory");
  if(wid==1){ if(lane==0) __hip_atomic_fetch_add(done+b*16+qb,1u,__ATOMIC_RELAXED,__HIP_MEMORY_SCOPE_AGENT); }
  #undef DMA_K
  #undef DMA_V
  #undef CMASK
  #undef MDMA
  #undef MWORD
  #undef MAPPLY
  #undef START
  #undef RESC
  #undef ROT
}
constexpr int ATTN_LDS_BYTES=LDS_BYTES;
struct AttnTensors { const bf16* Q; const bf16* K; const bf16* V; bf16* O; const unsigned char* MW; unsigned* done; };
template<int THRL=8> __device__ __forceinline__ void attn_phase(char*lds,const AttnTensors&T,int grid,int block){
  for(int v0=block;v0<256;v0+=grid){
    const int vcu=(grid==256)?((v0%8)*32+v0/8):v0; const int bh=vcu>>3,s=vcu&7;
    attn_unit<THRL>(bh/NHEAD,bh%NHEAD,s,T.Q,T.K,T.V,T.O,T.MW,T.done,lds);
    attn_unit<THRL>(bh/NHEAD,bh%NHEAD,15-s,T.Q,T.K,T.V,T.O,T.MW,T.done,lds);
  }
}
#undef SBAR
#undef WAIT_BAR
}

__global__ void __launch_bounds__(512, 2) mk_fwd(Args args) {
  extern __shared__ __attribute__((aligned(16))) unsigned char lds_raw[];
  LAS unsigned char* lds = (LAS unsigned char*)lds_raw;
  volatile LAS unsigned* MISC = (volatile LAS unsigned*)(lds + MISC_OFF);
  const int tid = threadIdx.x, lane = tid & 63;
  const int wave = __builtin_amdgcn_readfirstlane(tid >> 6);
  const int G_ = gridDim.x;
  unsigned char* ws = args.ws;
  if (tid < 32) MISC[tid] = 0u;
  __syncthreads();
  XcdBarrier bar = xcd_barrier_post((unsigned*)(ws + WS_CTL) + CW_BAR + args.li * XCD_BAR_WORDS, MISC + 8);
  const int lo = args.ph_lo, hi = args.ph_hi;
#define IN(k) (lo <= (k) && (k) < hi)
  unsigned long long amp_acc = 0ull, t_lastexit = AMP_ON ? __builtin_amdgcn_s_memrealtime() : 0ull;
#define SEAM(k) do { if (IN(k) && (k) + 1 < hi) { if (!AMP_ON) { xcd_barrier(bar); } else { const unsigned long long tb_ = __builtin_amdgcn_s_memrealtime(); xcd_barrier(bar); const unsigned long long te_ = __builtin_amdgcn_s_memrealtime(); \
    if (((args.dup >> 16) & 15) == 1) amp_acc += te_ - tb_; \
    if (((args.dup >> 16) & 15) == 14 && (((unsigned)args.dup >> 28) & 15u) == (unsigned)(k)) amp_acc += te_ - t_lastexit; t_lastexit = te_; } } } while (0)

#define PHASE_IDS() int tid_p = tid; asm volatile("" : "+v"(tid_p)); const int lane_p = tid_p & 63; const int wave_p = __builtin_amdgcn_readfirstlane(tid_p >> 6)
#define AMP_T0() const unsigned long long tph_ = AMP_ON ? __builtin_amdgcn_s_memrealtime() : 0ull
#define AMP_T1(k) do { if (AMP_ON && ((args.dup >> 16) & 15) == 15 && (((unsigned)args.dup >> 28) & 15u) == (unsigned)(k)) amp_acc += __builtin_amdgcn_s_memrealtime() - tph_; } while (0)
  const float* x = args.in[0];
  const int* pos = (const int*)args.in[1];
  const float* g_mix = args.in[2];
  const float* w_in = args.in[3];
  us* WinT = (us*)(ws + WS_WIN); us* WcoT = (us*)(ws + WS_WCO); us* WaoT = (us*)(ws + WS_WAO); us* WoT = (us*)(ws + WS_WO);
  float* CT = (float*)(ws + WS_CT); float* ST = (float*)(ws + WS_ST);
  us* Hb = (us*)(ws + WS_HB);

  { AMP_T0(); if (IN(PH_PREP)) {
    LAS float* scr = (LAS float*)(lds + wave * 16384);
    const int gw = blockIdx.x * 8 + wave, NGW = G_ * 8;
    constexpr int I_IN = 16 * 168, I_CO = 8 * 32, I_AO = 8 * 32, I_O = 16 * 32;
    constexpr int NITEMS = I_IN + I_CO + I_AO + I_O;
    for (int it = gw; it < NITEMS; it += NGW) {
      int r = it;
      if (r < I_IN) { const int g = r % 168, kb = r / 168; p0_transpose_item(w_in, INC, 64 * kb, inproj_src(g), WinT, 1024, 32 * g, scr, lane); continue; }
      r -= I_IN;
      if (r < I_CO) { const int nb = r % 32, kb = r / 32; p0_transpose_item(args.in[8], 1024, 64 * kb, 32 * nb, WcoT, 512, 32 * nb, scr, lane); continue; }
      r -= I_CO;
      if (r < I_AO) { const int nb = r % 32, kb = r / 32; p0_transpose_item(args.in[9], 1024, 64 * kb, 32 * nb, WaoT, 512, 32 * nb, scr, lane); continue; }
      r -= I_AO;
      { const int nb = r % 32, kb = r / 32; p0_transpose_item(args.in[10], 1024, 64 * kb, 32 * nb, WoT, 1024, 32 * nb, scr, lane); }
    }
    for (int row = gw * 4; row < T; row += NGW * 4) rms_rows4_to_bf16(x + (size_t)row * D, g_mix, Hb + (size_t)row * D, lane);
    for (int i = blockIdx.x * 512 + tid; i < T * 32; i += G_ * 512) {
      const int t = i >> 5, d = i & 31;
      const float inv = 1.0f / powf(10000.0f, (float)(2 * d) / 64.0f);
      const float ang = (float)pos[t] * inv;
      const float n_ = rintf(ang * 0.15915494309189535f);
      float rr = __builtin_fmaf(-n_, 6.28125f, ang); rr = __builtin_fmaf(-n_, 1.9353071795864769e-3f, rr);
      const float rev = rr * 0.15915494309189535f;
      CT[i] = __builtin_amdgcn_cosf(rev); ST[i] = __builtin_amdgcn_sinf(rev);
    }
  }
  AMP_T1(PH_PREP); }
  SEAM(PH_PREP);
  { AMP_T0(); if (IN(PH_INPROJ)) {
    pg8::Gemm g{Hb, WinT, T, NIN, D};
    InProjOrder So; So.init(T, NIN, G_, (int)blockIdx.x); So.dep = (unsigned*)(ws + WS_CTL) + CW_DEP;
    EpiInProj E;
    E.G = (us*)(ws + WS_G); E.Q = (us*)(ws + WS_Q); E.K = (us*)(ws + WS_K); E.V = (us*)(ws + WS_V); E.QI = (us*)(ws + WS_QI);
    E.KI = (us*)(ws + WS_KI); E.GC = (us*)(ws + WS_GC); E.GA = (us*)(ws + WS_GA); E.WI = (float*)(ws + WS_WI); E.CT = CT; E.ST = ST;
    pg8::gemm_phase<EpiInProj, InProjOrder, true, true>(lds, g, So, E);
    {
      const int nwg_ = (T / 256) * (NIN / 256); int n6 = nwg_ - 5 * G_; n6 = n6 < 0 ? 0 : (n6 > G_ ? G_ : n6);
      const bool all_ = (n6 == 0 || n6 == G_);
      const bool six = !all_ && (int)blockIdx.x < n6;
      const int nfree = all_ ? G_ : G_ - n6, myidx = all_ ? (int)blockIdx.x : (int)blockIdx.x - n6;
      if (!six && nfree > 0) {
        LAS float* scr = (LAS float*)(lds + wave * 16384);
        constexpr int I_GU = 16 * 16 * 16, I_DN = 16 * 4 * 32;
        for (int it = myidx * 8 + wave; it < I_GU + I_DN; it += nfree * 8) {
          int r = it;
      if (r < I_GU) {
        const int g16 = r & 15, kb = (r >> 4) & 15, e = r >> 8; const int ct = g16 >> 3, half = (g16 >> 2) & 1, q = g16 & 3;
        p0_transpose_item_fm((half ? args.in[17] : args.in[16]) + (size_t)e * 1024 * 256, 256, 64 * kb, 128 * ct + 32 * q, (us*)(ws + WS_WGU), 1024,
                             e * 16 + ct * 8 + half * 4 + q, scr, lane);
        continue; }
      r -= I_GU;
      { const int g = r & 31, kb = (r >> 5) & 3, e = r >> 7;
        p0_transpose_item_fm(args.in[18] + (size_t)e * 256 * 1024, 1024, 64 * kb, 32 * g, (us*)(ws + WS_WD), 256, e * 32 + g, scr, lane); }
        }
      }
    }
  }
  AMP_T1(PH_INPROJ); }
  { AMP_T0(); if (IN(PH_TOPK)) { PHASE_IDS();
    unsigned* ctl_ = (unsigned*)(ws + WS_CTL);
    if (threadIdx.x < 64) {
      unsigned sp = 0;
      while ((unsigned)__builtin_amdgcn_readfirstlane(__hip_atomic_load(ctl_ + CW_DEP, __ATOMIC_RELAXED, __HIP_MEMORY_SCOPE_AGENT)) < DEP_TARGET) { __builtin_amdgcn_s_sleep(2); if (++sp > (1u << 22)) break; }
      __builtin_amdgcn_fence(__ATOMIC_ACQUIRE, "agent");
      asm volatile("s_waitcnt vmcnt(0)" ::: "memory");
    }
    __syncthreads();
    topk_phase(lds, ws, tid_p, args.dup, amp_acc, MISC, 20, ctl_ + CW_TQ, 768, 255);
    conv_phase(lds, ws, args.in[4], args.in[5], args.in[6], args.in[7], tid_p, lane_p, wave_p, MISC, ctl_ + CW_TQ + 1);
    topk_phase(lds, ws, tid_p, args.dup, amp_acc, MISC, 22, ctl_ + CW_TQ + 2, 256, 63);
  }
  AMP_T1(PH_TOPK); }
  SEAM(PH_TOPK);
  { AMP_T0(); if (IN(PH_ATTN)) {
    attn_body::AttnTensors Tn{(const attn_body::bf16*)(ws + WS_Q), (const attn_body::bf16*)(ws + WS_K), (const attn_body::bf16*)(ws + WS_V),
                              (attn_body::bf16*)(ws + WS_AO), (const unsigned char*)(ws + WS_MW), (unsigned*)(ws + WS_CTL) + CW_ATTN};
    attn_body::attn_phase<8>((char*)lds_raw, Tn, G_, (int)blockIdx.x);
  }
  AMP_T1(PH_ATTN); }
  { AMP_T0(); if (IN(PH_MIX)) {
    us* M1 = (us*)(ws + WS_M1);
    DualOrder So; So.init(T, 1024, G_, (int)blockIdx.x); So.ready = (const unsigned*)(ws + WS_CTL) + CW_ATTN;
    pg8::Gemm g0{(const us*)(ws + WS_NA), WcoT, T, 1024, 512}, g1{(const us*)(ws + WS_AO), WaoT, T, 1024, 512};
    EpiGate2 E; E.gc = (const us*)(ws + WS_GC); E.ga = (const us*)(ws + WS_GA); E.M1 = M1;
    pg8::gemm_phase<EpiGate2, DualOrder, true, true>(lds, g0, So, E, g1);
  }
  AMP_T1(PH_MIX); }
  SEAM(PH_MIX);
  { AMP_T0(); if (IN(PH_WO)) {
    pg8::Gemm g{(const us*)(ws + WS_M1), WoT, T, 1024, 1024};
    pg8::StaticOrder So; So.init(T, 1024, G_, (int)blockIdx.x);
    EpiRes E; E.base = x; E.x1b = (us*)(ws + WS_X1B);
    pg8::gemm_phase<EpiRes, pg8::StaticOrder, true, true>(lds, g, So, E);
  }
  AMP_T1(PH_WO); }
  SEAM(PH_WO);
  const unsigned long long tr0_ = AMP_ON ? __builtin_amdgcn_s_memrealtime() : 0ull;
  if (IN(PH_ROUTE)) { PHASE_IDS(); route_phase(lds, ws, (const us*)(ws + WS_X1B), args.in[11], args.in[12], args.in[13], args.in[14], args.in[15], tid_p, lane_p, wave_p, args.dup); }
  if (AMP_ON && ((args.dup >> 16) & 15) == 4) amp_acc += __builtin_amdgcn_s_memrealtime() - tr0_;
  SEAM(PH_ROUTE);
  { AMP_T0(); if (IN(PH_MOE1)) { PHASE_IDS(); moe_phase<0>(lds, ws, MISC, tid_p, args.dup); }
  AMP_T1(PH_MOE1); }
  SEAM(PH_MOE1);
  if (AMP_ON && ((args.dup >> 16) & 15) == 5) { for (int i_ = 0; i_ < 10; ++i_) xcd_barrier(bar); }
  { AMP_T0(); if (IN(PH_FINAL)) { PHASE_IDS(); final_phase(ws, (const us*)(ws + WS_X1B), args.out, args.in[19], lane_p, wave_p, args.dup); }
  AMP_T1(PH_FINAL); }
  if (AMP_ON && ((args.dup >> 16) & 15) && (int)blockIdx.x == ((args.dup >> 20) & 255)) { const unsigned long long t1 = __builtin_amdgcn_s_memrealtime(); while (__builtin_amdgcn_s_memrealtime() - t1 < 9ull * amp_acc) __builtin_amdgcn_s_sleep(8); }
}

constexpr int SHIP_MODE = 0;
constexpr int PROBE_MODE = 0;
constexpr int PROBE_K = -1;
extern "C" void kernel_launch(void* const* d_in, const int* in_sizes, int n_in, void* d_out, int out_size, void* d_ws, size_t ws_size,
                              hipStream_t stream) {
  static int grid = 0;
  if (grid == 0) {
    int dev = 0, cus = 0, per_cu = 0;
    hipGetDevice(&dev);
    hipDeviceGetAttribute(&cus, hipDeviceAttributeMultiprocessorCount, dev);
    hipFuncSetAttribute((const void*)mk_fwd, hipFuncAttributeMaxDynamicSharedMemorySize, LDS_BYTES);
    hipOccupancyMaxActiveBlocksPerMultiprocessor(&per_cu, (const void*)mk_fwd, 512, LDS_BYTES);
    if (per_cu < 1) { fprintf(stderr, "kernel_launch: occupancy query says %d blocks/CU\n", per_cu); per_cu = 1; }
    grid = cus;
  }
  hipMemsetAsync((char*)d_ws + WS_CTL, 0, CTL_ZERO_BYTES, stream);
  Args a{};
  for (int i = 0; i < 20; ++i) a.in[i] = (const float*)d_in[i];
  a.out = (float*)d_out; a.ws = (unsigned char*)d_ws;
  auto launch = [&](int lo, int hi, int li, int mode = 0) {
    a.ph_lo = lo; a.ph_hi = hi; a.li = li; a.dup = mode;
    void* kargs[] = {&a};
    hipError_t e = hipLaunchCooperativeKernel((const void*)mk_fwd, dim3(grid), dim3(512), kargs, LDS_BYTES, stream);
    if (e != hipSuccess) fprintf(stderr, "cooperative launch failed: %s (grid %d)\n", hipGetErrorString(e), grid);
  };
  if (PROBE_K == -1) launch(PH_PREP, PH_END, 0, SHIP_MODE);
  else if (PROBE_K == -2) { launch(PH_PREP, PH_ATTN, 0); launch(PH_ATTN, PH_MIX, 1); launch(PH_MIX, PH_END, 2); }
  else { int li = 0; if (PROBE_K > 0) launch(PH_PREP, PROBE_K, li++); launch(PROBE_K, PROBE_K + 1, li++, PROBE_MODE); if (PROBE_K == PH_MOE1) hipMemsetAsync((char*)d_ws + WS_CTL + 96 * 4, 0, (512 - 96) * 4, stream); launch(PROBE_K, PROBE_K + 1, li++); if (PROBE_K + 1 < PH_END) launch(PROBE_K + 1, PH_END, li++); }

}
```

```cpp
#include <hip/hip_runtime.h>
#include <hip/hip_bf16.h>
#include <stdint.h>
#include <cstdio>

typedef unsigned short us;

constexpr int D = 1024, NB = 4, S = 4096, T = NB * S;
constexpr int TOPK = 256;
constexpr float EPS = 1e-6f;
constexpr int OFF_U = 0, OFF_Q = 1024, OFF_K = 1536, OFF_V = 2048, OFF_QI = 2560, OFF_KI = 3072, OFF_WI = 3136,
              OFF_GC = 3144, OFF_GA = 4168, INC = 5192;
constexpr int NIN = 5376;
constexpr float QSCALE = 0.125f * 1.4426950408889634f;
constexpr float IDX_SCALE = 0.04419417382415922f;

__device__ __forceinline__ us f2bf_(float f) {
  unsigned u = __float_as_uint(f);
  u += 0x7FFFu + ((u >> 16) & 1u);
  return (us)(u >> 16);
}
__device__ __forceinline__ float bf2f(us h) { return __uint_as_float(((unsigned)h) << 16); }
__device__ __forceinline__ float sigmoidf_(float x) { return 1.0f / (1.0f + expf(-x)); }
__device__ __forceinline__ float fsigmoid(float x) { return __builtin_amdgcn_rcpf(1.0f + __builtin_amdgcn_exp2f(-1.4426950408889634f * x)); }

namespace pg8 {
#define PG8_LAS __attribute__((address_space(3)))
typedef unsigned short bf16_t;
typedef short bf16x8 __attribute__((ext_vector_type(8)));
typedef float f32x4 __attribute__((ext_vector_type(4)));
typedef unsigned u32x4 __attribute__((ext_vector_type(4)));
constexpr int BM = 256, BK = 64, HALF = 128, HTB = HALF * BK * 2  , STAGE_BYTES = 8 * HTB, NXCD = 8, WGM = 8;

__host__ __device__ __forceinline__ int lds_byte(int r, int c) { const int st = (r >> 4) * 2 + (c >> 5), rr = r & 15, cc = c & 31, ob = rr * 64 + cc * 2; return st * 1024 + (ob ^ (((ob >> 9) & 1) << 5)); }
__host__ __device__ __forceinline__ void stage_rc(int b, int& R, int& C) { const int st = b / 1024, sb = b % 1024, swz = sb ^ (((sb >> 9) & 1) << 5); R = (st >> 1) * 16 + swz / 64; C = (st & 1) * 32 + (swz % 64) / 2; }
__host__ __device__ __forceinline__ int perm32(int rho) { const int n = rho >> 4, i = rho & 15; return 8 * (i >> 2) + 4 * n + (i & 3); }

struct Unit { int pm, pn, sel; };
struct Gemm { const bf16_t* A; const bf16_t* Bt; int M, N, K; };

struct StaticOrder {
    int nM, nN, nwg, G, c;
    __host__ __device__ void init(int M, int N, int G_, int c_) { nM = M / BM; nN = N / BM; nwg = nM * nN; G = G_; c = c_; }
    __host__ __device__ bool next(int i, Unit& u) const {
        const long L = (long)i * G + c; if (L >= nwg) return false;
        int wgid = (int)L; { const int q = nwg / NXCD, r = nwg % NXCD, xcd = wgid % NXCD, off = wgid / NXCD; wgid = (xcd < r ? xcd * (q + 1) : r * (q + 1) + (xcd - r) * q) + off; }
        const int nig = WGM * nN, gid = wgid / nig, fm = gid * WGM, gsz = (nM - fm) < WGM ? (nM - fm) : WGM;
        u.pm = fm + ((wgid % nig) % gsz); u.pn = (wgid % nig) / gsz; u.sel = 0; return true;
    }
    __device__ __forceinline__ void a_ready(const Unit&) const {}
    __device__ __forceinline__ void done(const Unit&) const {}
};

__device__ __forceinline__ unsigned cvt_pk_bf16(float lo, float hi) { unsigned r; asm volatile("v_cvt_pk_bf16_f32 %0, %1, %2" : "=v"(r) : "v"(lo), "v"(hi)); return r; }
typedef float f32x2 __attribute__((ext_vector_type(2)));
__device__ __forceinline__ f32x2 gelu_pk(f32x2 v) {
    const f32x2 av = __builtin_elementwise_abs(v), d = av * 0.2316418882f + 1.0f;
    f32x2 t; t.x = __builtin_amdgcn_rcpf(d.x); t.y = __builtin_amdgcn_rcpf(d.y);
    f32x2 q = t * 0.5307027145f + (-0.7265760135f); q = q * t + 0.7107068705f; q = q * t + (-0.142248368f); q = q * t + 0.127414796f; q = q * t;
    const f32x2 s = (v * v) * (-0.72134752044f);
    f32x2 e; e.x = __builtin_amdgcn_exp2f(s.x); e.y = __builtin_amdgcn_exp2f(s.y);
    const f32x2 m = v * (q * e), r = v - m;
    f32x2 o; o.x = v.x < 0.f ? m.x : r.x; o.y = v.y < 0.f ? m.y : r.y; return o;
}

template <int ACT  > struct EpiBf16 {
    static constexpr bool PERM = true, AFTER_DRAIN = false, CHAIN = false; static_assert(ACT == 0 || ACT == 1, "EpiBf16: ACT is 0 (none) or 1 (gelu_pk)");
    bf16_t* O; int ldc; const float* bias; int split_cols; size_t split_stride; float scale0;
    __device__ __forceinline__ void operator()(const f32x4 (&acc)[2][2][4][2], const Unit& u, int wr, int wc, int fr, int fq) const {
        const int row0 = u.pm * BM + wr * 64 + fr; int colt = u.pn * BM; bf16_t* base = O;
        float sc = 1.f; if (split_cols) { const int t = colt / split_cols; base += (size_t)t * split_stride; colt -= t * split_cols; if (t == 0) sc = scale0; }
        const int col0 = colt + wc * 32 + 8 * fq, bcol0 = u.pn * BM + wc * 32 + 8 * fq;
        f32x4 bv[2][2];
#pragma unroll
        for (int bj = 0; bj < 2; ++bj)
#pragma unroll
            for (int n = 0; n < 2; ++n) bv[bj][n] = bias ? *(const f32x4*)(bias + bcol0 + bj * HALF + 4 * n) : (f32x4){0.f, 0.f, 0.f, 0.f};
#pragma unroll
        for (int ai = 0; ai < 2; ++ai)
#pragma unroll
            for (int m = 0; m < 4; ++m) { bf16_t* rowp = base + (size_t)(row0 + ai * HALF + m * 16) * ldc + col0;
#pragma unroll
                for (int bj = 0; bj < 2; ++bj) { f32x4 v0 = acc[ai][bj][m][0] + bv[bj][0], v1 = acc[ai][bj][m][1] + bv[bj][1];
                    if (ACT == 1) { f32x2 a = gelu_pk((f32x2){v0[0], v0[1]}), b = gelu_pk((f32x2){v0[2], v0[3]}), c = gelu_pk((f32x2){v1[0], v1[1]}), d = gelu_pk((f32x2){v1[2], v1[3]});
                        v0 = (f32x4){a.x, a.y, b.x, b.y}; v1 = (f32x4){c.x, c.y, d.x, d.y}; }
                    v0 = v0 * sc; v1 = v1 * sc; u32x4 w; w.x = cvt_pk_bf16(v0[0], v0[1]); w.y = cvt_pk_bf16(v0[2], v0[3]); w.z = cvt_pk_bf16(v1[0], v1[1]); w.w = cvt_pk_bf16(v1[2], v1[3]);
                    *(u32x4*)(rowp + bj * HALF) = w; } }
    }
};

struct PanelStats {
    unsigned* xbuf;
    unsigned* cnt;
    unsigned* tmo;
    int ntn; float eps;
    unsigned code;
    __device__ __forceinline__ bool run(const f32x4 (&v)[2][2][4][2], const Unit& u, int wr, int wc, int fr, int fq, PG8_LAS unsigned char* lds, int wid, int lane) const {
        typedef float f32x2v __attribute__((ext_vector_type(2)));
        PG8_LAS f32x2v* P = (PG8_LAS f32x2v*)lds;
        PG8_LAS f32x2v* S = (PG8_LAS f32x2v*)(lds + 8192);
        PG8_LAS unsigned* flag = (PG8_LAS unsigned*)(lds + 8192 + 2048);
#pragma unroll
        for (int ai = 0; ai < 2; ++ai)
#pragma unroll
            for (int m = 0; m < 4; ++m) {
                float s = 0.f;
#pragma unroll
                for (int bj = 0; bj < 2; ++bj)
#pragma unroll
                    for (int n = 0; n < 2; ++n) { const f32x4 x = v[ai][bj][m][n]; s += (x[0] + x[1]) + (x[2] + x[3]); }
                s += __shfl_xor(s, 16); s += __shfl_xor(s, 32);
                const float mw = s * (1.0f / 64.0f); float q = 0.f;
#pragma unroll
                for (int bj = 0; bj < 2; ++bj)
#pragma unroll
                    for (int n = 0; n < 2; ++n) { const f32x4 d = v[ai][bj][m][n] - mw; q += (d[0] * d[0] + d[1] * d[1]) + (d[2] * d[2] + d[3] * d[3]); }
                q += __shfl_xor(q, 16); q += __shfl_xor(q, 32);
                if (fq == 0) P[(ai * HALF + wr * 64 + m * 16 + fr) * 4 + wc] = (f32x2v){mw, q};
            }
        asm volatile("s_waitcnt lgkmcnt(0)" ::: "memory"); __builtin_amdgcn_s_barrier(); asm volatile("" ::: "memory");
#if defined(BROKEN_EXCHANGE_NO_WAIT)
#warning BROKEN CONTROL BUILD: the row-statistics exchange does not wait; results are wrong by design
        if (blockIdx.x >= 64) { const long long t0_ = clock64(); while (clock64() - t0_ < 60000) __builtin_amdgcn_s_sleep(8); }
#endif
        const int row = wid * 32 + (lane & 31);
        if (lane < 32) {
            const f32x2v a = P[row * 4 + 0], b = P[row * 4 + 1], c = P[row * 4 + 2], d = P[row * 4 + 3];
            const float mt = (a.x + b.x + c.x + d.x) * 0.25f;
            const float da = a.x - mt, db = b.x - mt, dc = c.x - mt, dd = d.x - mt;
            const float m2 = (a.y + b.y) + (c.y + d.y) + 64.0f * ((da * da + db * db) + (dc * dc + dd * dd));
            unsigned long long* slot = (unsigned long long*)xbuf + ((size_t)(u.pm * BM + row) * 4 + u.pn);
            __hip_atomic_store(slot, ((unsigned long long)__float_as_uint(m2) << 32) | __float_as_uint(mt), __ATOMIC_RELAXED, __HIP_MEMORY_SCOPE_AGENT);
        }
        asm volatile("s_waitcnt vmcnt(0)" ::: "memory");
        if (lane == 0) __hip_atomic_fetch_add(cnt + 64 * u.pm, 1u, __ATOMIC_RELAXED, __HIP_MEMORY_SCOPE_AGENT);
        if (wid == 0) {
            bool dead = false; const unsigned long long t0 = __builtin_amdgcn_s_memrealtime(); const unsigned want = 8u * (unsigned)ntn;
            for (;;) {
#if defined(BROKEN_EXCHANGE_NO_WAIT)
                break;
#endif
                if ((unsigned)__builtin_amdgcn_readfirstlane(__hip_atomic_load(cnt + 64 * u.pm, __ATOMIC_RELAXED, __HIP_MEMORY_SCOPE_AGENT)) >= want) break;
                if (__builtin_amdgcn_s_memrealtime() - t0 > 2000000ull) {
                    if (lane == 0) { unsigned expect = 0u; __hip_atomic_compare_exchange_strong(tmo + 1, &expect, code | (unsigned)(u.pm & 0xff), __ATOMIC_RELAXED, __ATOMIC_RELAXED, __HIP_MEMORY_SCOPE_AGENT);
                                     __hip_atomic_store(tmo, 1u, __ATOMIC_RELAXED, __HIP_MEMORY_SCOPE_AGENT); }
                    dead = true; break; }
                __builtin_amdgcn_s_sleep(2);
            }
            __builtin_amdgcn_fence(__ATOMIC_ACQUIRE, "agent");
            if (lane == 0) flag[0] = dead ? 1u : 0u;
        }
        asm volatile("s_waitcnt vmcnt(0) lgkmcnt(0)" ::: "memory"); __builtin_amdgcn_s_barrier(); asm volatile("" ::: "memory");
        const bool bad = flag[0] != 0u;
        if (lane < 32) {
            const unsigned long long* slot = (const unsigned long long*)xbuf + (size_t)(u.pm * BM + row) * 4; float mt[4], m2[4]; float ms = 0.f;
#pragma unroll
            for (int t = 0; t < 4; ++t) { if (t < ntn) { const unsigned long long w = __hip_atomic_load(slot + t, __ATOMIC_RELAXED, __HIP_MEMORY_SCOPE_AGENT); mt[t] = __uint_as_float((unsigned)w); m2[t] = __uint_as_float((unsigned)(w >> 32)); } else { mt[t] = 0.f; m2[t] = 0.f; } ms += mt[t]; }
            const float mean = ms / (float)ntn; float q = 0.f;
#pragma unroll
            for (int t = 0; t < 4; ++t) if (t < ntn) { const float dm = mt[t] - mean; q += m2[t] + 256.0f * dm * dm; }
            S[row] = (f32x2v){mean, 1.0f / sqrtf(q / (256.0f * (float)ntn) + eps)};
        }
        asm volatile("s_waitcnt lgkmcnt(0)" ::: "memory"); __builtin_amdgcn_s_barrier(); asm volatile("" ::: "memory");
        return bad;
    }
};
struct EpiLnRes {
    static constexpr bool PERM = false, AFTER_DRAIN = true, CHAIN = false;
    const float* base; float* out; int ldc; const float* bias; PanelStats st; unsigned poison;
    __device__ __forceinline__ void fused(f32x4 (&acc)[2][2][4][2], const Unit& u, int wr, int wc, int fr, int fq, PG8_LAS unsigned char* lds, int wid, int lane) const {
        typedef float f32x2v __attribute__((ext_vector_type(2)));
        const PG8_LAS f32x2v* S = (const PG8_LAS f32x2v*)(lds + 8192);
        const int col0 = u.pn * BM + wc * 32 + 4 * fq;
#pragma unroll
        for (int bj = 0; bj < 2; ++bj)
#pragma unroll
            for (int n = 0; n < 2; ++n) { const f32x4 bv = bias ? *(const f32x4*)(bias + col0 + bj * HALF + n * 16) : (f32x4){0.f, 0.f, 0.f, 0.f};
#pragma unroll
                for (int ai = 0; ai < 2; ++ai)
#pragma unroll
                    for (int m = 0; m < 4; ++m) acc[ai][bj][m][n] += bv; }
        f32x4 pre[4][2][2];
#pragma unroll
        for (int m = 0; m < 4; ++m) { const size_t off = (size_t)(u.pm * BM + wr * 64 + m * 16 + fr) * ldc + col0;
#pragma unroll
            for (int bj = 0; bj < 2; ++bj)
#pragma unroll
                for (int n = 0; n < 2; ++n) pre[m][bj][n] = *(const f32x4*)(base + off + bj * HALF + n * 16); }
        const bool bad = st.run(acc, u, wr, wc, fr, fq, lds, wid, lane) || poison != 0u;
        const float qnan = __builtin_nanf("");
#pragma unroll
        for (int ai = 0; ai < 2; ++ai)
#pragma unroll
            for (int m = 0; m < 4; ++m) { const int r = ai * HALF + wr * 64 + m * 16 + fr; const f32x2v sr = S[r]; const size_t off = (size_t)(u.pm * BM + r) * ldc + col0;
#pragma unroll
                for (int bj = 0; bj < 2; ++bj)
#pragma unroll
                    for (int n = 0; n < 2; ++n) { const f32x4 bs = ai == 0 ? pre[m][bj][n] : *(const f32x4*)(base + off + bj * HALF + n * 16); f32x4 o = bs + (acc[ai][bj][m][n] - sr.x) * sr.y;
                        if (bad) o = (f32x4){qnan, qnan, qnan, qnan}; *(f32x4*)(out + off + bj * HALF + n * 16) = o; }
                if (m & 1) asm volatile("" ::: "memory"); }
    }
};
struct EpiLnResLn {
    static constexpr bool PERM = false, AFTER_DRAIN = true, CHAIN = false;
    const float* base; float* out; bf16_t* xn; int ldc; const float* bias; PanelStats st1, st2; unsigned poison;
    __device__ __forceinline__ void fused(f32x4 (&acc)[2][2][4][2], const Unit& u, int wr, int wc, int fr, int fq, PG8_LAS unsigned char* lds, int wid, int lane) const {
        typedef float f32x2v __attribute__((ext_vector_type(2))); typedef unsigned u32x2v __attribute__((ext_vector_type(2)));
        const PG8_LAS f32x2v* S = (const PG8_LAS f32x2v*)(lds + 8192);
        const int col0 = u.pn * BM + wc * 32 + 4 * fq;
#pragma unroll
        for (int bj = 0; bj < 2; ++bj)
#pragma unroll
            for (int n = 0; n < 2; ++n) { const f32x4 bv = bias ? *(const f32x4*)(bias + col0 + bj * HALF + n * 16) : (f32x4){0.f, 0.f, 0.f, 0.f};
#pragma unroll
                for (int ai = 0; ai < 2; ++ai)
#pragma unroll
                    for (int m = 0; m < 4; ++m) acc[ai][bj][m][n] += bv; }
        bool bad = st1.run(acc, u, wr, wc, fr, fq, lds, wid, lane) || poison != 0u;
        const float qnan = __builtin_nanf("");
#pragma unroll
        for (int ai = 0; ai < 2; ++ai)
#pragma unroll
            for (int m = 0; m < 4; ++m) { const int r = ai * HALF + wr * 64 + m * 16 + fr; const f32x2v sr = S[r]; const size_t off = (size_t)(u.pm * BM + r) * ldc + col0;
#pragma unroll
                for (int bj = 0; bj < 2; ++bj)
#pragma unroll
                    for (int n = 0; n < 2; ++n) { const f32x4 bs = *(const f32x4*)(base + off + bj * HALF + n * 16); acc[ai][bj][m][n] = bs + (acc[ai][bj][m][n] - sr.x) * sr.y; }
                asm volatile("" : "+v"(acc[ai][0][m][0]), "+v"(acc[ai][0][m][1]), "+v"(acc[ai][1][m][0]), "+v"(acc[ai][1][m][1]));
                if (m & 1) asm volatile("" ::: "memory"); }
        const bool bad1 = bad;
        bad = st2.run(acc, u, wr, wc, fr, fq, lds, wid, lane) || bad;
#pragma unroll
        for (int ai = 0; ai < 2; ++ai)
#pragma unroll
            for (int m = 0; m < 4; ++m) { const int r = ai * HALF + wr * 64 + m * 16 + fr; const f32x2v sr = S[r]; const size_t off = (size_t)(u.pm * BM + r) * ldc + col0;
#pragma unroll
                for (int bj = 0; bj < 2; ++bj)
#pragma unroll
                    for (int n = 0; n < 2; ++n) { const f32x4 x1 = acc[ai][bj][m][n]; *(f32x4*)(out + off + bj * HALF + n * 16) = bad1 ? (f32x4){qnan, qnan, qnan, qnan} : x1;
                        const f32x4 o = (x1 - sr.x) * sr.y; u32x2v w; w.x = cvt_pk_bf16(o[0], o[1]); w.y = cvt_pk_bf16(o[2], o[3]);
                        if (bad) { w.x = 0x7fc07fc0u; w.y = 0x7fc07fc0u; } *(u32x2v*)(xn + off + bj * HALF + n * 16) = w; }
                asm volatile("" ::: "memory"); }
    }
};

template <class Epi, class Sched, bool ALIGN_EPI = false, bool SP2 = false>
__device__ __forceinline__ void gemm_phase(PG8_LAS unsigned char* lds, const Gemm g, const Sched& S, const Epi& E, const Gemm g1 = Gemm{nullptr, nullptr, 0, 0, 0}) {
    const int tid = threadIdx.x, wid = __builtin_amdgcn_readfirstlane(tid >> 6), lane = tid & 63, wr = wid >> 2, wc = wid & 3, fr = lane & 15, fq = lane >> 4;
    const int K = g.K, nt = K / BK;
    unsigned voffA[2], voffB[2];
#pragma unroll
    for (int i = 0; i < 2; ++i) { int R, C; stage_rc(tid * 16 + i * 8192, R, C); const int Rb = Epi::PERM ? ((R & ~31) + perm32(R & 31)) : R;
        voffA[i] = (unsigned)(R * K + C) * 2u; voffB[i] = (unsigned)(Rb * K + C) * 2u; }
    const size_t kstep = (size_t)(BK * 2);
    const size_t hstep = (size_t)HALF * K * 2;
    const size_t tstep = 2 * hstep;
    const unsigned ldsw = (unsigned)wid * 1024u;
    const int aoff = lds_byte(wr * 64 + fr, fq * 8), boff = lds_byte(wc * 32 + fr, fq * 8);
#define PG8_SA(b, h) (((b) * 2 + (h)) * HTB)
#define PG8_SB(b, h) ((4 + (b) * 2 + (h)) * HTB)
#define PG8_STAGE(bufoff, gbase, voff) do { _Pragma("unroll") for (int _i = 0; _i < 2; ++_i) \
        __builtin_amdgcn_global_load_lds((const unsigned*)((const char*)(gbase) + (voff)[_i]), (PG8_LAS unsigned*)(lds + (bufoff) + ldsw + _i * 8192), 16, 0, 0); } while (0)
#define PG8_LDA(dst, b, h) do { _Pragma("unroll") for (int m = 0; m < 4; ++m) _Pragma("unroll") for (int k = 0; k < 2; ++k) dst[m][k] = *(const PG8_LAS bf16x8*)(lds + PG8_SA(b, h) + aoff + m * 2048 + k * 1024); } while (0)
#define PG8_LDB(dst, b, h) do { _Pragma("unroll") for (int n = 0; n < 2; ++n) _Pragma("unroll") for (int k = 0; k < 2; ++k) dst[n][k] = *(const PG8_LAS bf16x8*)(lds + PG8_SB(b, h) + boff + n * 2048 + k * 1024); } while (0)
#define PG8_MMA(ai, bj, At, Bt) do { __builtin_amdgcn_s_setprio(1); _Pragma("unroll") for (int m = 0; m < 4; ++m) _Pragma("unroll") for (int n = 0; n < 2; ++n) _Pragma("unroll") for (int k = 0; k < 2; ++k) \
        acc[ai][bj][m][n] = __builtin_amdgcn_mfma_f32_16x16x32_bf16(Bt[n][k], At[m][k], acc[ai][bj][m][n], 0, 0, 0); __builtin_amdgcn_s_setprio(0); } while (0)
#define PG8_WAIT_V(n) asm volatile("s_waitcnt vmcnt(" #n ")" ::: "memory")
#define PG8_WAIT_L(n) asm volatile("s_waitcnt lgkmcnt(" #n ")" ::: "memory")
#define PG8_BAR __builtin_amdgcn_s_barrier()
#define PG8_SCHED __builtin_amdgcn_sched_barrier(0)
    Unit cur, nxt; int ui = 0;
    if (!S.next(0, cur)) return;
    f32x4 acc[2][2][4][2];
#pragma unroll
    for (int a = 0; a < 2; ++a)
#pragma unroll
        for (int b = 0; b < 2; ++b)
#pragma unroll
            for (int m = 0; m < 4; ++m)
#pragma unroll
                for (int n = 0; n < 2; ++n) acc[a][b][m][n] = (f32x4){0.f, 0.f, 0.f, 0.f};
    bf16x8 At[4][2], B0[2][2], B1[2][2];
    const char* cA = (const char*)(cur.sel ? g1.A : g.A) + (size_t)cur.pm * tstep; const char* cB = (const char*)(cur.sel ? g1.Bt : g.Bt) + (size_t)cur.pn * tstep;
    S.a_ready(cur);
    if constexpr (SP2) {
        PG8_STAGE(PG8_SB(0, 0), cB, voffB); PG8_STAGE(PG8_SB(0, 1), cB + hstep, voffB); PG8_STAGE(PG8_SA(0, 0), cA, voffA); PG8_STAGE(PG8_SA(0, 1), cA + hstep, voffA);
        if (wr == 1) PG8_BAR;
        PG8_WAIT_V(2); PG8_BAR;
        PG8_STAGE(PG8_SB(1, 0), cB + kstep, voffB); PG8_STAGE(PG8_SA(1, 0), cA + kstep, voffA); PG8_STAGE(PG8_SB(1, 1), cB + hstep + kstep, voffB);
        PG8_WAIT_V(6); PG8_BAR;
    } else {
        PG8_STAGE(PG8_SB(0, 0), cB, voffB); PG8_STAGE(PG8_SA(0, 0), cA, voffA); PG8_STAGE(PG8_SB(0, 1), cB + hstep, voffB); PG8_STAGE(PG8_SA(0, 1), cA + hstep, voffA);
        if (wr == 1) PG8_BAR;
        PG8_WAIT_V(4); PG8_BAR;
        PG8_STAGE(PG8_SB(1, 0), cB + kstep, voffB); PG8_STAGE(PG8_SA(1, 0), cA + kstep, voffA); PG8_STAGE(PG8_SB(1, 1), cB + hstep + kstep, voffB);
        PG8_WAIT_V(6); PG8_BAR;
    }
    for (;;) {
        const bool has_next = S.next(ui + 1, nxt);
        const char* nA = has_next ? (const char*)(nxt.sel ? g1.A : g.A) + (size_t)nxt.pm * tstep : cA; const char* nB = has_next ? (const char*)(nxt.sel ? g1.Bt : g.Bt) + (size_t)nxt.pn * tstep : cB;
        for (int t = 0; t < nt; t += 2) {
            const bool last = (t == nt - 2);
            const char* a1 = cA + (size_t)(t + 1) * kstep;
            const char* a2 = last ? nA : cA + (size_t)(t + 2) * kstep; const char* b2 = last ? nB : cB + (size_t)(t + 2) * kstep;
            const char* a3 = a2 + kstep; const char* b3 = b2 + kstep;
            if (last && has_next) S.a_ready(nxt);
            if constexpr (SP2) {
            PG8_LDB(B0, 0, 0); PG8_LDB(B1, 0, 1); PG8_SCHED; PG8_LDA(At, 0, 0); PG8_STAGE(PG8_SA(1, 1), a1 + hstep, voffA);
            PG8_WAIT_V(8); PG8_WAIT_L(0); PG8_BAR; PG8_MMA(0, 0, At, B0); PG8_MMA(0, 1, At, B1); PG8_BAR; PG8_SCHED;
            PG8_LDA(At, 0, 1); PG8_STAGE(PG8_SB(0, 0), b2, voffB); PG8_STAGE(PG8_SB(0, 1), b2 + hstep, voffB); PG8_STAGE(PG8_SA(0, 0), a2, voffA);
            PG8_WAIT_V(8); PG8_WAIT_L(0); PG8_BAR; PG8_MMA(1, 0, At, B0); PG8_MMA(1, 1, At, B1); PG8_BAR; PG8_SCHED;
            PG8_LDB(B0, 1, 0); PG8_LDB(B1, 1, 1); PG8_SCHED; PG8_LDA(At, 1, 0); PG8_STAGE(PG8_SA(0, 1), a2 + hstep, voffA);
            PG8_WAIT_V(8); PG8_WAIT_L(0); PG8_BAR; PG8_MMA(0, 0, At, B0); PG8_MMA(0, 1, At, B1); PG8_BAR; PG8_SCHED;
            PG8_LDA(At, 1, 1); PG8_STAGE(PG8_SB(1, 0), b3, voffB); PG8_STAGE(PG8_SB(1, 1), b3 + hstep, voffB); PG8_STAGE(PG8_SA(1, 0), a3, voffA);
            PG8_WAIT_V(8); PG8_WAIT_L(0); PG8_BAR; PG8_MMA(1, 0, At, B0); PG8_MMA(1, 1, At, B1); PG8_BAR; PG8_SCHED;
            } else {
            PG8_LDB(B0, 0, 0); PG8_SCHED; PG8_LDA(At, 0, 0); PG8_STAGE(PG8_SA(1, 1), a1 + hstep, voffA);
            PG8_WAIT_L(8); PG8_BAR; PG8_WAIT_L(0); PG8_MMA(0, 0, At, B0); PG8_BAR; PG8_SCHED;
            PG8_LDB(B1, 0, 1); PG8_STAGE(PG8_SB(0, 0), b2, voffB);
            PG8_BAR; PG8_WAIT_L(0); PG8_MMA(0, 1, At, B1); PG8_BAR;
            PG8_LDA(At, 0, 1); PG8_STAGE(PG8_SA(0, 0), a2, voffA);
            PG8_BAR; PG8_WAIT_L(0); PG8_MMA(1, 0, At, B0); PG8_BAR; PG8_SCHED;
            PG8_STAGE(PG8_SB(0, 1), b2 + hstep, voffB);
            PG8_WAIT_V(6); PG8_BAR; PG8_MMA(1, 1, At, B1); PG8_BAR;
            PG8_LDB(B0, 1, 0); PG8_SCHED; PG8_LDA(At, 1, 0); PG8_STAGE(PG8_SA(0, 1), a2 + hstep, voffA);
            PG8_WAIT_L(8); PG8_BAR; PG8_WAIT_L(0); PG8_MMA(0, 0, At, B0); PG8_BAR; PG8_SCHED;
            PG8_LDB(B1, 1, 1); PG8_STAGE(PG8_SB(1, 0), b3, voffB);
            PG8_BAR; PG8_WAIT_L(0); PG8_MMA(0, 1, At, B1); PG8_BAR;
            PG8_LDA(At, 1, 1); PG8_STAGE(PG8_SA(1, 0), a3, voffA);
            PG8_BAR; PG8_WAIT_L(0); PG8_MMA(1, 0, At, B0); PG8_BAR; PG8_SCHED;
            PG8_STAGE(PG8_SB(1, 1), b3 + hstep, voffB);
            PG8_WAIT_V(6); PG8_BAR; PG8_MMA(1, 1, At, B1); PG8_BAR;
            }
        }
        if constexpr (ALIGN_EPI) { if (wr == 0) PG8_BAR; }
        bool keep_acc = false;
        if constexpr (Epi::CHAIN) { keep_acc = E.chain(acc, cur, wr, wc, fr, fq); }
        if constexpr (!Epi::AFTER_DRAIN) { if (!keep_acc) { E(acc, cur, wr, wc, fr, fq); } S.done(cur); }
        if (!has_next) break;
        if (!keep_acc) {
#pragma unroll
        for (int a = 0; a < 2; ++a)
#pragma unroll
            for (int b = 0; b < 2; ++b)
#pragma unroll
                for (int m = 0; m < 4; ++m)
#pragma unroll
                    for (int n = 0; n < 2; ++n) acc[a][b][m][n] = (f32x4){0.f, 0.f, 0.f, 0.f};
        }
        cur = nxt; cA = nA; cB = nB; ++ui;
        if constexpr (ALIGN_EPI) { if (wr == 1) PG8_BAR; }
    }
    PG8_WAIT_V(0);
    if constexpr (!ALIGN_EPI) { if (wr == 0) PG8_BAR; }
    PG8_BAR;
    if constexpr (Epi::AFTER_DRAIN) { E.fused(acc, cur, wr, wc, fr, fq, lds, wid, lane); S.done(cur); }
#undef PG8_SA
#undef PG8_SB
#undef PG8_STAGE
#undef PG8_LDA
#undef PG8_LDB
#undef PG8_MMA
#undef PG8_WAIT_V
#undef PG8_WAIT_L
#undef PG8_BAR
#undef PG8_SCHED
}
}

#define GAS __attribute__((address_space(1)))
#define LAS __attribute__((address_space(3)))
typedef unsigned v4u __attribute__((ext_vector_type(4)));
typedef float f32x4 __attribute__((ext_vector_type(4)));
typedef short bf16x8 __attribute__((ext_vector_type(8)));
typedef GAS unsigned gu32;
typedef GAS unsigned long long gu64;
#define RLX_AGENT __ATOMIC_RELAXED, __HIP_MEMORY_SCOPE_AGENT
#define LDS_WAIT() asm volatile("s_waitcnt lgkmcnt(0)" ::: "memory")
#define VM_WAIT() asm volatile("s_waitcnt vmcnt(0)" ::: "memory")
__device__ __forceinline__ unsigned f2bf(float f) { unsigned u = __builtin_bit_cast(unsigned, f); return (u + 0x7fffu + ((u >> 16) & 1u)) >> 16; }
__device__ __forceinline__ unsigned pk2(float lo, float hi) { return f2bf(lo) | (f2bf(hi) << 16); }
__device__ __forceinline__ float wave_sum(float v) {
#pragma unroll
  for (int o = 1; o < 64; o <<= 1) v += __shfl_xor(v, o);
  return v;
}
__device__ __forceinline__ float wave_sum_dpp(float v) {
  v += __builtin_bit_cast(float, __builtin_amdgcn_update_dpp(0, __builtin_bit_cast(int, v), 0xB1, 0xF, 0xF, true));
  v += __builtin_bit_cast(float, __builtin_amdgcn_update_dpp(0, __builtin_bit_cast(int, v), 0x4E, 0xF, 0xF, true));
  v += __builtin_bit_cast(float, __builtin_amdgcn_update_dpp(0, __builtin_bit_cast(int, v), 0x141, 0xF, 0xF, true));
  v += __builtin_bit_cast(float, __builtin_amdgcn_update_dpp(0, __builtin_bit_cast(int, v), 0x140, 0xF, 0xF, true));
  v += __builtin_bit_cast(float, __builtin_amdgcn_update_dpp(0, __builtin_bit_cast(int, v), 0x142, 0xA, 0xF, true));
  v += __builtin_bit_cast(float, __builtin_amdgcn_update_dpp(0, __builtin_bit_cast(int, v), 0x143, 0xC, 0xF, true));
  return __builtin_bit_cast(float, __builtin_amdgcn_readlane(__builtin_bit_cast(int, v), 63));
}

#define XB_TMO      128
#define XB_XCNT(j)  (256  + 64 * (j))
#define XB_XSUB(j)  (1280 + 64 * (j))
#define XB_XGEN(j)  (2304 + 64 * (j))
#define XB_TOP      3328
#define XB_TOPGEN   3392
#define XCD_BAR_WORDS 3456
#define XB_SPIN_CAP (1u << 18)

__device__ __forceinline__ unsigned xb_ld(unsigned* p)              { return __hip_atomic_load(p, __ATOMIC_RELAXED, __HIP_MEMORY_SCOPE_AGENT); }
__device__ __forceinline__ unsigned xb_add(unsigned* p, unsigned v) { return __hip_atomic_fetch_add(p, v, __ATOMIC_RELAXED, __HIP_MEMORY_SCOPE_AGENT); }
__device__ __forceinline__ unsigned xb_xcc_id() { return (unsigned)__builtin_amdgcn_s_getreg((3 << 11) | 20) & 0xFu; }
#define XB_SPIN(cond, bar) do { unsigned _sp = 0; while (cond) { __builtin_amdgcn_s_sleep(1); \
    if ((++_sp & 255u) == 0u) { if (xb_ld(&(bar)[XB_TMO])) break; if (_sp > XB_SPIN_CAP) { atomicAdd(&(bar)[XB_TMO], 1u); break; } } } } while (0)

struct XcdBarrier {
    unsigned* bar; unsigned x;
    volatile LAS unsigned* st;
};

__device__ __forceinline__ XcdBarrier xcd_barrier_post(unsigned* bar, volatile LAS unsigned* st) {
    XcdBarrier b; b.bar = bar; b.x = xb_xcc_id(); b.st = st;
    if (threadIdx.x == 0) (void)xb_add(&bar[XB_XCNT(b.x)], 1u);
    return b;
}
__device__ __forceinline__ void xcd_barrier_complete(unsigned* bar, unsigned x, unsigned& nloc, unsigned& nx) {
    const unsigned G = gridDim.x * gridDim.y * gridDim.z;
    unsigned sum, cnt, mine, sp = 0u;
    for (;;) {
        sum = 0u; cnt = 0u; mine = 0u;
#pragma unroll
        for (unsigned j = 0; j < 16; ++j) { const unsigned c = xb_ld(&bar[XB_XCNT(j)]); sum += c; cnt += (c > 0u) ? 1u : 0u; mine = (j == x) ? c : mine; }
        if (sum == G) break;
        __builtin_amdgcn_s_sleep(1);
        if ((++sp & 255u) == 0u) { if (xb_ld(&bar[XB_TMO])) break; if (sp > XB_SPIN_CAP) { atomicAdd(&bar[XB_TMO], 1u); break; } }
    }
    nloc = mine > 0u ? mine : 1u; nx = cnt > 0u ? cnt : 1u;
}

__device__ __forceinline__ void xcd_barrier(const XcdBarrier& b) {
    asm volatile("s_waitcnt vmcnt(0)" ::: "memory");
    __syncthreads();
    if (threadIdx.x == 0) {
        unsigned* bar = b.bar;
        __builtin_amdgcn_s_waitcnt(0);
        unsigned nloc = b.st[0], nx = b.st[1];
        if (nloc == 0u) { xcd_barrier_complete(bar, b.x, nloc, nx); b.st[0] = nloc; b.st[1] = nx; }
        const unsigned old = xb_add(&bar[XB_XSUB(b.x)], 1u);
        const unsigned gen = old / nloc;
        if (old + 1u == (gen + 1u) * nloc) {
            __builtin_amdgcn_fence(__ATOMIC_RELEASE, "agent");
            asm volatile("s_waitcnt vmcnt(0)" ::: "memory");
            const unsigned og = xb_add(&bar[XB_TOP], 1u);
            const unsigned tg = og / nx;
            if (og + 1u == (tg + 1u) * nx) xb_add(&bar[XB_TOPGEN], 1u);
            else XB_SPIN(xb_ld(&bar[XB_TOPGEN]) == tg, bar);
            __builtin_amdgcn_fence(__ATOMIC_ACQUIRE, "agent");
            xb_add(&bar[XB_XGEN(b.x)], 1u);
            asm volatile("s_waitcnt vmcnt(0)" ::: "memory");
        } else {
            XB_SPIN(xb_ld(&bar[XB_XGEN(b.x)]) == gen, bar);
            __builtin_amdgcn_fence(__ATOMIC_ACQUIRE, "agent");
            asm volatile("s_waitcnt vmcnt(0)" ::: "memory");
        }
    }
    __syncthreads();
}


namespace sg {
typedef float f32x16 __attribute__((ext_vector_type(16)));
constexpr int BM = 128, BN = 256, BK = 64, RS = 144;
constexpr int A_BYTES = BM * RS;
__device__ __forceinline__ int crow(int r, int hi) { return (r & 3) + 8 * (r >> 2) + 4 * hi; }
template <class Epi>
__device__ __forceinline__ void tile(LAS unsigned char* lds, const us* const (&ap)[2], const us* bf0, const us* bf1, int K, const Epi& E, int tid) {
  const int lane = tid & 63, wave = __builtin_amdgcn_readfirstlane(tid >> 6), wm = wave >> 2, wn = wave & 3;
  const int r32 = lane & 31, hi = lane >> 5;
  f32x16 acc[2][2];
#pragma unroll
  for (int a = 0; a < 2; ++a)
#pragma unroll
    for (int b = 0; b < 2; ++b)
#pragma unroll
      for (int r = 0; r < 16; ++r) acc[a][b][r] = 0.f;
  v4u ra0[2], ra1[2];
  bf16x8 bq[2][4];
  unsigned wa[2];
#pragma unroll
  for (int i = 0; i < 2; ++i) { const int c = tid + 512 * i; wa[i] = (unsigned)((c >> 3) * RS + (c & 7) * 16); }
  const unsigned aoff = (unsigned)((wm * 64 + r32) * RS + hi * 16);
  const int nk = K / BK;
#define SG_LOADA(RA, kt_) do { const int kc_ = (kt_) < nk ? (kt_) : nk - 1; \
    _Pragma("unroll") for (int i = 0; i < 2; ++i) RA[i] = *(const v4u*)(ap[i] + kc_ * BK); } while (0)
#define SG_LOADB1(ks, kt_) do { const int kc_ = (kt_) < nk ? (kt_) : nk - 1; \
    bq[0][ks] = *(const bf16x8*)(bf0 + (size_t)(kc_ * 4 + (ks)) * 512); bq[1][ks] = *(const bf16x8*)(bf1 + (size_t)(kc_ * 4 + (ks)) * 512); } while (0)
#define SG_WRITEA(RA, bufoff) do { \
    _Pragma("unroll") for (int i = 0; i < 2; ++i) *(LAS v4u*)(lds + (bufoff) + wa[i]) = RA[i]; } while (0)
#define SG_COMPUTE(bufoff, ktn_) do { \
    _Pragma("unroll") for (int ks = 0; ks < 4; ++ks) { \
      bf16x8 af[2]; \
      _Pragma("unroll") for (int m = 0; m < 2; ++m) af[m] = *(const LAS bf16x8*)(lds + (bufoff) + aoff + m * 32 * RS + ks * 32); \
      _Pragma("unroll") for (int h = 0; h < 2; ++h) \
        _Pragma("unroll") for (int m = 0; m < 2; ++m) acc[h][m] = __builtin_amdgcn_mfma_f32_32x32x16_bf16(bq[h][ks], af[m], acc[h][m], 0, 0, 0); \
      SG_LOADB1(ks, ktn_); } } while (0)
  SG_LOADA(ra0, 0);
#pragma unroll
  for (int ks = 0; ks < 4; ++ks) SG_LOADB1(ks, 0);
  SG_LOADA(ra1, 1);
  SG_WRITEA(ra0, 0);
  __syncthreads();
  for (int kt = 0; kt < nk; kt += 2) {
    SG_LOADA(ra0, kt + 2);
    SG_COMPUTE(0, kt + 1);
    SG_WRITEA(ra1, A_BYTES);
    __syncthreads();
    SG_LOADA(ra1, kt + 3);
    SG_COMPUTE(A_BYTES, kt + 2);
    SG_WRITEA(ra0, 0);
    __syncthreads();
  }
#undef SG_LOADA
#undef SG_LOADB1
#undef SG_WRITEA
#undef SG_COMPUTE
  E(acc, wm, wn, r32, hi);
}
template <class Epi>
__device__ __forceinline__ void tile_wide(LAS unsigned char* lds, const us* const (&ap)[2], const us* bf0, const us* bf1, int K, const Epi& E, int tid) {
  const int lane = tid & 63, wave = __builtin_amdgcn_readfirstlane(tid >> 6);
  const int r32 = lane & 31, hi = lane >> 5;
  f32x16 acc[2][4];
#pragma unroll
  for (int a = 0; a < 2; ++a)
#pragma unroll
    for (int b = 0; b < 4; ++b)
#pragma unroll
      for (int r = 0; r < 16; ++r) acc[a][b][r] = 0.f;
  v4u ra0[2];
  bf16x8 bq[2][4];
  unsigned wa[2];
#pragma unroll
  for (int i = 0; i < 2; ++i) { const int c = tid + 512 * i; wa[i] = (unsigned)((c >> 3) * RS + (c & 7) * 16); }
  const unsigned aoff = (unsigned)(r32 * RS + hi * 16);
  const int nk = K / BK;
#define SGW_LOADA(RA, kt_) do { const int kc_ = (kt_) < nk ? (kt_) : nk - 1; \
    _Pragma("unroll") for (int i = 0; i < 2; ++i) RA[i] = *(const v4u*)(ap[i] + kc_ * BK); } while (0)
#define SGW_LOADB1(ks, kt_) do { const int kc_ = (kt_) < nk ? (kt_) : nk - 1; \
    bq[0][ks] = *(const bf16x8*)(bf0 + (size_t)(kc_ * 4 + (ks)) * 512); bq[1][ks] = *(const bf16x8*)(bf1 + (size_t)(kc_ * 4 + (ks)) * 512); } while (0)
#define SGW_WRITEA(RA, bufoff) do { \
    _Pragma("unroll") for (int i = 0; i < 2; ++i) *(LAS v4u*)(lds + (bufoff) + wa[i]) = RA[i]; } while (0)
#define SGW_LDA(dst, bufoff, ks) do { _Pragma("unroll") for (int m = 0; m < 4; ++m) dst[m] = *(const LAS bf16x8*)(lds + (bufoff) + aoff + m * 32 * RS + (ks) * 32); } while (0)
#define SGW_MMA(afr, ks, ktn_) do { \
      _Pragma("unroll") for (int h = 0; h < 2; ++h) \
        _Pragma("unroll") for (int m = 0; m < 4; ++m) acc[h][m] = __builtin_amdgcn_mfma_f32_32x32x16_bf16(bq[h][ks], afr[m], acc[h][m], 0, 0, 0); \
      SGW_LOADB1(ks, ktn_); __builtin_amdgcn_sched_barrier(0); } while (0)
#define SGW_COMPUTE(bufoff, ktn_) do { bf16x8 afA[4], afB[4]; \
    SGW_LDA(afA, bufoff, 0); \
    SGW_LDA(afB, bufoff, 1); SGW_MMA(afA, 0, ktn_); \
    SGW_LDA(afA, bufoff, 2); SGW_MMA(afB, 1, ktn_); \
    SGW_LDA(afB, bufoff, 3); SGW_MMA(afA, 2, ktn_); \
    SGW_MMA(afB, 3, ktn_); } while (0)
  SGW_LOADA(ra0, 0);
#pragma unroll
  for (int ks = 0; ks < 4; ++ks) SGW_LOADB1(ks, 0);
  SGW_WRITEA(ra0, 0);
  __syncthreads();
  for (int kt = 0; kt < nk; kt += 2) {
    SGW_LOADA(ra0, kt + 1); __builtin_amdgcn_sched_barrier(0);
    SGW_COMPUTE(0, kt + 1);
    SGW_WRITEA(ra0, A_BYTES);
    __syncthreads();
    SGW_LOADA(ra0, kt + 2); __builtin_amdgcn_sched_barrier(0);
    SGW_COMPUTE(A_BYTES, kt + 2);
    SGW_WRITEA(ra0, 0);
    __syncthreads();
  }
#undef SGW_LOADA
#undef SGW_LOADB1
#undef SGW_WRITEA
#undef SGW_COMPUTE
#undef SGW_LDA
#undef SGW_MMA
  E(acc, wave, r32, hi);
}
constexpr int ARS = 528;
template <class Epi>
__device__ __forceinline__ void tile_resident(LAS unsigned char* lds, const us* bf0, const us* bf1, const Epi& E, int tid) {
  const int lane = tid & 63, wave = __builtin_amdgcn_readfirstlane(tid >> 6), wm = wave >> 2, wn = wave & 3;
  const int r32 = lane & 31, hi = lane >> 5;
  f32x16 acc[2][2];
#pragma unroll
  for (int a = 0; a < 2; ++a)
#pragma unroll
    for (int b = 0; b < 2; ++b)
#pragma unroll
      for (int r = 0; r < 16; ++r) acc[a][b][r] = 0.f;
  bf16x8 bq[2][4];
  const unsigned aoff = (unsigned)((wm * 64 + r32) * ARS + hi * 16);
#define SGR_LOADB1(ks, kc_) do { bq[0][ks] = *(const bf16x8*)(bf0 + (size_t)((kc_) * 4 + (ks)) * 512); bq[1][ks] = *(const bf16x8*)(bf1 + (size_t)((kc_) * 4 + (ks)) * 512); } while (0)
#pragma unroll
  for (int ks = 0; ks < 4; ++ks) SGR_LOADB1(ks, 0);
  bf16x8 afA[2], afB[2];
#define SGR_LDA(dst, st_) do { _Pragma("unroll") for (int m = 0; m < 2; ++m) dst[m] = *(const LAS bf16x8*)(lds + aoff + m * 32 * ARS + (st_) * 32); } while (0)
#define SGR_MMA(afr, st_) do { \
      _Pragma("unroll") for (int h = 0; h < 2; ++h) \
        _Pragma("unroll") for (int m = 0; m < 2; ++m) acc[h][m] = __builtin_amdgcn_mfma_f32_32x32x16_bf16(bq[h][(st_) & 3], afr[m], acc[h][m], 0, 0, 0); \
      if ((st_) < 12) SGR_LOADB1((st_) & 3, ((st_) >> 2) + 1); \
      __builtin_amdgcn_sched_barrier(0); } while (0)
  SGR_LDA(afA, 0);
#pragma unroll
  for (int st = 0; st < 16; st += 2) {
    SGR_LDA(afB, st + 1); SGR_MMA(afA, st);
    if (st + 2 < 16) SGR_LDA(afA, st + 2);
    SGR_MMA(afB, st + 1);
  }
#undef SGR_LDA
#undef SGR_MMA
#undef SGR_LOADB1
  E(acc, wm, wn, r32, hi);
}
}

constexpr size_t MiB = 1u << 20;
constexpr size_t WS_CTL = 0, CTL_ZERO_BYTES = 64 * 1024;
constexpr int CW_BAR = 1024;
constexpr size_t WS_WIN = 1 * MiB;
constexpr size_t WS_WCO = 12 * MiB;
constexpr size_t WS_WAO = 13 * MiB;
constexpr size_t WS_WO = 14 * MiB;
constexpr size_t WS_CT = 16 * MiB, WS_ST = 18 * MiB;
constexpr size_t WS_KI = 20 * MiB;
constexpr size_t WS_WI = 22 * MiB;
constexpr size_t WS_HB = 24 * MiB;
constexpr size_t WS_G = 56 * MiB;
constexpr size_t WS_QI = 72 * MiB, WS_K = 88 * MiB, WS_V = 104 * MiB, WS_Q = 120 * MiB;
constexpr size_t WS_GC = 136 * MiB, WS_GA = 168 * MiB;
constexpr size_t WS_NA = 200 * MiB, WS_AO = 216 * MiB;
constexpr size_t WS_M1 = 56 * MiB;
constexpr int CW_ATTN = 512;
constexpr size_t WS_Y1 = 88 * MiB;
constexpr size_t WS_X1B = 168 * MiB;
constexpr size_t WS_END = 232 * MiB;

constexpr int LDS_BYTES = 147456;
constexpr int MISC_OFF = LDS_BYTES - 256;

constexpr bool AMP_ON = false;
struct Args {
  const float* in[20];
  float* out;
  unsigned char* ws;
  int ph_lo, ph_hi, li, dup;
};
enum { PH_PREP = 0, PH_INPROJ = 1, PH_CONV = 2, PH_TOPK = 3, PH_ATTN = 4, PH_MIX = 5, PH_WO = 6, PH_ROUTE = 7, PH_MOE1 = 8, PH_MOE2 = 9, PH_FINAL = 10, PH_END = 11 };

constexpr int CW_M1 = 576, CW_X1 = 640;
template <bool ACCUM> struct EpiGate {
  static constexpr bool PERM = true, AFTER_DRAIN = false, CHAIN = false;
  const us* gate; us* M1;
  __device__ __forceinline__ void operator()(const pg8::f32x4 (&acc)[2][2][4][2], const pg8::Unit& u, int wr, int wc, int fr, int fq) const {
    const int row0 = u.pm * 256 + wr * 64 + fr, col0 = u.pn * 256 + wc * 32 + 8 * fq;
#pragma unroll
    for (int ai = 0; ai < 2; ++ai)
#pragma unroll
      for (int mh = 0; mh < 2; ++mh) {
        v4u gw[2][2], pw[2][2];
#pragma unroll
        for (int mm = 0; mm < 2; ++mm)
#pragma unroll
          for (int bj = 0; bj < 2; ++bj) {
            const size_t off = (size_t)(row0 + ai * 128 + (2 * mh + mm) * 16) * 1024 + col0 + bj * 128;
            gw[mm][bj] = *(const v4u*)(gate + off);
            if (ACCUM) pw[mm][bj] = *(const v4u*)(M1 + off);
          }
        __builtin_amdgcn_sched_barrier(0);
#pragma unroll
        for (int mm = 0; mm < 2; ++mm)
#pragma unroll
          for (int bj = 0; bj < 2; ++bj) {
            const int m = 2 * mh + mm;
            const size_t off = (size_t)(row0 + ai * 128 + m * 16) * 1024 + col0 + bj * 128;
            const v4u g = gw[mm][bj];
            const f32x4 v0 = acc[ai][bj][m][0], v1 = acc[ai][bj][m][1];
            float o[8];
            o[0] = __uint_as_float(g.x << 16) * v0[0]; o[1] = __uint_as_float(g.x & 0xffff0000u) * v0[1];
            o[2] = __uint_as_float(g.y << 16) * v0[2]; o[3] = __uint_as_float(g.y & 0xffff0000u) * v0[3];
            o[4] = __uint_as_float(g.z << 16) * v1[0]; o[5] = __uint_as_float(g.z & 0xffff0000u) * v1[1];
            o[6] = __uint_as_float(g.w << 16) * v1[2]; o[7] = __uint_as_float(g.w & 0xffff0000u) * v1[3];
            if (ACCUM) {
              const v4u p = pw[mm][bj];
              o[0] += __uint_as_float(p.x << 16); o[1] += __uint_as_float(p.x & 0xffff0000u);
              o[2] += __uint_as_float(p.y << 16); o[3] += __uint_as_float(p.y & 0xffff0000u);
              o[4] += __uint_as_float(p.z << 16); o[5] += __uint_as_float(p.z & 0xffff0000u);
              o[6] += __uint_as_float(p.w << 16); o[7] += __uint_as_float(p.w & 0xffff0000u);
            }
            v4u w; w.x = pk2(o[0], o[1]); w.y = pk2(o[2], o[3]); w.z = pk2(o[4], o[5]); w.w = pk2(o[6], o[7]);
            *(v4u*)(M1 + off) = w;
          }
        __builtin_amdgcn_sched_barrier(0);
      }
  }
};
struct DualOrder : pg8::StaticOrder {
  const unsigned* ready;
  __device__ bool next(int i, pg8::Unit& u) const { if (i >= 2) return false; const bool ok = pg8::StaticOrder::next(0, u); u.sel = i; return ok; }
  __device__ __forceinline__ void a_ready(const pg8::Unit& u) const {
    if (u.sel == 0) return;
    if (threadIdx.x < 64) {
      unsigned sp = 0;
      while ((unsigned)__builtin_amdgcn_readfirstlane(__hip_atomic_load(ready + u.pm, __ATOMIC_RELAXED, __HIP_MEMORY_SCOPE_AGENT)) < 8u) { __builtin_amdgcn_s_sleep(2); if (++sp > (1u << 22)) break; }
      __builtin_amdgcn_fence(__ATOMIC_ACQUIRE, "agent");
      asm volatile("s_waitcnt vmcnt(0)" ::: "memory");
    }
    asm volatile("" ::: "memory"); __builtin_amdgcn_s_barrier(); asm volatile("" ::: "memory");
  }
};
struct EpiGate2 {
  static constexpr bool PERM = true, AFTER_DRAIN = false, CHAIN = true;
  const us *gc, *ga; us* M1;
  __device__ __forceinline__ bool chain(pg8::f32x4 (&acc)[2][2][4][2], const pg8::Unit& u, int wr, int wc, int fr, int fq) const {
    if (u.sel != 0) return false;
    const int row0 = u.pm * 256 + wr * 64 + fr, col0 = u.pn * 256 + wc * 32 + 8 * fq;
#pragma unroll
    for (int ai = 0; ai < 2; ++ai)
#pragma unroll
      for (int mh = 0; mh < 2; ++mh) {
        v4u gw[2][2], hw[2][2];
#pragma unroll
        for (int mm = 0; mm < 2; ++mm)
#pragma unroll
          for (int bj = 0; bj < 2; ++bj) {
            const size_t off = (size_t)(row0 + ai * 128 + (2 * mh + mm) * 16) * 1024 + col0 + bj * 128;
            gw[mm][bj] = *(const v4u*)(gc + off); hw[mm][bj] = *(const v4u*)(ga + off);
          }
        __builtin_amdgcn_sched_barrier(0);
#pragma unroll
        for (int mm = 0; mm < 2; ++mm)
#pragma unroll
          for (int bj = 0; bj < 2; ++bj) {
            const int m = 2 * mh + mm;
            const v4u g = gw[mm][bj], h = hw[mm][bj];
            f32x4& v0 = acc[ai][bj][m][0]; f32x4& v1 = acc[ai][bj][m][1];
            v0[0] *= __uint_as_float(g.x << 16) * __builtin_amdgcn_rcpf(__uint_as_float(h.x << 16)); v0[1] *= __uint_as_float(g.x & 0xffff0000u) * __builtin_amdgcn_rcpf(__uint_as_float(h.x & 0xffff0000u));
            v0[2] *= __uint_as_float(g.y << 16) * __builtin_amdgcn_rcpf(__uint_as_float(h.y << 16)); v0[3] *= __uint_as_float(g.y & 0xffff0000u) * __builtin_amdgcn_rcpf(__uint_as_float(h.y & 0xffff0000u));
            v1[0] *= __uint_as_float(g.z << 16) * __builtin_amdgcn_rcpf(__uint_as_float(h.z << 16)); v1[1] *= __uint_as_float(g.z & 0xffff0000u) * __builtin_amdgcn_rcpf(__uint_as_float(h.z & 0xffff0000u));
            v1[2] *= __uint_as_float(g.w << 16) * __builtin_amdgcn_rcpf(__uint_as_float(h.w << 16)); v1[3] *= __uint_as_float(g.w & 0xffff0000u) * __builtin_amdgcn_rcpf(__uint_as_float(h.w & 0xffff0000u));
          }
        __builtin_amdgcn_sched_barrier(0);
      }
    return true;
  }
  __device__ __forceinline__ void operator()(const pg8::f32x4 (&acc)[2][2][4][2], const pg8::Unit& u, int wr, int wc, int fr, int fq) const {
    EpiGate<false> E; E.gate = ga; E.M1 = M1; E(acc, u, wr, wc, fr, fq);
  }
};
struct EpiRes {
  static constexpr bool PERM = true, AFTER_DRAIN = false, CHAIN = false;
  const float* base; us* x1b;
  __device__ __forceinline__ void operator()(const pg8::f32x4 (&acc)[2][2][4][2], const pg8::Unit& u, int wr, int wc, int fr, int fq) const {
    const int row0 = u.pm * 256 + wr * 64 + fr, col0 = u.pn * 256 + wc * 32 + 8 * fq;
#pragma unroll
    for (int ai = 0; ai < 2; ++ai)
#pragma unroll
      for (int mh = 0; mh < 2; ++mh) {
        f32x4 b[2][2][2];
#pragma unroll
        for (int mm = 0; mm < 2; ++mm)
#pragma unroll
          for (int bj = 0; bj < 2; ++bj)
#pragma unroll
            for (int n = 0; n < 2; ++n) b[mm][bj][n] = *(const f32x4*)(base + (size_t)(row0 + ai * 128 + (2 * mh + mm) * 16) * 1024 + col0 + bj * 128 + n * 4);
        __builtin_amdgcn_sched_barrier(0);
#pragma unroll
        for (int mm = 0; mm < 2; ++mm)
#pragma unroll
          for (int bj = 0; bj < 2; ++bj) {
            const f32x4 o0 = b[mm][bj][0] + acc[ai][bj][2 * mh + mm][0], o1 = b[mm][bj][1] + acc[ai][bj][2 * mh + mm][1];
            v4u w; w.x = pk2(o0[0], o0[1]); w.y = pk2(o0[2], o0[3]); w.z = pk2(o1[0], o1[1]); w.w = pk2(o1[2], o1[3]);
            *(v4u*)(x1b + (size_t)(row0 + ai * 128 + (2 * mh + mm) * 16) * 1024 + col0 + bj * 128) = w;
          }
        __builtin_amdgcn_sched_barrier(0);
      }
  }
};

__device__ __forceinline__ void p0_transpose_item(const float* __restrict__ W, int ldw, int k0, int n_src, us* __restrict__ WT, int ldt, int dst_row0,
                                                  LAS float* scr, int lane) {
  if (n_src >= 0) {
#pragma unroll 8
    for (int i = 0; i < 32; ++i) { const int kk = 2 * i + (lane >> 5); scr[kk * 33 + (lane & 31)] = W[(size_t)(k0 + kk) * ldw + n_src + (lane & 31)]; }
  } else {
#pragma unroll 8
    for (int i = 0; i < 32; ++i) { const int kk = 2 * i + (lane >> 5); scr[kk * 33 + (lane & 31)] = 0.f; }
  }
  LDS_WAIT(); asm volatile("" ::: "memory");
  const int c = lane & 7;
#pragma unroll
  for (int j = 0; j < 4; ++j) {
    const int n = (lane >> 3) + 8 * j;
    const LAS float* s = scr + (8 * c) * 33 + n;
    v4u o;
    o.x = pk2(s[0 * 33], s[1 * 33]); o.y = pk2(s[2 * 33], s[3 * 33]); o.z = pk2(s[4 * 33], s[5 * 33]); o.w = pk2(s[6 * 33], s[7 * 33]);
    *(v4u*)(WT + (size_t)(dst_row0 + n) * ldt + k0 + 8 * c) = o;
  }
  LDS_WAIT(); asm volatile("" ::: "memory");
}
__device__ __forceinline__ void p0_transpose_item_fm(const float* __restrict__ W, int ldw, int k0, int n_src, us* __restrict__ WT, int K, int g,
                                                     LAS float* scr, int lane, const float* __restrict__ kscale = nullptr) {
#pragma unroll 8
  for (int i = 0; i < 32; ++i) { const int kk = 2 * i + (lane >> 5); scr[kk * 33 + (lane & 31)] = W[(size_t)(k0 + kk) * ldw + n_src + (lane & 31)]; }
  LDS_WAIT(); asm volatile("" ::: "memory");
  const int c = lane & 7;
#pragma unroll
  for (int j = 0; j < 4; ++j) {
    const int n = (lane >> 3) + 8 * j;
    const LAS float* s = scr + (8 * c) * 33 + n;
    v4u o;
    f32x4 g0 = (f32x4){1.f, 1.f, 1.f, 1.f}, g1 = g0;
    if (kscale) { g0 = *(const f32x4*)(kscale + k0 + 8 * c); g1 = *(const f32x4*)(kscale + k0 + 8 * c + 4); }
    o.x = pk2(s[0 * 33] * g0[0], s[1 * 33] * g0[1]); o.y = pk2(s[2 * 33] * g0[2], s[3 * 33] * g0[3]); o.z = pk2(s[4 * 33] * g1[0], s[5 * 33] * g1[1]); o.w = pk2(s[6 * 33] * g1[2], s[7 * 33] * g1[3]);
    *(v4u*)(WT + ((((size_t)g * (K >> 4) + (k0 >> 4) + (c >> 1)) * 2 + (c & 1)) * 32 + n) * 8) = o;
  }
  LDS_WAIT(); asm volatile("" ::: "memory");
}
__device__ __forceinline__ int inproj_src(int g) {
  const int pn = g >> 3, bj = (g >> 2) & 1, wc = g & 3;
  if (pn < 4) return (bj ? 512 : 0) + pn * 128 + wc * 32;
  if (pn < 12) { const int type = (pn - 4) >> 1, head = ((pn - 4) & 1) * 4 + wc; return OFF_Q + type * 512 + head * 64 + bj * 32; }
  if (pn < 20) return (pn < 16 ? OFF_GC : OFF_GA) + ((pn - 12) & 3) * 256 + bj * 128 + wc * 32;
  if (wc == 0) return OFF_KI + bj * 32;
  if (wc == 1 && bj == 0) return OFF_WI;
  return -1;
}
__device__ __forceinline__ void rms_row_to_bf16(const float* __restrict__ xrow, const float* __restrict__ g, us* __restrict__ orow, int lane) {
  const f32x4* xr = (const f32x4*)xrow + lane;
  f32x4 v[4]; float s = 0.f;
#pragma unroll
  for (int j = 0; j < 4; ++j) { v[j] = xr[64 * j]; s += (v[j].x * v[j].x + v[j].y * v[j].y) + (v[j].z * v[j].z + v[j].w * v[j].w); }
  const float rstd = 1.0f / sqrtf(wave_sum(s) * (1.0f / D) + EPS);
#pragma unroll
  for (int j = 0; j < 4; ++j) {
    const f32x4 gg = ((const f32x4*)g)[lane + 64 * j];
    unsigned long long o = (unsigned long long)pk2(v[j].x * rstd * gg.x, v[j].y * rstd * gg.y) |
                           ((unsigned long long)pk2(v[j].z * rstd * gg.z, v[j].w * rstd * gg.w) << 32);
    ((unsigned long long*)orow)[lane + 64 * j] = o;
  }
}

__device__ __forceinline__ void rms_rows4_to_bf16(const float* __restrict__ x0, const float* __restrict__ g, us* __restrict__ o0, int lane) {
  f32x4 v[4][4];
#pragma unroll
  for (int r = 0; r < 4; ++r)
#pragma unroll
    for (int j = 0; j < 4; ++j) v[r][j] = ((const f32x4*)(x0 + (size_t)r * D))[lane + 64 * j];
  __builtin_amdgcn_sched_barrier(0);
#pragma unroll
  for (int r = 0; r < 4; ++r) {
    float s = 0.f;
#pragma unroll
    for (int j = 0; j < 4; ++j) s += (v[r][j].x * v[r][j].x + v[r][j].y * v[r][j].y) + (v[r][j].z * v[r][j].z + v[r][j].w * v[r][j].w);
    const float rstd = 1.0f / sqrtf(wave_sum_dpp(s) * (1.0f / D) + EPS);
#pragma unroll
    for (int j = 0; j < 4; ++j) {
      const f32x4 gg = ((const f32x4*)g)[lane + 64 * j];
      unsigned long long o = (unsigned long long)pk2(v[r][j].x * rstd * gg.x, v[r][j].y * rstd * gg.y) |
                             ((unsigned long long)pk2(v[r][j].z * rstd * gg.z, v[r][j].w * rstd * gg.w) << 32);
      ((unsigned long long*)(o0 + (size_t)r * D))[lane + 64 * j] = o;
    }
  }
}

constexpr int CW_DEP = 104;
constexpr unsigned DEP_TARGET = 7u * 64u * 8u;
constexpr int CW_TQ = 100;
struct InProjOrder : pg8::StaticOrder {
  unsigned* dep;
  __device__ __forceinline__ static int perm(int r) { return r == 0 ? 20 : (r < 3 ? r + 9 : (r < 13 ? r - 3 : r - 1)); }
  __device__ __forceinline__ static bool is_dep(int pn) { return pn < 4 || pn == 10 || pn == 11 || pn == 20; }
  __device__ bool next(int i, pg8::Unit& u) const { const bool ok = pg8::StaticOrder::next(i, u); u.pn = perm(u.pn); return ok; }
  __device__ __forceinline__ void done(const pg8::Unit& u) const {
    if (is_dep(u.pn)) {
      asm volatile("s_waitcnt vmcnt(0)" ::: "memory");
      if ((threadIdx.x & 63) == 0) __hip_atomic_fetch_add(dep, 1u, __ATOMIC_RELAXED, __HIP_MEMORY_SCOPE_AGENT);
    }
  }
};
__device__ __forceinline__ void st16_wt_g(void* ptr, v4u v) { asm volatile("global_store_dwordx4 %0, %1, off sc1\n\ts_nop 1" :: "v"(ptr), "v"(v) : "memory"); }

struct EpiInProj {
  static constexpr bool PERM = true, AFTER_DRAIN = false, CHAIN = false;
  us *G, *Q, *K, *V, *QI, *KI, *GC, *GA; float* WI; const float *CT, *ST;
  __device__ __forceinline__ void operator()(const pg8::f32x4 (&acc)[2][2][4][2], const pg8::Unit& u, int wr, int wc, int fr, int fq) const {
    const int pn = u.pn;
    const int row0 = u.pm * 256 + wr * 64 + fr;
    if (pn < 4) {
#pragma unroll
      for (int ai = 0; ai < 2; ++ai)
#pragma unroll
        for (int m = 0; m < 4; ++m) {
          const int row = row0 + ai * 128 + m * 16;
          const f32x4 a0 = acc[ai][0][m][0], a1 = acc[ai][0][m][1], b0 = acc[ai][1][m][0], b1 = acc[ai][1][m][1];
          v4u w;
          w.x = pk2(a0[0] * fsigmoid(b0[0]), a0[1] * fsigmoid(b0[1])); w.y = pk2(a0[2] * fsigmoid(b0[2]), a0[3] * fsigmoid(b0[3]));
          w.z = pk2(a1[0] * fsigmoid(b1[0]), a1[1] * fsigmoid(b1[1])); w.w = pk2(a1[2] * fsigmoid(b1[2]), a1[3] * fsigmoid(b1[3]));
          st16_wt_g(G + (size_t)row * 512 + pn * 128 + wc * 32 + 8 * fq, w);
        }
    } else if (pn < 12) {
      const int type = (pn - 4) >> 1, head = ((pn - 4) & 1) * 4 + wc;
      us* dst = type == 0 ? Q : (type == 1 ? K : (type == 2 ? V : QI));
      const float sc = type == 0 ? QSCALE : 1.0f;
#pragma unroll
      for (int ai = 0; ai < 2; ++ai)
#pragma unroll
        for (int m = 0; m < 4; ++m) {
          const int row = row0 + ai * 128 + m * 16;
          const f32x4 x10 = acc[ai][0][m][0], x11 = acc[ai][0][m][1], x20 = acc[ai][1][m][0], x21 = acc[ai][1][m][1];
          f32x4 o10, o11, o20, o21;
          if (type == 2) { o10 = x10; o11 = x11; o20 = x20; o21 = x21; }
          else {
            const f32x4 c0 = *(const f32x4*)(CT + (size_t)row * 32 + 8 * fq), c1 = *(const f32x4*)(CT + (size_t)row * 32 + 8 * fq + 4);
            const f32x4 s0 = *(const f32x4*)(ST + (size_t)row * 32 + 8 * fq), s1 = *(const f32x4*)(ST + (size_t)row * 32 + 8 * fq + 4);
            o10 = (x10 * c0 - x20 * s0) * sc; o11 = (x11 * c1 - x21 * s1) * sc;
            o20 = (x20 * c0 + x10 * s0) * sc; o21 = (x21 * c1 + x11 * s1) * sc;
          }
          v4u w1, w2;
          w1.x = pk2(o10[0], o10[1]); w1.y = pk2(o10[2], o10[3]); w1.z = pk2(o11[0], o11[1]); w1.w = pk2(o11[2], o11[3]);
          w2.x = pk2(o20[0], o20[1]); w2.y = pk2(o20[2], o20[3]); w2.z = pk2(o21[0], o21[1]); w2.w = pk2(o21[2], o21[3]);
          us* p = dst + (size_t)row * 512 + head * 64 + 8 * fq;
          if (type == 3) { st16_wt_g(p, w1); st16_wt_g(p + 32, w2); } else { *(v4u*)p = w1; *(v4u*)(p + 32) = w2; }
        }
    } else if (pn < 20) {
      us* dst = pn < 16 ? GC : GA;
      const int cb = ((pn - 12) & 3) * 256 + wc * 32 + 8 * fq;
#pragma unroll
      for (int ai = 0; ai < 2; ++ai)
#pragma unroll
        for (int m = 0; m < 4; ++m) {
          const int row = row0 + ai * 128 + m * 16;
#pragma unroll
          for (int bj = 0; bj < 2; ++bj) {
            const f32x4 v0 = acc[ai][bj][m][0], v1 = acc[ai][bj][m][1];
            v4u w;
            const float lo_ = pn < 16 ? 0.f : 1e-30f;
            w.x = pk2(fmaxf(fsigmoid(v0[0]), lo_), fmaxf(fsigmoid(v0[1]), lo_)); w.y = pk2(fmaxf(fsigmoid(v0[2]), lo_), fmaxf(fsigmoid(v0[3]), lo_));
            w.z = pk2(fmaxf(fsigmoid(v1[0]), lo_), fmaxf(fsigmoid(v1[1]), lo_)); w.w = pk2(fmaxf(fsigmoid(v1[2]), lo_), fmaxf(fsigmoid(v1[3]), lo_));
            *(v4u*)(dst + (size_t)row * 1024 + cb + bj * 128) = w;
          }
        }
    } else {
      if (wc == 0) {
#pragma unroll
        for (int ai = 0; ai < 2; ++ai)
#pragma unroll
          for (int m = 0; m < 4; ++m) {
            const int row = row0 + ai * 128 + m * 16;
            const f32x4 x10 = acc[ai][0][m][0], x11 = acc[ai][0][m][1], x20 = acc[ai][1][m][0], x21 = acc[ai][1][m][1];
            const f32x4 c0 = *(const f32x4*)(CT + (size_t)row * 32 + 8 * fq), c1 = *(const f32x4*)(CT + (size_t)row * 32 + 8 * fq + 4);
            const f32x4 s0 = *(const f32x4*)(ST + (size_t)row * 32 + 8 * fq), s1 = *(const f32x4*)(ST + (size_t)row * 32 + 8 * fq + 4);
            const f32x4 o10 = x10 * c0 - x20 * s0, o11 = x11 * c1 - x21 * s1, o20 = x20 * c0 + x10 * s0, o21 = x21 * c1 + x11 * s1;
            v4u w1, w2;
            w1.x = pk2(o10[0], o10[1]); w1.y = pk2(o10[2], o10[3]); w1.z = pk2(o11[0], o11[1]); w1.w = pk2(o11[2], o11[3]);
            w2.x = pk2(o20[0], o20[1]); w2.y = pk2(o20[2], o20[3]); w2.z = pk2(o21[0], o21[1]); w2.w = pk2(o21[2], o21[3]);
            us* p = KI + ((size_t)(row >> 5) * 8 * 32 + (row & 31)) * 8;
            st16_wt_g(p + (size_t)fq * 256, w1); st16_wt_g(p + (size_t)(4 + fq) * 256, w2);
          }
      } else if (wc == 1 && fq == 0) {
#pragma unroll
        for (int ai = 0; ai < 2; ++ai)
#pragma unroll
          for (int m = 0; m < 4; ++m) {
            const int row = row0 + ai * 128 + m * 16;
            const f32x4 wa_ = acc[ai][0][m][0] * IDX_SCALE, wb_ = acc[ai][0][m][1] * IDX_SCALE;
            st16_wt_g(WI + (size_t)row * 8, (v4u){__float_as_uint(wa_[0]), __float_as_uint(wa_[1]), __float_as_uint(wa_[2]), __float_as_uint(wa_[3])});
            st16_wt_g(WI + (size_t)row * 8 + 4, (v4u){__float_as_uint(wb_[0]), __float_as_uint(wb_[1]), __float_as_uint(wb_[2]), __float_as_uint(wb_[3])});
          }
      }
    }
  }
};


constexpr size_t WS_WGU = 232 * MiB;
constexpr size_t WS_WD = 248 * MiB;
constexpr size_t WS_H2 = WS_HB;
constexpr size_t WS_YS = 72 * MiB;
constexpr size_t WS_HID = 136 * MiB;
constexpr size_t WS_LIST = 160 * MiB;
constexpr size_t WS_COMB = 162 * MiB;
constexpr size_t WS_RSTD = 163 * MiB;
constexpr int CW_CNT = 64;
constexpr int LIST_CAP = 16384;

__device__ __forceinline__ void moe_offsets(const unsigned* cnt, int (&rb_start)[17], int (&row_off)[17]) {
  int a = 0, b = 0;
#pragma unroll
  for (int e = 0; e < 16; ++e) { rb_start[e] = a; row_off[e] = b; const int n = (int)__hip_atomic_load(cnt + e, RLX_AGENT); const int nb = (n + 127) >> 7; a += nb; b += nb * 128; }
  rb_start[16] = a; row_off[16] = b;
}

constexpr size_t WS_WR = 11 * MiB + 512 * 1024;
__device__ __forceinline__ void route_weights_item(us* __restrict__ WR, const float* __restrict__ g_ffn, const float* __restrict__ w_rg, const float* __restrict__ w_re, int i) {
  const int l = i & 63, nt = (i >> 6) & 3, ks = i >> 8;
  const int o = 16 * (nt & 1) + (l & 15), k0 = 32 * ks + 8 * (l >> 4);
  unsigned w[4];
#pragma unroll
  for (int jj = 0; jj < 4; ++jj) {
    unsigned h2[2];
#pragma unroll
    for (int j2 = 0; j2 < 2; ++j2) {
      const int k = k0 + 2 * jj + j2;
      float v = 0.f;
      if (o < 4) v = w_rg[k * 4 + o]; else if (o < 20) v = w_re[k * 16 + (o - 4)];
      v *= g_ffn[k];
      const unsigned hi = f2bf_(v);
      h2[j2] = (nt < 2) ? hi : f2bf_(v - __uint_as_float(hi << 16));
    }
    w[jj] = h2[0] | (h2[1] << 16);
  }
  *(v4u*)(WR + (size_t)i * 8) = (v4u){w[0], w[1], w[2], w[3]};
}

__device__ __forceinline__ void route_phase(LAS unsigned char* lds, unsigned char* ws, const us* x1b, const float* b_rg, const float* b_re, int tid, int lane, int wave, int mode) {
  LAS float* LG = (LAS float*)lds;
  LAS float* SS = (LAS float*)(lds + 16896);
  LAS int* cnt_l = (LAS int*)(lds + 20480);
  LAS int* base_l = cnt_l + 16;
  LAS int* tok_e = base_l + 16;
  LAS int* tok_p = tok_e + 128;
  unsigned* cnt = (unsigned*)(ws + WS_CTL) + CW_CNT;
  int* LIST = (int*)(ws + WS_LIST);
  float* COMB = (float*)(ws + WS_COMB);
  float* RSTD = (float*)(ws + WS_RSTD);
  const us* WR = (const us*)(ws + WS_WR);
  if (tid < 16) cnt_l[tid] = 0;
  const int t0 = blockIdx.x * 64;
  {
    const int mblk = wave & 3, kh = wave >> 2;
    const us* arow = x1b + (size_t)(t0 + 16 * mblk + (lane & 15)) * D + kh * 512 + 8 * (lane >> 4);
    bf16x8 a[16];
#pragma unroll
    for (int ks = 0; ks < 16; ++ks) a[ks] = *(const bf16x8*)(arow + 32 * ks);
    const us* bbase = WR + ((size_t)(kh * 16) * 4 * 64 + lane) * 8;
    f32x4 acc0 = (f32x4){0.f, 0.f, 0.f, 0.f}, acc1 = acc0;
    float ssq = 0.f;
#pragma unroll
    for (int c = 0; c < 4; ++c) {
      bf16x8 bfr[4][4];
#pragma unroll
      for (int k4 = 0; k4 < 4; ++k4)
#pragma unroll
        for (int nt = 0; nt < 4; ++nt) bfr[k4][nt] = *(const bf16x8*)(bbase + (size_t)((c * 4 + k4) * 4 + nt) * 512);
      __builtin_amdgcn_sched_barrier(0);
#pragma unroll
      for (int k4 = 0; k4 < 4; ++k4) {
        const bf16x8 av = a[c * 4 + k4];
        acc0 = __builtin_amdgcn_mfma_f32_16x16x32_bf16(av, bfr[k4][0], acc0, 0, 0, 0);
        acc1 = __builtin_amdgcn_mfma_f32_16x16x32_bf16(av, bfr[k4][1], acc1, 0, 0, 0);
        acc0 = __builtin_amdgcn_mfma_f32_16x16x32_bf16(av, bfr[k4][2], acc0, 0, 0, 0);
        acc1 = __builtin_amdgcn_mfma_f32_16x16x32_bf16(av, bfr[k4][3], acc1, 0, 0, 0);
        const v4u au = __builtin_bit_cast(v4u, av);
#pragma unroll
        for (int d = 0; d < 4; ++d) { const float lo_ = __uint_as_float(au[d] << 16), hi_ = __uint_as_float(au[d] & 0xffff0000u); ssq = __builtin_fmaf(lo_, lo_, ssq); ssq = __builtin_fmaf(hi_, hi_, ssq); }
      }
    }
    ssq += __shfl_xor(ssq, 16); ssq += __shfl_xor(ssq, 32);
    LAS float* lg = LG + (kh * 64 + 16 * mblk + 4 * (lane >> 4)) * 33 + (lane & 15);
#pragma unroll
    for (int i = 0; i < 4; ++i) { lg[i * 33] = acc0[i]; lg[i * 33 + 16] = acc1[i]; }
    if (lane < 16) SS[kh * 64 + 16 * mblk + lane] = ssq;
  }
  __syncthreads();
  if (wave == 0) {
    const int t = t0 + lane;
    const LAS float* l0 = LG + lane * 33, *l1 = LG + (64 + lane) * 33;
    const float rstd = 1.0f / sqrtf((SS[lane] + SS[64 + lane]) * (1.0f / D) + EPS);
    RSTD[t] = rstd;
    const float g0 = (l0[0] + l1[0]) * rstd + b_rg[0], g1 = (l0[1] + l1[1]) * rstd + b_rg[1], g2 = (l0[2] + l1[2]) * rstd + b_rg[2], g3 = (l0[3] + l1[3]) * rstd + b_rg[3];
    int gi = 0; float gm = g0;
    if (g1 > gm) { gm = g1; gi = 1; }
    if (g2 > gm) { gm = g2; gi = 2; }
    if (g3 > gm) { gm = g3; gi = 3; }
    const float pg = 1.0f / (expf(g0 - gm) + expf(g1 - gm) + expf(g2 - gm) + expf(g3 - gm));
    const f32x4 be = *(const f32x4*)(b_re + gi * 4);
    const LAS float* e0p = l0 + 4 + gi * 4, *e1p = l1 + 4 + gi * 4;
    const float e0 = (e0p[0] + e1p[0]) * rstd + be[0], e1 = (e0p[1] + e1p[1]) * rstd + be[1], e2 = (e0p[2] + e1p[2]) * rstd + be[2], e3 = (e0p[3] + e1p[3]) * rstd + be[3];
    int i0 = 0; float m0 = e0;
    if (e1 > m0) { m0 = e1; i0 = 1; }
    if (e2 > m0) { m0 = e2; i0 = 2; }
    if (e3 > m0) { m0 = e3; i0 = 3; }
    int i1 = -1; float m1 = -INFINITY;
    if (i0 != 0 && e0 > m1) { m1 = e0; i1 = 0; }
    if (i0 != 1 && e1 > m1) { m1 = e1; i1 = 1; }
    if (i0 != 2 && e2 > m1) { m1 = e2; i1 = 2; }
    if (i0 != 3 && e3 > m1) { m1 = e3; i1 = 3; }
    const float r = expf(m1 - m0);
    const float c0 = pg / (1.0f + r), c1 = pg * r / (1.0f + r);
    const int ea = gi * 4 + i0, eb = gi * 4 + i1;
    tok_e[lane * 2] = ea; tok_e[lane * 2 + 1] = eb;
    tok_p[lane * 2] = atomicAdd((int*)(cnt_l + ea), 1);
    tok_p[lane * 2 + 1] = atomicAdd((int*)(cnt_l + eb), 1);
    *(unsigned long long*)(COMB + t * 2) = (unsigned long long)__float_as_uint(c0) | ((unsigned long long)__float_as_uint(c1) << 32);
  }
  __syncthreads();
  if (mode & 1) return;
  if (tid < 16) base_l[tid] = (int)__hip_atomic_fetch_add(cnt + tid, (unsigned)cnt_l[tid], RLX_AGENT);
  __syncthreads();
  if (tid < 128) {
    const int e = tok_e[tid], p = base_l[e] + tok_p[tid];
    LIST[e * LIST_CAP + p] = (blockIdx.x * 64 + (tid >> 1)) * 2 + (tid & 1);
  }
}

constexpr int SG_EPI_STAGE = 9216;
__device__ __forceinline__ void st16_wt(us* p, v4u v) { asm volatile("global_store_dwordx4 %0, %1, off sc1\n\ts_nop 1" :: "v"(p), "v"(v) : "memory"); }
struct EpiMoe1 {
  us* HID; int hid_row0, nvalid; LAS unsigned char* stage;
  const LAS float* rstd_l;
  __device__ __forceinline__ void operator()(const sg::f32x16 (&acc)[2][4], int wave, int r32, int hi) const {
    const int lane = r32 + 32 * hi;
    LAS unsigned char* st = stage + wave * SG_EPI_STAGE;
#pragma unroll
    for (int m = 0; m < 4; ++m) {
      const float rs = rstd_l[32 * m + r32];
#pragma unroll
      for (int q = 0; q < 4; ++q) {
        float h[4];
#pragma unroll
        for (int i = 0; i < 4; ++i) { const float g = acc[0][m][4 * q + i] * rs, u = acc[1][m][4 * q + i] * rs; h[i] = g * fsigmoid(g) * u; }
        *(LAS unsigned long long*)(st + (m * 32 + r32) * 72 + (8 * q + 4 * hi) * 2) = (unsigned long long)pk2(h[0], h[1]) | ((unsigned long long)pk2(h[2], h[3]) << 32);
      }
    }
    LDS_WAIT();
#pragma unroll
    for (int i = 0; i < 8; ++i) {
      const int rr = i * 16 + (lane >> 2), c = lane & 3;
      const unsigned long long lo = *(const LAS unsigned long long*)(st + rr * 72 + c * 16), hi2 = *(const LAS unsigned long long*)(st + rr * 72 + c * 16 + 8);
      const v4u v = (v4u){(unsigned)lo, (unsigned)(lo >> 32), (unsigned)hi2, (unsigned)(hi2 >> 32)};
      if (rr < nvalid) st16_wt(HID + (size_t)(hid_row0 + rr) * 256 + wave * 32 + c * 8, v);
      asm volatile("" ::: "memory");
    }
    LDS_WAIT();
  }
};
struct EpiMoe2 {
  us* YS; const LAS int* slots; int ct, nvalid; LAS unsigned char* stage;
  __device__ __forceinline__ void operator()(const sg::f32x16 (&acc)[2][2], int wm, int wn, int r32, int hi) const {
    const int lane = r32 + 32 * hi;
    LAS unsigned char* st = stage + (wm * 4 + wn) * SG_EPI_STAGE;
#pragma unroll
    for (int m = 0; m < 2; ++m) {
#pragma unroll
      for (int h = 0; h < 2; ++h)
#pragma unroll
        for (int q = 0; q < 4; ++q)
          *(LAS unsigned long long*)(st + r32 * 144 + (h * 32 + 8 * q + 4 * hi) * 2) =
              (unsigned long long)pk2(acc[h][m][4 * q], acc[h][m][4 * q + 1]) | ((unsigned long long)pk2(acc[h][m][4 * q + 2], acc[h][m][4 * q + 3]) << 32);
      LDS_WAIT();
#pragma unroll
      for (int i = 0; i < 4; ++i) {
        const int rr = i * 8 + (lane >> 3), c = lane & 7, grow = wm * 64 + m * 32 + rr;
        const v4u v = *(const LAS v4u*)(st + rr * 144 + c * 16);
        if (grow < nvalid) { const int slot = slots[grow]; *(v4u*)(YS + (size_t)slot * 1024 + ct * 256 + (c >> 2) * 128 + wn * 32 + (c & 3) * 8) = v; }
        asm volatile("" ::: "memory");
      }
      LDS_WAIT();
    }
  }
};

constexpr int CW_Q = 96;
constexpr int CW_READY = 128;
constexpr int MOE_SLOTS = LDS_BYTES - 1024;
constexpr int MOE_TAB = LDS_BYTES - 512;
constexpr int MOE_STG1 = 40960, MOE_STG2 = 67584;
template <int PART> __device__ __forceinline__ void moe_phase(LAS unsigned char* lds, unsigned char* ws, volatile LAS unsigned* MISC, int tid0, int mode) {
  int tid = tid0;
  unsigned* ctl = (unsigned*)(ws + WS_CTL);
  const unsigned* cnt = ctl + CW_CNT;
  LAS int* tab = (LAS int*)(lds + MOE_TAB);
  if (tid == 0) {
    int a = 0, b = 0;
    for (int e = 0; e < 16; ++e) { tab[e] = a; tab[17 + e] = b; const int n = (int)__hip_atomic_load(cnt + e, RLX_AGENT); tab[34 + e] = n; const int nb = (n + 127) >> 7; a += nb; b += nb * 128; }
    tab[16] = a; tab[33] = b;
  }
  __syncthreads();
  const int nrb = __builtin_amdgcn_readfirstlane(tab[16]);
  const int* LIST = (const int*)(ws + WS_LIST);
  const us* X1B = (const us*)(ws + WS_X1B);
  const float* RSTD = (const float*)(ws + WS_RSTD);
  const us* WguT = (const us*)(ws + WS_WGU);
  const us* WdT = (const us*)(ws + WS_WD);
  us* HID = (us*)(ws + WS_HID);
  const int wave_ = __builtin_amdgcn_readfirstlane(tid0 >> 6);
  unsigned long long tp_acc = 0ull, tp_0 = 0ull; const int tprobe = AMP_ON ? mode >> 8 : 0;
  if (tprobe == 3) tp_0 = __builtin_amdgcn_s_memrealtime();
  for (;;) {
    if (wave_ == 0) {   const int lane_ = tid0 & 63;
      unsigned v_ = 0u;
      if (lane_ == 0) v_ = __hip_atomic_fetch_add(ctl + CW_Q + (PART == 2 ? 1 : 0), 1u, RLX_AGENT) + (PART == 2 ? (unsigned)nrb : 0u);
      MISC[16] = (unsigned)__builtin_amdgcn_readfirstlane((int)v_);
    }
    __syncthreads();
    asm volatile("" : "+v"(tid));
    const int lane_ = tid & 63, wn_ = (tid >> 6) & 3;
    const int q = __builtin_amdgcn_readfirstlane((int)MISC[16]);
    if (q >= (PART == 1 ? 1 : 3) * nrb) break;
    const bool down = q >= nrb;
    if (tprobe == (down ? 2 : 1)) tp_0 = __builtin_amdgcn_s_memrealtime();
    const int rb = down ? (q - nrb) >> 1 : q;
    int e = 0;
#pragma unroll
    for (int k = 1; k < 16; ++k) if (rb >= tab[k]) e = k;
    const int n_e = tab[34 + e], row0 = tab[17 + e];
    const int r0 = (rb - tab[e]) * 128, nvalid = min(128, n_e - r0);
    if (!down) {
      const us* ap[2];
#pragma unroll
      for (int i = 0; i < 2; ++i) { const int c = tid + 512 * i; int r = c >> 3; if (r >= nvalid) r = 0; const int tok = LIST[e * LIST_CAP + r0 + r] >> 1; ap[i] = X1B + (size_t)tok * D + (c & 7) * 8; }
      if (tid < 128) ((LAS float*)(lds + MOE_SLOTS))[tid] = RSTD[LIST[e * LIST_CAP + r0 + (tid < nvalid ? tid : 0)] >> 1];
      const us* bf0 = WguT + ((size_t)(e * 16 + (wave_ >> 2) * 8 + (wave_ & 3)) * 64 * 2 + (lane_ >> 5)) * 256 + (lane_ & 31) * 8;
      const us* bf1 = bf0 + (size_t)4 * 64 * 512;
      EpiMoe1 E; E.HID = HID; E.hid_row0 = row0 + r0; E.nvalid = nvalid; E.stage = lds + MOE_STG1; E.rstd_l = (const LAS float*)(lds + MOE_SLOTS);
      sg::tile_wide(lds, ap, bf0, bf1, 1024, E, tid);
      asm volatile("s_waitcnt vmcnt(0)" ::: "memory");
      __syncthreads();
      if (wave_ == 1) { if (lane_ == 0) __hip_atomic_fetch_add(ctl + CW_READY + rb, 1u, RLX_AGENT); }
    } else {
      if (PART == 0 && wave_ == 2) { if (lane_ == 0) {
        unsigned sp = 0;
        while (__hip_atomic_load(ctl + CW_READY + rb, RLX_AGENT) < 1u) { __builtin_amdgcn_s_sleep(2); if (++sp > (1u << 22)) break; }
        __builtin_amdgcn_fence(__ATOMIC_ACQUIRE, "agent");
        asm volatile("s_waitcnt vmcnt(0)" ::: "memory");
      } }
      __syncthreads();
      if (tid < 128) ((LAS int*)(lds + MOE_SLOTS))[tid] = LIST[e * LIST_CAP + r0 + (tid < nvalid ? tid : 0)];
      {
        const us* hrow = HID + (size_t)(row0 + r0) * 256;
#pragma unroll
        for (int i = 0; i < 8; ++i) { const int c = tid + 512 * i; const int r = c >> 5, ch = c & 31;
          const v4u v = *(const v4u*)(hrow + (size_t)r * 256 + ch * 8);
          *(LAS v4u*)(lds + r * sg::ARS + ch * 16) = v; }
      }
      __syncthreads();
#pragma unroll 1
      for (int ct = 2 * ((q - nrb) & 1); ct < 2 * ((q - nrb) & 1) + 2; ++ct) {
        const us* bf0 = WdT + ((size_t)(e * 32 + ct * 8 + wn_) * 16 * 2 + (lane_ >> 5)) * 256 + (lane_ & 31) * 8;
        const us* bf1 = bf0 + (size_t)4 * 16 * 512;
        EpiMoe2 E; E.YS = (us*)(ws + WS_YS); E.slots = (const LAS int*)(lds + MOE_SLOTS); E.ct = ct; E.nvalid = nvalid; E.stage = lds + MOE_STG2;
        sg::tile_resident(lds, bf0, bf1, E, tid);
      }
      __syncthreads();
    }
    if (tprobe == (down ? 2 : 1)) tp_acc += __builtin_amdgcn_s_memrealtime() - tp_0;
  }
  if (tprobe == 3) tp_acc = __builtin_amdgcn_s_memrealtime() - tp_0;
  if (tprobe && blockIdx.x == 0) { const unsigned long long t1 = __builtin_amdgcn_s_memrealtime(); while (__builtin_amdgcn_s_memrealtime() - t1 < 9ull * tp_acc) __builtin_amdgcn_s_sleep(8); }
}
__device__ __forceinline__ void final_phase(unsigned char* ws, const us* x1b, float* out, const float* g_final, int lane, int wave, int mode) {
  const us* YS = (const us*)(ws + WS_YS);
  const float* COMB = (const float*)(ws + WS_COMB);
  for (int t = blockIdx.x * 8 + wave; t < T; t += gridDim.x * 8) {
    const unsigned long long* xr = (const unsigned long long*)(x1b + (size_t)t * D) + lane;
    const float c0 = COMB[t * 2], c1 = COMB[t * 2 + 1];
    const unsigned long long* y0 = (const unsigned long long*)(YS + (size_t)(2 * t) * D) + lane;
    const unsigned long long* y1 = (const unsigned long long*)(YS + (size_t)(2 * t + 1) * D) + lane;
    f32x4 v[4]; float s = 0.f;
#pragma unroll
    for (int j = 0; j < 4; ++j) {
      const unsigned long long xx = xr[64 * j];
      const unsigned long long a = y0[64 * j], b = y1[64 * j];
      v[j].x = __uint_as_float((unsigned)xx << 16) + (c0 * __uint_as_float((unsigned)a << 16) + c1 * __uint_as_float((unsigned)b << 16));
      v[j].y = __uint_as_float((unsigned)xx & 0xffff0000u) + (c0 * __uint_as_float((unsigned)a & 0xffff0000u) + c1 * __uint_as_float((unsigned)b & 0xffff0000u));
      v[j].z = __uint_as_float((unsigned)(xx >> 32) << 16) + (c0 * __uint_as_float((unsigned)(a >> 32) << 16) + c1 * __uint_as_float((unsigned)(b >> 32) << 16));
      v[j].w = __uint_as_float((unsigned)(xx >> 32) & 0xffff0000u) + (c0 * __uint_as_float((unsigned)(a >> 32) & 0xffff0000u) + c1 * __uint_as_float((unsigned)(b >> 32) & 0xffff0000u));
      s += (v[j].x * v[j].x + v[j].y * v[j].y) + (v[j].z * v[j].z + v[j].w * v[j].w);
    }
    const float rstd = 1.0f / sqrtf(wave_sum(s) * (1.0f / D) + EPS);
    f32x4* orow = (mode & 1) ? (f32x4*)((float*)(ws + WS_G) + (size_t)(t & 4095) * D) + lane : (f32x4*)(out + (size_t)t * D) + lane;
#pragma unroll
    for (int j = 0; j < 4; ++j) { const f32x4 gg = ((const f32x4*)g_final)[lane + 64 * j]; orow[64 * j] = v[j] * rstd * gg; }
  }
}

__device__ __forceinline__ void conv_phase(LAS unsigned char* lds, unsigned char* ws, const float* __restrict__ w_dw, const float* __restrict__ b_dw,
                                           const float* __restrict__ ln_g, const float* __restrict__ ln_b, int tid, int lane, int wave,
                                           volatile LAS unsigned* MISC, unsigned* qhead) {
  const us* G = (const us*)(ws + WS_G);
  us* NA = (us*)(ws + WS_NA);
  LAS us* gl = (LAS us*)lds;
  LAS float* ctile = (LAS float*)(lds + 63488);
  float w[31];
#pragma unroll
  for (int j = 0; j < 31; ++j) w[j] = w_dw[j * 512 + tid];
  const float bias = b_dw[tid];
  const int wave_u = __builtin_amdgcn_readfirstlane(wave);
  for (;;) {
    if (wave_u == 0) {
      unsigned v_ = 0u;
      if (lane == 0) v_ = __hip_atomic_fetch_add(qhead, 1u, __ATOMIC_RELAXED, __HIP_MEMORY_SCOPE_AGENT);
      MISC[21] = (unsigned)__builtin_amdgcn_readfirstlane((int)v_);
    }
    __syncthreads();
    const int tile = __builtin_amdgcn_readfirstlane((int)MISC[21]);
    if (tile >= T / 32) break;
    const int t0 = tile * 32, tt0 = t0 & (S - 1);
    for (int c = tid; c < 62 * 64; c += 512) {
      const int r = c >> 6, ch = c & 63;
      v4u v = (v4u){0u, 0u, 0u, 0u};
      if (tt0 - 30 + r >= 0) v = *(const v4u*)(G + (size_t)(t0 - 30 + r) * 512 + ch * 8);
      *(LAS v4u*)(gl + r * 512 + ch * 8) = v;
    }
    __syncthreads();
#pragma unroll 1
    for (int p = 0; p < 4; ++p) {
      float acc[8];
#pragma unroll
      for (int o = 0; o < 8; ++o) acc[o] = bias;
#pragma unroll
      for (int rr = 0; rr < 38; ++rr) {
        const float gv = __uint_as_float(((unsigned)gl[(p * 8 + rr) * 512 + tid]) << 16);
#pragma unroll
        for (int o = 0; o < 8; ++o) { const int j = rr - o; if (j >= 0 && j < 31) acc[o] += w[j] * gv; }
      }
#pragma unroll
      for (int o = 0; o < 8; ++o) ctile[(p * 8 + o) * 512 + tid] = acc[o];
    }
    __syncthreads();
#pragma unroll
    for (int q = 0; q < 4; ++q) {
      const int tok = wave * 4 + q;
      const f32x4 a = *(const LAS f32x4*)(ctile + tok * 512 + 4 * lane), b = *(const LAS f32x4*)(ctile + tok * 512 + 256 + 4 * lane);
      const float mu = wave_sum((a.x + a.y) + (a.z + a.w) + (b.x + b.y) + (b.z + b.w)) * (1.0f / 512);
      const f32x4 da = a - mu, db = b - mu;
      const float var = wave_sum((da.x * da.x + da.y * da.y) + (da.z * da.z + da.w * da.w) + (db.x * db.x + db.y * db.y) + (db.z * db.z + db.w * db.w)) * (1.0f / 512);
      const float rs = 1.0f / sqrtf(var + EPS);
      const f32x4 ga = *(const f32x4*)(ln_g + 4 * lane), gb = *(const f32x4*)(ln_g + 256 + 4 * lane);
      const f32x4 ba = *(const f32x4*)(ln_b + 4 * lane), bb = *(const f32x4*)(ln_b + 256 + 4 * lane);
      f32x4 na = da * rs * ga + ba, nb = db * rs * gb + bb;
      na.x *= fsigmoid(na.x); na.y *= fsigmoid(na.y); na.z *= fsigmoid(na.z); na.w *= fsigmoid(na.w);
      nb.x *= fsigmoid(nb.x); nb.y *= fsigmoid(nb.y); nb.z *= fsigmoid(nb.z); nb.w *= fsigmoid(nb.w);
      us* dst = NA + (size_t)(t0 + tok) * 512;
      *(unsigned long long*)(dst + 4 * lane) = (unsigned long long)pk2(na.x, na.y) | ((unsigned long long)pk2(na.z, na.w) << 32);
      *(unsigned long long*)(dst + 256 + 4 * lane) = (unsigned long long)pk2(nb.x, nb.y) | ((unsigned long long)pk2(nb.z, nb.w) << 32);
    }
  }
}

__device__ __forceinline__ unsigned pk_sub_sat_u16(unsigned a, unsigned b) { unsigned r; asm("v_pk_sub_u16 %0, %1, %2 clamp" : "=v"(r) : "v"(a), "v"(b)); return r; }
__device__ __forceinline__ unsigned pk_min_u16(unsigned a, unsigned b) { unsigned r; asm("v_pk_min_u16 %0, %1, %2" : "=v"(r) : "v"(a), "v"(b)); return r; }
__device__ __forceinline__ unsigned pk_add_u16(unsigned a, unsigned b) { unsigned r; asm("v_pk_add_u16 %0, %1, %2" : "=v"(r) : "v"(a), "v"(b)); return r; }
__device__ __forceinline__ int wave_isum(int v) {
#pragma unroll
  for (int o = 1; o < 64; o <<= 1) v += __shfl_xor(v, o);
  return v;
}
__device__ __forceinline__ unsigned f16key(float sc) {
  sc += 0.0f;
  const _Float16 h = (_Float16)sc;
  const unsigned b = (unsigned)__builtin_bit_cast(unsigned short, h);
  const unsigned m = (unsigned)((int)(b << 16) >> 31);
  return (b ^ (m | 0x8000u)) & 0xFFFFu;
}
__device__ __forceinline__ int wave_isum_dpp(int v) {
  v += __builtin_amdgcn_update_dpp(0, v, 0xB1, 0xF, 0xF, true);
  v += __builtin_amdgcn_update_dpp(0, v, 0x4E, 0xF, 0xF, true);
  v += __builtin_amdgcn_update_dpp(0, v, 0x141, 0xF, 0xF, true);
  v += __builtin_amdgcn_update_dpp(0, v, 0x140, 0xF, 0xF, true);
  v += __builtin_amdgcn_update_dpp(0, v, 0x142, 0xA, 0xF, true);
  v += __builtin_amdgcn_update_dpp(0, v, 0x143, 0xC, 0xF, true);
  return __builtin_amdgcn_readlane(v, 63);
}
__device__ __forceinline__ void tk_count4(unsigned& acc, const v4u k, unsigned cm1p, unsigned one2) {
  unsigned t0, t1, t2, t3;
  asm("v_pk_sub_u16 %1, %5, %9 clamp\n\tv_pk_sub_u16 %2, %6, %9 clamp\n\tv_pk_sub_u16 %3, %7, %9 clamp\n\tv_pk_sub_u16 %4, %8, %9 clamp\n\t"
      "v_pk_min_u16 %1, %1, %10\n\tv_pk_min_u16 %2, %2, %10\n\tv_pk_min_u16 %3, %3, %10\n\tv_pk_min_u16 %4, %4, %10\n\t"
      "v_pk_add_u16 %1, %1, %2\n\tv_pk_add_u16 %3, %3, %4\n\tv_pk_add_u16 %0, %0, %1\n\tv_pk_add_u16 %0, %0, %3"
      : "+v"(acc), "=&v"(t0), "=&v"(t1), "=&v"(t2), "=&v"(t3)
      : "v"(k.x), "v"(k.y), "v"(k.z), "v"(k.w), "v"(cm1p), "v"(one2));
}
template <int NQ> __device__ __forceinline__ int tk_count(const v4u (&kq)[NQ], unsigned cm1p, unsigned one2) {
  unsigned a0 = 0u, a1 = 0u;
#pragma unroll
  for (int q = 0; q < NQ; ++q) { if (q & 1) tk_count4(a1, kq[q], cm1p, one2); else tk_count4(a0, kq[q], cm1p, one2); }
  const unsigned a = a0 + a1;
  return wave_isum_dpp((int)((a & 0xffffu) + (a >> 16)));
}
template <int NQ> __device__ __forceinline__ void tk_select(const LAS us* KEYS, const LAS unsigned* HIST, unsigned char* MWB, int T0, int N_unit, int nkw, int wave, int lane) {
  const unsigned one2 = 0x00010001u;
#pragma unroll 1
  for (int jj = 0; jj < 2; ++jj) {
    const int j = 2 * wave + jj;
    v4u kq[NQ];
#pragma unroll
    for (int q = 0; q < NQ; ++q) {
      const int ci = lane + 64 * q;
      kq[q] = (v4u){0u, 0u, 0u, 0u};
      if (ci * 8 < N_unit) kq[q] = *(const LAS v4u*)(KEYS + j * 4096 + ci * 8);
    }
    unsigned prefix = 0u; int cge = 0, bit0 = 15;
    {
      const unsigned h01 = HIST[j * 128 + 2 * lane], h23 = HIST[j * 128 + 2 * lane + 1];
      const int c0 = (int)(h01 & 0xffffu), c1 = (int)(h01 >> 16), c2 = (int)(h23 & 0xffffu), c3 = (int)(h23 >> 16);
      const int t4 = (c0 + c1) + (c2 + c3);
      int p = t4;
      p += __builtin_amdgcn_update_dpp(0, p, 0x111, 0xF, 0xF, true);
      p += __builtin_amdgcn_update_dpp(0, p, 0x112, 0xF, 0xF, true);
      p += __builtin_amdgcn_update_dpp(0, p, 0x114, 0xF, 0xF, true);
      p += __builtin_amdgcn_update_dpp(0, p, 0x118, 0xF, 0xF, true);
      p += __builtin_amdgcn_update_dpp(0, p, 0x142, 0xA, 0xF, true);
      p += __builtin_amdgcn_update_dpp(0, p, 0x143, 0xC, 0xF, true);
      const int total = __builtin_amdgcn_readlane(p, 63);
      const int suf = total - p + t4;
      const unsigned long long okm = __ballot(suf >= TOPK);
      if (okm != 0ull) {
        const int ls = 63 - __builtin_clzll(okm);
        const int above = __builtin_amdgcn_readlane(suf - t4, ls);
        const int d3 = __builtin_amdgcn_readlane(c3, ls), d2 = __builtin_amdgcn_readlane(c2, ls), d1 = __builtin_amdgcn_readlane(c1, ls), d0 = __builtin_amdgcn_readlane(c0, ls);
        int bsel, cnt_ge;
        if (above + d3 >= TOPK) { bsel = 3; cnt_ge = above + d3; }
        else if (above + d3 + d2 >= TOPK) { bsel = 2; cnt_ge = above + d3 + d2; }
        else if (above + d3 + d2 + d1 >= TOPK) { bsel = 1; cnt_ge = above + d3 + d2 + d1; }
        else { bsel = 0; cnt_ge = above + d3 + d2 + d1 + d0; }
        prefix = (unsigned)(4 * ls + bsel) << 8; cge = cnt_ge; bit0 = 7;
      }
    }
#pragma unroll 1
    for (int bit = bit0; bit >= 0; --bit) {
      const unsigned cand = prefix | (1u << bit), cm1 = cand - 1u, cp = cm1 | (cm1 << 16);
      const int cnt = tk_count<NQ>(kq, cp, one2);
      if (cnt >= TOPK) { prefix = cand; cge = cnt; }
    }
    const unsigned tau = prefix, tp = tau | (tau << 16);
    unsigned char* mrow = MWB + (size_t)(T0 + j) * 512;
#define TK_STORE(q_, f0, f1, f2, f3) do { const unsigned by_ = ((f0) & 1u) | (((f0) >> 16) << 1) | (((f1) & 1u) << 2) | (((f1) >> 16) << 3) | (((f2) & 1u) << 4) | (((f2) >> 16) << 5) | \
        (((f3) & 1u) << 6) | (((f3) >> 16) << 7); const int ci_ = lane + 64 * (q_); if (ci_ * 8 < nkw) mrow[ci_] = (unsigned char)by_; } while (0)
    if (tau == 0u) {
#pragma unroll
      for (int q = 0; q < NQ; ++q) {
        TK_STORE(q, pk_min_u16(kq[q].x, one2), pk_min_u16(kq[q].y, one2), pk_min_u16(kq[q].z, one2), pk_min_u16(kq[q].w, one2)); }
    } else if (cge == TOPK) {
      const unsigned cm1 = tau - 1u, cp = cm1 | (cm1 << 16);
#pragma unroll
      for (int q = 0; q < NQ; ++q) {
        TK_STORE(q, pk_min_u16(pk_sub_sat_u16(kq[q].x, cp), one2), pk_min_u16(pk_sub_sat_u16(kq[q].y, cp), one2),
                 pk_min_u16(pk_sub_sat_u16(kq[q].z, cp), one2), pk_min_u16(pk_sub_sat_u16(kq[q].w, cp), one2)); }
    } else {
      const int cgt = tk_count<NQ>(kq, tp, one2);
      const int need = TOPK - cgt;
      int base = 0;
#pragma unroll
      for (int q = 0; q < NQ; ++q) {
        unsigned gt[4], eq[4];
        gt[0] = pk_min_u16(pk_sub_sat_u16(kq[q].x, tp), one2); gt[1] = pk_min_u16(pk_sub_sat_u16(kq[q].y, tp), one2);
        gt[2] = pk_min_u16(pk_sub_sat_u16(kq[q].z, tp), one2); gt[3] = pk_min_u16(pk_sub_sat_u16(kq[q].w, tp), one2);
        eq[0] = pk_min_u16(kq[q].x ^ tp, one2) ^ one2; eq[1] = pk_min_u16(kq[q].y ^ tp, one2) ^ one2;
        eq[2] = pk_min_u16(kq[q].z ^ tp, one2) ^ one2; eq[3] = pk_min_u16(kq[q].w ^ tp, one2) ^ one2;
        const unsigned es = (eq[0] + eq[1]) + (eq[2] + eq[3]);
        const int ecnt = (int)((es & 0xffffu) + (es >> 16));
        if (__ballot(ecnt != 0) != 0ull) {
          int pre = 0, tot = 0;
#pragma unroll
          for (int bb = 0; bb < 4; ++bb) {
            const unsigned long long bal = __ballot((ecnt >> bb) & 1);
            pre += (int)__builtin_amdgcn_mbcnt_hi((unsigned)(bal >> 32), __builtin_amdgcn_mbcnt_lo((unsigned)bal, 0u)) << bb;
            tot += __popcll(bal) << bb;
          }
          int rk = base + pre;
#pragma unroll
          for (int d = 0; d < 4; ++d) {
            const unsigned e_lo = eq[d] & 1u, e_hi = eq[d] >> 16;
            const unsigned s_lo = (e_lo && rk < need) ? 1u : 0u; rk += (int)e_lo;
            const unsigned s_hi = (e_hi && rk < need) ? 1u : 0u; rk += (int)e_hi;
            gt[d] |= s_lo | (s_hi << 16);
          }
          base += tot;
        }
        TK_STORE(q, gt[0], gt[1], gt[2], gt[3]);
      }
    }
#undef TK_STORE
  }
}

__device__ __forceinline__ void topk_phase(LAS unsigned char* lds, unsigned char* ws, unsigned char* mw, int tid0, int mode, unsigned long long& amp_acc,
                                           volatile LAS unsigned* MISC, int mword, unsigned* qhead, int nunits, int blk_hi) {
  const int ampk = AMP_ON ? (mode >> 16) & 15 : 0;
  typedef float f32x16 __attribute__((ext_vector_type(16)));
  const us* QI = (const us*)(ws + WS_QI);
  const us* KI = (const us*)(ws + WS_KI);
  const float* WI = (const float*)(ws + WS_WI);
  unsigned char* MWB = mw;
  LAS us* KEYS = (LAS us*)lds;
  LAS unsigned* HIST = (LAS unsigned*)(lds + 131072);
  const int wave_u = __builtin_amdgcn_readfirstlane(tid0 >> 6);
  int tid = tid0;
  for (;;) {
    if (wave_u == 0) {
      unsigned v_ = 0u;
      if ((tid0 & 63) == 0) v_ = __hip_atomic_fetch_add(qhead, 1u, __ATOMIC_RELAXED, __HIP_MEMORY_SCOPE_AGENT);
      MISC[mword] = (unsigned)__builtin_amdgcn_readfirstlane((int)v_);
    }
    __syncthreads();
    const int u = __builtin_amdgcn_readfirstlane((int)MISC[mword]);
    if (u >= nunits) break;
    asm volatile("" : "+v"(tid));
    const int lane = tid & 63, wave = tid >> 6;
    const int r = lane & 31, hh = lane >> 5;
    const int a_tok = ((r >> 3) >> 1) + 2 * ((r >> 2) & 1), a_head = (r & 3) + 4 * ((r >> 3) & 1);
    const int rp = wave & 1, kg = wave >> 1;
    const int b = u & 3, blk = blk_hi - (u >> 2);
    const int tt0 = blk * 16, T0 = b * S + tt0, tmax = tt0 + 15, nkt = (tmax >> 5) + 1;
    ((LAS v4u*)HIST)[tid] = (v4u){0u, 0u, 0u, 0u};
    __syncthreads();
    const unsigned long long ta_ = AMP_ON ? __builtin_amdgcn_s_memrealtime() : 0ull;
    if (!(mode & 2)) {
      bf16x8 afr[2][4];
#pragma unroll
      for (int mt = 0; mt < 2; ++mt)
#pragma unroll
        for (int ks = 0; ks < 4; ++ks) afr[mt][ks] = *(const bf16x8*)(QI + (size_t)(T0 + 8 * rp + 4 * mt + a_tok) * 512 + a_head * 64 + 16 * ks + 8 * hh);
      float wv[2][16];
#pragma unroll
      for (int mt = 0; mt < 2; ++mt)
#pragma unroll
        for (int tl = 0; tl < 2; ++tl) {
          const float* wp = WI + (size_t)(T0 + 8 * rp + 4 * mt + tl + 2 * hh) * 8;
          const f32x4 w0 = *(const f32x4*)wp, w1 = *(const f32x4*)(wp + 4);
          wv[mt][8 * tl + 0] = w0.x; wv[mt][8 * tl + 1] = w0.y; wv[mt][8 * tl + 2] = w0.z; wv[mt][8 * tl + 3] = w0.w;
          wv[mt][8 * tl + 4] = w1.x; wv[mt][8 * tl + 5] = w1.y; wv[mt][8 * tl + 6] = w1.z; wv[mt][8 * tl + 7] = w1.w;
        }
      const us* kbase = KI + ((size_t)(b * (S / 32)) * 8 * 32 + hh * 32 + r) * 8;
      bf16x8 bA[4], bB[4];
      const int klast = nkt - 1;
#define TK_LOADB(dst, kt_) do { const int kc_ = (kt_) < klast ? (kt_) : klast; _Pragma("unroll") for (int ks = 0; ks < 4; ++ks) dst[ks] = *(const bf16x8*)(kbase + (size_t)kc_ * 2048 + 512 * ks); } while (0)
#define TK_TILE(bfr, kt_) do { \
        f32x16 acc[2]; \
        _Pragma("unroll") for (int mt = 0; mt < 2; ++mt) { \
          _Pragma("unroll") for (int i = 0; i < 16; ++i) acc[mt][i] = 0.f; \
          _Pragma("unroll") for (int ks = 0; ks < 4; ++ks) acc[mt] = __builtin_amdgcn_mfma_f32_32x32x16_bf16(afr[mt][ks], bfr[ks], acc[mt], 0, 0, 0); } \
        const int s = (kt_) * 32 + r; \
        _Pragma("unroll") for (int mt = 0; mt < 2; ++mt) \
          _Pragma("unroll") for (int tl = 0; tl < 2; ++tl) { \
            float sc = 0.f; \
            _Pragma("unroll") for (int h8 = 0; h8 < 8; ++h8) { const float rl_ = __int_as_float(max(__float_as_int(acc[mt][8 * tl + h8]), 0));   \
              asm("v_fmac_f32_e32 %0, %1, %2" : "+v"(sc) : "v"(wv[mt][8 * tl + h8]), "v"(rl_)); }     \
            const int tokl = 8 * rp + 4 * mt + tl + 2 * hh; \
            const unsigned key = (s <= tt0 + tokl) ? f16key(sc) : 0u; \
            KEYS[tokl * 4096 + s] = (us)key; \
            if (key) __hip_atomic_fetch_add(HIST + tokl * 128 + (key >> 9), 1u << ((key >> 4) & 16u), __ATOMIC_RELAXED, __HIP_MEMORY_SCOPE_WORKGROUP);     \
          } } while (0)
      if (kg < nkt) {
        TK_LOADB(bA, kg);
        for (int kt = kg; kt < nkt; kt += 4) {
          TK_LOADB(bB, kt + 4);
          TK_TILE(bA, kt);
#pragma unroll
          for (int ks = 0; ks < 4; ++ks) bA[ks] = bB[ks];
        }
      }
#undef TK_LOADB
#undef TK_TILE
    }
    __syncthreads();
    const unsigned long long tb_ = AMP_ON ? __builtin_amdgcn_s_memrealtime() : 0ull;
    if (ampk == 2) amp_acc += tb_ - ta_;
    {
      const int N_unit = nkt * 32;
      const int nkw = ((tt0 >> 8) + 1) * 256;
      const int nq = (nkw + 511) >> 9;
      if (mode & 1) continue;
      switch (nq) {
        case 1: tk_select<1>(KEYS, HIST, MWB, T0, N_unit, nkw, wave, lane); break;
        case 2: tk_select<2>(KEYS, HIST, MWB, T0, N_unit, nkw, wave, lane); break;
        case 3: tk_select<3>(KEYS, HIST, MWB, T0, N_unit, nkw, wave, lane); break;
        case 4: tk_select<4>(KEYS, HIST, MWB, T0, N_unit, nkw, wave, lane); break;
        case 5: tk_select<5>(KEYS, HIST, MWB, T0, N_unit, nkw, wave, lane); break;
        case 6: tk_select<6>(KEYS, HIST, MWB, T0, N_unit, nkw, wave, lane); break;
        case 7: tk_select<7>(KEYS, HIST, MWB, T0, N_unit, nkw, wave, lane); break;
        default: tk_select<8>(KEYS, HIST, MWB, T0, N_unit, nkw, wave, lane); break;
      }
      if (ampk == 3) amp_acc += __builtin_amdgcn_s_memrealtime() - tb_;
    }
  }
}

namespace attn_body {
using bf16=__hip_bfloat16;
using bf16x8=__attribute__((ext_vector_type(8)))short;
using s16x4=__attribute__((ext_vector_type(4)))short;
using f32x16=__attribute__((ext_vector_type(16)))float;
using u32x4=__attribute__((ext_vector_type(4)))unsigned;
constexpr int BATCH=4,NHEAD=8,SEQ=4096,D=64,DM=NHEAD*D;
constexpr int NW=8,QBLK=32,QB=QBLK*NW,KVBLK=64,NQB=SEQ/QB;
constexpr int ATTN_PITCH=DM, ATTN_UNIT_ROWS=QB;
__device__ __forceinline__ int crow(int r,int hi){return (r&3)+8*(r>>2)+4*hi;}
#define SBAR() __builtin_amdgcn_sched_barrier(0)
__device__ __forceinline__ void cmask(f32x16&p0,f32x16&p1,int jb,int qrel,int hi){
  const float NEG=-INFINITY; int kb=64*jb+4*hi;
  #pragma unroll
  for(int r=0;r<16;++r){int kv=kb+(r&3)+8*(r>>2); if(kv>qrel)p0[r]=NEG; if(kv+32>qrel)p1[r]=NEG;}
}

constexpr int NSLOT=3, SLOTB=8192;
constexpr int LDS_K=0, LDS_V=NSLOT*SLOTB, LDS_WS=2*NSLOT*SLOTB, LDS_OST=LDS_WS+NW*64*4, LDS_MK=LDS_OST+NW*4096, LDS_BYTES=LDS_MK+NW*2048;
constexpr float C2=0.125f*1.4426950408889634f;
__device__ __forceinline__ void glds16(const void*gsrc,unsigned lds_dst){unsigned keep;
  asm volatile("s_mov_b32 %0, m0\n\ts_mov_b32 m0, %2\n\ts_nop 0\n\tglobal_load_lds_dwordx4 %1, off\n\ts_mov_b32 m0, %0":"=&s"(keep):"v"(gsrc),"s"(lds_dst):"memory");}
__device__ __forceinline__ float max3f(float a,float b,float c){float r;asm("v_max3_f32 %0, %1, %2, %3":"=v"(r):"v"(a),"v"(b),"v"(c));return r;}
__device__ __forceinline__ float max2f(float a,float b){float r;asm("v_max_f32_e32 %0, %1, %2":"=v"(r):"v"(a),"v"(b));return r;}
__device__ __forceinline__ float fadd_s(float a,float b){float r;asm("v_add_f32_e32 %0, %1, %2":"=v"(r):"v"(a),"v"(b));return r;}
__device__ __forceinline__ float fsub_s(float a,float b){float r;asm("v_sub_f32_e32 %0, %1, %2":"=v"(r):"v"(a),"v"(b));return r;}
typedef float f32x2_t __attribute__((ext_vector_type(2))); typedef __bf16 bf16x2_t __attribute__((ext_vector_type(2)));
__device__ __forceinline__ unsigned cvtpk_s(float lo,float hi){f32x2_t v={lo,hi};bf16x2_t b=__builtin_convertvector(v,bf16x2_t);return __builtin_bit_cast(unsigned,b);}
#define WAIT_BAR(N) asm volatile("s_waitcnt vmcnt(" #N ") lgkmcnt(0)\n\ts_barrier":::"memory")

__device__ __forceinline__ void qkt(f32x16&p0,f32x16&p1,const char*Kslot,const bf16x8*qr,const f32x16&negm,int r32,int hi){
  const char*kb=Kslot+hi*1024+r32*16;
  #pragma unroll
  for(int d0=0;d0<4;++d0){
    const bf16x8 b0=*reinterpret_cast<const bf16x8*>(kb+d0*2048);
    const bf16x8 b1=*reinterpret_cast<const bf16x8*>(kb+d0*2048+512);
    if(d0==0){p0=__builtin_amdgcn_mfma_f32_32x32x16_bf16(b0,qr[0],negm,0,0,0);p1=__builtin_amdgcn_mfma_f32_32x32x16_bf16(b1,qr[0],negm,0,0,0);}
    else{p0=__builtin_amdgcn_mfma_f32_32x32x16_bf16(b0,qr[d0],p0,0,0,0);p1=__builtin_amdgcn_mfma_f32_32x32x16_bf16(b1,qr[d0],p1,0,0,0);}}
}
typedef __attribute__((address_space(3))) const char* lds_cptr;
typedef short v4i16_t __attribute__((ext_vector_type(4)));
__device__ __forceinline__ void kload8(bf16x8*kf,lds_cptr kp){
  kf[0]=*(const __attribute__((address_space(3))) bf16x8*)(kp);      kf[1]=*(const __attribute__((address_space(3))) bf16x8*)(kp+512);
  kf[2]=*(const __attribute__((address_space(3))) bf16x8*)(kp+2048); kf[3]=*(const __attribute__((address_space(3))) bf16x8*)(kp+2560);
  kf[4]=*(const __attribute__((address_space(3))) bf16x8*)(kp+4096); kf[5]=*(const __attribute__((address_space(3))) bf16x8*)(kp+4608);
  kf[6]=*(const __attribute__((address_space(3))) bf16x8*)(kp+6144); kf[7]=*(const __attribute__((address_space(3))) bf16x8*)(kp+6656);
}
__device__ __forceinline__ void kload2(bf16x8*kf,lds_cptr kp,int j){ kf[2*j]=*(const __attribute__((address_space(3))) bf16x8*)(kp+j*2048); kf[2*j+1]=*(const __attribute__((address_space(3))) bf16x8*)(kp+j*2048+512); }
__device__ __forceinline__ s16x4 vtr(lds_cptr p){ return __builtin_bit_cast(s16x4,__builtin_amdgcn_ds_read_tr16_b64_v4i16((__attribute__((address_space(3))) v4i16_t*)p)); }
__device__ __forceinline__ float rowmax(const f32x16&p0,const f32x16&p1){
  float a=max3f(p0[0],p0[1],p1[0]),b=max3f(p0[2],p0[3],p1[1]);a=max3f(a,p1[2],p1[3]);
  #pragma unroll
  for(int r=4;r<16;r+=4){a=max3f(a,p0[r],p0[r+1]);b=max3f(b,p0[r+2],p0[r+3]);a=max3f(a,p1[r],p1[r+1]);b=max3f(b,p1[r+2],p1[r+3]);}
  const float m=max2f(a,b);
  auto rr=__builtin_amdgcn_permlane32_swap(__float_as_uint(m),__float_as_uint(m),false,false);
  return max2f(__uint_as_float(rr[0]),__uint_as_float(rr[1]));
}
__device__ __forceinline__ void pv(f32x16*o,int vb,bf16x8 pa0,bf16x8 pa1,bf16x8 pa2,bf16x8 pa3){
  #pragma unroll
  for(int d0=0;d0<2;++d0){s16x4 lo[4],hi[4];
    #pragma unroll
    for(int ks=0;ks<4;++ks){
      asm volatile("ds_read_b64_tr_b16 %0,%1 offset:%c2":"=&v"(lo[ks]):"v"(vb),"i"(d0*4096+ks*1024):"memory");
      asm volatile("ds_read_b64_tr_b16 %0,%1 offset:%c2":"=&v"(hi[ks]):"v"(vb),"i"(d0*4096+ks*1024+512):"memory");}
    asm volatile("s_waitcnt lgkmcnt(0)":::"memory");SBAR();
    #define PK(k) (bf16x8){lo[k][0],lo[k][1],lo[k][2],lo[k][3],hi[k][0],hi[k][1],hi[k][2],hi[k][3]}
    o[d0]=__builtin_amdgcn_mfma_f32_32x32x16_bf16(pa0,PK(0),o[d0],0,0,0);
    o[d0]=__builtin_amdgcn_mfma_f32_32x32x16_bf16(pa1,PK(1),o[d0],0,0,0);
    o[d0]=__builtin_amdgcn_mfma_f32_32x32x16_bf16(pa2,PK(2),o[d0],0,0,0);
    o[d0]=__builtin_amdgcn_mfma_f32_32x32x16_bf16(pa3,PK(3),o[d0],0,0,0);
    #undef PK
  }
}

#ifndef ATTN_STORE16
#define ATTN_STORE16(p,v) asm volatile("global_store_dwordx4 %0, %1, off sc1\n\ts_nop 1"::"v"(p),"v"(v):"memory")
#endif
template<int THRL> __device__ __forceinline__ void attn_unit(int b,int h,int qb,const bf16*Q,const bf16*__restrict__ K,const bf16*__restrict__ V,bf16*O,const unsigned char*MW,unsigned*done,char*shm){
  const int tid=threadIdx.x,lane=tid&63,r32=lane&31,hi=lane>>5; const int wid=__builtin_amdgcn_readfirstlane(tid>>6);
  const long rowbase=(long)b*SEQ; const int q0=qb*QB;
  const bf16*Qw=Q+(rowbase+q0+wid*QBLK)*DM+h*D;
  const bf16*Kh=K+rowbase*DM+h*D,*Vh=V+rowbase*DM+h*D;
  const unsigned lds0=(unsigned)(uintptr_t)shm;
  float*wsf=(float*)(shm+LDS_WS)+wid*64;
  const bf16*ksrc=Kh+(long)lane*DM+wid*8;
  const bf16*vsrc=Vh+(long)(16*(wid&3)+(lane>>2))*DM+(wid>>2)*32+(lane&3)*8;
  const unsigned kdst=lds0+LDS_K+wid*1024, vdst=lds0+LDS_V+wid*1024;
  #define DMA_K(t,slot) glds16(ksrc+(long)(t)*KVBLK*DM,(unsigned)__builtin_amdgcn_readfirstlane(kdst+(slot)))
  #define DMA_V(t,slot) glds16(vsrc+(long)(t)*KVBLK*DM,(unsigned)__builtin_amdgcn_readfirstlane(vdst+(slot)))
  const int vb0=(int)(lds0+LDS_V)+((lane>>4)&1)*32+(lane&3)*8+(4*hi+((lane&15)>>2))*64;
  const char*Kbase=shm+LDS_K; bf16x8 kf[8];
  const lds_cptr shm3=(lds_cptr)shm; const lds_cptr kp0=shm3+LDS_K+hi*1024+r32*16; const lds_cptr vp0=shm3+LDS_V+((lane>>4)&1)*32+(lane&3)*8+(4*hi+((lane&15)>>2))*64;
  const int NT=(q0+QB)/KVBLK;
  const unsigned char*msrc=MW+((size_t)(rowbase+q0+wid*QBLK+(lane>>1)))*512+(lane&1)*16;
  const unsigned mdst=lds0+LDS_MK+wid*2048;
  #define MDMA(g) glds16(msrc+(g)*32,(unsigned)__builtin_amdgcn_readfirstlane(mdst+((g)&1)*1024))
  const lds_cptr mkp=(lds_cptr)shm+LDS_MK+wid*2048+r32*32;
  #define MWORD(t) (*(const __attribute__((address_space(3))) unsigned long long*)(mkp+(((t)>>2)&1)*1024+(((t)>>1)&1)*16+((t)&1)*8))
  #define MAPPLY(X,B,w) do{ X[B]=__uint_as_float(__float_as_uint(X[B])&(unsigned)__builtin_amdgcn_sbfe((int)(w),((B)&3)+8*((B)>>2),1)); }while(0)
  MDMA(0); if(q0+QB>4*KVBLK){MDMA(1);}
  DMA_K(0,0);DMA_V(0,0);DMA_K(1,SLOTB);
  bf16x8 qr[4];
  #pragma unroll
  for(int d0=0;d0<4;++d0)qr[d0]=*reinterpret_cast<const bf16x8*>(&Qw[(long)r32*DM+d0*16+hi*8]);
  float mhat=0.f,l_reg=0.f;f32x16 o[2];o[0]=f32x16{};o[1]=f32x16{};f32x16 negm=f32x16{};asm volatile("":"+v"(negm));
  const int qrel=wid*QBLK+r32;
  #define CMASK(P0,P1,t) do{int jb_=(t)-(NT-4); if(jb_>=0)cmask(P0,P1,jb_,qrel,hi);}while(0)
  bool resc=false;
  #define START(P0,P1) do{ const float rm=rowmax(P0,P1); resc=false; \
    { const float dl=rm; mhat=fadd_s(mhat,dl); \
      _Pragma("unroll") for(int r=0;r<16;++r){P0[r]=fsub_s(P0[r],dl);P1[r]=fsub_s(P1[r],dl);} \
      _Pragma("unroll") for(int r=0;r<16;++r)negm[r]=-mhat; asm volatile("":"+v"(negm)); } \
    _Pragma("unroll") for(int r=0;r<16;++r)P0[r]=__builtin_amdgcn_exp2f(P0[r]); }while(0)
  #define RESC() do{ if(resc){ asm volatile("s_waitcnt lgkmcnt(0)":::"memory"); \
      _Pragma("unroll") for(int d_=0;d_<2;++d_) _Pragma("unroll") for(int r=0;r<16;++r)o[d_][r]*=wsf[crow(r,hi)]; } }while(0)
  f32x16 pA0,pA1,pB0,pB1;
  int sl_prev=0,sl_cur=0,sl_next=SLOTB;
  #define ROT() do{sl_prev=sl_cur;sl_cur=sl_next;sl_next=(sl_next==(NSLOT-1)*SLOTB)?0:sl_next+SLOTB;}while(0)
  DMA_K(2,2*SLOTB);
  WAIT_BAR(3);
  qkt(pA0,pA1,Kbase,qr,negm,r32,hi);asm volatile("s_nop 15\n\ts_nop 7":"+v"(pA0),"+v"(pA1));
  START(pA0,pA1);
  _Pragma("unroll") for(int r=0;r<16;++r)pA1[r]=__builtin_amdgcn_exp2f(pA1[r]);
  { const unsigned long long mw_=MWORD(0); const unsigned wl_=(unsigned)mw_>>(4*hi), wh_=(unsigned)(mw_>>32)>>(4*hi);
    _Pragma("unroll") for(int r=0;r<16;++r){ MAPPLY(pA0,r,wl_); MAPPLY(pA1,r,wh_); } }
  WAIT_BAR(0);
  DMA_K(3,0);DMA_V(1,SLOTB);
  ROT();
  kload8(kf,kp0+sl_cur);
  WAIT_BAR(2);
  s16x4 vlo[8],vhi[8]; u32x4 pw0,pw1,pw2,pw3;
  #define PKW(P,B) cvtpk_s(P[B],P[B+1])
  #define PAF(k) __builtin_bit_cast(bf16x8,pw##k)
  #define VFR(i) (bf16x8){vlo[i][0],vlo[i][1],vlo[i][2],vlo[i][3],vhi[i][0],vhi[i][1],vhi[i][2],vhi[i][3]}
  #define PIN(x) asm volatile("":"+v"(x))
  #define MX3(a,b,c) __builtin_fmaxf(__builtin_fmaxf((a),(b)),(c))
  #define GAPA(MF,A0,A1,A2,A3,W0,W1,PW) do{ MF; sacc+=A0; sacc+=A1; sacc+=A2; sacc+=A3; PIN(sacc); W0; W1; PIN(PW); SBAR(); }while(0)
  #define EX(v) __builtin_amdgcn_exp2f(v)
  #define GAPB(MF,X,B,w) do{ MF; X[B]=EX(X[B]); X[B+1]=EX(X[B+1]); X[B+2]=EX(X[B+2]); X[B+3]=EX(X[B+3]); MAPPLY(X,B,w); MAPPLY(X,B+1,w); MAPPLY(X,B+2,w); MAPPLY(X,B+3,w); PIN(X); SBAR(); }while(0)
  #define VRD(i) do{ vlo[i]=vtr(vp_+(((i)>>2)*4096+((i)&3)*1024)); vhi[i]=vtr(vp_+(((i)>>2)*4096+((i)&3)*1024+512)); }while(0)
  #define KRD(G,j) do{ if(G){ kload2(kf,kp0+sl_next,j); SBAR(); } }while(0)
  #define STEP(C0,C1,P0,P1,t,GK,GV,GL) do{ SBAR(); \
    const lds_cptr vp_=vp0+sl_prev; \
    VRD(0); SBAR(); float sacc=(P0[0]+P0[1]); \
    GAPA(C0=__builtin_amdgcn_mfma_f32_32x32x16_bf16(kf[0],qr[0],negm,0,0,0), P0[2],P0[3],P0[4],P0[5],     pw0[0]=PKW(P0,0), pw0[1]=PKW(P0,2), pw0); \
    VRD(4); SBAR(); GAPA(C1=__builtin_amdgcn_mfma_f32_32x32x16_bf16(kf[1],qr[0],negm,0,0,0), P0[6],P0[7],P0[8],P0[9],     pw0[2]=PKW(P0,4), pw0[3]=PKW(P0,6), pw0); \
    VRD(1); SBAR(); GAPA(C0=__builtin_amdgcn_mfma_f32_32x32x16_bf16(kf[2],qr[1],C0,0,0,0),   P0[10],P0[11],P0[12],P0[13], pw1[0]=PKW(P0,8), pw1[1]=PKW(P0,10), pw1); \
    VRD(5); SBAR(); GAPA(C1=__builtin_amdgcn_mfma_f32_32x32x16_bf16(kf[3],qr[1],C1,0,0,0),   P0[14],P0[15],P1[0],P1[1],   pw1[2]=PKW(P0,12),pw1[3]=PKW(P0,14), pw1); \
    VRD(2); SBAR(); GAPA(C0=__builtin_amdgcn_mfma_f32_32x32x16_bf16(kf[4],qr[2],C0,0,0,0),   P1[2],P1[3],P1[4],P1[5],     pw2[0]=PKW(P1,0), pw2[1]=PKW(P1,2), pw2); \
    VRD(6); SBAR(); GAPA(C1=__builtin_amdgcn_mfma_f32_32x32x16_bf16(kf[5],qr[2],C1,0,0,0),   P1[6],P1[7],P1[8],P1[9],     pw2[2]=PKW(P1,4), pw2[3]=PKW(P1,6), pw2); \
    VRD(3); SBAR(); GAPA(C0=__builtin_amdgcn_mfma_f32_32x32x16_bf16(kf[6],qr[3],C0,0,0,0),   P1[10],P1[11],P1[12],P1[13], pw3[0]=PKW(P1,8), pw3[1]=PKW(P1,10), pw3); \
    VRD(7); SBAR(); GAPA(C1=__builtin_amdgcn_mfma_f32_32x32x16_bf16(kf[7],qr[3],C1,0,0,0),   P1[14],P1[15],0.f,0.f,       pw3[2]=PKW(P1,12),pw3[3]=PKW(P1,14), pw3); \
    l_reg+=sacc; \
    if((((t)&3)==0)&&((t)+4<NT)){MDMA(((t)>>2)+1);} \
    if(GK){DMA_K((t)+3,sl_cur);} if(GV){DMA_V((t)+1,sl_next);} \
    const unsigned long long mw_=MWORD(t); const unsigned wl_=(unsigned)mw_>>(4*hi), wh_=(unsigned)(mw_>>32)>>(4*hi); \
    { float a=MX3(C0[0],C0[1],C1[0]),b=MX3(C0[2],C0[3],C1[1]); a=MX3(a,C1[2],C1[3]); \
      _Pragma("unroll") for(int r=4;r<16;r+=4){a=MX3(a,C0[r],C0[r+1]);b=MX3(b,C0[r+2],C0[r+3]);a=MX3(a,C1[r],C1[r+1]);b=MX3(b,C1[r+2],C1[r+3]);} \
      float rm=__builtin_fmaxf(a,b); { auto rr=__builtin_amdgcn_permlane32_swap(__float_as_uint(rm),__float_as_uint(rm),false,false); rm=__builtin_fmaxf(__uint_as_float(rr[0]),__uint_as_float(rr[1])); } \
      resc=false; \
      if(__builtin_expect(__any(rm>(float)THRL),0)){ const float dl=__builtin_fmaxf(rm,0.f); mhat+=dl; \
        _Pragma("unroll") for(int r=0;r<16;++r){C0[r]-=dl;C1[r]-=dl;} \
        _Pragma("unroll") for(int r=0;r<16;++r)negm[r]=-mhat; asm volatile("":"+v"(negm)); \
        const float f=__builtin_amdgcn_exp2f(-dl); l_reg*=f; if(hi==0)wsf[r32]=f; resc=true; } } \
    SBAR(); \
    GAPB(o[0]=__builtin_amdgcn_mfma_f32_32x32x16_bf16(PAF(0),VFR(0),o[0],0,0,0), C0,0,wl_); \
    GAPB(o[1]=__builtin_amdgcn_mfma_f32_32x32x16_bf16(PAF(0),VFR(4),o[1],0,0,0), C0,4,wl_); \
    KRD(GL,0); GAPB(o[0]=__builtin_amdgcn_mfma_f32_32x32x16_bf16(PAF(1),VFR(1),o[0],0,0,0), C0,8,wl_); \
    KRD(GL,1); GAPB(o[1]=__builtin_amdgcn_mfma_f32_32x32x16_bf16(PAF(1),VFR(5),o[1],0,0,0), C0,12,wl_); \
    KRD(GL,2); GAPB(o[0]=__builtin_amdgcn_mfma_f32_32x32x16_bf16(PAF(2),VFR(2),o[0],0,0,0), C1,0,wh_); \
    KRD(GL,3); GAPB(o[1]=__builtin_amdgcn_mfma_f32_32x32x16_bf16(PAF(2),VFR(6),o[1],0,0,0), C1,4,wh_); \
    GAPB(o[0]=__builtin_amdgcn_mfma_f32_32x32x16_bf16(PAF(3),VFR(3),o[0],0,0,0), C1,8,wh_); \
    GAPB(o[1]=__builtin_amdgcn_mfma_f32_32x32x16_bf16(PAF(3),VFR(7),o[1],0,0,0), C1,12,wh_); \
    }while(0)
  int t=1;
  #undef CMASK
  #define CMASK(P0,P1,t) do{}while(0)
  for(;t+5<NT;t+=2){
    STEP(pB0,pB1,pA0,pA1,t,true,true,true);     WAIT_BAR(2); RESC(); ROT();
    STEP(pA0,pA1,pB0,pB1,t+1,true,true,true);   WAIT_BAR(2); RESC(); ROT();
  }
  #undef CMASK
  #define CMASK(P0,P1,t) do{int jb_=(t)-(NT-4); if(jb_>=0)cmask(P0,P1,jb_,qrel,hi);}while(0)
  #define ENDW(tt) do{ if((tt)+3<NT){WAIT_BAR(2);} else if((tt)+2<NT){WAIT_BAR(1);} else {WAIT_BAR(0);} }while(0)
  for(;t+1<NT;t+=2){
    STEP(pB0,pB1,pA0,pA1,t,(t+3<NT),(t+1<NT),(t+1<NT));       ENDW(t);   RESC(); ROT();
    STEP(pA0,pA1,pB0,pB1,t+1,(t+4<NT),(t+2<NT),(t+2<NT));     ENDW(t+1); RESC(); ROT();
  }
  STEP(pB0,pB1,pA0,pA1,NT-1,false,false,false); RESC();
  { float sacc=pB0[0]+pB0[1]; _Pragma("unroll") for(int r=2;r<16;++r)sacc+=pB0[r]; _Pragma("unroll") for(int r=0;r<16;++r)sacc+=pB1[r]; l_reg+=sacc;
    pw0=(u32x4){PKW(pB0,0),PKW(pB0,2),PKW(pB0,4),PKW(pB0,6)};pw1=(u32x4){PKW(pB0,8),PKW(pB0,10),PKW(pB0,12),PKW(pB0,14)};pw2=(u32x4){PKW(pB1,0),PKW(pB1,2),PKW(pB1,4),PKW(pB1,6)};pw3=(u32x4){PKW(pB1,8),PKW(pB1,10),PKW(pB1,12),PKW(pB1,14)};
    SBAR(); pv(o,vb0+sl_cur,PAF(0),PAF(1),PAF(2),PAF(3)); }
  #undef PKW
  #undef PAF
  #undef VFR
  #undef PIN
  #undef MX3
  #undef GAPA
  #undef GAPB
  #undef EX
  #undef VRD
  #undef KRD
  #undef STEP
  #undef ENDW
  {auto rr=__builtin_amdgcn_permlane32_swap(__float_as_uint(l_reg),__float_as_uint(l_reg),false,false);l_reg=__uint_as_float(rr[0])+__uint_as_float(rr[1]);}
  if(hi==0)wsf[32+r32]=l_reg;asm volatile("s_waitcnt lgkmcnt(0)":::"memory");
  float rli[16];
  #pragma unroll
  for(int r=0;r<16;++r)rli[r]=__builtin_amdgcn_rcpf(wsf[32+crow(r,hi)]);
  bf16*Ow=O+(rowbase+q0+wid*QBLK)*DM+h*D;
  { bf16*stg=(bf16*)(shm+LDS_OST)+wid*2048;
    #pragma unroll
    for(int r=0;r<16;++r){const int orow=crow(r,hi);
      #pragma unroll
      for(int d0=0;d0<2;++d0)stg[orow*64+d0*32+r32]=__float2bfloat16(o[d0][r]*rli[r]);}
    asm volatile("s_waitcnt lgkmcnt(0)":::"memory");
    #pragma unroll
    for(int i=0;i<4;++i){const int row=i*8+(lane>>3),ch=lane&7; const u32x4 v=*(const u32x4*)(stg+row*64+ch*8); ATTN_STORE16(Ow+(long)row*DM+ch*8,v);} }
  asm volatile("s_waitcnt vmcnt(0) lgkmcnt(0)\n\ts_barrier":::"memory");
  if(wid==1){ if(lane==0) __hip_atomic_fetch_add(done+b*16+qb,1u,__ATOMIC_RELAXED,__HIP_MEMORY_SCOPE_AGENT); }
  #undef DMA_K
  #undef DMA_V
  #undef CMASK
  #undef MDMA
  #undef MWORD
  #undef MAPPLY
  #undef START
  #undef RESC
  #undef ROT
}
constexpr int ATTN_LDS_BYTES=LDS_BYTES;
struct AttnTensors { const bf16* Q; const bf16* K; const bf16* V; bf16* O; const unsigned char* MW; unsigned* done; };
template<int THRL=8> __device__ __forceinline__ void attn_phase(char*lds,const AttnTensors&T,int grid,int block){
  for(int v0=block;v0<256;v0+=grid){
    const int vcu=(grid==256)?((v0%8)*32+v0/8):v0; const int bh=vcu>>3,s=vcu&7;
    attn_unit<THRL>(bh/NHEAD,bh%NHEAD,s,T.Q,T.K,T.V,T.O,T.MW,T.done,lds);
    attn_unit<THRL>(bh/NHEAD,bh%NHEAD,15-s,T.Q,T.K,T.V,T.O,T.MW,T.done,lds);
  }
}
#undef SBAR
#undef WAIT_BAR
}

__global__ void __launch_bounds__(512, 2) mk_fwd(Args args) {
  extern __shared__ __attribute__((aligned(16))) unsigned char lds_raw[];
  LAS unsigned char* lds = (LAS unsigned char*)lds_raw;
  volatile LAS unsigned* MISC = (volatile LAS unsigned*)(lds + MISC_OFF);
  const int tid = threadIdx.x, lane = tid & 63;
  const int wave = __builtin_amdgcn_readfirstlane(tid >> 6);
  const int G_ = gridDim.x;
  unsigned char* ws = args.ws;
  if (tid < 32) MISC[tid] = 0u;
  __syncthreads();
  XcdBarrier bar = xcd_barrier_post((unsigned*)(ws + WS_CTL) + CW_BAR + args.li * XCD_BAR_WORDS, MISC + 8);
  const int lo = args.ph_lo, hi = args.ph_hi;
#define IN(k) (lo <= (k) && (k) < hi)
  unsigned long long amp_acc = 0ull, t_lastexit = AMP_ON ? __builtin_amdgcn_s_memrealtime() : 0ull;
#define SEAM(k) do { if (IN(k) && (k) + 1 < hi) { if (!AMP_ON) { xcd_barrier(bar); } else { const unsigned long long tb_ = __builtin_amdgcn_s_memrealtime(); xcd_barrier(bar); const unsigned long long te_ = __builtin_amdgcn_s_memrealtime(); \
    if (((args.dup >> 16) & 15) == 1) amp_acc += te_ - tb_; \
    if (((args.dup >> 16) & 15) == 14 && (((unsigned)args.dup >> 28) & 15u) == (unsigned)(k)) amp_acc += te_ - t_lastexit; t_lastexit = te_; } } } while (0)

#define PHASE_IDS() int tid_p = tid; asm volatile("" : "+v"(tid_p)); const int lane_p = tid_p & 63; const int wave_p = __builtin_amdgcn_readfirstlane(tid_p >> 6)
#define AMP_T0() const unsigned long long tph_ = AMP_ON ? __builtin_amdgcn_s_memrealtime() : 0ull
#define AMP_T1(k) do { if (AMP_ON && ((args.dup >> 16) & 15) == 15 && (((unsigned)args.dup >> 28) & 15u) == (unsigned)(k)) amp_acc += __builtin_amdgcn_s_memrealtime() - tph_; } while (0)
  const float* x = args.in[0];
  const int* pos = (const int*)args.in[1];
  const float* g_mix = args.in[2];
  const float* w_in = args.in[3];
  us* WinT = (us*)(ws + WS_WIN); us* WcoT = (us*)(ws + WS_WCO); us* WaoT = (us*)(ws + WS_WAO); us* WoT = (us*)(ws + WS_WO);
  float* CT = (float*)(ws + WS_CT); float* ST = (float*)(ws + WS_ST);
  us* Hb = (us*)(ws + WS_HB);

  { AMP_T0(); if (IN(PH_PREP)) {
    LAS float* scr = (LAS float*)(lds + wave * 16384);
    const int gw = blockIdx.x * 8 + wave, NGW = G_ * 8;
    constexpr int I_IN = 16 * 168, I_CO = 8 * 32, I_AO = 8 * 32, I_O = 16 * 32;
    constexpr int NITEMS = I_IN + I_CO + I_AO + I_O;
    for (int it = gw; it < NITEMS; it += NGW) {
      int r = it;
      if (r < I_IN) { const int g = r % 168, kb = r / 168; p0_transpose_item(w_in, INC, 64 * kb, inproj_src(g), WinT, 1024, 32 * g, scr, lane); continue; }
      r -= I_IN;
      if (r < I_CO) { const int nb = r % 32, kb = r / 32; p0_transpose_item(args.in[8], 1024, 64 * kb, 32 * nb, WcoT, 512, 32 * nb, scr, lane); continue; }
      r -= I_CO;
      if (r < I_AO) { const int nb = r % 32, kb = r / 32; p0_transpose_item(args.in[9], 1024, 64 * kb, 32 * nb, WaoT, 512, 32 * nb, scr, lane); continue; }
      r -= I_AO;
      { const int nb = r % 32, kb = r / 32; p0_transpose_item(args.in[10], 1024, 64 * kb, 32 * nb, WoT, 1024, 32 * nb, scr, lane); }
    }
    for (int row = gw * 4; row < T; row += NGW * 4) rms_rows4_to_bf16(x + (size_t)row * D, g_mix, Hb + (size_t)row * D, lane);
    for (int i = blockIdx.x * 512 + tid; i < T * 32; i += G_ * 512) {
      const int t = i >> 5, d = i & 31;
      const float inv = 1.0f / powf(10000.0f, (float)(2 * d) / 64.0f);
      const float ang = (float)pos[t] * inv;
      const float n_ = rintf(ang * 0.15915494309189535f);
      float rr = __builtin_fmaf(-n_, 6.28125f, ang); rr = __builtin_fmaf(-n_, 1.9353071795864769e-3f, rr);
      const float rev = rr * 0.15915494309189535f;
      CT[i] = __builtin_amdgcn_cosf(rev); ST[i] = __builtin_amdgcn_sinf(rev);
    }
    for (int i = blockIdx.x * 512 + tid; i < 8192; i += G_ * 512) route_weights_item((us*)(ws + WS_WR), args.in[11], args.in[12], args.in[14], i);
  }
  AMP_T1(PH_PREP); }
  SEAM(PH_PREP);
  { AMP_T0(); if (IN(PH_INPROJ)) {
    pg8::Gemm g{Hb, WinT, T, NIN, D};
    InProjOrder So; So.init(T, NIN, G_, (int)blockIdx.x); So.dep = (unsigned*)(ws + WS_CTL) + CW_DEP;
    EpiInProj E;
    E.G = (us*)(ws + WS_G); E.Q = (us*)(ws + WS_Q); E.K = (us*)(ws + WS_K); E.V = (us*)(ws + WS_V); E.QI = (us*)(ws + WS_QI);
    E.KI = (us*)(ws + WS_KI); E.GC = (us*)(ws + WS_GC); E.GA = (us*)(ws + WS_GA); E.WI = (float*)(ws + WS_WI); E.CT = CT; E.ST = ST;
    pg8::gemm_phase<EpiInProj, InProjOrder, true, true>(lds, g, So, E);
    {
      const int nwg_ = (T / 256) * (NIN / 256); int n6 = nwg_ - 5 * G_; n6 = n6 < 0 ? 0 : (n6 > G_ ? G_ : n6);
      const bool all_ = (n6 == 0 || n6 == G_);
      const bool six = !all_ && (int)blockIdx.x < n6;
      const int nfree = all_ ? G_ : G_ - n6, myidx = all_ ? (int)blockIdx.x : (int)blockIdx.x - n6;
      if (!six && nfree > 0) {
        LAS float* scr = (LAS float*)(lds + wave * 16384);
        constexpr int I_GU = 16 * 16 * 16, I_DN = 16 * 4 * 32;
        for (int it = myidx * 8 + wave; it < I_GU + I_DN; it += nfree * 8) {
          int r = it;
      if (r < I_GU) {
        const int g16 = r & 15, kb = (r >> 4) & 15, e = r >> 8; const int ct = g16 >> 3, half = (g16 >> 2) & 1, q = g16 & 3;
        p0_transpose_item_fm((half ? args.in[17] : args.in[16]) + (size_t)e * 1024 * 256, 256, 64 * kb, 128 * ct + 32 * q, (us*)(ws + WS_WGU), 1024,
                             e * 16 + ct * 8 + half * 4 + q, scr, lane, args.in[11]);
        continue; }
      r -= I_GU;
      { const int g = r & 31, kb = (r >> 5) & 3, e = r >> 7;
        p0_transpose_item_fm(args.in[18] + (size_t)e * 256 * 1024, 1024, 64 * kb, 32 * g, (us*)(ws + WS_WD), 256, e * 32 + g, scr, lane); }
        }
      }
    }
  }
  AMP_T1(PH_INPROJ); }
  { AMP_T0(); if (IN(PH_TOPK)) { PHASE_IDS();
    unsigned* ctl_ = (unsigned*)(ws + WS_CTL);
    if (threadIdx.x < 64) {
      unsigned sp = 0;
      while ((unsigned)__builtin_amdgcn_readfirstlane(__hip_atomic_load(ctl_ + CW_DEP, __ATOMIC_RELAXED, __HIP_MEMORY_SCOPE_AGENT)) < DEP_TARGET) { __builtin_amdgcn_s_sleep(2); if (++sp > (1u << 22)) break; }
      __builtin_amdgcn_fence(__ATOMIC_ACQUIRE, "agent");
      asm volatile("s_waitcnt vmcnt(0)" ::: "memory");
    }
    __syncthreads();
    topk_phase(lds, ws, (unsigned char*)args.out, tid_p, args.dup, amp_acc, MISC, 20, ctl_ + CW_TQ, 768, 255);
    conv_phase(lds, ws, args.in[4], args.in[5], args.in[6], args.in[7], tid_p, lane_p, wave_p, MISC, ctl_ + CW_TQ + 1);
    topk_phase(lds, ws, (unsigned char*)args.out, tid_p, args.dup, amp_acc, MISC, 22, ctl_ + CW_TQ + 2, 256, 63);
  }
  AMP_T1(PH_TOPK); }
  SEAM(PH_TOPK);
  { AMP_T0(); if (IN(PH_ATTN)) {
    attn_body::AttnTensors Tn{(const attn_body::bf16*)(ws + WS_Q), (const attn_body::bf16*)(ws + WS_K), (const attn_body::bf16*)(ws + WS_V),
                              (attn_body::bf16*)(ws + WS_AO), (const unsigned char*)args.out, (unsigned*)(ws + WS_CTL) + CW_ATTN};
    attn_body::attn_phase<8>((char*)lds_raw, Tn, G_, (int)blockIdx.x);
  }
  AMP_T1(PH_ATTN); }
  { AMP_T0(); if (IN(PH_MIX)) {
    us* M1 = (us*)(ws + WS_M1);
    DualOrder So; So.init(T, 1024, G_, (int)blockIdx.x); So.ready = (const unsigned*)(ws + WS_CTL) + CW_ATTN;
    pg8::Gemm g0{(const us*)(ws + WS_NA), WcoT, T, 1024, 512}, g1{(const us*)(ws + WS_AO), WaoT, T, 1024, 512};
    EpiGate2 E; E.gc = (const us*)(ws + WS_GC); E.ga = (const us*)(ws + WS_GA); E.M1 = M1;
    pg8::gemm_phase<EpiGate2, DualOrder, true, true>(lds, g0, So, E, g1);
  }
  AMP_T1(PH_MIX); }
  SEAM(PH_MIX);
  { AMP_T0(); if (IN(PH_WO)) {
    pg8::Gemm g{(const us*)(ws + WS_M1), WoT, T, 1024, 1024};
    pg8::StaticOrder So; So.init(T, 1024, G_, (int)blockIdx.x);
    EpiRes E; E.base = x; E.x1b = (us*)(ws + WS_X1B);
    pg8::gemm_phase<EpiRes, pg8::StaticOrder, true, true>(lds, g, So, E);
  }
  AMP_T1(PH_WO); }
  SEAM(PH_WO);
  const unsigned long long tr0_ = AMP_ON ? __builtin_amdgcn_s_memrealtime() : 0ull;
  if (IN(PH_ROUTE)) { PHASE_IDS(); route_phase(lds, ws, (const us*)(ws + WS_X1B), args.in[13], args.in[15], tid_p, lane_p, wave_p, args.dup); }
  if (AMP_ON && ((args.dup >> 16) & 15) == 4) amp_acc += __builtin_amdgcn_s_memrealtime() - tr0_;
  SEAM(PH_ROUTE);
  { AMP_T0(); if (IN(PH_MOE1)) { PHASE_IDS(); moe_phase<0>(lds, ws, MISC, tid_p, args.dup); }
  AMP_T1(PH_MOE1); }
  SEAM(PH_MOE1);
  if (AMP_ON && ((args.dup >> 16) & 15) == 5) { for (int i_ = 0; i_ < 10; ++i_) xcd_barrier(bar); }
  { AMP_T0(); if (IN(PH_FINAL)) { PHASE_IDS(); final_phase(ws, (const us*)(ws + WS_X1B), args.out, args.in[19], lane_p, wave_p, args.dup); }
  AMP_T1(PH_FINAL); }
  if (AMP_ON && ((args.dup >> 16) & 15) && (int)blockIdx.x == ((args.dup >> 20) & 255)) { const unsigned long long t1 = __builtin_amdgcn_s_memrealtime(); while (__builtin_amdgcn_s_memrealtime() - t1 < 9ull * amp_acc) __builtin_amdgcn_s_sleep(8); }
}

constexpr int SHIP_MODE = 0;
constexpr int PROBE_MODE = 0;
constexpr int PROBE_K = -1;
extern "C" void kernel_launch(void* const* d_in, const int* in_sizes, int n_in, void* d_out, int out_size, void* d_ws, size_t ws_size,
                              hipStream_t stream) {
  static int grid = 0;
  if (grid == 0) {
    int dev = 0, cus = 0, per_cu = 0;
    hipGetDevice(&dev);
    hipDeviceGetAttribute(&cus, hipDeviceAttributeMultiprocessorCount, dev);
    hipFuncSetAttribute((const void*)mk_fwd, hipFuncAttributeMaxDynamicSharedMemorySize, LDS_BYTES);
    hipOccupancyMaxActiveBlocksPerMultiprocessor(&per_cu, (const void*)mk_fwd, 512, LDS_BYTES);
    if (per_cu < 1) { fprintf(stderr, "kernel_launch: occupancy query says %d blocks/CU\n", per_cu); per_cu = 1; }
    grid = cus;
  }
  hipMemsetAsync((char*)d_ws + WS_CTL, 0, CTL_ZERO_BYTES, stream);
  Args a{};
  for (int i = 0; i < 20; ++i) a.in[i] = (const float*)d_in[i];
  a.out = (float*)d_out; a.ws = (unsigned char*)d_ws;
  auto launch = [&](int lo, int hi, int li, int mode = 0) {
    a.ph_lo = lo; a.ph_hi = hi; a.li = li; a.dup = mode;
    void* kargs[] = {&a};
    hipError_t e = hipLaunchCooperativeKernel((const void*)mk_fwd, dim3(grid), dim3(512), kargs, LDS_BYTES, stream);
    if (e != hipSuccess) fprintf(stderr, "cooperative launch failed: %s (grid %d)\n", hipGetErrorString(e), grid);
  };
  if (PROBE_K == -1) launch(PH_PREP, PH_END, 0, SHIP_MODE);
  else if (PROBE_K == -2) { launch(PH_PREP, PH_ATTN, 0); launch(PH_ATTN, PH_MIX, 1); launch(PH_MIX, PH_END, 2); }
  else { int li = 0; if (PROBE_K > 0) launch(PH_PREP, PROBE_K, li++); launch(PROBE_K, PROBE_K + 1, li++, PROBE_MODE); if (PROBE_K == PH_MOE1) hipMemsetAsync((char*)d_ws + WS_CTL + 96 * 4, 0, (512 - 96) * 4, stream); launch(PROBE_K, PROBE_K + 1, li++); if (PROBE_K + 1 < PH_END) launch(PROBE_K + 1, PH_END, li++); }

}
```

```cpp
#include <hip/hip_runtime.h>
#include <hip/hip_bf16.h>
#include <stdint.h>
#include <cstdio>

typedef unsigned short us;

constexpr int D = 1024, NB = 4, S = 4096, T = NB * S;
constexpr int TOPK = 256;
constexpr float EPS = 1e-6f;
constexpr int OFF_U = 0, OFF_Q = 1024, OFF_K = 1536, OFF_V = 2048, OFF_QI = 2560, OFF_KI = 3072, OFF_WI = 3136,
              OFF_GC = 3144, OFF_GA = 4168, INC = 5192;
constexpr int NIN = 5376;
constexpr float QSCALE = 0.125f * 1.4426950408889634f;
constexpr float IDX_SCALE = 0.04419417382415922f;

__device__ __forceinline__ us f2bf_(float f) {
  unsigned u = __float_as_uint(f);
  u += 0x7FFFu + ((u >> 16) & 1u);
  return (us)(u >> 16);
}
__device__ __forceinline__ float bf2f(us h) { return __uint_as_float(((unsigned)h) << 16); }
__device__ __forceinline__ float sigmoidf_(float x) { return 1.0f / (1.0f + expf(-x)); }
__device__ __forceinline__ float fsigmoid(float x) { return __builtin_amdgcn_rcpf(1.0f + __builtin_amdgcn_exp2f(-1.4426950408889634f * x)); }

namespace pg8 {
#define PG8_LAS __attribute__((address_space(3)))
typedef unsigned short bf16_t;
typedef short bf16x8 __attribute__((ext_vector_type(8)));
typedef float f32x4 __attribute__((ext_vector_type(4)));
typedef unsigned u32x4 __attribute__((ext_vector_type(4)));
constexpr int BM = 256, BK = 64, HALF = 128, HTB = HALF * BK * 2  , STAGE_BYTES = 8 * HTB, NXCD = 8, WGM = 8;

__host__ __device__ __forceinline__ int lds_byte(int r, int c) { const int st = (r >> 4) * 2 + (c >> 5), rr = r & 15, cc = c & 31, ob = rr * 64 + cc * 2; return st * 1024 + (ob ^ (((ob >> 9) & 1) << 5)); }
__host__ __device__ __forceinline__ void stage_rc(int b, int& R, int& C) { const int st = b / 1024, sb = b % 1024, swz = sb ^ (((sb >> 9) & 1) << 5); R = (st >> 1) * 16 + swz / 64; C = (st & 1) * 32 + (swz % 64) / 2; }
__host__ __device__ __forceinline__ int perm32(int rho) { const int n = rho >> 4, i = rho & 15; return 8 * (i >> 2) + 4 * n + (i & 3); }

struct Unit { int pm, pn, sel; };
struct Gemm { const bf16_t* A; const bf16_t* Bt; int M, N, K; };

struct StaticOrder {
    int nM, nN, nwg, G, c;
    __host__ __device__ void init(int M, int N, int G_, int c_) { nM = M / BM; nN = N / BM; nwg = nM * nN; G = G_; c = c_; }
    __host__ __device__ bool next(int i, Unit& u) const {
        const long L = (long)i * G + c; if (L >= nwg) return false;
        int wgid = (int)L; { const int q = nwg / NXCD, r = nwg % NXCD, xcd = wgid % NXCD, off = wgid / NXCD; wgid = (xcd < r ? xcd * (q + 1) : r * (q + 1) + (xcd - r) * q) + off; }
        const int nig = WGM * nN, gid = wgid / nig, fm = gid * WGM, gsz = (nM - fm) < WGM ? (nM - fm) : WGM;
        u.pm = fm + ((wgid % nig) % gsz); u.pn = (wgid % nig) / gsz; u.sel = 0; return true;
    }
    __device__ __forceinline__ void a_ready(const Unit&) const {}
    __device__ __forceinline__ void done(const Unit&) const {}
};

__device__ __forceinline__ unsigned cvt_pk_bf16(float lo, float hi) { unsigned r; asm volatile("v_cvt_pk_bf16_f32 %0, %1, %2" : "=v"(r) : "v"(lo), "v"(hi)); return r; }
typedef float f32x2 __attribute__((ext_vector_type(2)));
__device__ __forceinline__ f32x2 gelu_pk(f32x2 v) {
    const f32x2 av = __builtin_elementwise_abs(v), d = av * 0.2316418882f + 1.0f;
    f32x2 t; t.x = __builtin_amdgcn_rcpf(d.x); t.y = __builtin_amdgcn_rcpf(d.y);
    f32x2 q = t * 0.5307027145f + (-0.7265760135f); q = q * t + 0.7107068705f; q = q * t + (-0.142248368f); q = q * t + 0.127414796f; q = q * t;
    const f32x2 s = (v * v) * (-0.72134752044f);
    f32x2 e; e.x = __builtin_amdgcn_exp2f(s.x); e.y = __builtin_amdgcn_exp2f(s.y);
    const f32x2 m = v * (q * e), r = v - m;
    f32x2 o; o.x = v.x < 0.f ? m.x : r.x; o.y = v.y < 0.f ? m.y : r.y; return o;
}

template <int ACT  > struct EpiBf16 {
    static constexpr bool PERM = true, AFTER_DRAIN = false, CHAIN = false; static_assert(ACT == 0 || ACT == 1, "EpiBf16: ACT is 0 (none) or 1 (gelu_pk)");
    bf16_t* O; int ldc; const float* bias; int split_cols; size_t split_stride; float scale0;
    __device__ __forceinline__ void operator()(const f32x4 (&acc)[2][2][4][2], const Unit& u, int wr, int wc, int fr, int fq) const {
        const int row0 = u.pm * BM + wr * 64 + fr; int colt = u.pn * BM; bf16_t* base = O;
        float sc = 1.f; if (split_cols) { const int t = colt / split_cols; base += (size_t)t * split_stride; colt -= t * split_cols; if (t == 0) sc = scale0; }
        const int col0 = colt + wc * 32 + 8 * fq, bcol0 = u.pn * BM + wc * 32 + 8 * fq;
        f32x4 bv[2][2];
#pragma unroll
        for (int bj = 0; bj < 2; ++bj)
#pragma unroll
            for (int n = 0; n < 2; ++n) bv[bj][n] = bias ? *(const f32x4*)(bias + bcol0 + bj * HALF + 4 * n) : (f32x4){0.f, 0.f, 0.f, 0.f};
#pragma unroll
        for (int ai = 0; ai < 2; ++ai)
#pragma unroll
            for (int m = 0; m < 4; ++m) { bf16_t* rowp = base + (size_t)(row0 + ai * HALF + m * 16) * ldc + col0;
#pragma unroll
                for (int bj = 0; bj < 2; ++bj) { f32x4 v0 = acc[ai][bj][m][0] + bv[bj][0], v1 = acc[ai][bj][m][1] + bv[bj][1];
                    if (ACT == 1) { f32x2 a = gelu_pk((f32x2){v0[0], v0[1]}), b = gelu_pk((f32x2){v0[2], v0[3]}), c = gelu_pk((f32x2){v1[0], v1[1]}), d = gelu_pk((f32x2){v1[2], v1[3]});
                        v0 = (f32x4){a.x, a.y, b.x, b.y}; v1 = (f32x4){c.x, c.y, d.x, d.y}; }
                    v0 = v0 * sc; v1 = v1 * sc; u32x4 w; w.x = cvt_pk_bf16(v0[0], v0[1]); w.y = cvt_pk_bf16(v0[2], v0[3]); w.z = cvt_pk_bf16(v1[0], v1[1]); w.w = cvt_pk_bf16(v1[2], v1[3]);
                    *(u32x4*)(rowp + bj * HALF) = w; } }
    }
};

struct PanelStats {
    unsigned* xbuf;
    unsigned* cnt;
    unsigned* tmo;
    int ntn; float eps;
    unsigned code;
    __device__ __forceinline__ bool run(const f32x4 (&v)[2][2][4][2], const Unit& u, int wr, int wc, int fr, int fq, PG8_LAS unsigned char* lds, int wid, int lane) const {
        typedef float f32x2v __attribute__((ext_vector_type(2)));
        PG8_LAS f32x2v* P = (PG8_LAS f32x2v*)lds;
        PG8_LAS f32x2v* S = (PG8_LAS f32x2v*)(lds + 8192);
        PG8_LAS unsigned* flag = (PG8_LAS unsigned*)(lds + 8192 + 2048);
#pragma unroll
        for (int ai = 0; ai < 2; ++ai)
#pragma unroll
            for (int m = 0; m < 4; ++m) {
                float s = 0.f;
#pragma unroll
                for (int bj = 0; bj < 2; ++bj)
#pragma unroll
                    for (int n = 0; n < 2; ++n) { const f32x4 x = v[ai][bj][m][n]; s += (x[0] + x[1]) + (x[2] + x[3]); }
                s += __shfl_xor(s, 16); s += __shfl_xor(s, 32);
                const float mw = s * (1.0f / 64.0f); float q = 0.f;
#pragma unroll
                for (int bj = 0; bj < 2; ++bj)
#pragma unroll
                    for (int n = 0; n < 2; ++n) { const f32x4 d = v[ai][bj][m][n] - mw; q += (d[0] * d[0] + d[1] * d[1]) + (d[2] * d[2] + d[3] * d[3]); }
                q += __shfl_xor(q, 16); q += __shfl_xor(q, 32);
                if (fq == 0) P[(ai * HALF + wr * 64 + m * 16 + fr) * 4 + wc] = (f32x2v){mw, q};
            }
        asm volatile("s_waitcnt lgkmcnt(0)" ::: "memory"); __builtin_amdgcn_s_barrier(); asm volatile("" ::: "memory");
#if defined(BROKEN_EXCHANGE_NO_WAIT)
#warning BROKEN CONTROL BUILD: the row-statistics exchange does not wait; results are wrong by design
        if (blockIdx.x >= 64) { const long long t0_ = clock64(); while (clock64() - t0_ < 60000) __builtin_amdgcn_s_sleep(8); }
#endif
        const int row = wid * 32 + (lane & 31);
        if (lane < 32) {
            const f32x2v a = P[row * 4 + 0], b = P[row * 4 + 1], c = P[row * 4 + 2], d = P[row * 4 + 3];
            const float mt = (a.x + b.x + c.x + d.x) * 0.25f;
            const float da = a.x - mt, db = b.x - mt, dc = c.x - mt, dd = d.x - mt;
            const float m2 = (a.y + b.y) + (c.y + d.y) + 64.0f * ((da * da + db * db) + (dc * dc + dd * dd));
            unsigned long long* slot = (unsigned long long*)xbuf + ((size_t)(u.pm * BM + row) * 4 + u.pn);
            __hip_atomic_store(slot, ((unsigned long long)__float_as_uint(m2) << 32) | __float_as_uint(mt), __ATOMIC_RELAXED, __HIP_MEMORY_SCOPE_AGENT);
        }
        asm volatile("s_waitcnt vmcnt(0)" ::: "memory");
        if (lane == 0) __hip_atomic_fetch_add(cnt + 64 * u.pm, 1u, __ATOMIC_RELAXED, __HIP_MEMORY_SCOPE_AGENT);
        if (wid == 0) {
            bool dead = false; const unsigned long long t0 = __builtin_amdgcn_s_memrealtime(); const unsigned want = 8u * (unsigned)ntn;
            for (;;) {
#if defined(BROKEN_EXCHANGE_NO_WAIT)
                break;
#endif
                if ((unsigned)__builtin_amdgcn_readfirstlane(__hip_atomic_load(cnt + 64 * u.pm, __ATOMIC_RELAXED, __HIP_MEMORY_SCOPE_AGENT)) >= want) break;
                if (__builtin_amdgcn_s_memrealtime() - t0 > 2000000ull) {
                    if (lane == 0) { unsigned expect = 0u; __hip_atomic_compare_exchange_strong(tmo + 1, &expect, code | (unsigned)(u.pm & 0xff), __ATOMIC_RELAXED, __ATOMIC_RELAXED, __HIP_MEMORY_SCOPE_AGENT);
                                     __hip_atomic_store(tmo, 1u, __ATOMIC_RELAXED, __HIP_MEMORY_SCOPE_AGENT); }
                    dead = true; break; }
                __builtin_amdgcn_s_sleep(2);
            }
            __builtin_amdgcn_fence(__ATOMIC_ACQUIRE, "agent");
            if (lane == 0) flag[0] = dead ? 1u : 0u;
        }
        asm volatile("s_waitcnt vmcnt(0) lgkmcnt(0)" ::: "memory"); __builtin_amdgcn_s_barrier(); asm volatile("" ::: "memory");
        const bool bad = flag[0] != 0u;
        if (lane < 32) {
            const unsigned long long* slot = (const unsigned long long*)xbuf + (size_t)(u.pm * BM + row) * 4; float mt[4], m2[4]; float ms = 0.f;
#pragma unroll
            for (int t = 0; t < 4; ++t) { if (t < ntn) { const unsigned long long w = __hip_atomic_load(slot + t, __ATOMIC_RELAXED, __HIP_MEMORY_SCOPE_AGENT); mt[t] = __uint_as_float((unsigned)w); m2[t] = __uint_as_float((unsigned)(w >> 32)); } else { mt[t] = 0.f; m2[t] = 0.f; } ms += mt[t]; }
            const float mean = ms / (float)ntn; float q = 0.f;
#pragma unroll
            for (int t = 0; t < 4; ++t) if (t < ntn) { const float dm = mt[t] - mean; q += m2[t] + 256.0f * dm * dm; }
            S[row] = (f32x2v){mean, 1.0f / sqrtf(q / (256.0f * (float)ntn) + eps)};
        }
        asm volatile("s_waitcnt lgkmcnt(0)" ::: "memory"); __builtin_amdgcn_s_barrier(); asm volatile("" ::: "memory");
        return bad;
    }
};
struct EpiLnRes {
    static constexpr bool PERM = false, AFTER_DRAIN = true, CHAIN = false;
    const float* base; float* out; int ldc; const float* bias; PanelStats st; unsigned poison;
    __device__ __forceinline__ void fused(f32x4 (&acc)[2][2][4][2], const Unit& u, int wr, int wc, int fr, int fq, PG8_LAS unsigned char* lds, int wid, int lane) const {
        typedef float f32x2v __attribute__((ext_vector_type(2)));
        const PG8_LAS f32x2v* S = (const PG8_LAS f32x2v*)(lds + 8192);
        const int col0 = u.pn * BM + wc * 32 + 4 * fq;
#pragma unroll
        for (int bj = 0; bj < 2; ++bj)
#pragma unroll
            for (int n = 0; n < 2; ++n) { const f32x4 bv = bias ? *(const f32x4*)(bias + col0 + bj * HALF + n * 16) : (f32x4){0.f, 0.f, 0.f, 0.f};
#pragma unroll
                for (int ai = 0; ai < 2; ++ai)
#pragma unroll
                    for (int m = 0; m < 4; ++m) acc[ai][bj][m][n] += bv; }
        f32x4 pre[4][2][2];
#pragma unroll
        for (int m = 0; m < 4; ++m) { const size_t off = (size_t)(u.pm * BM + wr * 64 + m * 16 + fr) * ldc + col0;
#pragma unroll
            for (int bj = 0; bj < 2; ++bj)
#pragma unroll
                for (int n = 0; n < 2; ++n) pre[m][bj][n] = *(const f32x4*)(base + off + bj * HALF + n * 16); }
        const bool bad = st.run(acc, u, wr, wc, fr, fq, lds, wid, lane) || poison != 0u;
        const float qnan = __builtin_nanf("");
#pragma unroll
        for (int ai = 0; ai < 2; ++ai)
#pragma unroll
            for (int m = 0; m < 4; ++m) { const int r = ai * HALF + wr * 64 + m * 16 + fr; const f32x2v sr = S[r]; const size_t off = (size_t)(u.pm * BM + r) * ldc + col0;
#pragma unroll
                for (int bj = 0; bj < 2; ++bj)
#pragma unroll
                    for (int n = 0; n < 2; ++n) { const f32x4 bs = ai == 0 ? pre[m][bj][n] : *(const f32x4*)(base + off + bj * HALF + n * 16); f32x4 o = bs + (acc[ai][bj][m][n] - sr.x) * sr.y;
                        if (bad) o = (f32x4){qnan, qnan, qnan, qnan}; *(f32x4*)(out + off + bj * HALF + n * 16) = o; }
                if (m & 1) asm volatile("" ::: "memory"); }
    }
};
struct EpiLnResLn {
    static constexpr bool PERM = false, AFTER_DRAIN = true, CHAIN = false;
    const float* base; float* out; bf16_t* xn; int ldc; const float* bias; PanelStats st1, st2; unsigned poison;
    __device__ __forceinline__ void fused(f32x4 (&acc)[2][2][4][2], const Unit& u, int wr, int wc, int fr, int fq, PG8_LAS unsigned char* lds, int wid, int lane) const {
        typedef float f32x2v __attribute__((ext_vector_type(2))); typedef unsigned u32x2v __attribute__((ext_vector_type(2)));
        const PG8_LAS f32x2v* S = (const PG8_LAS f32x2v*)(lds + 8192);
        const int col0 = u.pn * BM + wc * 32 + 4 * fq;
#pragma unroll
        for (int bj = 0; bj < 2; ++bj)
#pragma unroll
            for (int n = 0; n < 2; ++n) { const f32x4 bv = bias ? *(const f32x4*)(bias + col0 + bj * HALF + n * 16) : (f32x4){0.f, 0.f, 0.f, 0.f};
#pragma unroll
                for (int ai = 0; ai < 2; ++ai)
#pragma unroll
                    for (int m = 0; m < 4; ++m) acc[ai][bj][m][n] += bv; }
        bool bad = st1.run(acc, u, wr, wc, fr, fq, lds, wid, lane) || poison != 0u;
        const float qnan = __builtin_nanf("");
#pragma unroll
        for (int ai = 0; ai < 2; ++ai)
#pragma unroll
            for (int m = 0; m < 4; ++m) { const int r = ai * HALF + wr * 64 + m * 16 + fr; const f32x2v sr = S[r]; const size_t off = (size_t)(u.pm * BM + r) * ldc + col0;
#pragma unroll
                for (int bj = 0; bj < 2; ++bj)
#pragma unroll
                    for (int n = 0; n < 2; ++n) { const f32x4 bs = *(const f32x4*)(base + off + bj * HALF + n * 16); acc[ai][bj][m][n] = bs + (acc[ai][bj][m][n] - sr.x) * sr.y; }
                asm volatile("" : "+v"(acc[ai][0][m][0]), "+v"(acc[ai][0][m][1]), "+v"(acc[ai][1][m][0]), "+v"(acc[ai][1][m][1]));
                if (m & 1) asm volatile("" ::: "memory"); }
        const bool bad1 = bad;
        bad = st2.run(acc, u, wr, wc, fr, fq, lds, wid, lane) || bad;
#pragma unroll
        for (int ai = 0; ai < 2; ++ai)
#pragma unroll
            for (int m = 0; m < 4; ++m) { const int r = ai * HALF + wr * 64 + m * 16 + fr; const f32x2v sr = S[r]; const size_t off = (size_t)(u.pm * BM + r) * ldc + col0;
#pragma unroll
                for (int bj = 0; bj < 2; ++bj)
#pragma unroll
                    for (int n = 0; n < 2; ++n) { const f32x4 x1 = acc[ai][bj][m][n]; *(f32x4*)(out + off + bj * HALF + n * 16) = bad1 ? (f32x4){qnan, qnan, qnan, qnan} : x1;
                        const f32x4 o = (x1 - sr.x) * sr.y; u32x2v w; w.x = cvt_pk_bf16(o[0], o[1]); w.y = cvt_pk_bf16(o[2], o[3]);
                        if (bad) { w.x = 0x7fc07fc0u; w.y = 0x7fc07fc0u; } *(u32x2v*)(xn + off + bj * HALF + n * 16) = w; }
                asm volatile("" ::: "memory"); }
    }
};

template <class Epi, class Sched, bool ALIGN_EPI = false, bool SP2 = false>
__device__ __forceinline__ void gemm_phase(PG8_LAS unsigned char* lds, const Gemm g, const Sched& S, const Epi& E, const Gemm g1 = Gemm{nullptr, nullptr, 0, 0, 0}) {
    const int tid = threadIdx.x, wid = __builtin_amdgcn_readfirstlane(tid >> 6), lane = tid & 63, wr = wid >> 2, wc = wid & 3, fr = lane & 15, fq = lane >> 4;
    const int K = g.K, nt = K / BK;
    unsigned voffA[2], voffB[2];
#pragma unroll
    for (int i = 0; i < 2; ++i) { int R, C; stage_rc(tid * 16 + i * 8192, R, C); const int Rb = Epi::PERM ? ((R & ~31) + perm32(R & 31)) : R;
        voffA[i] = (unsigned)(R * K + C) * 2u; voffB[i] = (unsigned)(Rb * K + C) * 2u; }
    const size_t kstep = (size_t)(BK * 2);
    const size_t hstep = (size_t)HALF * K * 2;
    const size_t tstep = 2 * hstep;
    const unsigned ldsw = (unsigned)wid * 1024u;
    const int aoff = lds_byte(wr * 64 + fr, fq * 8), boff = lds_byte(wc * 32 + fr, fq * 8);
#define PG8_SA(b, h) (((b) * 2 + (h)) * HTB)
#define PG8_SB(b, h) ((4 + (b) * 2 + (h)) * HTB)
#define PG8_STAGE(bufoff, gbase, voff) do { _Pragma("unroll") for (int _i = 0; _i < 2; ++_i) \
        __builtin_amdgcn_global_load_lds((const unsigned*)((const char*)(gbase) + (voff)[_i]), (PG8_LAS unsigned*)(lds + (bufoff) + ldsw + _i * 8192), 16, 0, 0); } while (0)
#define PG8_LDA(dst, b, h) do { _Pragma("unroll") for (int m = 0; m < 4; ++m) _Pragma("unroll") for (int k = 0; k < 2; ++k) dst[m][k] = *(const PG8_LAS bf16x8*)(lds + PG8_SA(b, h) + aoff + m * 2048 + k * 1024); } while (0)
#define PG8_LDB(dst, b, h) do { _Pragma("unroll") for (int n = 0; n < 2; ++n) _Pragma("unroll") for (int k = 0; k < 2; ++k) dst[n][k] = *(const PG8_LAS bf16x8*)(lds + PG8_SB(b, h) + boff + n * 2048 + k * 1024); } while (0)
#define PG8_MMA(ai, bj, At, Bt) do { __builtin_amdgcn_s_setprio(1); _Pragma("unroll") for (int m = 0; m < 4; ++m) _Pragma("unroll") for (int n = 0; n < 2; ++n) _Pragma("unroll") for (int k = 0; k < 2; ++k) \
        acc[ai][bj][m][n] = __builtin_amdgcn_mfma_f32_16x16x32_bf16(Bt[n][k], At[m][k], acc[ai][bj][m][n], 0, 0, 0); __builtin_amdgcn_s_setprio(0); } while (0)
#define PG8_WAIT_V(n) asm volatile("s_waitcnt vmcnt(" #n ")" ::: "memory")
#define PG8_WAIT_L(n) asm volatile("s_waitcnt lgkmcnt(" #n ")" ::: "memory")
#define PG8_BAR __builtin_amdgcn_s_barrier()
#define PG8_SCHED __builtin_amdgcn_sched_barrier(0)
    Unit cur, nxt; int ui = 0;
    if (!S.next(0, cur)) return;
    f32x4 acc[2][2][4][2];
#pragma unroll
    for (int a = 0; a < 2; ++a)
#pragma unroll
        for (int b = 0; b < 2; ++b)
#pragma unroll
            for (int m = 0; m < 4; ++m)
#pragma unroll
                for (int n = 0; n < 2; ++n) acc[a][b][m][n] = (f32x4){0.f, 0.f, 0.f, 0.f};
    bf16x8 At[4][2], B0[2][2], B1[2][2];
    const char* cA = (const char*)(cur.sel ? g1.A : g.A) + (size_t)cur.pm * tstep; const char* cB = (const char*)(cur.sel ? g1.Bt : g.Bt) + (size_t)cur.pn * tstep;
    S.a_ready(cur);
    if constexpr (SP2) {
        PG8_STAGE(PG8_SB(0, 0), cB, voffB); PG8_STAGE(PG8_SB(0, 1), cB + hstep, voffB); PG8_STAGE(PG8_SA(0, 0), cA, voffA); PG8_STAGE(PG8_SA(0, 1), cA + hstep, voffA);
        if (wr == 1) PG8_BAR;
        PG8_WAIT_V(2); PG8_BAR;
        PG8_STAGE(PG8_SB(1, 0), cB + kstep, voffB); PG8_STAGE(PG8_SA(1, 0), cA + kstep, voffA); PG8_STAGE(PG8_SB(1, 1), cB + hstep + kstep, voffB);
        PG8_WAIT_V(6); PG8_BAR;
    } else {
        PG8_STAGE(PG8_SB(0, 0), cB, voffB); PG8_STAGE(PG8_SA(0, 0), cA, voffA); PG8_STAGE(PG8_SB(0, 1), cB + hstep, voffB); PG8_STAGE(PG8_SA(0, 1), cA + hstep, voffA);
        if (wr == 1) PG8_BAR;
        PG8_WAIT_V(4); PG8_BAR;
        PG8_STAGE(PG8_SB(1, 0), cB + kstep, voffB); PG8_STAGE(PG8_SA(1, 0), cA + kstep, voffA); PG8_STAGE(PG8_SB(1, 1), cB + hstep + kstep, voffB);
        PG8_WAIT_V(6); PG8_BAR;
    }
    for (;;) {
        const bool has_next = S.next(ui + 1, nxt);
        const char* nA = has_next ? (const char*)(nxt.sel ? g1.A : g.A) + (size_t)nxt.pm * tstep : cA; const char* nB = has_next ? (const char*)(nxt.sel ? g1.Bt : g.Bt) + (size_t)nxt.pn * tstep : cB;
        for (int t = 0; t < nt; t += 2) {
            const bool last = (t == nt - 2);
            const char* a1 = cA + (size_t)(t + 1) * kstep;
            const char* a2 = last ? nA : cA + (size_t)(t + 2) * kstep; const char* b2 = last ? nB : cB + (size_t)(t + 2) * kstep;
            const char* a3 = a2 + kstep; const char* b3 = b2 + kstep;
            if (last && has_next) S.a_ready(nxt);
            if constexpr (SP2) {
            PG8_LDB(B0, 0, 0); PG8_LDB(B1, 0, 1); PG8_SCHED; PG8_LDA(At, 0, 0); PG8_STAGE(PG8_SA(1, 1), a1 + hstep, voffA);
            PG8_WAIT_V(8); PG8_WAIT_L(0); PG8_BAR; PG8_MMA(0, 0, At, B0); PG8_MMA(0, 1, At, B1); PG8_BAR; PG8_SCHED;
            PG8_LDA(At, 0, 1); PG8_STAGE(PG8_SB(0, 0), b2, voffB); PG8_STAGE(PG8_SB(0, 1), b2 + hstep, voffB); PG8_STAGE(PG8_SA(0, 0), a2, voffA);
            PG8_WAIT_V(8); PG8_WAIT_L(0); PG8_BAR; PG8_MMA(1, 0, At, B0); PG8_MMA(1, 1, At, B1); PG8_BAR; PG8_SCHED;
            PG8_LDB(B0, 1, 0); PG8_LDB(B1, 1, 1); PG8_SCHED; PG8_LDA(At, 1, 0); PG8_STAGE(PG8_SA(0, 1), a2 + hstep, voffA);
            PG8_WAIT_V(8); PG8_WAIT_L(0); PG8_BAR; PG8_MMA(0, 0, At, B0); PG8_MMA(0, 1, At, B1); PG8_BAR; PG8_SCHED;
            PG8_LDA(At, 1, 1); PG8_STAGE(PG8_SB(1, 0), b3, voffB); PG8_STAGE(PG8_SB(1, 1), b3 + hstep, voffB); PG8_STAGE(PG8_SA(1, 0), a3, voffA);
            PG8_WAIT_V(8); PG8_WAIT_L(0); PG8_BAR; PG8_MMA(1, 0, At, B0); PG8_MMA(1, 1, At, B1); PG8_BAR; PG8_SCHED;
            } else {
            PG8_LDB(B0, 0, 0); PG8_SCHED; PG8_LDA(At, 0, 0); PG8_STAGE(PG8_SA(1, 1), a1 + hstep, voffA);
            PG8_WAIT_L(8); PG8_BAR; PG8_WAIT_L(0); PG8_MMA(0, 0, At, B0); PG8_BAR; PG8_SCHED;
            PG8_LDB(B1, 0, 1); PG8_STAGE(PG8_SB(0, 0), b2, voffB);
            PG8_BAR; PG8_WAIT_L(0); PG8_MMA(0, 1, At, B1); PG8_BAR;
            PG8_LDA(At, 0, 1); PG8_STAGE(PG8_SA(0, 0), a2, voffA);
            PG8_BAR; PG8_WAIT_L(0); PG8_MMA(1, 0, At, B0); PG8_BAR; PG8_SCHED;
            PG8_STAGE(PG8_SB(0, 1), b2 + hstep, voffB);
            PG8_WAIT_V(6); PG8_BAR; PG8_MMA(1, 1, At, B1); PG8_BAR;
            PG8_LDB(B0, 1, 0); PG8_SCHED; PG8_LDA(At, 1, 0); PG8_STAGE(PG8_SA(0, 1), a2 + hstep, voffA);
            PG8_WAIT_L(8); PG8_BAR; PG8_WAIT_L(0); PG8_MMA(0, 0, At, B0); PG8_BAR; PG8_SCHED;
            PG8_LDB(B1, 1, 1); PG8_STAGE(PG8_SB(1, 0), b3, voffB);
            PG8_BAR; PG8_WAIT_L(0); PG8_MMA(0, 1, At, B1); PG8_BAR;
            PG8_LDA(At, 1, 1); PG8_STAGE(PG8_SA(1, 0), a3, voffA);
            PG8_BAR; PG8_WAIT_L(0); PG8_MMA(1, 0, At, B0); PG8_BAR; PG8_SCHED;
            PG8_STAGE(PG8_SB(1, 1), b3 + hstep, voffB);
            PG8_WAIT_V(6); PG8_BAR; PG8_MMA(1, 1, At, B1); PG8_BAR;
            }
        }
        if constexpr (ALIGN_EPI) { if (wr == 0) PG8_BAR; }
        bool keep_acc = false;
        if constexpr (Epi::CHAIN) { keep_acc = E.chain(acc, cur, wr, wc, fr, fq); }
        if constexpr (!Epi::AFTER_DRAIN) { if (!keep_acc) { E(acc, cur, wr, wc, fr, fq); } S.done(cur); }
        if (!has_next) break;
        if (!keep_acc) {
#pragma unroll
        for (int a = 0; a < 2; ++a)
#pragma unroll
            for (int b = 0; b < 2; ++b)
#pragma unroll
                for (int m = 0; m < 4; ++m)
#pragma unroll
                    for (int n = 0; n < 2; ++n) acc[a][b][m][n] = (f32x4){0.f, 0.f, 0.f, 0.f};
        }
        cur = nxt; cA = nA; cB = nB; ++ui;
        if constexpr (ALIGN_EPI) { if (wr == 1) PG8_BAR; }
    }
    PG8_WAIT_V(0);
    if constexpr (!ALIGN_EPI) { if (wr == 0) PG8_BAR; }
    PG8_BAR;
    if constexpr (Epi::AFTER_DRAIN) { E.fused(acc, cur, wr, wc, fr, fq, lds, wid, lane); S.done(cur); }
#undef PG8_SA
#undef PG8_SB
#undef PG8_STAGE
#undef PG8_LDA
#undef PG8_LDB
#undef PG8_MMA
#undef PG8_WAIT_V
#undef PG8_WAIT_L
#undef PG8_BAR
#undef PG8_SCHED
}
}

#define GAS __attribute__((address_space(1)))
#define LAS __attribute__((address_space(3)))
typedef unsigned v4u __attribute__((ext_vector_type(4)));
typedef float f32x4 __attribute__((ext_vector_type(4)));
typedef short bf16x8 __attribute__((ext_vector_type(8)));
typedef GAS unsigned gu32;
typedef GAS unsigned long long gu64;
#define RLX_AGENT __ATOMIC_RELAXED, __HIP_MEMORY_SCOPE_AGENT
#define LDS_WAIT() asm volatile("s_waitcnt lgkmcnt(0)" ::: "memory")
#define VM_WAIT() asm volatile("s_waitcnt vmcnt(0)" ::: "memory")
__device__ __forceinline__ unsigned f2bf(float f) { unsigned u = __builtin_bit_cast(unsigned, f); return (u + 0x7fffu + ((u >> 16) & 1u)) >> 16; }
__device__ __forceinline__ unsigned pk2(float lo, float hi) { return f2bf(lo) | (f2bf(hi) << 16); }
__device__ __forceinline__ float wave_sum(float v) {
#pragma unroll
  for (int o = 1; o < 64; o <<= 1) v += __shfl_xor(v, o);
  return v;
}
__device__ __forceinline__ float wave_sum_dpp(float v) {
  v += __builtin_bit_cast(float, __builtin_amdgcn_update_dpp(0, __builtin_bit_cast(int, v), 0xB1, 0xF, 0xF, true));
  v += __builtin_bit_cast(float, __builtin_amdgcn_update_dpp(0, __builtin_bit_cast(int, v), 0x4E, 0xF, 0xF, true));
  v += __builtin_bit_cast(float, __builtin_amdgcn_update_dpp(0, __builtin_bit_cast(int, v), 0x141, 0xF, 0xF, true));
  v += __builtin_bit_cast(float, __builtin_amdgcn_update_dpp(0, __builtin_bit_cast(int, v), 0x140, 0xF, 0xF, true));
  v += __builtin_bit_cast(float, __builtin_amdgcn_update_dpp(0, __builtin_bit_cast(int, v), 0x142, 0xA, 0xF, true));
  v += __builtin_bit_cast(float, __builtin_amdgcn_update_dpp(0, __builtin_bit_cast(int, v), 0x143, 0xC, 0xF, true));
  return __builtin_bit_cast(float, __builtin_amdgcn_readlane(__builtin_bit_cast(int, v), 63));
}

#define XB_TMO      128
#define XB_XCNT(j)  (256  + 64 * (j))
#define XB_XSUB(j)  (1280 + 64 * (j))
#define XB_XGEN(j)  (2304 + 64 * (j))
#define XB_TOP      3328
#define XB_TOPGEN   3392
#define XCD_BAR_WORDS 3456
#define XB_SPIN_CAP (1u << 18)

__device__ __forceinline__ unsigned xb_ld(unsigned* p)              { return __hip_atomic_load(p, __ATOMIC_RELAXED, __HIP_MEMORY_SCOPE_AGENT); }
__device__ __forceinline__ unsigned xb_add(unsigned* p, unsigned v) { return __hip_atomic_fetch_add(p, v, __ATOMIC_RELAXED, __HIP_MEMORY_SCOPE_AGENT); }
__device__ __forceinline__ unsigned xb_xcc_id() { return (unsigned)__builtin_amdgcn_s_getreg((3 << 11) | 20) & 0xFu; }
#define XB_SPIN(cond, bar) do { unsigned _sp = 0; while (cond) { __builtin_amdgcn_s_sleep(1); \
    if ((++_sp & 255u) == 0u) { if (xb_ld(&(bar)[XB_TMO])) break; if (_sp > XB_SPIN_CAP) { atomicAdd(&(bar)[XB_TMO], 1u); break; } } } } while (0)

struct XcdBarrier {
    unsigned* bar; unsigned x;
    volatile LAS unsigned* st;
};

__device__ __forceinline__ XcdBarrier xcd_barrier_post(unsigned* bar, volatile LAS unsigned* st) {
    XcdBarrier b; b.bar = bar; b.x = xb_xcc_id(); b.st = st;
    if (threadIdx.x == 0) (void)xb_add(&bar[XB_XCNT(b.x)], 1u);
    return b;
}
__device__ __forceinline__ void xcd_barrier_complete(unsigned* bar, unsigned x, unsigned& nloc, unsigned& nx) {
    const unsigned G = gridDim.x * gridDim.y * gridDim.z;
    unsigned sum, cnt, mine, sp = 0u;
    for (;;) {
        sum = 0u; cnt = 0u; mine = 0u;
#pragma unroll
        for (unsigned j = 0; j < 16; ++j) { const unsigned c = xb_ld(&bar[XB_XCNT(j)]); sum += c; cnt += (c > 0u) ? 1u : 0u; mine = (j == x) ? c : mine; }
        if (sum == G) break;
        __builtin_amdgcn_s_sleep(1);
        if ((++sp & 255u) == 0u) { if (xb_ld(&bar[XB_TMO])) break; if (sp > XB_SPIN_CAP) { atomicAdd(&bar[XB_TMO], 1u); break; } }
    }
    nloc = mine > 0u ? mine : 1u; nx = cnt > 0u ? cnt : 1u;
}

__device__ __forceinline__ void xcd_barrier(const XcdBarrier& b) {
    asm volatile("s_waitcnt vmcnt(0)" ::: "memory");
    __syncthreads();
    if (threadIdx.x == 0) {
        unsigned* bar = b.bar;
        __builtin_amdgcn_s_waitcnt(0);
        unsigned nloc = b.st[0], nx = b.st[1];
        if (nloc == 0u) { xcd_barrier_complete(bar, b.x, nloc, nx); b.st[0] = nloc; b.st[1] = nx; }
        const unsigned old = xb_add(&bar[XB_XSUB(b.x)], 1u);
        const unsigned gen = old / nloc;
        if (old + 1u == (gen + 1u) * nloc) {
            __builtin_amdgcn_fence(__ATOMIC_RELEASE, "agent");
            asm volatile("s_waitcnt vmcnt(0)" ::: "memory");
            const unsigned og = xb_add(&bar[XB_TOP], 1u);
            const unsigned tg = og / nx;
            if (og + 1u == (tg + 1u) * nx) xb_add(&bar[XB_TOPGEN], 1u);
            else XB_SPIN(xb_ld(&bar[XB_TOPGEN]) == tg, bar);
            __builtin_amdgcn_fence(__ATOMIC_ACQUIRE, "agent");
            xb_add(&bar[XB_XGEN(b.x)], 1u);
            asm volatile("s_waitcnt vmcnt(0)" ::: "memory");
        } else {
            XB_SPIN(xb_ld(&bar[XB_XGEN(b.x)]) == gen, bar);
            __builtin_amdgcn_fence(__ATOMIC_ACQUIRE, "agent");
            asm volatile("s_waitcnt vmcnt(0)" ::: "memory");
        }
    }
    __syncthreads();
}


namespace sg {
typedef float f32x16 __attribute__((ext_vector_type(16)));
constexpr int BM = 128, BN = 256, BK = 64, RS = 144;
constexpr int A_BYTES = BM * RS;
__device__ __forceinline__ int crow(int r, int hi) { return (r & 3) + 8 * (r >> 2) + 4 * hi; }
template <class Epi>
__device__ __forceinline__ void tile(LAS unsigned char* lds, const us* const (&ap)[2], const us* bf0, const us* bf1, int K, const Epi& E, int tid) {
  const int lane = tid & 63, wave = __builtin_amdgcn_readfirstlane(tid >> 6), wm = wave >> 2, wn = wave & 3;
  const int r32 = lane & 31, hi = lane >> 5;
  f32x16 acc[2][2];
#pragma unroll
  for (int a = 0; a < 2; ++a)
#pragma unroll
    for (int b = 0; b < 2; ++b)
#pragma unroll
      for (int r = 0; r < 16; ++r) acc[a][b][r] = 0.f;
  v4u ra0[2], ra1[2];
  bf16x8 bq[2][4];
  unsigned wa[2];
#pragma unroll
  for (int i = 0; i < 2; ++i) { const int c = tid + 512 * i; wa[i] = (unsigned)((c >> 3) * RS + (c & 7) * 16); }
  const unsigned aoff = (unsigned)((wm * 64 + r32) * RS + hi * 16);
  const int nk = K / BK;
#define SG_LOADA(RA, kt_) do { const int kc_ = (kt_) < nk ? (kt_) : nk - 1; \
    _Pragma("unroll") for (int i = 0; i < 2; ++i) RA[i] = *(const v4u*)(ap[i] + kc_ * BK); } while (0)
#define SG_LOADB1(ks, kt_) do { const int kc_ = (kt_) < nk ? (kt_) : nk - 1; \
    bq[0][ks] = *(const bf16x8*)(bf0 + (size_t)(kc_ * 4 + (ks)) * 512); bq[1][ks] = *(const bf16x8*)(bf1 + (size_t)(kc_ * 4 + (ks)) * 512); } while (0)
#define SG_WRITEA(RA, bufoff) do { \
    _Pragma("unroll") for (int i = 0; i < 2; ++i) *(LAS v4u*)(lds + (bufoff) + wa[i]) = RA[i]; } while (0)
#define SG_COMPUTE(bufoff, ktn_) do { \
    _Pragma("unroll") for (int ks = 0; ks < 4; ++ks) { \
      bf16x8 af[2]; \
      _Pragma("unroll") for (int m = 0; m < 2; ++m) af[m] = *(const LAS bf16x8*)(lds + (bufoff) + aoff + m * 32 * RS + ks * 32); \
      _Pragma("unroll") for (int h = 0; h < 2; ++h) \
        _Pragma("unroll") for (int m = 0; m < 2; ++m) acc[h][m] = __builtin_amdgcn_mfma_f32_32x32x16_bf16(bq[h][ks], af[m], acc[h][m], 0, 0, 0); \
      SG_LOADB1(ks, ktn_); } } while (0)
  SG_LOADA(ra0, 0);
#pragma unroll
  for (int ks = 0; ks < 4; ++ks) SG_LOADB1(ks, 0);
  SG_LOADA(ra1, 1);
  SG_WRITEA(ra0, 0);
  __syncthreads();
  for (int kt = 0; kt < nk; kt += 2) {
    SG_LOADA(ra0, kt + 2);
    SG_COMPUTE(0, kt + 1);
    SG_WRITEA(ra1, A_BYTES);
    __syncthreads();
    SG_LOADA(ra1, kt + 3);
    SG_COMPUTE(A_BYTES, kt + 2);
    SG_WRITEA(ra0, 0);
    __syncthreads();
  }
#undef SG_LOADA
#undef SG_LOADB1
#undef SG_WRITEA
#undef SG_COMPUTE
  E(acc, wm, wn, r32, hi);
}
template <class Epi>
__device__ __forceinline__ void tile_wide(LAS unsigned char* lds, const us* const (&ap)[2], const us* bf0, const us* bf1, int K, const Epi& E, int tid) {
  const int lane = tid & 63, wave = __builtin_amdgcn_readfirstlane(tid >> 6);
  const int r32 = lane & 31, hi = lane >> 5;
  f32x16 acc[2][4];
#pragma unroll
  for (int a = 0; a < 2; ++a)
#pragma unroll
    for (int b = 0; b < 4; ++b)
#pragma unroll
      for (int r = 0; r < 16; ++r) acc[a][b][r] = 0.f;
  v4u ra0[2];
  bf16x8 bq[2][4];
  unsigned wa[2];
#pragma unroll
  for (int i = 0; i < 2; ++i) { const int c = tid + 512 * i; wa[i] = (unsigned)((c >> 3) * RS + (c & 7) * 16); }
  const unsigned aoff = (unsigned)(r32 * RS + hi * 16);
  const int nk = K / BK;
#define SGW_LOADA(RA, kt_) do { const int kc_ = (kt_) < nk ? (kt_) : nk - 1; \
    _Pragma("unroll") for (int i = 0; i < 2; ++i) RA[i] = *(const v4u*)(ap[i] + kc_ * BK); } while (0)
#define SGW_LOADB1(ks, kt_) do { const int kc_ = (kt_) < nk ? (kt_) : nk - 1; \
    bq[0][ks] = *(const bf16x8*)(bf0 + (size_t)(kc_ * 4 + (ks)) * 512); bq[1][ks] = *(const bf16x8*)(bf1 + (size_t)(kc_ * 4 + (ks)) * 512); } while (0)
#define SGW_WRITEA(RA, bufoff) do { \
    _Pragma("unroll") for (int i = 0; i < 2; ++i) *(LAS v4u*)(lds + (bufoff) + wa[i]) = RA[i]; } while (0)
#define SGW_LDA(dst, bufoff, ks) do { _Pragma("unroll") for (int m = 0; m < 4; ++m) dst[m] = *(const LAS bf16x8*)(lds + (bufoff) + aoff + m * 32 * RS + (ks) * 32); } while (0)
#define SGW_MMA(afr, ks, ktn_) do { \
      _Pragma("unroll") for (int h = 0; h < 2; ++h) \
        _Pragma("unroll") for (int m = 0; m < 4; ++m) acc[h][m] = __builtin_amdgcn_mfma_f32_32x32x16_bf16(bq[h][ks], afr[m], acc[h][m], 0, 0, 0); \
      SGW_LOADB1(ks, ktn_); __builtin_amdgcn_sched_barrier(0); } while (0)
#define SGW_COMPUTE(bufoff, ktn_) do { bf16x8 afA[4], afB[4]; \
    SGW_LDA(afA, bufoff, 0); \
    SGW_LDA(afB, bufoff, 1); SGW_MMA(afA, 0, ktn_); \
    SGW_LDA(afA, bufoff, 2); SGW_MMA(afB, 1, ktn_); \
    SGW_LDA(afB, bufoff, 3); SGW_MMA(afA, 2, ktn_); \
    SGW_MMA(afB, 3, ktn_); } while (0)
  SGW_LOADA(ra0, 0);
#pragma unroll
  for (int ks = 0; ks < 4; ++ks) SGW_LOADB1(ks, 0);
  SGW_WRITEA(ra0, 0);
  __syncthreads();
  for (int kt = 0; kt < nk; kt += 2) {
    SGW_LOADA(ra0, kt + 1); __builtin_amdgcn_sched_barrier(0);
    SGW_COMPUTE(0, kt + 1);
    SGW_WRITEA(ra0, A_BYTES);
    __syncthreads();
    SGW_LOADA(ra0, kt + 2); __builtin_amdgcn_sched_barrier(0);
    SGW_COMPUTE(A_BYTES, kt + 2);
    SGW_WRITEA(ra0, 0);
    __syncthreads();
  }
#undef SGW_LOADA
#undef SGW_LOADB1
#undef SGW_WRITEA
#undef SGW_COMPUTE
#undef SGW_LDA
#undef SGW_MMA
  E(acc, wave, r32, hi);
}
constexpr int ARS = 528;
template <class Epi>
__device__ __forceinline__ void tile_resident(LAS unsigned char* lds, const us* bf0, const us* bf1, const Epi& E, int tid) {
  const int lane = tid & 63, wave = __builtin_amdgcn_readfirstlane(tid >> 6), wm = wave >> 2, wn = wave & 3;
  const int r32 = lane & 31, hi = lane >> 5;
  f32x16 acc[2][2];
#pragma unroll
  for (int a = 0; a < 2; ++a)
#pragma unroll
    for (int b = 0; b < 2; ++b)
#pragma unroll
      for (int r = 0; r < 16; ++r) acc[a][b][r] = 0.f;
  bf16x8 bq[2][4];
  const unsigned aoff = (unsigned)((wm * 64 + r32) * ARS + hi * 16);
#define SGR_LOADB1(ks, kc_) do { bq[0][ks] = *(const bf16x8*)(bf0 + (size_t)((kc_) * 4 + (ks)) * 512); bq[1][ks] = *(const bf16x8*)(bf1 + (size_t)((kc_) * 4 + (ks)) * 512); } while (0)
#pragma unroll
  for (int ks = 0; ks < 4; ++ks) SGR_LOADB1(ks, 0);
  bf16x8 afA[2], afB[2];
#define SGR_LDA(dst, st_) do { _Pragma("unroll") for (int m = 0; m < 2; ++m) dst[m] = *(const LAS bf16x8*)(lds + aoff + m * 32 * ARS + (st_) * 32); } while (0)
#define SGR_MMA(afr, st_) do { \
      _Pragma("unroll") for (int h = 0; h < 2; ++h) \
        _Pragma("unroll") for (int m = 0; m < 2; ++m) acc[h][m] = __builtin_amdgcn_mfma_f32_32x32x16_bf16(bq[h][(st_) & 3], afr[m], acc[h][m], 0, 0, 0); \
      if ((st_) < 12) SGR_LOADB1((st_) & 3, ((st_) >> 2) + 1); \
      __builtin_amdgcn_sched_barrier(0); } while (0)
  SGR_LDA(afA, 0);
#pragma unroll
  for (int st = 0; st < 16; st += 2) {
    SGR_LDA(afB, st + 1); SGR_MMA(afA, st);
    if (st + 2 < 16) SGR_LDA(afA, st + 2);
    SGR_MMA(afB, st + 1);
  }
#undef SGR_LDA
#undef SGR_MMA
#undef SGR_LOADB1
  E(acc, wm, wn, r32, hi);
}
}

constexpr size_t MiB = 1u << 20;
constexpr size_t WS_CTL = 0, CTL_ZERO_BYTES = 64 * 1024;
constexpr int CW_BAR = 1024;
constexpr size_t WS_WIN = 1 * MiB;
constexpr size_t WS_WCO = 12 * MiB;
constexpr size_t WS_WAO = 13 * MiB;
constexpr size_t WS_WO = 14 * MiB;
constexpr size_t WS_CT = 16 * MiB, WS_ST = 18 * MiB;
constexpr size_t WS_KI = 20 * MiB;
constexpr size_t WS_WI = 22 * MiB;
constexpr size_t WS_HB = 24 * MiB;
constexpr size_t WS_G = 56 * MiB;
constexpr size_t WS_QI = 72 * MiB, WS_K = 88 * MiB, WS_V = 104 * MiB, WS_Q = 120 * MiB;
constexpr size_t WS_GC = 136 * MiB, WS_GA = 168 * MiB;
constexpr size_t WS_NA = 200 * MiB, WS_AO = 216 * MiB;
constexpr size_t WS_M1 = 56 * MiB;
constexpr int CW_ATTN = 512;
constexpr size_t WS_Y1 = 88 * MiB;
constexpr size_t WS_X1B = 168 * MiB;
constexpr size_t WS_END = 232 * MiB;

constexpr int LDS_BYTES = 147456;
constexpr int MISC_OFF = LDS_BYTES - 256;

constexpr bool AMP_ON = false;
struct Args {
  const float* in[20];
  float* out;
  unsigned char* ws;
  int ph_lo, ph_hi, li, dup;
};
enum { PH_PREP = 0, PH_INPROJ = 1, PH_CONV = 2, PH_TOPK = 3, PH_ATTN = 4, PH_MIX = 5, PH_WO = 6, PH_ROUTE = 7, PH_MOE1 = 8, PH_MOE2 = 9, PH_FINAL = 10, PH_END = 11 };

constexpr int CW_M1 = 576, CW_X1 = 640;
template <bool ACCUM> struct EpiGate {
  static constexpr bool PERM = true, AFTER_DRAIN = false, CHAIN = false;
  const us* gate; us* M1;
  __device__ __forceinline__ void operator()(const pg8::f32x4 (&acc)[2][2][4][2], const pg8::Unit& u, int wr, int wc, int fr, int fq) const {
    const int row0 = u.pm * 256 + wr * 64 + fr, col0 = u.pn * 256 + wc * 32 + 8 * fq;
#pragma unroll
    for (int ai = 0; ai < 2; ++ai)
#pragma unroll
      for (int mh = 0; mh < 2; ++mh) {
        v4u gw[2][2], pw[2][2];
#pragma unroll
        for (int mm = 0; mm < 2; ++mm)
#pragma unroll
          for (int bj = 0; bj < 2; ++bj) {
            const size_t off = (size_t)(row0 + ai * 128 + (2 * mh + mm) * 16) * 1024 + col0 + bj * 128;
            gw[mm][bj] = *(const v4u*)(gate + off);
            if (ACCUM) pw[mm][bj] = *(const v4u*)(M1 + off);
          }
        __builtin_amdgcn_sched_barrier(0);
#pragma unroll
        for (int mm = 0; mm < 2; ++mm)
#pragma unroll
          for (int bj = 0; bj < 2; ++bj) {
            const int m = 2 * mh + mm;
            const size_t off = (size_t)(row0 + ai * 128 + m * 16) * 1024 + col0 + bj * 128;
            const v4u g = gw[mm][bj];
            const f32x4 v0 = acc[ai][bj][m][0], v1 = acc[ai][bj][m][1];
            float o[8];
            o[0] = __uint_as_float(g.x << 16) * v0[0]; o[1] = __uint_as_float(g.x & 0xffff0000u) * v0[1];
            o[2] = __uint_as_float(g.y << 16) * v0[2]; o[3] = __uint_as_float(g.y & 0xffff0000u) * v0[3];
            o[4] = __uint_as_float(g.z << 16) * v1[0]; o[5] = __uint_as_float(g.z & 0xffff0000u) * v1[1];
            o[6] = __uint_as_float(g.w << 16) * v1[2]; o[7] = __uint_as_float(g.w & 0xffff0000u) * v1[3];
            if (ACCUM) {
              const v4u p = pw[mm][bj];
              o[0] += __uint_as_float(p.x << 16); o[1] += __uint_as_float(p.x & 0xffff0000u);
              o[2] += __uint_as_float(p.y << 16); o[3] += __uint_as_float(p.y & 0xffff0000u);
              o[4] += __uint_as_float(p.z << 16); o[5] += __uint_as_float(p.z & 0xffff0000u);
              o[6] += __uint_as_float(p.w << 16); o[7] += __uint_as_float(p.w & 0xffff0000u);
            }
            v4u w; w.x = pk2(o[0], o[1]); w.y = pk2(o[2], o[3]); w.z = pk2(o[4], o[5]); w.w = pk2(o[6], o[7]);
            *(v4u*)(M1 + off) = w;
          }
        __builtin_amdgcn_sched_barrier(0);
      }
  }
};
struct DualOrder : pg8::StaticOrder {
  const unsigned* ready;
  __device__ bool next(int i, pg8::Unit& u) const { if (i >= 2) return false; const bool ok = pg8::StaticOrder::next(0, u); u.sel = i; return ok; }
  __device__ __forceinline__ void a_ready(const pg8::Unit& u) const {
    if (u.sel == 0) return;
    if (threadIdx.x < 64) {
      unsigned sp = 0;
      while ((unsigned)__builtin_amdgcn_readfirstlane(__hip_atomic_load(ready + u.pm, __ATOMIC_RELAXED, __HIP_MEMORY_SCOPE_AGENT)) < 8u) { __builtin_amdgcn_s_sleep(2); if (++sp > (1u << 22)) break; }
      __builtin_amdgcn_fence(__ATOMIC_ACQUIRE, "agent");
      asm volatile("s_waitcnt vmcnt(0)" ::: "memory");
    }
    asm volatile("" ::: "memory"); __builtin_amdgcn_s_barrier(); asm volatile("" ::: "memory");
  }
};
struct EpiGate2 {
  static constexpr bool PERM = true, AFTER_DRAIN = false, CHAIN = true;
  const us *gc, *ga; us* M1;
  __device__ __forceinline__ bool chain(pg8::f32x4 (&acc)[2][2][4][2], const pg8::Unit& u, int wr, int wc, int fr, int fq) const {
    if (u.sel != 0) return false;
    const int row0 = u.pm * 256 + wr * 64 + fr, col0 = u.pn * 256 + wc * 32 + 8 * fq;
#pragma unroll
    for (int ai = 0; ai < 2; ++ai)
#pragma unroll
      for (int mh = 0; mh < 2; ++mh) {
        v4u gw[2][2], hw[2][2];
#pragma unroll
        for (int mm = 0; mm < 2; ++mm)
#pragma unroll
          for (int bj = 0; bj < 2; ++bj) {
            const size_t off = (size_t)(row0 + ai * 128 + (2 * mh + mm) * 16) * 1024 + col0 + bj * 128;
            gw[mm][bj] = *(const v4u*)(gc + off); hw[mm][bj] = *(const v4u*)(ga + off);
          }
        __builtin_amdgcn_sched_barrier(0);
#pragma unroll
        for (int mm = 0; mm < 2; ++mm)
#pragma unroll
          for (int bj = 0; bj < 2; ++bj) {
            const int m = 2 * mh + mm;
            const v4u g = gw[mm][bj], h = hw[mm][bj];
            f32x4& v0 = acc[ai][bj][m][0]; f32x4& v1 = acc[ai][bj][m][1];
            v0[0] *= __uint_as_float(g.x << 16) * __builtin_amdgcn_rcpf(__uint_as_float(h.x << 16)); v0[1] *= __uint_as_float(g.x & 0xffff0000u) * __builtin_amdgcn_rcpf(__uint_as_float(h.x & 0xffff0000u));
            v0[2] *= __uint_as_float(g.y << 16) * __builtin_amdgcn_rcpf(__uint_as_float(h.y << 16)); v0[3] *= __uint_as_float(g.y & 0xffff0000u) * __builtin_amdgcn_rcpf(__uint_as_float(h.y & 0xffff0000u));
            v1[0] *= __uint_as_float(g.z << 16) * __builtin_amdgcn_rcpf(__uint_as_float(h.z << 16)); v1[1] *= __uint_as_float(g.z & 0xffff0000u) * __builtin_amdgcn_rcpf(__uint_as_float(h.z & 0xffff0000u));
            v1[2] *= __uint_as_float(g.w << 16) * __builtin_amdgcn_rcpf(__uint_as_float(h.w << 16)); v1[3] *= __uint_as_float(g.w & 0xffff0000u) * __builtin_amdgcn_rcpf(__uint_as_float(h.w & 0xffff0000u));
          }
        __builtin_amdgcn_sched_barrier(0);
      }
    return true;
  }
  __device__ __forceinline__ void operator()(const pg8::f32x4 (&acc)[2][2][4][2], const pg8::Unit& u, int wr, int wc, int fr, int fq) const {
    EpiGate<false> E; E.gate = ga; E.M1 = M1; E(acc, u, wr, wc, fr, fq);
  }
};
struct EpiRes {
  static constexpr bool PERM = true, AFTER_DRAIN = false, CHAIN = false;
  const float* base; us* x1b;
  __device__ __forceinline__ void operator()(const pg8::f32x4 (&acc)[2][2][4][2], const pg8::Unit& u, int wr, int wc, int fr, int fq) const {
    const int row0 = u.pm * 256 + wr * 64 + fr, col0 = u.pn * 256 + wc * 32 + 8 * fq;
#pragma unroll
    for (int ai = 0; ai < 2; ++ai)
#pragma unroll
      for (int mh = 0; mh < 2; ++mh) {
        f32x4 b[2][2][2];
#pragma unroll
        for (int mm = 0; mm < 2; ++mm)
#pragma unroll
          for (int bj = 0; bj < 2; ++bj)
#pragma unroll
            for (int n = 0; n < 2; ++n) b[mm][bj][n] = *(const f32x4*)(base + (size_t)(row0 + ai * 128 + (2 * mh + mm) * 16) * 1024 + col0 + bj * 128 + n * 4);
        __builtin_amdgcn_sched_barrier(0);
#pragma unroll
        for (int mm = 0; mm < 2; ++mm)
#pragma unroll
          for (int bj = 0; bj < 2; ++bj) {
            const f32x4 o0 = b[mm][bj][0] + acc[ai][bj][2 * mh + mm][0], o1 = b[mm][bj][1] + acc[ai][bj][2 * mh + mm][1];
            v4u w; w.x = pk2(o0[0], o0[1]); w.y = pk2(o0[2], o0[3]); w.z = pk2(o1[0], o1[1]); w.w = pk2(o1[2], o1[3]);
            *(v4u*)(x1b + (size_t)(row0 + ai * 128 + (2 * mh + mm) * 16) * 1024 + col0 + bj * 128) = w;
          }
        __builtin_amdgcn_sched_barrier(0);
      }
  }
};

__device__ __forceinline__ void p0_transpose_item(const float* __restrict__ W, int ldw, int k0, int n_src, us* __restrict__ WT, int ldt, int dst_row0,
                                                  LAS float* scr, int lane) {
  if (n_src >= 0) {
#pragma unroll 8
    for (int i = 0; i < 32; ++i) { const int kk = 2 * i + (lane >> 5); scr[kk * 33 + (lane & 31)] = W[(size_t)(k0 + kk) * ldw + n_src + (lane & 31)]; }
  } else {
#pragma unroll 8
    for (int i = 0; i < 32; ++i) { const int kk = 2 * i + (lane >> 5); scr[kk * 33 + (lane & 31)] = 0.f; }
  }
  LDS_WAIT(); asm volatile("" ::: "memory");
  const int c = lane & 7;
#pragma unroll
  for (int j = 0; j < 4; ++j) {
    const int n = (lane >> 3) + 8 * j;
    const LAS float* s = scr + (8 * c) * 33 + n;
    v4u o;
    o.x = pk2(s[0 * 33], s[1 * 33]); o.y = pk2(s[2 * 33], s[3 * 33]); o.z = pk2(s[4 * 33], s[5 * 33]); o.w = pk2(s[6 * 33], s[7 * 33]);
    *(v4u*)(WT + (size_t)(dst_row0 + n) * ldt + k0 + 8 * c) = o;
  }
  LDS_WAIT(); asm volatile("" ::: "memory");
}
__device__ __forceinline__ void p0_transpose_item_fm(const float* __restrict__ W, int ldw, int k0, int n_src, us* __restrict__ WT, int K, int g,
                                                     LAS float* scr, int lane, const float* __restrict__ kscale = nullptr) {
#pragma unroll 8
  for (int i = 0; i < 32; ++i) { const int kk = 2 * i + (lane >> 5); scr[kk * 33 + (lane & 31)] = W[(size_t)(k0 + kk) * ldw + n_src + (lane & 31)]; }
  LDS_WAIT(); asm volatile("" ::: "memory");
  const int c = lane & 7;
#pragma unroll
  for (int j = 0; j < 4; ++j) {
    const int n = (lane >> 3) + 8 * j;
    const LAS float* s = scr + (8 * c) * 33 + n;
    v4u o;
    f32x4 g0 = (f32x4){1.f, 1.f, 1.f, 1.f}, g1 = g0;
    if (kscale) { g0 = *(const f32x4*)(kscale + k0 + 8 * c); g1 = *(const f32x4*)(kscale + k0 + 8 * c + 4); }
    o.x = pk2(s[0 * 33] * g0[0], s[1 * 33] * g0[1]); o.y = pk2(s[2 * 33] * g0[2], s[3 * 33] * g0[3]); o.z = pk2(s[4 * 33] * g1[0], s[5 * 33] * g1[1]); o.w = pk2(s[6 * 33] * g1[2], s[7 * 33] * g1[3]);
    *(v4u*)(WT + ((((size_t)g * (K >> 4) + (k0 >> 4) + (c >> 1)) * 2 + (c & 1)) * 32 + n) * 8) = o;
  }
  LDS_WAIT(); asm volatile("" ::: "memory");
}
__device__ __forceinline__ int inproj_src(int g) {
  const int pn = g >> 3, bj = (g >> 2) & 1, wc = g & 3;
  if (pn < 4) return (bj ? 512 : 0) + pn * 128 + wc * 32;
  if (pn < 12) { const int type = (pn - 4) >> 1, head = ((pn - 4) & 1) * 4 + wc; return OFF_Q + type * 512 + head * 64 + bj * 32; }
  if (pn < 20) return (pn < 16 ? OFF_GC : OFF_GA) + ((pn - 12) & 3) * 256 + bj * 128 + wc * 32;
  if (wc == 0) return OFF_KI + bj * 32;
  if (wc == 1 && bj == 0) return OFF_WI;
  return -1;
}
__device__ __forceinline__ void rms_row_to_bf16(const float* __restrict__ xrow, const float* __restrict__ g, us* __restrict__ orow, int lane) {
  const f32x4* xr = (const f32x4*)xrow + lane;
  f32x4 v[4]; float s = 0.f;
#pragma unroll
  for (int j = 0; j < 4; ++j) { v[j] = xr[64 * j]; s += (v[j].x * v[j].x + v[j].y * v[j].y) + (v[j].z * v[j].z + v[j].w * v[j].w); }
  const float rstd = 1.0f / sqrtf(wave_sum(s) * (1.0f / D) + EPS);
#pragma unroll
  for (int j = 0; j < 4; ++j) {
    const f32x4 gg = ((const f32x4*)g)[lane + 64 * j];
    unsigned long long o = (unsigned long long)pk2(v[j].x * rstd * gg.x, v[j].y * rstd * gg.y) |
                           ((unsigned long long)pk2(v[j].z * rstd * gg.z, v[j].w * rstd * gg.w) << 32);
    ((unsigned long long*)orow)[lane + 64 * j] = o;
  }
}

__device__ __forceinline__ void rms_rows4_to_bf16(const float* __restrict__ x0, const float* __restrict__ g, us* __restrict__ o0, int lane) {
  f32x4 v[4][4];
#pragma unroll
  for (int r = 0; r < 4; ++r)
#pragma unroll
    for (int j = 0; j < 4; ++j) v[r][j] = ((const f32x4*)(x0 + (size_t)r * D))[lane + 64 * j];
  __builtin_amdgcn_sched_barrier(0);
#pragma unroll
  for (int r = 0; r < 4; ++r) {
    float s = 0.f;
#pragma unroll
    for (int j = 0; j < 4; ++j) s += (v[r][j].x * v[r][j].x + v[r][j].y * v[r][j].y) + (v[r][j].z * v[r][j].z + v[r][j].w * v[r][j].w);
    const float rstd = 1.0f / sqrtf(wave_sum_dpp(s) * (1.0f / D) + EPS);
#pragma unroll
    for (int j = 0; j < 4; ++j) {
      const f32x4 gg = ((const f32x4*)g)[lane + 64 * j];
      unsigned long long o = (unsigned long long)pk2(v[r][j].x * rstd * gg.x, v[r][j].y * rstd * gg.y) |
                             ((unsigned long long)pk2(v[r][j].z * rstd * gg.z, v[r][j].w * rstd * gg.w) << 32);
      ((unsigned long long*)(o0 + (size_t)r * D))[lane + 64 * j] = o;
    }
  }
}

constexpr int CW_DEP = 104;
constexpr unsigned DEP_TARGET = 7u * 64u * 8u;
constexpr int CW_TQ = 100;
struct InProjOrder : pg8::StaticOrder {
  unsigned* dep;
  __device__ __forceinline__ static int perm(int r) { return r == 0 ? 20 : (r < 3 ? r + 9 : (r < 13 ? r - 3 : r - 1)); }
  __device__ __forceinline__ static bool is_dep(int pn) { return pn < 4 || pn == 10 || pn == 11 || pn == 20; }
  __device__ bool next(int i, pg8::Unit& u) const { const bool ok = pg8::StaticOrder::next(i, u); u.pn = perm(u.pn); return ok; }
  __device__ __forceinline__ void done(const pg8::Unit& u) const {
    if (is_dep(u.pn)) {
      asm volatile("s_waitcnt vmcnt(0)" ::: "memory");
      if ((threadIdx.x & 63) == 0) __hip_atomic_fetch_add(dep, 1u, __ATOMIC_RELAXED, __HIP_MEMORY_SCOPE_AGENT);
    }
  }
};
__device__ __forceinline__ void st16_wt_g(void* ptr, v4u v) { asm volatile("global_store_dwordx4 %0, %1, off sc1\n\ts_nop 1" :: "v"(ptr), "v"(v) : "memory"); }

struct EpiInProj {
  static constexpr bool PERM = true, AFTER_DRAIN = false, CHAIN = false;
  us *G, *Q, *K, *V, *QI, *KI, *GC, *GA; float* WI; const float *CT, *ST;
  __device__ __forceinline__ void operator()(const pg8::f32x4 (&acc)[2][2][4][2], const pg8::Unit& u, int wr, int wc, int fr, int fq) const {
    const int pn = u.pn;
    const int row0 = u.pm * 256 + wr * 64 + fr;
    if (pn < 4) {
#pragma unroll
      for (int ai = 0; ai < 2; ++ai)
#pragma unroll
        for (int m = 0; m < 4; ++m) {
          const int row = row0 + ai * 128 + m * 16;
          const f32x4 a0 = acc[ai][0][m][0], a1 = acc[ai][0][m][1], b0 = acc[ai][1][m][0], b1 = acc[ai][1][m][1];
          v4u w;
          w.x = pk2(a0[0] * fsigmoid(b0[0]), a0[1] * fsigmoid(b0[1])); w.y = pk2(a0[2] * fsigmoid(b0[2]), a0[3] * fsigmoid(b0[3]));
          w.z = pk2(a1[0] * fsigmoid(b1[0]), a1[1] * fsigmoid(b1[1])); w.w = pk2(a1[2] * fsigmoid(b1[2]), a1[3] * fsigmoid(b1[3]));
          st16_wt_g(G + (size_t)row * 512 + pn * 128 + wc * 32 + 8 * fq, w);
        }
    } else if (pn < 12) {
      const int type = (pn - 4) >> 1, head = ((pn - 4) & 1) * 4 + wc;
      us* dst = type == 0 ? Q : (type == 1 ? K : (type == 2 ? V : QI));
      const float sc = type == 0 ? QSCALE : 1.0f;
#pragma unroll
      for (int ai = 0; ai < 2; ++ai)
#pragma unroll
        for (int m = 0; m < 4; ++m) {
          const int row = row0 + ai * 128 + m * 16;
          const f32x4 x10 = acc[ai][0][m][0], x11 = acc[ai][0][m][1], x20 = acc[ai][1][m][0], x21 = acc[ai][1][m][1];
          f32x4 o10, o11, o20, o21;
          if (type == 2) { o10 = x10; o11 = x11; o20 = x20; o21 = x21; }
          else {
            const f32x4 c0 = *(const f32x4*)(CT + (size_t)row * 32 + 8 * fq), c1 = *(const f32x4*)(CT + (size_t)row * 32 + 8 * fq + 4);
            const f32x4 s0 = *(const f32x4*)(ST + (size_t)row * 32 + 8 * fq), s1 = *(const f32x4*)(ST + (size_t)row * 32 + 8 * fq + 4);
            o10 = (x10 * c0 - x20 * s0) * sc; o11 = (x11 * c1 - x21 * s1) * sc;
            o20 = (x20 * c0 + x10 * s0) * sc; o21 = (x21 * c1 + x11 * s1) * sc;
          }
          v4u w1, w2;
          w1.x = pk2(o10[0], o10[1]); w1.y = pk2(o10[2], o10[3]); w1.z = pk2(o11[0], o11[1]); w1.w = pk2(o11[2], o11[3]);
          w2.x = pk2(o20[0], o20[1]); w2.y = pk2(o20[2], o20[3]); w2.z = pk2(o21[0], o21[1]); w2.w = pk2(o21[2], o21[3]);
          us* p = dst + (size_t)row * 512 + head * 64 + 8 * fq;
          if (type == 3) { st16_wt_g(p, w1); st16_wt_g(p + 32, w2); } else { *(v4u*)p = w1; *(v4u*)(p + 32) = w2; }
        }
    } else if (pn < 20) {
      us* dst = pn < 16 ? GC : GA;
      const int cb = ((pn - 12) & 3) * 256 + wc * 32 + 8 * fq;
#pragma unroll
      for (int ai = 0; ai < 2; ++ai)
#pragma unroll
        for (int m = 0; m < 4; ++m) {
          const int row = row0 + ai * 128 + m * 16;
#pragma unroll
          for (int bj = 0; bj < 2; ++bj) {
            const f32x4 v0 = acc[ai][bj][m][0], v1 = acc[ai][bj][m][1];
            v4u w;
            const float lo_ = pn < 16 ? 0.f : 1e-30f;
            w.x = pk2(fmaxf(fsigmoid(v0[0]), lo_), fmaxf(fsigmoid(v0[1]), lo_)); w.y = pk2(fmaxf(fsigmoid(v0[2]), lo_), fmaxf(fsigmoid(v0[3]), lo_));
            w.z = pk2(fmaxf(fsigmoid(v1[0]), lo_), fmaxf(fsigmoid(v1[1]), lo_)); w.w = pk2(fmaxf(fsigmoid(v1[2]), lo_), fmaxf(fsigmoid(v1[3]), lo_));
            *(v4u*)(dst + (size_t)row * 1024 + cb + bj * 128) = w;
          }
        }
    } else {
      if (wc == 0) {
#pragma unroll
        for (int ai = 0; ai < 2; ++ai)
#pragma unroll
          for (int m = 0; m < 4; ++m) {
            const int row = row0 + ai * 128 + m * 16;
            const f32x4 x10 = acc[ai][0][m][0], x11 = acc[ai][0][m][1], x20 = acc[ai][1][m][0], x21 = acc[ai][1][m][1];
            const f32x4 c0 = *(const f32x4*)(CT + (size_t)row * 32 + 8 * fq), c1 = *(const f32x4*)(CT + (size_t)row * 32 + 8 * fq + 4);
            const f32x4 s0 = *(const f32x4*)(ST + (size_t)row * 32 + 8 * fq), s1 = *(const f32x4*)(ST + (size_t)row * 32 + 8 * fq + 4);
            const f32x4 o10 = x10 * c0 - x20 * s0, o11 = x11 * c1 - x21 * s1, o20 = x20 * c0 + x10 * s0, o21 = x21 * c1 + x11 * s1;
            v4u w1, w2;
            w1.x = pk2(o10[0], o10[1]); w1.y = pk2(o10[2], o10[3]); w1.z = pk2(o11[0], o11[1]); w1.w = pk2(o11[2], o11[3]);
            w2.x = pk2(o20[0], o20[1]); w2.y = pk2(o20[2], o20[3]); w2.z = pk2(o21[0], o21[1]); w2.w = pk2(o21[2], o21[3]);
            us* p = KI + ((size_t)(row >> 5) * 8 * 32 + (row & 31)) * 8;
            st16_wt_g(p + (size_t)fq * 256, w1); st16_wt_g(p + (size_t)(4 + fq) * 256, w2);
          }
      } else if (wc == 1 && fq == 0) {
#pragma unroll
        for (int ai = 0; ai < 2; ++ai)
#pragma unroll
          for (int m = 0; m < 4; ++m) {
            const int row = row0 + ai * 128 + m * 16;
            const f32x4 wa_ = acc[ai][0][m][0] * IDX_SCALE, wb_ = acc[ai][0][m][1] * IDX_SCALE;
            st16_wt_g(WI + (size_t)row * 8, (v4u){__float_as_uint(wa_[0]), __float_as_uint(wa_[1]), __float_as_uint(wa_[2]), __float_as_uint(wa_[3])});
            st16_wt_g(WI + (size_t)row * 8 + 4, (v4u){__float_as_uint(wb_[0]), __float_as_uint(wb_[1]), __float_as_uint(wb_[2]), __float_as_uint(wb_[3])});
          }
      }
    }
  }
};


constexpr size_t WS_WGU = 232 * MiB;
constexpr size_t WS_WD = 248 * MiB;
constexpr size_t WS_YS = 72 * MiB;
constexpr size_t WS_HID = 136 * MiB;
constexpr size_t WS_LIST = 160 * MiB;
constexpr size_t WS_COMB = 162 * MiB;
constexpr size_t WS_RSTD = 163 * MiB;
constexpr int CW_CNT = 64;
constexpr int LIST_CAP = 16384;

__device__ __forceinline__ void moe_offsets(const unsigned* cnt, int (&rb_start)[17], int (&row_off)[17]) {
  int a = 0, b = 0;
#pragma unroll
  for (int e = 0; e < 16; ++e) { rb_start[e] = a; row_off[e] = b; const int n = (int)__hip_atomic_load(cnt + e, RLX_AGENT); const int nb = (n + 127) >> 7; a += nb; b += nb * 128; }
  rb_start[16] = a; row_off[16] = b;
}

constexpr size_t WS_WR = 11 * MiB + 512 * 1024;
__device__ __forceinline__ void route_weights_item(us* __restrict__ WR, const float* __restrict__ g_ffn, const float* __restrict__ w_rg, const float* __restrict__ w_re, int i) {
  const int l = i & 63, nt = (i >> 6) & 3, ks = i >> 8;
  const int o = 16 * (nt & 1) + (l & 15), k0 = 32 * ks + 8 * (l >> 4);
  unsigned w[4];
#pragma unroll
  for (int jj = 0; jj < 4; ++jj) {
    unsigned h2[2];
#pragma unroll
    for (int j2 = 0; j2 < 2; ++j2) {
      const int k = k0 + 2 * jj + j2;
      float v = 0.f;
      if (o < 4) v = w_rg[k * 4 + o]; else if (o < 20) v = w_re[k * 16 + (o - 4)];
      v *= g_ffn[k];
      const unsigned hi = f2bf_(v);
      h2[j2] = (nt < 2) ? hi : f2bf_(v - __uint_as_float(hi << 16));
    }
    w[jj] = h2[0] | (h2[1] << 16);
  }
  *(v4u*)(WR + (size_t)i * 8) = (v4u){w[0], w[1], w[2], w[3]};
}

__device__ __forceinline__ void route_phase(LAS unsigned char* lds, unsigned char* ws, const us* x1b, const float* b_rg, const float* b_re, int tid, int lane, int wave, int mode) {
  LAS float* LG = (LAS float*)lds;
  LAS float* SS = (LAS float*)(lds + 16896);
  LAS int* cnt_l = (LAS int*)(lds + 20480);
  LAS int* base_l = cnt_l + 16;
  LAS int* tok_e = base_l + 16;
  LAS int* tok_p = tok_e + 128;
  unsigned* cnt = (unsigned*)(ws + WS_CTL) + CW_CNT;
  int* LIST = (int*)(ws + WS_LIST);
  float* COMB = (float*)(ws + WS_COMB);
  float* RSTD = (float*)(ws + WS_RSTD);
  const us* WR = (const us*)(ws + WS_WR);
  if (tid < 16) cnt_l[tid] = 0;
  const int t0 = blockIdx.x * 64;
  {
    const int mblk = wave & 3, kh = wave >> 2;
    const us* arow = x1b + (size_t)(t0 + 16 * mblk + (lane & 15)) * D + kh * 512 + 8 * (lane >> 4);
    bf16x8 a[16];
#pragma unroll
    for (int ks = 0; ks < 16; ++ks) a[ks] = *(const bf16x8*)(arow + 32 * ks);
    const us* bbase = WR + ((size_t)(kh * 16) * 4 * 64 + lane) * 8;
    f32x4 acc0 = (f32x4){0.f, 0.f, 0.f, 0.f}, acc1 = acc0;
    float ssq = 0.f;
#pragma unroll
    for (int c = 0; c < 4; ++c) {
      bf16x8 bfr[4][4];
#pragma unroll
      for (int k4 = 0; k4 < 4; ++k4)
#pragma unroll
        for (int nt = 0; nt < 4; ++nt) bfr[k4][nt] = *(const bf16x8*)(bbase + (size_t)((c * 4 + k4) * 4 + nt) * 512);
      __builtin_amdgcn_sched_barrier(0);
#pragma unroll
      for (int k4 = 0; k4 < 4; ++k4) {
        const bf16x8 av = a[c * 4 + k4];
        acc0 = __builtin_amdgcn_mfma_f32_16x16x32_bf16(av, bfr[k4][0], acc0, 0, 0, 0);
        acc1 = __builtin_amdgcn_mfma_f32_16x16x32_bf16(av, bfr[k4][1], acc1, 0, 0, 0);
        acc0 = __builtin_amdgcn_mfma_f32_16x16x32_bf16(av, bfr[k4][2], acc0, 0, 0, 0);
        acc1 = __builtin_amdgcn_mfma_f32_16x16x32_bf16(av, bfr[k4][3], acc1, 0, 0, 0);
        const v4u au = __builtin_bit_cast(v4u, av);
#pragma unroll
        for (int d = 0; d < 4; ++d) { const float lo_ = __uint_as_float(au[d] << 16), hi_ = __uint_as_float(au[d] & 0xffff0000u); ssq = __builtin_fmaf(lo_, lo_, ssq); ssq = __builtin_fmaf(hi_, hi_, ssq); }
      }
    }
    ssq += __shfl_xor(ssq, 16); ssq += __shfl_xor(ssq, 32);
    LAS float* lg = LG + (kh * 64 + 16 * mblk + 4 * (lane >> 4)) * 33 + (lane & 15);
#pragma unroll
    for (int i = 0; i < 4; ++i) { lg[i * 33] = acc0[i]; lg[i * 33 + 16] = acc1[i]; }
    if (lane < 16) SS[kh * 64 + 16 * mblk + lane] = ssq;
  }
  __syncthreads();
  if (wave == 0) {
    const int t = t0 + lane;
    const LAS float* l0 = LG + lane * 33, *l1 = LG + (64 + lane) * 33;
    const float rstd = 1.0f / sqrtf((SS[lane] + SS[64 + lane]) * (1.0f / D) + EPS);
    RSTD[t] = rstd;
    const float g0 = (l0[0] + l1[0]) * rstd + b_rg[0], g1 = (l0[1] + l1[1]) * rstd + b_rg[1], g2 = (l0[2] + l1[2]) * rstd + b_rg[2], g3 = (l0[3] + l1[3]) * rstd + b_rg[3];
    int gi = 0; float gm = g0;
    if (g1 > gm) { gm = g1; gi = 1; }
    if (g2 > gm) { gm = g2; gi = 2; }
    if (g3 > gm) { gm = g3; gi = 3; }
    const float pg = 1.0f / (expf(g0 - gm) + expf(g1 - gm) + expf(g2 - gm) + expf(g3 - gm));
    const f32x4 be = *(const f32x4*)(b_re + gi * 4);
    const LAS float* e0p = l0 + 4 + gi * 4, *e1p = l1 + 4 + gi * 4;
    const float e0 = (e0p[0] + e1p[0]) * rstd + be[0], e1 = (e0p[1] + e1p[1]) * rstd + be[1], e2 = (e0p[2] + e1p[2]) * rstd + be[2], e3 = (e0p[3] + e1p[3]) * rstd + be[3];
    int i0 = 0; float m0 = e0;
    if (e1 > m0) { m0 = e1; i0 = 1; }
    if (e2 > m0) { m0 = e2; i0 = 2; }
    if (e3 > m0) { m0 = e3; i0 = 3; }
    int i1 = -1; float m1 = -INFINITY;
    if (i0 != 0 && e0 > m1) { m1 = e0; i1 = 0; }
    if (i0 != 1 && e1 > m1) { m1 = e1; i1 = 1; }
    if (i0 != 2 && e2 > m1) { m1 = e2; i1 = 2; }
    if (i0 != 3 && e3 > m1) { m1 = e3; i1 = 3; }
    const float r = expf(m1 - m0);
    const float c0 = pg / (1.0f + r), c1 = pg * r / (1.0f + r);
    const int ea = gi * 4 + i0, eb = gi * 4 + i1;
    tok_e[lane * 2] = ea; tok_e[lane * 2 + 1] = eb;
    tok_p[lane * 2] = atomicAdd((int*)(cnt_l + ea), 1);
    tok_p[lane * 2 + 1] = atomicAdd((int*)(cnt_l + eb), 1);
    *(unsigned long long*)(COMB + t * 2) = (unsigned long long)__float_as_uint(c0) | ((unsigned long long)__float_as_uint(c1) << 32);
  }
  __syncthreads();
  if (mode & 1) return;
  if (tid < 16) base_l[tid] = (int)__hip_atomic_fetch_add(cnt + tid, (unsigned)cnt_l[tid], RLX_AGENT);
  __syncthreads();
  if (tid < 128) {
    const int e = tok_e[tid], p = base_l[e] + tok_p[tid];
    LIST[e * LIST_CAP + p] = (blockIdx.x * 64 + (tid >> 1)) * 2 + (tid & 1);
  }
}

constexpr int SG_EPI_STAGE = 9216;
__device__ __forceinline__ void st16_wt(us* p, v4u v) { asm volatile("global_store_dwordx4 %0, %1, off sc1\n\ts_nop 1" :: "v"(p), "v"(v) : "memory"); }
struct EpiMoe1 {
  us* HID; int hid_row0, nvalid; LAS unsigned char* stage;
  const LAS float* rstd_l;
  __device__ __forceinline__ void operator()(const sg::f32x16 (&acc)[2][4], int wave, int r32, int hi) const {
    const int lane = r32 + 32 * hi;
    LAS unsigned char* st = stage + wave * SG_EPI_STAGE;
#pragma unroll
    for (int m = 0; m < 4; ++m) {
      const float rs = rstd_l[32 * m + r32];
#pragma unroll
      for (int q = 0; q < 4; ++q) {
        float h[4];
#pragma unroll
        for (int i = 0; i < 4; ++i) { const float g = acc[0][m][4 * q + i] * rs, u = acc[1][m][4 * q + i] * rs; h[i] = g * fsigmoid(g) * u; }
        *(LAS unsigned long long*)(st + (m * 32 + r32) * 72 + (8 * q + 4 * hi) * 2) = (unsigned long long)pk2(h[0], h[1]) | ((unsigned long long)pk2(h[2], h[3]) << 32);
      }
    }
    LDS_WAIT();
#pragma unroll
    for (int i = 0; i < 8; ++i) {
      const int rr = i * 16 + (lane >> 2), c = lane & 3;
      const unsigned long long lo = *(const LAS unsigned long long*)(st + rr * 72 + c * 16), hi2 = *(const LAS unsigned long long*)(st + rr * 72 + c * 16 + 8);
      const v4u v = (v4u){(unsigned)lo, (unsigned)(lo >> 32), (unsigned)hi2, (unsigned)(hi2 >> 32)};
      if (rr < nvalid) st16_wt(HID + (size_t)(hid_row0 + rr) * 256 + wave * 32 + c * 8, v);
      asm volatile("" ::: "memory");
    }
    LDS_WAIT();
  }
};
struct EpiMoe2 {
  us* YS; const LAS int* slots; int ct, nvalid; LAS unsigned char* stage;
  __device__ __forceinline__ void operator()(const sg::f32x16 (&acc)[2][2], int wm, int wn, int r32, int hi) const {
    const int lane = r32 + 32 * hi;
    LAS unsigned char* st = stage + (wm * 4 + wn) * SG_EPI_STAGE;
#pragma unroll
    for (int m = 0; m < 2; ++m) {
#pragma unroll
      for (int h = 0; h < 2; ++h)
#pragma unroll
        for (int q = 0; q < 4; ++q)
          *(LAS unsigned long long*)(st + r32 * 144 + (h * 32 + 8 * q + 4 * hi) * 2) =
              (unsigned long long)pk2(acc[h][m][4 * q], acc[h][m][4 * q + 1]) | ((unsigned long long)pk2(acc[h][m][4 * q + 2], acc[h][m][4 * q + 3]) << 32);
      LDS_WAIT();
#pragma unroll
      for (int i = 0; i < 4; ++i) {
        const int rr = i * 8 + (lane >> 3), c = lane & 7, grow = wm * 64 + m * 32 + rr;
        const v4u v = *(const LAS v4u*)(st + rr * 144 + c * 16);
        if (grow < nvalid) { const int slot = slots[grow]; *(v4u*)(YS + (size_t)slot * 1024 + ct * 256 + (c >> 2) * 128 + wn * 32 + (c & 3) * 8) = v; }
        asm volatile("" ::: "memory");
      }
      LDS_WAIT();
    }
  }
};

constexpr int CW_Q = 96;
constexpr int CW_READY = 128;
constexpr int MOE_SLOTS = LDS_BYTES - 1024;
constexpr int MOE_TAB = LDS_BYTES - 512;
constexpr int MOE_STG1 = 40960, MOE_STG2 = 67584;
template <int PART> __device__ __forceinline__ void moe_phase(LAS unsigned char* lds, unsigned char* ws, volatile LAS unsigned* MISC, int tid0, int mode) {
  int tid = tid0;
  unsigned* ctl = (unsigned*)(ws + WS_CTL);
  const unsigned* cnt = ctl + CW_CNT;
  LAS int* tab = (LAS int*)(lds + MOE_TAB);
  if (tid < 64) {
    const int n = tid < 16 ? (int)__hip_atomic_load(cnt + (tid & 15), RLX_AGENT) : 0;
    const int nb = (n + 127) >> 7;
    int incl = nb;
#pragma unroll
    for (int d = 1; d < 16; d <<= 1) { const int o = __shfl_up(incl, d); if ((tid & 63) >= d) incl += o; }
    if (tid < 16) { tab[tid] = incl - nb; tab[17 + tid] = (incl - nb) * 128; tab[34 + tid] = n; }
    if (tid == 15) { tab[16] = incl; tab[33] = incl * 128; }
  }
  __syncthreads();
  const int nrb = __builtin_amdgcn_readfirstlane(tab[16]);
  const int* LIST = (const int*)(ws + WS_LIST);
  const us* X1B = (const us*)(ws + WS_X1B);
  const float* RSTD = (const float*)(ws + WS_RSTD);
  const us* WguT = (const us*)(ws + WS_WGU);
  const us* WdT = (const us*)(ws + WS_WD);
  us* HID = (us*)(ws + WS_HID);
  const int wave_ = __builtin_amdgcn_readfirstlane(tid0 >> 6);
  unsigned long long tp_acc = 0ull, tp_0 = 0ull; const int tprobe = AMP_ON ? mode >> 8 : 0;
  if (tprobe == 3) tp_0 = __builtin_amdgcn_s_memrealtime();
  for (;;) {
    if (wave_ == 0) {   const int lane_ = tid0 & 63;
      unsigned v_ = 0u;
      if (lane_ == 0) v_ = __hip_atomic_fetch_add(ctl + CW_Q + (PART == 2 ? 1 : 0), 1u, RLX_AGENT) + (PART == 2 ? (unsigned)nrb : 0u);
      MISC[16] = (unsigned)__builtin_amdgcn_readfirstlane((int)v_);
    }
    __syncthreads();
    asm volatile("" : "+v"(tid));
    const int lane_ = tid & 63, wn_ = (tid >> 6) & 3;
    const int q = __builtin_amdgcn_readfirstlane((int)MISC[16]);
    if (q >= (PART == 1 ? 1 : 3) * nrb) break;
    const bool down = q >= nrb;
    if (tprobe == (down ? 2 : 1)) tp_0 = __builtin_amdgcn_s_memrealtime();
    const int rb = down ? (q - nrb) >> 1 : q;
    int e = 0;
#pragma unroll
    for (int k = 1; k < 16; ++k) if (rb >= tab[k]) e = k;
    const int n_e = tab[34 + e], row0 = tab[17 + e];
    const int r0 = (rb - tab[e]) * 128, nvalid = min(128, n_e - r0);
    if (!down) {
      const us* ap[2];
#pragma unroll
      for (int i = 0; i < 2; ++i) { const int c = tid + 512 * i; int r = c >> 3; if (r >= nvalid) r = 0; const int tok = LIST[e * LIST_CAP + r0 + r] >> 1; ap[i] = X1B + (size_t)tok * D + (c & 7) * 8; }
      if (tid < 128) ((LAS float*)(lds + MOE_SLOTS))[tid] = RSTD[LIST[e * LIST_CAP + r0 + (tid < nvalid ? tid : 0)] >> 1];
      const us* bf0 = WguT + ((size_t)(e * 16 + (wave_ >> 2) * 8 + (wave_ & 3)) * 64 * 2 + (lane_ >> 5)) * 256 + (lane_ & 31) * 8;
      const us* bf1 = bf0 + (size_t)4 * 64 * 512;
      EpiMoe1 E; E.HID = HID; E.hid_row0 = row0 + r0; E.nvalid = nvalid; E.stage = lds + MOE_STG1; E.rstd_l = (const LAS float*)(lds + MOE_SLOTS);
      sg::tile_wide(lds, ap, bf0, bf1, 1024, E, tid);
      asm volatile("s_waitcnt vmcnt(0)" ::: "memory");
      __syncthreads();
      if (wave_ == 1) { if (lane_ == 0) __hip_atomic_fetch_add(ctl + CW_READY + rb, 1u, RLX_AGENT); }
    } else {
      if (PART == 0 && wave_ == 2) { if (lane_ == 0) {
        unsigned sp = 0;
        while (__hip_atomic_load(ctl + CW_READY + rb, RLX_AGENT) < 1u) { __builtin_amdgcn_s_sleep(2); if (++sp > (1u << 22)) break; }
        __builtin_amdgcn_fence(__ATOMIC_ACQUIRE, "agent");
        asm volatile("s_waitcnt vmcnt(0)" ::: "memory");
      } }
      __syncthreads();
      if (tid < 128) ((LAS int*)(lds + MOE_SLOTS))[tid] = LIST[e * LIST_CAP + r0 + (tid < nvalid ? tid : 0)];
      {
        const us* hrow = HID + (size_t)(row0 + r0) * 256;
#pragma unroll
        for (int i = 0; i < 8; ++i) { const int c = tid + 512 * i; const int r = c >> 5, ch = c & 31;
          const v4u v = *(const v4u*)(hrow + (size_t)r * 256 + ch * 8);
          *(LAS v4u*)(lds + r * sg::ARS + ch * 16) = v; }
      }
      __syncthreads();
#pragma unroll 1
      for (int ct = 2 * ((q - nrb) & 1); ct < 2 * ((q - nrb) & 1) + 2; ++ct) {
        const us* bf0 = WdT + ((size_t)(e * 32 + ct * 8 + wn_) * 16 * 2 + (lane_ >> 5)) * 256 + (lane_ & 31) * 8;
        const us* bf1 = bf0 + (size_t)4 * 16 * 512;
        EpiMoe2 E; E.YS = (us*)(ws + WS_YS); E.slots = (const LAS int*)(lds + MOE_SLOTS); E.ct = ct; E.nvalid = nvalid; E.stage = lds + MOE_STG2;
        sg::tile_resident(lds, bf0, bf1, E, tid);
      }
      __syncthreads();
    }
    if (tprobe == (down ? 2 : 1)) tp_acc += __builtin_amdgcn_s_memrealtime() - tp_0;
  }
  if (tprobe == 3) tp_acc = __builtin_amdgcn_s_memrealtime() - tp_0;
  if (tprobe && blockIdx.x == 0) { const unsigned long long t1 = __builtin_amdgcn_s_memrealtime(); while (__builtin_amdgcn_s_memrealtime() - t1 < 9ull * tp_acc) __builtin_amdgcn_s_sleep(8); }
}
__device__ __forceinline__ void final_phase(unsigned char* ws, const us* x1b, float* out, const float* g_final, int lane, int wave, int mode) {
  const us* YS = (const us*)(ws + WS_YS);
  const float* COMB = (const float*)(ws + WS_COMB);
  for (int t = blockIdx.x * 8 + wave; t < T; t += gridDim.x * 8) {
    const unsigned long long* xr = (const unsigned long long*)(x1b + (size_t)t * D) + lane;
    const float c0 = COMB[t * 2], c1 = COMB[t * 2 + 1];
    const unsigned long long* y0 = (const unsigned long long*)(YS + (size_t)(2 * t) * D) + lane;
    const unsigned long long* y1 = (const unsigned long long*)(YS + (size_t)(2 * t + 1) * D) + lane;
    f32x4 v[4]; float s = 0.f;
#pragma unroll
    for (int j = 0; j < 4; ++j) {
      const unsigned long long xx = xr[64 * j];
      const unsigned long long a = y0[64 * j], b = y1[64 * j];
      v[j].x = __uint_as_float((unsigned)xx << 16) + (c0 * __uint_as_float((unsigned)a << 16) + c1 * __uint_as_float((unsigned)b << 16));
      v[j].y = __uint_as_float((unsigned)xx & 0xffff0000u) + (c0 * __uint_as_float((unsigned)a & 0xffff0000u) + c1 * __uint_as_float((unsigned)b & 0xffff0000u));
      v[j].z = __uint_as_float((unsigned)(xx >> 32) << 16) + (c0 * __uint_as_float((unsigned)(a >> 32) << 16) + c1 * __uint_as_float((unsigned)(b >> 32) << 16));
      v[j].w = __uint_as_float((unsigned)(xx >> 32) & 0xffff0000u) + (c0 * __uint_as_float((unsigned)(a >> 32) & 0xffff0000u) + c1 * __uint_as_float((unsigned)(b >> 32) & 0xffff0000u));
      s += (v[j].x * v[j].x + v[j].y * v[j].y) + (v[j].z * v[j].z + v[j].w * v[j].w);
    }
    const float rstd = 1.0f / sqrtf(wave_sum(s) * (1.0f / D) + EPS);
    f32x4* orow = (mode & 1) ? (f32x4*)((float*)(ws + WS_G) + (size_t)(t & 4095) * D) + lane : (f32x4*)(out + (size_t)t * D) + lane;
#pragma unroll
    for (int j = 0; j < 4; ++j) { const f32x4 gg = ((const f32x4*)g_final)[lane + 64 * j]; orow[64 * j] = v[j] * rstd * gg; }
  }
}

__device__ __forceinline__ void conv_phase(LAS unsigned char* lds, unsigned char* ws, const float* __restrict__ w_dw, const float* __restrict__ b_dw,
                                           const float* __restrict__ ln_g, const float* __restrict__ ln_b, int tid, int lane, int wave,
                                           volatile LAS unsigned* MISC, unsigned* qhead) {
  const us* G = (const us*)(ws + WS_G);
  us* NA = (us*)(ws + WS_NA);
  LAS us* gl = (LAS us*)lds;
  LAS float* ctile = (LAS float*)(lds + 63488);
  float w[31];
#pragma unroll
  for (int j = 0; j < 31; ++j) w[j] = w_dw[j * 512 + tid];
  const float bias = b_dw[tid];
  const int wave_u = __builtin_amdgcn_readfirstlane(wave);
  for (;;) {
    if (wave_u == 0) {
      unsigned v_ = 0u;
      if (lane == 0) v_ = __hip_atomic_fetch_add(qhead, 1u, __ATOMIC_RELAXED, __HIP_MEMORY_SCOPE_AGENT);
      MISC[21] = (unsigned)__builtin_amdgcn_readfirstlane((int)v_);
    }
    __syncthreads();
    const int tile = __builtin_amdgcn_readfirstlane((int)MISC[21]);
    if (tile >= T / 32) break;
    const int t0 = tile * 32, tt0 = t0 & (S - 1);
    for (int c = tid; c < 62 * 64; c += 512) {
      const int r = c >> 6, ch = c & 63;
      v4u v = (v4u){0u, 0u, 0u, 0u};
      if (tt0 - 30 + r >= 0) v = *(const v4u*)(G + (size_t)(t0 - 30 + r) * 512 + ch * 8);
      *(LAS v4u*)(gl + r * 512 + ch * 8) = v;
    }
    __syncthreads();
#pragma unroll 1
    for (int p = 0; p < 4; ++p) {
      float acc[8];
#pragma unroll
      for (int o = 0; o < 8; ++o) acc[o] = bias;
#pragma unroll
      for (int rr = 0; rr < 38; ++rr) {
        const float gv = __uint_as_float(((unsigned)gl[(p * 8 + rr) * 512 + tid]) << 16);
#pragma unroll
        for (int o = 0; o < 8; ++o) { const int j = rr - o; if (j >= 0 && j < 31) acc[o] += w[j] * gv; }
      }
#pragma unroll
      for (int o = 0; o < 8; ++o) ctile[(p * 8 + o) * 512 + tid] = acc[o];
    }
    __syncthreads();
#pragma unroll
    for (int q = 0; q < 4; ++q) {
      const int tok = wave * 4 + q;
      const f32x4 a = *(const LAS f32x4*)(ctile + tok * 512 + 4 * lane), b = *(const LAS f32x4*)(ctile + tok * 512 + 256 + 4 * lane);
      const float mu = wave_sum((a.x + a.y) + (a.z + a.w) + (b.x + b.y) + (b.z + b.w)) * (1.0f / 512);
      const f32x4 da = a - mu, db = b - mu;
      const float var = wave_sum((da.x * da.x + da.y * da.y) + (da.z * da.z + da.w * da.w) + (db.x * db.x + db.y * db.y) + (db.z * db.z + db.w * db.w)) * (1.0f / 512);
      const float rs = 1.0f / sqrtf(var + EPS);
      const f32x4 ga = *(const f32x4*)(ln_g + 4 * lane), gb = *(const f32x4*)(ln_g + 256 + 4 * lane);
      const f32x4 ba = *(const f32x4*)(ln_b + 4 * lane), bb = *(const f32x4*)(ln_b + 256 + 4 * lane);
      f32x4 na = da * rs * ga + ba, nb = db * rs * gb + bb;
      na.x *= fsigmoid(na.x); na.y *= fsigmoid(na.y); na.z *= fsigmoid(na.z); na.w *= fsigmoid(na.w);
      nb.x *= fsigmoid(nb.x); nb.y *= fsigmoid(nb.y); nb.z *= fsigmoid(nb.z); nb.w *= fsigmoid(nb.w);
      us* dst = NA + (size_t)(t0 + tok) * 512;
      *(unsigned long long*)(dst + 4 * lane) = (unsigned long long)pk2(na.x, na.y) | ((unsigned long long)pk2(na.z, na.w) << 32);
      *(unsigned long long*)(dst + 256 + 4 * lane) = (unsigned long long)pk2(nb.x, nb.y) | ((unsigned long long)pk2(nb.z, nb.w) << 32);
    }
  }
}

__device__ __forceinline__ unsigned pk_sub_sat_u16(unsigned a, unsigned b) { unsigned r; asm("v_pk_sub_u16 %0, %1, %2 clamp" : "=v"(r) : "v"(a), "v"(b)); return r; }
__device__ __forceinline__ unsigned pk_min_u16(unsigned a, unsigned b) { unsigned r; asm("v_pk_min_u16 %0, %1, %2" : "=v"(r) : "v"(a), "v"(b)); return r; }
__device__ __forceinline__ unsigned pk_add_u16(unsigned a, unsigned b) { unsigned r; asm("v_pk_add_u16 %0, %1, %2" : "=v"(r) : "v"(a), "v"(b)); return r; }
__device__ __forceinline__ int wave_isum(int v) {
#pragma unroll
  for (int o = 1; o < 64; o <<= 1) v += __shfl_xor(v, o);
  return v;
}
__device__ __forceinline__ unsigned f16key(float sc) {
  sc += 0.0f;
  const _Float16 h = (_Float16)sc;
  const unsigned b = (unsigned)__builtin_bit_cast(unsigned short, h);
  const unsigned m = (unsigned)((int)(b << 16) >> 31);
  return (b ^ (m | 0x8000u)) & 0xFFFFu;
}
__device__ __forceinline__ int wave_isum_dpp(int v) {
  v += __builtin_amdgcn_update_dpp(0, v, 0xB1, 0xF, 0xF, true);
  v += __builtin_amdgcn_update_dpp(0, v, 0x4E, 0xF, 0xF, true);
  v += __builtin_amdgcn_update_dpp(0, v, 0x141, 0xF, 0xF, true);
  v += __builtin_amdgcn_update_dpp(0, v, 0x140, 0xF, 0xF, true);
  v += __builtin_amdgcn_update_dpp(0, v, 0x142, 0xA, 0xF, true);
  v += __builtin_amdgcn_update_dpp(0, v, 0x143, 0xC, 0xF, true);
  return __builtin_amdgcn_readlane(v, 63);
}
__device__ __forceinline__ void tk_count4(unsigned& acc, const v4u k, unsigned cm1p, unsigned one2) {
  unsigned t0, t1, t2, t3;
  asm("v_pk_sub_u16 %1, %5, %9 clamp\n\tv_pk_sub_u16 %2, %6, %9 clamp\n\tv_pk_sub_u16 %3, %7, %9 clamp\n\tv_pk_sub_u16 %4, %8, %9 clamp\n\t"
      "v_pk_min_u16 %1, %1, %10\n\tv_pk_min_u16 %2, %2, %10\n\tv_pk_min_u16 %3, %3, %10\n\tv_pk_min_u16 %4, %4, %10\n\t"
      "v_pk_add_u16 %1, %1, %2\n\tv_pk_add_u16 %3, %3, %4\n\tv_pk_add_u16 %0, %0, %1\n\tv_pk_add_u16 %0, %0, %3"
      : "+v"(acc), "=&v"(t0), "=&v"(t1), "=&v"(t2), "=&v"(t3)
      : "v"(k.x), "v"(k.y), "v"(k.z), "v"(k.w), "v"(cm1p), "v"(one2));
}
template <int NQ> __device__ __forceinline__ int tk_count(const v4u (&kq)[NQ], unsigned cm1p, unsigned one2) {
  unsigned a0 = 0u, a1 = 0u;
#pragma unroll
  for (int q = 0; q < NQ; ++q) { if (q & 1) tk_count4(a1, kq[q], cm1p, one2); else tk_count4(a0, kq[q], cm1p, one2); }
  const unsigned a = a0 + a1;
  return wave_isum_dpp((int)((a & 0xffffu) + (a >> 16)));
}
template <int NQ> __device__ __forceinline__ void tk_select(const LAS us* KEYS, const LAS unsigned* HIST, unsigned char* MWB, int T0, int N_unit, int nkw, int wave, int lane) {
  const unsigned one2 = 0x00010001u;
#pragma unroll 1
  for (int jj = 0; jj < 2; ++jj) {
    const int j = 2 * wave + jj;
    v4u kq[NQ];
#pragma unroll
    for (int q = 0; q < NQ; ++q) {
      const int ci = lane + 64 * q;
      kq[q] = (v4u){0u, 0u, 0u, 0u};
      if (ci * 8 < N_unit) kq[q] = *(const LAS v4u*)(KEYS + j * 4096 + ci * 8);
    }
    unsigned prefix = 0u; int cge = 0, bit0 = 15;
    {
      const unsigned h01 = HIST[j * 128 + 2 * lane], h23 = HIST[j * 128 + 2 * lane + 1];
      const int c0 = (int)(h01 & 0xffffu), c1 = (int)(h01 >> 16), c2 = (int)(h23 & 0xffffu), c3 = (int)(h23 >> 16);
      const int t4 = (c0 + c1) + (c2 + c3);
      int p = t4;
      p += __builtin_amdgcn_update_dpp(0, p, 0x111, 0xF, 0xF, true);
      p += __builtin_amdgcn_update_dpp(0, p, 0x112, 0xF, 0xF, true);
      p += __builtin_amdgcn_update_dpp(0, p, 0x114, 0xF, 0xF, true);
      p += __builtin_amdgcn_update_dpp(0, p, 0x118, 0xF, 0xF, true);
      p += __builtin_amdgcn_update_dpp(0, p, 0x142, 0xA, 0xF, true);
      p += __builtin_amdgcn_update_dpp(0, p, 0x143, 0xC, 0xF, true);
      const int total = __builtin_amdgcn_readlane(p, 63);
      const int suf = total - p + t4;
      const unsigned long long okm = __ballot(suf >= TOPK);
      if (okm != 0ull) {
        const int ls = 63 - __builtin_clzll(okm);
        const int above = __builtin_amdgcn_readlane(suf - t4, ls);
        const int d3 = __builtin_amdgcn_readlane(c3, ls), d2 = __builtin_amdgcn_readlane(c2, ls), d1 = __builtin_amdgcn_readlane(c1, ls), d0 = __builtin_amdgcn_readlane(c0, ls);
        int bsel, cnt_ge;
        if (above + d3 >= TOPK) { bsel = 3; cnt_ge = above + d3; }
        else if (above + d3 + d2 >= TOPK) { bsel = 2; cnt_ge = above + d3 + d2; }
        else if (above + d3 + d2 + d1 >= TOPK) { bsel = 1; cnt_ge = above + d3 + d2 + d1; }
        else { bsel = 0; cnt_ge = above + d3 + d2 + d1 + d0; }
        prefix = (unsigned)(4 * ls + bsel) << 8; cge = cnt_ge; bit0 = 7;
      }
    }
#pragma unroll 1
    for (int bit = bit0; bit >= 0; --bit) {
      const unsigned cand = prefix | (1u << bit), cm1 = cand - 1u, cp = cm1 | (cm1 << 16);
      const int cnt = tk_count<NQ>(kq, cp, one2);
      if (cnt >= TOPK) { prefix = cand; cge = cnt; }
    }
    const unsigned tau = prefix, tp = tau | (tau << 16);
    unsigned char* mrow = MWB + (size_t)(T0 + j) * 512;
#define TK_STORE(q_, f0, f1, f2, f3) do { const unsigned by_ = ((f0) & 1u) | (((f0) >> 16) << 1) | (((f1) & 1u) << 2) | (((f1) >> 16) << 3) | (((f2) & 1u) << 4) | (((f2) >> 16) << 5) | \
        (((f3) & 1u) << 6) | (((f3) >> 16) << 7); const int ci_ = lane + 64 * (q_); if (ci_ * 8 < nkw) mrow[ci_] = (unsigned char)by_; } while (0)
    if (tau == 0u) {
#pragma unroll
      for (int q = 0; q < NQ; ++q) {
        TK_STORE(q, pk_min_u16(kq[q].x, one2), pk_min_u16(kq[q].y, one2), pk_min_u16(kq[q].z, one2), pk_min_u16(kq[q].w, one2)); }
    } else if (cge == TOPK) {
      const unsigned cm1 = tau - 1u, cp = cm1 | (cm1 << 16);
#pragma unroll
      for (int q = 0; q < NQ; ++q) {
        TK_STORE(q, pk_min_u16(pk_sub_sat_u16(kq[q].x, cp), one2), pk_min_u16(pk_sub_sat_u16(kq[q].y, cp), one2),
                 pk_min_u16(pk_sub_sat_u16(kq[q].z, cp), one2), pk_min_u16(pk_sub_sat_u16(kq[q].w, cp), one2)); }
    } else {
      const int cgt = tk_count<NQ>(kq, tp, one2);
      const int need = TOPK - cgt;
      int base = 0;
#pragma unroll
      for (int q = 0; q < NQ; ++q) {
        unsigned gt[4], eq[4];
        gt[0] = pk_min_u16(pk_sub_sat_u16(kq[q].x, tp), one2); gt[1] = pk_min_u16(pk_sub_sat_u16(kq[q].y, tp), one2);
        gt[2] = pk_min_u16(pk_sub_sat_u16(kq[q].z, tp), one2); gt[3] = pk_min_u16(pk_sub_sat_u16(kq[q].w, tp), one2);
        eq[0] = pk_min_u16(kq[q].x ^ tp, one2) ^ one2; eq[1] = pk_min_u16(kq[q].y ^ tp, one2) ^ one2;
        eq[2] = pk_min_u16(kq[q].z ^ tp, one2) ^ one2; eq[3] = pk_min_u16(kq[q].w ^ tp, one2) ^ one2;
        const unsigned es = (eq[0] + eq[1]) + (eq[2] + eq[3]);
        const int ecnt = (int)((es & 0xffffu) + (es >> 16));
        if (__ballot(ecnt != 0) != 0ull) {
          int pre = 0, tot = 0;
#pragma unroll
          for (int bb = 0; bb < 4; ++bb) {
            const unsigned long long bal = __ballot((ecnt >> bb) & 1);
            pre += (int)__builtin_amdgcn_mbcnt_hi((unsigned)(bal >> 32), __builtin_amdgcn_mbcnt_lo((unsigned)bal, 0u)) << bb;
            tot += __popcll(bal) << bb;
          }
          int rk = base + pre;
#pragma unroll
          for (int d = 0; d < 4; ++d) {
            const unsigned e_lo = eq[d] & 1u, e_hi = eq[d] >> 16;
            const unsigned s_lo = (e_lo && rk < need) ? 1u : 0u; rk += (int)e_lo;
            const unsigned s_hi = (e_hi && rk < need) ? 1u : 0u; rk += (int)e_hi;
            gt[d] |= s_lo | (s_hi << 16);
          }
          base += tot;
        }
        TK_STORE(q, gt[0], gt[1], gt[2], gt[3]);
      }
    }
#undef TK_STORE
  }
}

__device__ __forceinline__ void topk_phase(LAS unsigned char* lds, unsigned char* ws, unsigned char* mw, int tid0, int mode, unsigned long long& amp_acc,
                                           volatile LAS unsigned* MISC, int mword, unsigned* qhead, int nunits, int blk_hi) {
  const int ampk = AMP_ON ? (mode >> 16) & 15 : 0;
  typedef float f32x16 __attribute__((ext_vector_type(16)));
  const us* QI = (const us*)(ws + WS_QI);
  const us* KI = (const us*)(ws + WS_KI);
  const float* WI = (const float*)(ws + WS_WI);
  unsigned char* MWB = mw;
  LAS us* KEYS = (LAS us*)lds;
  LAS unsigned* HIST = (LAS unsigned*)(lds + 131072);
  const int wave_u = __builtin_amdgcn_readfirstlane(tid0 >> 6);
  int tid = tid0;
  for (;;) {
    if (wave_u == 0) {
      unsigned v_ = 0u;
      if ((tid0 & 63) == 0) v_ = __hip_atomic_fetch_add(qhead, 1u, __ATOMIC_RELAXED, __HIP_MEMORY_SCOPE_AGENT);
      MISC[mword] = (unsigned)__builtin_amdgcn_readfirstlane((int)v_);
    }
    __syncthreads();
    const int u = __builtin_amdgcn_readfirstlane((int)MISC[mword]);
    if (u >= nunits) break;
    asm volatile("" : "+v"(tid));
    const int lane = tid & 63, wave = tid >> 6;
    const int r = lane & 31, hh = lane >> 5;
    const int a_tok = ((r >> 3) >> 1) + 2 * ((r >> 2) & 1), a_head = (r & 3) + 4 * ((r >> 3) & 1);
    const int rp = wave & 1, kg = wave >> 1;
    const int b = u & 3, blk = blk_hi - (u >> 2);
    const int tt0 = blk * 16, T0 = b * S + tt0, tmax = tt0 + 15, nkt = (tmax >> 5) + 1;
    ((LAS v4u*)HIST)[tid] = (v4u){0u, 0u, 0u, 0u};
    __syncthreads();
    const unsigned long long ta_ = AMP_ON ? __builtin_amdgcn_s_memrealtime() : 0ull;
    if (!(mode & 2)) {
      bf16x8 afr[2][4];
#pragma unroll
      for (int mt = 0; mt < 2; ++mt)
#pragma unroll
        for (int ks = 0; ks < 4; ++ks) afr[mt][ks] = *(const bf16x8*)(QI + (size_t)(T0 + 8 * rp + 4 * mt + a_tok) * 512 + a_head * 64 + 16 * ks + 8 * hh);
      float wv[2][16];
#pragma unroll
      for (int mt = 0; mt < 2; ++mt)
#pragma unroll
        for (int tl = 0; tl < 2; ++tl) {
          const float* wp = WI + (size_t)(T0 + 8 * rp + 4 * mt + tl + 2 * hh) * 8;
          const f32x4 w0 = *(const f32x4*)wp, w1 = *(const f32x4*)(wp + 4);
          wv[mt][8 * tl + 0] = w0.x; wv[mt][8 * tl + 1] = w0.y; wv[mt][8 * tl + 2] = w0.z; wv[mt][8 * tl + 3] = w0.w;
          wv[mt][8 * tl + 4] = w1.x; wv[mt][8 * tl + 5] = w1.y; wv[mt][8 * tl + 6] = w1.z; wv[mt][8 * tl + 7] = w1.w;
        }
      const us* kbase = KI + ((size_t)(b * (S / 32)) * 8 * 32 + hh * 32 + r) * 8;
      bf16x8 bA[4], bB[4];
      const int klast = nkt - 1;
#define TK_LOADB(dst, kt_) do { const int kc_ = (kt_) < klast ? (kt_) : klast; _Pragma("unroll") for (int ks = 0; ks < 4; ++ks) dst[ks] = *(const bf16x8*)(kbase + (size_t)kc_ * 2048 + 512 * ks); } while (0)
#define TK_TILE(bfr, kt_) do { \
        f32x16 acc[2]; \
        _Pragma("unroll") for (int mt = 0; mt < 2; ++mt) { \
          _Pragma("unroll") for (int i = 0; i < 16; ++i) acc[mt][i] = 0.f; \
          _Pragma("unroll") for (int ks = 0; ks < 4; ++ks) acc[mt] = __builtin_amdgcn_mfma_f32_32x32x16_bf16(afr[mt][ks], bfr[ks], acc[mt], 0, 0, 0); } \
        const int s = (kt_) * 32 + r; \
        _Pragma("unroll") for (int mt = 0; mt < 2; ++mt) \
          _Pragma("unroll") for (int tl = 0; tl < 2; ++tl) { \
            float sc = 0.f; \
            _Pragma("unroll") for (int h8 = 0; h8 < 8; ++h8) { const float rl_ = __int_as_float(max(__float_as_int(acc[mt][8 * tl + h8]), 0));   \
              asm("v_fmac_f32_e32 %0, %1, %2" : "+v"(sc) : "v"(wv[mt][8 * tl + h8]), "v"(rl_)); }     \
            const int tokl = 8 * rp + 4 * mt + tl + 2 * hh; \
            const unsigned key = (s <= tt0 + tokl) ? f16key(sc) : 0u; \
            KEYS[tokl * 4096 + s] = (us)key; \
            if (key) __hip_atomic_fetch_add(HIST + tokl * 128 + (key >> 9), 1u << ((key >> 4) & 16u), __ATOMIC_RELAXED, __HIP_MEMORY_SCOPE_WORKGROUP);     \
          } } while (0)
      if (kg < nkt) {
        TK_LOADB(bA, kg);
        for (int kt = kg; kt < nkt; kt += 4) {
          TK_LOADB(bB, kt + 4);
          TK_TILE(bA, kt);
#pragma unroll
          for (int ks = 0; ks < 4; ++ks) bA[ks] = bB[ks];
        }
      }
#undef TK_LOADB
#undef TK_TILE
    }
    __syncthreads();
    const unsigned long long tb_ = AMP_ON ? __builtin_amdgcn_s_memrealtime() : 0ull;
    if (ampk == 2) amp_acc += tb_ - ta_;
    {
      const int N_unit = nkt * 32;
      const int nkw = ((tt0 >> 8) + 1) * 256;
      const int nq = (nkw + 511) >> 9;
      if (mode & 1) continue;
      switch (nq) {
        case 1: tk_select<1>(KEYS, HIST, MWB, T0, N_unit, nkw, wave, lane); break;
        case 2: tk_select<2>(KEYS, HIST, MWB, T0, N_unit, nkw, wave, lane); break;
        case 3: tk_select<3>(KEYS, HIST, MWB, T0, N_unit, nkw, wave, lane); break;
        case 4: tk_select<4>(KEYS, HIST, MWB, T0, N_unit, nkw, wave, lane); break;
        case 5: tk_select<5>(KEYS, HIST, MWB, T0, N_unit, nkw, wave, lane); break;
        case 6: tk_select<6>(KEYS, HIST, MWB, T0, N_unit, nkw, wave, lane); break;
        case 7: tk_select<7>(KEYS, HIST, MWB, T0, N_unit, nkw, wave, lane); break;
        default: tk_select<8>(KEYS, HIST, MWB, T0, N_unit, nkw, wave, lane); break;
      }
      if (ampk == 3) amp_acc += __builtin_amdgcn_s_memrealtime() - tb_;
    }
  }
}

namespace attn_body {
using bf16=__hip_bfloat16;
using bf16x8=__attribute__((ext_vector_type(8)))short;
using s16x4=__attribute__((ext_vector_type(4)))short;
using f32x16=__attribute__((ext_vector_type(16)))float;
using u32x4=__attribute__((ext_vector_type(4)))unsigned;
constexpr int BATCH=4,NHEAD=8,SEQ=4096,D=64,DM=NHEAD*D;
constexpr int NW=8,QBLK=32,QB=QBLK*NW,KVBLK=64,NQB=SEQ/QB;
constexpr int ATTN_PITCH=DM, ATTN_UNIT_ROWS=QB;
__device__ __forceinline__ int crow(int r,int hi){return (r&3)+8*(r>>2)+4*hi;}
#define SBAR() __builtin_amdgcn_sched_barrier(0)
__device__ __forceinline__ void cmask(f32x16&p0,f32x16&p1,int jb,int qrel,int hi){
  const float NEG=-INFINITY; int kb=64*jb+4*hi;
  #pragma unroll
  for(int r=0;r<16;++r){int kv=kb+(r&3)+8*(r>>2); if(kv>qrel)p0[r]=NEG; if(kv+32>qrel)p1[r]=NEG;}
}

constexpr int NSLOT=3, SLOTB=8192;
constexpr int LDS_K=0, LDS_V=NSLOT*SLOTB, LDS_WS=2*NSLOT*SLOTB, LDS_OST=LDS_WS+NW*64*4, LDS_MK=LDS_OST+NW*4096, LDS_BYTES=LDS_MK+NW*2048;
constexpr float C2=0.125f*1.4426950408889634f;
__device__ __forceinline__ void glds16(const void*gsrc,unsigned lds_dst){unsigned keep;
  asm volatile("s_mov_b32 %0, m0\n\ts_mov_b32 m0, %2\n\ts_nop 0\n\tglobal_load_lds_dwordx4 %1, off\n\ts_mov_b32 m0, %0":"=&s"(keep):"v"(gsrc),"s"(lds_dst):"memory");}
__device__ __forceinline__ float max3f(float a,float b,float c){float r;asm("v_max3_f32 %0, %1, %2, %3":"=v"(r):"v"(a),"v"(b),"v"(c));return r;}
__device__ __forceinline__ float max2f(float a,float b){float r;asm("v_max_f32_e32 %0, %1, %2":"=v"(r):"v"(a),"v"(b));return r;}
__device__ __forceinline__ float fadd_s(float a,float b){float r;asm("v_add_f32_e32 %0, %1, %2":"=v"(r):"v"(a),"v"(b));return r;}
__device__ __forceinline__ float fsub_s(float a,float b){float r;asm("v_sub_f32_e32 %0, %1, %2":"=v"(r):"v"(a),"v"(b));return r;}
typedef float f32x2_t __attribute__((ext_vector_type(2))); typedef __bf16 bf16x2_t __attribute__((ext_vector_type(2)));
__device__ __forceinline__ unsigned cvtpk_s(float lo,float hi){f32x2_t v={lo,hi};bf16x2_t b=__builtin_convertvector(v,bf16x2_t);return __builtin_bit_cast(unsigned,b);}
#define WAIT_BAR(N) asm volatile("s_waitcnt vmcnt(" #N ") lgkmcnt(0)\n\ts_barrier":::"memory")

__device__ __forceinline__ void qkt(f32x16&p0,f32x16&p1,const char*Kslot,const bf16x8*qr,const f32x16&negm,int r32,int hi){
  const char*kb=Kslot+hi*1024+r32*16;
  #pragma unroll
  for(int d0=0;d0<4;++d0){
    const bf16x8 b0=*reinterpret_cast<const bf16x8*>(kb+d0*2048);
    const bf16x8 b1=*reinterpret_cast<const bf16x8*>(kb+d0*2048+512);
    if(d0==0){p0=__builtin_amdgcn_mfma_f32_32x32x16_bf16(b0,qr[0],negm,0,0,0);p1=__builtin_amdgcn_mfma_f32_32x32x16_bf16(b1,qr[0],negm,0,0,0);}
    else{p0=__builtin_amdgcn_mfma_f32_32x32x16_bf16(b0,qr[d0],p0,0,0,0);p1=__builtin_amdgcn_mfma_f32_32x32x16_bf16(b1,qr[d0],p1,0,0,0);}}
}
typedef __attribute__((address_space(3))) const char* lds_cptr;
typedef short v4i16_t __attribute__((ext_vector_type(4)));
__device__ __forceinline__ void kload8(bf16x8*kf,lds_cptr kp){
  kf[0]=*(const __attribute__((address_space(3))) bf16x8*)(kp);      kf[1]=*(const __attribute__((address_space(3))) bf16x8*)(kp+512);
  kf[2]=*(const __attribute__((address_space(3))) bf16x8*)(kp+2048); kf[3]=*(const __attribute__((address_space(3))) bf16x8*)(kp+2560);
  kf[4]=*(const __attribute__((address_space(3))) bf16x8*)(kp+4096); kf[5]=*(const __attribute__((address_space(3))) bf16x8*)(kp+4608);
  kf[6]=*(const __attribute__((address_space(3))) bf16x8*)(kp+6144); kf[7]=*(const __attribute__((address_space(3))) bf16x8*)(kp+6656);
}
__device__ __forceinline__ void kload2(bf16x8*kf,lds_cptr kp,int j){ kf[2*j]=*(const __attribute__((address_space(3))) bf16x8*)(kp+j*2048); kf[2*j+1]=*(const __attribute__((address_space(3))) bf16x8*)(kp+j*2048+512); }
__device__ __forceinline__ s16x4 vtr(lds_cptr p){ return __builtin_bit_cast(s16x4,__builtin_amdgcn_ds_read_tr16_b64_v4i16((__attribute__((address_space(3))) v4i16_t*)p)); }
__device__ __forceinline__ float rowmax(const f32x16&p0,const f32x16&p1){
  float a=max3f(p0[0],p0[1],p1[0]),b=max3f(p0[2],p0[3],p1[1]);a=max3f(a,p1[2],p1[3]);
  #pragma unroll
  for(int r=4;r<16;r+=4){a=max3f(a,p0[r],p0[r+1]);b=max3f(b,p0[r+2],p0[r+3]);a=max3f(a,p1[r],p1[r+1]);b=max3f(b,p1[r+2],p1[r+3]);}
  const float m=max2f(a,b);
  auto rr=__builtin_amdgcn_permlane32_swap(__float_as_uint(m),__float_as_uint(m),false,false);
  return max2f(__uint_as_float(rr[0]),__uint_as_float(rr[1]));
}
__device__ __forceinline__ void pv(f32x16*o,int vb,bf16x8 pa0,bf16x8 pa1,bf16x8 pa2,bf16x8 pa3){
  #pragma unroll
  for(int d0=0;d0<2;++d0){s16x4 lo[4],hi[4];
    #pragma unroll
    for(int ks=0;ks<4;++ks){
      asm volatile("ds_read_b64_tr_b16 %0,%1 offset:%c2":"=&v"(lo[ks]):"v"(vb),"i"(d0*4096+ks*1024):"memory");
      asm volatile("ds_read_b64_tr_b16 %0,%1 offset:%c2":"=&v"(hi[ks]):"v"(vb),"i"(d0*4096+ks*1024+512):"memory");}
    asm volatile("s_waitcnt lgkmcnt(0)":::"memory");SBAR();
    #define PK(k) (bf16x8){lo[k][0],lo[k][1],lo[k][2],lo[k][3],hi[k][0],hi[k][1],hi[k][2],hi[k][3]}
    o[d0]=__builtin_amdgcn_mfma_f32_32x32x16_bf16(pa0,PK(0),o[d0],0,0,0);
    o[d0]=__builtin_amdgcn_mfma_f32_32x32x16_bf16(pa1,PK(1),o[d0],0,0,0);
    o[d0]=__builtin_amdgcn_mfma_f32_32x32x16_bf16(pa2,PK(2),o[d0],0,0,0);
    o[d0]=__builtin_amdgcn_mfma_f32_32x32x16_bf16(pa3,PK(3),o[d0],0,0,0);
    #undef PK
  }
}

#ifndef ATTN_STORE16
#define ATTN_STORE16(p,v) asm volatile("global_store_dwordx4 %0, %1, off sc1\n\ts_nop 1"::"v"(p),"v"(v):"memory")
#endif
template<int THRL> __device__ __forceinline__ void attn_unit(int b,int h,int qb,const bf16*Q,const bf16*__restrict__ K,const bf16*__restrict__ V,bf16*O,const unsigned char*MW,unsigned*done,char*shm){
  const int tid=threadIdx.x,lane=tid&63,r32=lane&31,hi=lane>>5; const int wid=__builtin_amdgcn_readfirstlane(tid>>6);
  const long rowbase=(long)b*SEQ; const int q0=qb*QB;
  const bf16*Qw=Q+(rowbase+q0+wid*QBLK)*DM+h*D;
  const bf16*Kh=K+rowbase*DM+h*D,*Vh=V+rowbase*DM+h*D;
  const unsigned lds0=(unsigned)(uintptr_t)shm;
  float*wsf=(float*)(shm+LDS_WS)+wid*64;
  const bf16*ksrc=Kh+(long)lane*DM+wid*8;
  const bf16*vsrc=Vh+(long)(16*(wid&3)+(lane>>2))*DM+(wid>>2)*32+(lane&3)*8;
  const unsigned kdst=lds0+LDS_K+wid*1024, vdst=lds0+LDS_V+wid*1024;
  #define DMA_K(t,slot) glds16(ksrc+(long)(t)*KVBLK*DM,(unsigned)__builtin_amdgcn_readfirstlane(kdst+(slot)))
  #define DMA_V(t,slot) glds16(vsrc+(long)(t)*KVBLK*DM,(unsigned)__builtin_amdgcn_readfirstlane(vdst+(slot)))
  const int vb0=(int)(lds0+LDS_V)+((lane>>4)&1)*32+(lane&3)*8+(4*hi+((lane&15)>>2))*64;
  const char*Kbase=shm+LDS_K; bf16x8 kf[8];
  const lds_cptr shm3=(lds_cptr)shm; const lds_cptr kp0=shm3+LDS_K+hi*1024+r32*16; const lds_cptr vp0=shm3+LDS_V+((lane>>4)&1)*32+(lane&3)*8+(4*hi+((lane&15)>>2))*64;
  const int NT=(q0+QB)/KVBLK;
  const unsigned char*msrc=MW+((size_t)(rowbase+q0+wid*QBLK+(lane>>1)))*512+(lane&1)*16;
  const unsigned mdst=lds0+LDS_MK+wid*2048;
  #define MDMA(g) glds16(msrc+(g)*32,(unsigned)__builtin_amdgcn_readfirstlane(mdst+((g)&1)*1024))
  const lds_cptr mkp=(lds_cptr)shm+LDS_MK+wid*2048+r32*32;
  #define MWORD(t) (*(const __attribute__((address_space(3))) unsigned long long*)(mkp+(((t)>>2)&1)*1024+(((t)>>1)&1)*16+((t)&1)*8))
  #define MAPPLY(X,B,w) do{ X[B]=__uint_as_float(__float_as_uint(X[B])&(unsigned)__builtin_amdgcn_sbfe((int)(w),((B)&3)+8*((B)>>2),1)); }while(0)
  MDMA(0); if(q0+QB>4*KVBLK){MDMA(1);}
  DMA_K(0,0);DMA_V(0,0);DMA_K(1,SLOTB);
  bf16x8 qr[4];
  #pragma unroll
  for(int d0=0;d0<4;++d0)qr[d0]=*reinterpret_cast<const bf16x8*>(&Qw[(long)r32*DM+d0*16+hi*8]);
  float mhat=0.f,l_reg=0.f;f32x16 o[2];o[0]=f32x16{};o[1]=f32x16{};f32x16 negm=f32x16{};asm volatile("":"+v"(negm));
  const int qrel=wid*QBLK+r32;
  #define CMASK(P0,P1,t) do{int jb_=(t)-(NT-4); if(jb_>=0)cmask(P0,P1,jb_,qrel,hi);}while(0)
  bool resc=false;
  #define START(P0,P1) do{ const float rm=rowmax(P0,P1); resc=false; \
    { const float dl=rm; mhat=fadd_s(mhat,dl); \
      _Pragma("unroll") for(int r=0;r<16;++r){P0[r]=fsub_s(P0[r],dl);P1[r]=fsub_s(P1[r],dl);} \
      _Pragma("unroll") for(int r=0;r<16;++r)negm[r]=-mhat; asm volatile("":"+v"(negm)); } \
    _Pragma("unroll") for(int r=0;r<16;++r)P0[r]=__builtin_amdgcn_exp2f(P0[r]); }while(0)
  #define RESC() do{ if(resc){ asm volatile("s_waitcnt lgkmcnt(0)":::"memory"); \
      _Pragma("unroll") for(int d_=0;d_<2;++d_) _Pragma("unroll") for(int r=0;r<16;++r)o[d_][r]*=wsf[crow(r,hi)]; } }while(0)
  f32x16 pA0,pA1,pB0,pB1;
  int sl_prev=0,sl_cur=0,sl_next=SLOTB;
  #define ROT() do{sl_prev=sl_cur;sl_cur=sl_next;sl_next=(sl_next==(NSLOT-1)*SLOTB)?0:sl_next+SLOTB;}while(0)
  DMA_K(2,2*SLOTB);
  WAIT_BAR(3);
  qkt(pA0,pA1,Kbase,qr,negm,r32,hi);asm volatile("s_nop 15\n\ts_nop 7":"+v"(pA0),"+v"(pA1));
  START(pA0,pA1);
  _Pragma("unroll") for(int r=0;r<16;++r)pA1[r]=__builtin_amdgcn_exp2f(pA1[r]);
  { const unsigned long long mw_=MWORD(0); const unsigned wl_=(unsigned)mw_>>(4*hi), wh_=(unsigned)(mw_>>32)>>(4*hi);
    _Pragma("unroll") for(int r=0;r<16;++r){ MAPPLY(pA0,r,wl_); MAPPLY(pA1,r,wh_); } }
  WAIT_BAR(0);
  DMA_K(3,0);DMA_V(1,SLOTB);
  ROT();
  kload8(kf,kp0+sl_cur);
  WAIT_BAR(2);
  s16x4 vlo[8],vhi[8]; u32x4 pw0,pw1,pw2,pw3;
  #define PKW(P,B) cvtpk_s(P[B],P[B+1])
  #define PAF(k) __builtin_bit_cast(bf16x8,pw##k)
  #define VFR(i) (bf16x8){vlo[i][0],vlo[i][1],vlo[i][2],vlo[i][3],vhi[i][0],vhi[i][1],vhi[i][2],vhi[i][3]}
  #define PIN(x) asm volatile("":"+v"(x))
  #define MX3(a,b,c) __builtin_fmaxf(__builtin_fmaxf((a),(b)),(c))
  #define GAPA(MF,A0,A1,A2,A3,W0,W1,PW) do{ MF; sacc+=A0; sacc+=A1; sacc+=A2; sacc+=A3; PIN(sacc); W0; W1; PIN(PW); SBAR(); }while(0)
  #define EX(v) __builtin_amdgcn_exp2f(v)
  #define GAPB(MF,X,B,w) do{ MF; X[B]=EX(X[B]); X[B+1]=EX(X[B+1]); X[B+2]=EX(X[B+2]); X[B+3]=EX(X[B+3]); MAPPLY(X,B,w); MAPPLY(X,B+1,w); MAPPLY(X,B+2,w); MAPPLY(X,B+3,w); PIN(X); SBAR(); }while(0)
  #define VRD(i) do{ vlo[i]=vtr(vp_+(((i)>>2)*4096+((i)&3)*1024)); vhi[i]=vtr(vp_+(((i)>>2)*4096+((i)&3)*1024+512)); }while(0)
  #define KRD(G,j) do{ if(G){ kload2(kf,kp0+sl_next,j); SBAR(); } }while(0)
  #define STEP(C0,C1,P0,P1,t,GK,GV,GL) do{ SBAR(); \
    const lds_cptr vp_=vp0+sl_prev; \
    VRD(0); SBAR(); float sacc=(P0[0]+P0[1]); \
    GAPA(C0=__builtin_amdgcn_mfma_f32_32x32x16_bf16(kf[0],qr[0],negm,0,0,0), P0[2],P0[3],P0[4],P0[5],     pw0[0]=PKW(P0,0), pw0[1]=PKW(P0,2), pw0); \
    VRD(4); SBAR(); GAPA(C1=__builtin_amdgcn_mfma_f32_32x32x16_bf16(kf[1],qr[0],negm,0,0,0), P0[6],P0[7],P0[8],P0[9],     pw0[2]=PKW(P0,4), pw0[3]=PKW(P0,6), pw0); \
    VRD(1); SBAR(); GAPA(C0=__builtin_amdgcn_mfma_f32_32x32x16_bf16(kf[2],qr[1],C0,0,0,0),   P0[10],P0[11],P0[12],P0[13], pw1[0]=PKW(P0,8), pw1[1]=PKW(P0,10), pw1); \
    VRD(5); SBAR(); GAPA(C1=__builtin_amdgcn_mfma_f32_32x32x16_bf16(kf[3],qr[1],C1,0,0,0),   P0[14],P0[15],P1[0],P1[1],   pw1[2]=PKW(P0,12),pw1[3]=PKW(P0,14), pw1); \
    VRD(2); SBAR(); GAPA(C0=__builtin_amdgcn_mfma_f32_32x32x16_bf16(kf[4],qr[2],C0,0,0,0),   P1[2],P1[3],P1[4],P1[5],     pw2[0]=PKW(P1,0), pw2[1]=PKW(P1,2), pw2); \
    VRD(6); SBAR(); GAPA(C1=__builtin_amdgcn_mfma_f32_32x32x16_bf16(kf[5],qr[2],C1,0,0,0),   P1[6],P1[7],P1[8],P1[9],     pw2[2]=PKW(P1,4), pw2[3]=PKW(P1,6), pw2); \
    VRD(3); SBAR(); GAPA(C0=__builtin_amdgcn_mfma_f32_32x32x16_bf16(kf[6],qr[3],C0,0,0,0),   P1[10],P1[11],P1[12],P1[13], pw3[0]=PKW(P1,8), pw3[1]=PKW(P1,10), pw3); \
    VRD(7); SBAR(); GAPA(C1=__builtin_amdgcn_mfma_f32_32x32x16_bf16(kf[7],qr[3],C1,0,0,0),   P1[14],P1[15],0.f,0.f,       pw3[2]=PKW(P1,12),pw3[3]=PKW(P1,14), pw3); \
    l_reg+=sacc; \
    if((((t)&3)==0)&&((t)+4<NT)){MDMA(((t)>>2)+1);} \
    if(GK){DMA_K((t)+3,sl_cur);} if(GV){DMA_V((t)+1,sl_next);} \
    const unsigned long long mw_=MWORD(t); const unsigned wl_=(unsigned)mw_>>(4*hi), wh_=(unsigned)(mw_>>32)>>(4*hi); \
    { float a=MX3(C0[0],C0[1],C1[0]),b=MX3(C0[2],C0[3],C1[1]); a=MX3(a,C1[2],C1[3]); \
      _Pragma("unroll") for(int r=4;r<16;r+=4){a=MX3(a,C0[r],C0[r+1]);b=MX3(b,C0[r+2],C0[r+3]);a=MX3(a,C1[r],C1[r+1]);b=MX3(b,C1[r+2],C1[r+3]);} \
      float rm=__builtin_fmaxf(a,b); { auto rr=__builtin_amdgcn_permlane32_swap(__float_as_uint(rm),__float_as_uint(rm),false,false); rm=__builtin_fmaxf(__uint_as_float(rr[0]),__uint_as_float(rr[1])); } \
      resc=false; \
      if(__builtin_expect(__any(rm>(float)THRL),0)){ const float dl=__builtin_fmaxf(rm,0.f); mhat+=dl; \
        _Pragma("unroll") for(int r=0;r<16;++r){C0[r]-=dl;C1[r]-=dl;} \
        _Pragma("unroll") for(int r=0;r<16;++r)negm[r]=-mhat; asm volatile("":"+v"(negm)); \
        const float f=__builtin_amdgcn_exp2f(-dl); l_reg*=f; if(hi==0)wsf[r32]=f; resc=true; } } \
    SBAR(); \
    GAPB(o[0]=__builtin_amdgcn_mfma_f32_32x32x16_bf16(PAF(0),VFR(0),o[0],0,0,0), C0,0,wl_); \
    GAPB(o[1]=__builtin_amdgcn_mfma_f32_32x32x16_bf16(PAF(0),VFR(4),o[1],0,0,0), C0,4,wl_); \
    KRD(GL,0); GAPB(o[0]=__builtin_amdgcn_mfma_f32_32x32x16_bf16(PAF(1),VFR(1),o[0],0,0,0), C0,8,wl_); \
    KRD(GL,1); GAPB(o[1]=__builtin_amdgcn_mfma_f32_32x32x16_bf16(PAF(1),VFR(5),o[1],0,0,0), C0,12,wl_); \
    KRD(GL,2); GAPB(o[0]=__builtin_amdgcn_mfma_f32_32x32x16_bf16(PAF(2),VFR(2),o[0],0,0,0), C1,0,wh_); \
    KRD(GL,3); GAPB(o[1]=__builtin_amdgcn_mfma_f32_32x32x16_bf16(PAF(2),VFR(6),o[1],0,0,0), C1,4,wh_); \
    GAPB(o[0]=__builtin_amdgcn_mfma_f32_32x32x16_bf16(PAF(3),VFR(3),o[0],0,0,0), C1,8,wh_); \
    GAPB(o[1]=__builtin_amdgcn_mfma_f32_32x32x16_bf16(PAF(3),VFR(7),o[1],0,0,0), C1,12,wh_); \
    }while(0)
  int t=1;
  #undef CMASK
  #define CMASK(P0,P1,t) do{}while(0)
  for(;t+5<NT;t+=2){
    STEP(pB0,pB1,pA0,pA1,t,true,true,true);     WAIT_BAR(2); RESC(); ROT();
    STEP(pA0,pA1,pB0,pB1,t+1,true,true,true);   WAIT_BAR(2); RESC(); ROT();
  }
  #undef CMASK
  #define CMASK(P0,P1,t) do{int jb_=(t)-(NT-4); if(jb_>=0)cmask(P0,P1,jb_,qrel,hi);}while(0)
  #define ENDW(tt) do{ if((tt)+3<NT){WAIT_BAR(2);} else if((tt)+2<NT){WAIT_BAR(1);} else {WAIT_BAR(0);} }while(0)
  for(;t+1<NT;t+=2){
    STEP(pB0,pB1,pA0,pA1,t,(t+3<NT),(t+1<NT),(t+1<NT));       ENDW(t);   RESC(); ROT();
    STEP(pA0,pA1,pB0,pB1,t+1,(t+4<NT),(t+2<NT),(t+2<NT));     ENDW(t+1); RESC(); ROT();
  }
  STEP(pB0,pB1,pA0,pA1,NT-1,false,false,false); RESC();
  { float sacc=pB0[0]+pB0[1]; _Pragma("unroll") for(int r=2;r<16;++r)sacc+=pB0[r]; _Pragma("unroll") for(int r=0;r<16;++r)sacc+=pB1[r]; l_reg+=sacc;
    pw0=(u32x4){PKW(pB0,0),PKW(pB0,2),PKW(pB0,4),PKW(pB0,6)};pw1=(u32x4){PKW(pB0,8),PKW(pB0,10),PKW(pB0,12),PKW(pB0,14)};pw2=(u32x4){PKW(pB1,0),PKW(pB1,2),PKW(pB1,4),PKW(pB1,6)};pw3=(u32x4){PKW(pB1,8),PKW(pB1,10),PKW(pB1,12),PKW(pB1,14)};
    SBAR(); pv(o,vb0+sl_cur,PAF(0),PAF(1),PAF(2),PAF(3)); }
  #undef PKW
  #undef PAF
  #undef VFR
  #undef PIN
  #undef MX3
  #undef GAPA
  #undef GAPB
  #undef EX
  #undef VRD
  #undef KRD
  #undef STEP
  #undef ENDW
  {auto rr=__builtin_amdgcn_permlane32_swap(__float_as_uint(l_reg),__float_as_uint(l_reg),false,false);l_reg=__uint_as_float(rr[0])+__uint_as_float(rr[1]);}
  if(hi==0)wsf[32+r32]=l_reg;asm volatile("s_waitcnt lgkmcnt(0)":::"memory");
  float rli[16];
  #pragma unroll
  for(int r=0;r<16;++r)rli[r]=__builtin_amdgcn_rcpf(wsf[32+crow(r,hi)]);
  bf16*Ow=O+(rowbase+q0+wid*QBLK)*DM+h*D;
  { bf16*stg=(bf16*)(shm+LDS_OST)+wid*2048;
    #pragma unroll
    for(int r=0;r<16;++r){const int orow=crow(r,hi);
      #pragma unroll
      for(int d0=0;d0<2;++d0)stg[orow*64+d0*32+r32]=__float2bfloat16(o[d0][r]*rli[r]);}
    asm volatile("s_waitcnt lgkmcnt(0)":::"memory");
    #pragma unroll
    for(int i=0;i<4;++i){const int row=i*8+(lane>>3),ch=lane&7; const u32x4 v=*(const u32x4*)(stg+row*64+ch*8); ATTN_STORE16(Ow+(long)row*DM+ch*8,v);} }
  asm volatile("s_waitcnt vmcnt(0) lgkmcnt(0)\n\ts_barrier":::"memory");
  if(wid==1){ if(lane==0) __hip_atomic_fetch_add(done+b*16+qb,1u,__ATOMIC_RELAXED,__HIP_MEMORY_SCOPE_AGENT); }
  #undef DMA_K
  #undef DMA_V
  #undef CMASK
  #undef MDMA
  #undef MWORD
  #undef MAPPLY
  #undef START
  #undef RESC
  #undef ROT
}
constexpr int ATTN_LDS_BYTES=LDS_BYTES;
struct AttnTensors { const bf16* Q; const bf16* K; const bf16* V; bf16* O; const unsigned char* MW; unsigned* done; };
template<int THRL=8> __device__ __forceinline__ void attn_phase(char*lds,const AttnTensors&T,int grid,int block){
  for(int v0=block;v0<256;v0+=grid){
    const int vcu=(grid==256)?((v0%8)*32+v0/8):v0; const int bh=vcu>>3,s=vcu&7;
    attn_unit<THRL>(bh/NHEAD,bh%NHEAD,s,T.Q,T.K,T.V,T.O,T.MW,T.done,lds);
    attn_unit<THRL>(bh/NHEAD,bh%NHEAD,15-s,T.Q,T.K,T.V,T.O,T.MW,T.done,lds);
  }
}
#undef SBAR
#undef WAIT_BAR
}

__global__ void __launch_bounds__(512, 2) mk_fwd(Args args) {
  extern __shared__ __attribute__((aligned(16))) unsigned char lds_raw[];
  LAS unsigned char* lds = (LAS unsigned char*)lds_raw;
  volatile LAS unsigned* MISC = (volatile LAS unsigned*)(lds + MISC_OFF);
  const int tid = threadIdx.x, lane = tid & 63;
  const int wave = __builtin_amdgcn_readfirstlane(tid >> 6);
  const int G_ = gridDim.x;
  unsigned char* ws = args.ws;
  if (tid < 32) MISC[tid] = 0u;
  __syncthreads();
  XcdBarrier bar = xcd_barrier_post((unsigned*)(ws + WS_CTL) + CW_BAR + args.li * XCD_BAR_WORDS, MISC + 8);
  const int lo = args.ph_lo, hi = args.ph_hi;
#define IN(k) (lo <= (k) && (k) < hi)
  unsigned long long amp_acc = 0ull, t_lastexit = AMP_ON ? __builtin_amdgcn_s_memrealtime() : 0ull;
#define SEAM(k) do { if (IN(k) && (k) + 1 < hi) { if (!AMP_ON) { xcd_barrier(bar); } else { const unsigned long long tb_ = __builtin_amdgcn_s_memrealtime(); xcd_barrier(bar); const unsigned long long te_ = __builtin_amdgcn_s_memrealtime(); \
    if (((args.dup >> 16) & 15) == 1) amp_acc += te_ - tb_; \
    if (((args.dup >> 16) & 15) == 14 && (((unsigned)args.dup >> 28) & 15u) == (unsigned)(k)) amp_acc += te_ - t_lastexit; t_lastexit = te_; } } } while (0)

#define PHASE_IDS() int tid_p = tid; asm volatile("" : "+v"(tid_p)); const int lane_p = tid_p & 63; const int wave_p = __builtin_amdgcn_readfirstlane(tid_p >> 6)
#define AMP_T0() const unsigned long long tph_ = AMP_ON ? __builtin_amdgcn_s_memrealtime() : 0ull
#define AMP_T1(k) do { if (AMP_ON && ((args.dup >> 16) & 15) == 15 && (((unsigned)args.dup >> 28) & 15u) == (unsigned)(k)) amp_acc += __builtin_amdgcn_s_memrealtime() - tph_; } while (0)
  const float* x = args.in[0];
  const int* pos = (const int*)args.in[1];
  const float* g_mix = args.in[2];
  const float* w_in = args.in[3];
  us* WinT = (us*)(ws + WS_WIN); us* WcoT = (us*)(ws + WS_WCO); us* WaoT = (us*)(ws + WS_WAO); us* WoT = (us*)(ws + WS_WO);
  float* CT = (float*)(ws + WS_CT); float* ST = (float*)(ws + WS_ST);
  us* Hb = (us*)(ws + WS_HB);

  { AMP_T0(); if (IN(PH_PREP)) {
    LAS float* scr = (LAS float*)(lds + wave * 16384);
    const int gw = blockIdx.x * 8 + wave, NGW = G_ * 8;
    constexpr int I_IN = 16 * 168, I_CO = 8 * 32, I_AO = 8 * 32, I_O = 16 * 32;
    constexpr int NITEMS = I_IN + I_CO + I_AO + I_O;
    for (int it = gw; it < NITEMS; it += NGW) {
      int r = it;
      if (r < I_IN) { const int g = r % 168, kb = r / 168; p0_transpose_item(w_in, INC, 64 * kb, inproj_src(g), WinT, 1024, 32 * g, scr, lane); continue; }
      r -= I_IN;
      if (r < I_CO) { const int nb = r % 32, kb = r / 32; p0_transpose_item(args.in[8], 1024, 64 * kb, 32 * nb, WcoT, 512, 32 * nb, scr, lane); continue; }
      r -= I_CO;
      if (r < I_AO) { const int nb = r % 32, kb = r / 32; p0_transpose_item(args.in[9], 1024, 64 * kb, 32 * nb, WaoT, 512, 32 * nb, scr, lane); continue; }
      r -= I_AO;
      { const int nb = r % 32, kb = r / 32; p0_transpose_item(args.in[10], 1024, 64 * kb, 32 * nb, WoT, 1024, 32 * nb, scr, lane); }
    }
    for (int row = gw * 4; row < T; row += NGW * 4) rms_rows4_to_bf16(x + (size_t)row * D, g_mix, Hb + (size_t)row * D, lane);
    for (int i = blockIdx.x * 512 + tid; i < T * 32; i += G_ * 512) {
      const int t = i >> 5, d = i & 31;
      const float inv = 1.0f / powf(10000.0f, (float)(2 * d) / 64.0f);
      const float ang = (float)pos[t] * inv;
      const float n_ = rintf(ang * 0.15915494309189535f);
      float rr = __builtin_fmaf(-n_, 6.28125f, ang); rr = __builtin_fmaf(-n_, 1.9353071795864769e-3f, rr);
      const float rev = rr * 0.15915494309189535f;
      CT[i] = __builtin_amdgcn_cosf(rev); ST[i] = __builtin_amdgcn_sinf(rev);
    }
    for (int i = blockIdx.x * 512 + tid; i < 8192; i += G_ * 512) route_weights_item((us*)(ws + WS_WR), args.in[11], args.in[12], args.in[14], i);
  }
  AMP_T1(PH_PREP); }
  SEAM(PH_PREP);
  { AMP_T0(); if (IN(PH_INPROJ)) {
    pg8::Gemm g{Hb, WinT, T, NIN, D};
    InProjOrder So; So.init(T, NIN, G_, (int)blockIdx.x); So.dep = (unsigned*)(ws + WS_CTL) + CW_DEP;
    EpiInProj E;
    E.G = (us*)(ws + WS_G); E.Q = (us*)(ws + WS_Q); E.K = (us*)(ws + WS_K); E.V = (us*)(ws + WS_V); E.QI = (us*)(ws + WS_QI);
    E.KI = (us*)(ws + WS_KI); E.GC = (us*)(ws + WS_GC); E.GA = (us*)(ws + WS_GA); E.WI = (float*)(ws + WS_WI); E.CT = CT; E.ST = ST;
    pg8::gemm_phase<EpiInProj, InProjOrder, true, true>(lds, g, So, E);
    {
      const int nwg_ = (T / 256) * (NIN / 256); int n6 = nwg_ - 5 * G_; n6 = n6 < 0 ? 0 : (n6 > G_ ? G_ : n6);
      const bool all_ = (n6 == 0 || n6 == G_);
      const bool six = !all_ && (int)blockIdx.x < n6;
      const int nfree = all_ ? G_ : G_ - n6, myidx = all_ ? (int)blockIdx.x : (int)blockIdx.x - n6;
      if (!six && nfree > 0) {
        LAS float* scr = (LAS float*)(lds + wave * 16384);
        constexpr int I_GU = 16 * 16 * 16, I_DN = 16 * 4 * 32;
        for (int it = myidx * 8 + wave; it < I_GU + I_DN; it += nfree * 8) {
          int r = it;
      if (r < I_GU) {
        const int g16 = r & 15, kb = (r >> 4) & 15, e = r >> 8; const int ct = g16 >> 3, half = (g16 >> 2) & 1, q = g16 & 3;
        p0_transpose_item_fm((half ? args.in[17] : args.in[16]) + (size_t)e * 1024 * 256, 256, 64 * kb, 128 * ct + 32 * q, (us*)(ws + WS_WGU), 1024,
                             e * 16 + ct * 8 + half * 4 + q, scr, lane, args.in[11]);
        continue; }
      r -= I_GU;
      { const int g = r & 31, kb = (r >> 5) & 3, e = r >> 7;
        p0_transpose_item_fm(args.in[18] + (size_t)e * 256 * 1024, 1024, 64 * kb, 32 * g, (us*)(ws + WS_WD), 256, e * 32 + g, scr, lane); }
        }
      }
    }
  }
  AMP_T1(PH_INPROJ); }
  { AMP_T0(); if (IN(PH_TOPK)) { PHASE_IDS();
    unsigned* ctl_ = (unsigned*)(ws + WS_CTL);
    if (threadIdx.x < 64) {
      unsigned sp = 0;
      while ((unsigned)__builtin_amdgcn_readfirstlane(__hip_atomic_load(ctl_ + CW_DEP, __ATOMIC_RELAXED, __HIP_MEMORY_SCOPE_AGENT)) < DEP_TARGET) { __builtin_amdgcn_s_sleep(2); if (++sp > (1u << 22)) break; }
      __builtin_amdgcn_fence(__ATOMIC_ACQUIRE, "agent");
      asm volatile("s_waitcnt vmcnt(0)" ::: "memory");
    }
    __syncthreads();
    topk_phase(lds, ws, (unsigned char*)args.out, tid_p, args.dup, amp_acc, MISC, 20, ctl_ + CW_TQ, 768, 255);
    conv_phase(lds, ws, args.in[4], args.in[5], args.in[6], args.in[7], tid_p, lane_p, wave_p, MISC, ctl_ + CW_TQ + 1);
    topk_phase(lds, ws, (unsigned char*)args.out, tid_p, args.dup, amp_acc, MISC, 22, ctl_ + CW_TQ + 2, 256, 63);
  }
  AMP_T1(PH_TOPK); }
  SEAM(PH_TOPK);
  { AMP_T0(); if (IN(PH_ATTN)) {
    attn_body::AttnTensors Tn{(const attn_body::bf16*)(ws + WS_Q), (const attn_body::bf16*)(ws + WS_K), (const attn_body::bf16*)(ws + WS_V),
                              (attn_body::bf16*)(ws + WS_AO), (const unsigned char*)args.out, (unsigned*)(ws + WS_CTL) + CW_ATTN};
    attn_body::attn_phase<8>((char*)lds_raw, Tn, G_, (int)blockIdx.x);
  }
  AMP_T1(PH_ATTN); }
  { AMP_T0(); if (IN(PH_MIX)) {
    us* M1 = (us*)(ws + WS_M1);
    DualOrder So; So.init(T, 1024, G_, (int)blockIdx.x); So.ready = (const unsigned*)(ws + WS_CTL) + CW_ATTN;
    pg8::Gemm g0{(const us*)(ws + WS_NA), WcoT, T, 1024, 512}, g1{(const us*)(ws + WS_AO), WaoT, T, 1024, 512};
    EpiGate2 E; E.gc = (const us*)(ws + WS_GC); E.ga = (const us*)(ws + WS_GA); E.M1 = M1;
    pg8::gemm_phase<EpiGate2, DualOrder, true, true>(lds, g0, So, E, g1);
  }
  AMP_T1(PH_MIX); }
  SEAM(PH_MIX);
  { AMP_T0(); if (IN(PH_WO)) {
    pg8::Gemm g{(const us*)(ws + WS_M1), WoT, T, 1024, 1024};
    pg8::StaticOrder So; So.init(T, 1024, G_, (int)blockIdx.x);
    EpiRes E; E.base = x; E.x1b = (us*)(ws + WS_X1B);
    pg8::gemm_phase<EpiRes, pg8::StaticOrder, true, true>(lds, g, So, E);
  }
  AMP_T1(PH_WO); }
  SEAM(PH_WO);
  const unsigned long long tr0_ = AMP_ON ? __builtin_amdgcn_s_memrealtime() : 0ull;
  if (IN(PH_ROUTE)) { PHASE_IDS(); route_phase(lds, ws, (const us*)(ws + WS_X1B), args.in[13], args.in[15], tid_p, lane_p, wave_p, args.dup); }
  if (AMP_ON && ((args.dup >> 16) & 15) == 4) amp_acc += __builtin_amdgcn_s_memrealtime() - tr0_;
  SEAM(PH_ROUTE);
  { AMP_T0(); if (IN(PH_MOE1)) { PHASE_IDS(); moe_phase<0>(lds, ws, MISC, tid_p, args.dup); }
  AMP_T1(PH_MOE1); }
  SEAM(PH_MOE1);
  if (AMP_ON && ((args.dup >> 16) & 15) == 5) { for (int i_ = 0; i_ < 10; ++i_) xcd_barrier(bar); }
  { AMP_T0(); if (IN(PH_FINAL)) { PHASE_IDS(); final_phase(ws, (const us*)(ws + WS_X1B), args.out, args.in[19], lane_p, wave_p, args.dup); }
  AMP_T1(PH_FINAL); }
  if (AMP_ON && ((args.dup >> 16) & 15) && (int)blockIdx.x == ((args.dup >> 20) & 255)) { const unsigned long long t1 = __builtin_amdgcn_s_memrealtime(); while (__builtin_amdgcn_s_memrealtime() - t1 < 9ull * amp_acc) __builtin_amdgcn_s_sleep(8); }
}

constexpr int SHIP_MODE = 0;
constexpr int PROBE_MODE = 0;
constexpr int PROBE_K = -1;
extern "C" void kernel_launch(void* const* d_in, const int* in_sizes, int n_in, void* d_out, int out_size, void* d_ws, size_t ws_size,
                              hipStream_t stream) {
  static int grid = 0;
  if (grid == 0) {
    int dev = 0, cus = 0, per_cu = 0;
    hipGetDevice(&dev);
    hipDeviceGetAttribute(&cus, hipDeviceAttributeMultiprocessorCount, dev);
    hipFuncSetAttribute((const void*)mk_fwd, hipFuncAttributeMaxDynamicSharedMemorySize, LDS_BYTES);
    hipOccupancyMaxActiveBlocksPerMultiprocessor(&per_cu, (const void*)mk_fwd, 512, LDS_BYTES);
    if (per_cu < 1) { fprintf(stderr, "kernel_launch: occupancy query says %d blocks/CU\n", per_cu); per_cu = 1; }
    grid = cus;
  }
  hipMemsetAsync((char*)d_ws + WS_CTL, 0, CTL_ZERO_BYTES, stream);
  Args a{};
  for (int i = 0; i < 20; ++i) a.in[i] = (const float*)d_in[i];
  a.out = (float*)d_out; a.ws = (unsigned char*)d_ws;
  auto launch = [&](int lo, int hi, int li, int mode = 0) {
    a.ph_lo = lo; a.ph_hi = hi; a.li = li; a.dup = mode;
    void* kargs[] = {&a};
    hipError_t e = hipLaunchCooperativeKernel((const void*)mk_fwd, dim3(grid), dim3(512), kargs, LDS_BYTES, stream);
    if (e != hipSuccess) fprintf(stderr, "cooperative launch failed: %s (grid %d)\n", hipGetErrorString(e), grid);
  };
  if (PROBE_K == -1) launch(PH_PREP, PH_END, 0, SHIP_MODE);
  else if (PROBE_K == -2) { launch(PH_PREP, PH_ATTN, 0); launch(PH_ATTN, PH_MIX, 1); launch(PH_MIX, PH_END, 2); }
  else { int li = 0; if (PROBE_K > 0) launch(PH_PREP, PROBE_K, li++); launch(PROBE_K, PROBE_K + 1, li++, PROBE_MODE); if (PROBE_K == PH_MOE1) hipMemsetAsync((char*)d_ws + WS_CTL + 96 * 4, 0, (512 - 96) * 4, stream); launch(PROBE_K, PROBE_K + 1, li++); if (PROBE_K + 1 < PH_END) launch(PROBE_K + 1, PH_END, li++); }

}
```

```cpp
#include <hip/hip_runtime.h>
#include <hip/hip_bf16.h>
#include <stdint.h>
#include <cstdio>

typedef unsigned short us;

constexpr int D = 1024, NB = 4, S = 4096, T = NB * S;
constexpr int TOPK = 256;
constexpr float EPS = 1e-6f;
constexpr int OFF_U = 0, OFF_Q = 1024, OFF_K = 1536, OFF_V = 2048, OFF_QI = 2560, OFF_KI = 3072, OFF_WI = 3136,
              OFF_GC = 3144, OFF_GA = 4168, INC = 5192;
constexpr int NIN = 5376;
constexpr float QSCALE = 0.125f * 1.4426950408889634f;
constexpr float IDX_SCALE = 0.04419417382415922f;

__device__ __forceinline__ us f2bf_(float f) {
  unsigned u = __float_as_uint(f);
  u += 0x7FFFu + ((u >> 16) & 1u);
  return (us)(u >> 16);
}
__device__ __forceinline__ float bf2f(us h) { return __uint_as_float(((unsigned)h) << 16); }
__device__ __forceinline__ float sigmoidf_(float x) { return 1.0f / (1.0f + expf(-x)); }
__device__ __forceinline__ float fsigmoid(float x) { return __builtin_amdgcn_rcpf(1.0f + __builtin_amdgcn_exp2f(-1.4426950408889634f * x)); }

namespace pg8 {
#define PG8_LAS __attribute__((address_space(3)))
typedef unsigned short bf16_t;
typedef short bf16x8 __attribute__((ext_vector_type(8)));
typedef float f32x4 __attribute__((ext_vector_type(4)));
typedef unsigned u32x4 __attribute__((ext_vector_type(4)));
constexpr int BM = 256, BK = 64, HALF = 128, HTB = HALF * BK * 2  , STAGE_BYTES = 8 * HTB, NXCD = 8, WGM = 8;

__host__ __device__ __forceinline__ int lds_byte(int r, int c) { const int st = (r >> 4) * 2 + (c >> 5), rr = r & 15, cc = c & 31, ob = rr * 64 + cc * 2; return st * 1024 + (ob ^ (((ob >> 9) & 1) << 5)); }
__host__ __device__ __forceinline__ void stage_rc(int b, int& R, int& C) { const int st = b / 1024, sb = b % 1024, swz = sb ^ (((sb >> 9) & 1) << 5); R = (st >> 1) * 16 + swz / 64; C = (st & 1) * 32 + (swz % 64) / 2; }
__host__ __device__ __forceinline__ int perm32(int rho) { const int n = rho >> 4, i = rho & 15; return 8 * (i >> 2) + 4 * n + (i & 3); }

struct Unit { int pm, pn, sel; };
struct Gemm { const bf16_t* A; const bf16_t* Bt; int M, N, K; };

struct StaticOrder {
    int nM, nN, nwg, G, c;
    __host__ __device__ void init(int M, int N, int G_, int c_) { nM = M / BM; nN = N / BM; nwg = nM * nN; G = G_; c = c_; }
    __host__ __device__ bool next(int i, Unit& u) const {
        const long L = (long)i * G + c; if (L >= nwg) return false;
        int wgid = (int)L; { const int q = nwg / NXCD, r = nwg % NXCD, xcd = wgid % NXCD, off = wgid / NXCD; wgid = (xcd < r ? xcd * (q + 1) : r * (q + 1) + (xcd - r) * q) + off; }
        const int nig = WGM * nN, gid = wgid / nig, fm = gid * WGM, gsz = (nM - fm) < WGM ? (nM - fm) : WGM;
        u.pm = fm + ((wgid % nig) % gsz); u.pn = (wgid % nig) / gsz; u.sel = 0; return true;
    }
    __device__ __forceinline__ void a_ready(const Unit&) const {}
    __device__ __forceinline__ void done(const Unit&) const {}
};

__device__ __forceinline__ unsigned cvt_pk_bf16(float lo, float hi) { unsigned r; asm volatile("v_cvt_pk_bf16_f32 %0, %1, %2" : "=v"(r) : "v"(lo), "v"(hi)); return r; }
typedef float f32x2 __attribute__((ext_vector_type(2)));
__device__ __forceinline__ f32x2 gelu_pk(f32x2 v) {
    const f32x2 av = __builtin_elementwise_abs(v), d = av * 0.2316418882f + 1.0f;
    f32x2 t; t.x = __builtin_amdgcn_rcpf(d.x); t.y = __builtin_amdgcn_rcpf(d.y);
    f32x2 q = t * 0.5307027145f + (-0.7265760135f); q = q * t + 0.7107068705f; q = q * t + (-0.142248368f); q = q * t + 0.127414796f; q = q * t;
    const f32x2 s = (v * v) * (-0.72134752044f);
    f32x2 e; e.x = __builtin_amdgcn_exp2f(s.x); e.y = __builtin_amdgcn_exp2f(s.y);
    const f32x2 m = v * (q * e), r = v - m;
    f32x2 o; o.x = v.x < 0.f ? m.x : r.x; o.y = v.y < 0.f ? m.y : r.y; return o;
}

template <int ACT  > struct EpiBf16 {
    static constexpr bool PERM = true, AFTER_DRAIN = false, CHAIN = false; static_assert(ACT == 0 || ACT == 1, "EpiBf16: ACT is 0 (none) or 1 (gelu_pk)");
    bf16_t* O; int ldc; const float* bias; int split_cols; size_t split_stride; float scale0;
    __device__ __forceinline__ void operator()(const f32x4 (&acc)[2][2][4][2], const Unit& u, int wr, int wc, int fr, int fq) const {
        const int row0 = u.pm * BM + wr * 64 + fr; int colt = u.pn * BM; bf16_t* base = O;
        float sc = 1.f; if (split_cols) { const int t = colt / split_cols; base += (size_t)t * split_stride; colt -= t * split_cols; if (t == 0) sc = scale0; }
        const int col0 = colt + wc * 32 + 8 * fq, bcol0 = u.pn * BM + wc * 32 + 8 * fq;
        f32x4 bv[2][2];
#pragma unroll
        for (int bj = 0; bj < 2; ++bj)
#pragma unroll
            for (int n = 0; n < 2; ++n) bv[bj][n] = bias ? *(const f32x4*)(bias + bcol0 + bj * HALF + 4 * n) : (f32x4){0.f, 0.f, 0.f, 0.f};
#pragma unroll
        for (int ai = 0; ai < 2; ++ai)
#pragma unroll
            for (int m = 0; m < 4; ++m) { bf16_t* rowp = base + (size_t)(row0 + ai * HALF + m * 16) * ldc + col0;
#pragma unroll
                for (int bj = 0; bj < 2; ++bj) { f32x4 v0 = acc[ai][bj][m][0] + bv[bj][0], v1 = acc[ai][bj][m][1] + bv[bj][1];
                    if (ACT == 1) { f32x2 a = gelu_pk((f32x2){v0[0], v0[1]}), b = gelu_pk((f32x2){v0[2], v0[3]}), c = gelu_pk((f32x2){v1[0], v1[1]}), d = gelu_pk((f32x2){v1[2], v1[3]});
                        v0 = (f32x4){a.x, a.y, b.x, b.y}; v1 = (f32x4){c.x, c.y, d.x, d.y}; }
                    v0 = v0 * sc; v1 = v1 * sc; u32x4 w; w.x = cvt_pk_bf16(v0[0], v0[1]); w.y = cvt_pk_bf16(v0[2], v0[3]); w.z = cvt_pk_bf16(v1[0], v1[1]); w.w = cvt_pk_bf16(v1[2], v1[3]);
                    *(u32x4*)(rowp + bj * HALF) = w; } }
    }
};

struct PanelStats {
    unsigned* xbuf;
    unsigned* cnt;
    unsigned* tmo;
    int ntn; float eps;
    unsigned code;
    __device__ __forceinline__ bool run(const f32x4 (&v)[2][2][4][2], const Unit& u, int wr, int wc, int fr, int fq, PG8_LAS unsigned char* lds, int wid, int lane) const {
        typedef float f32x2v __attribute__((ext_vector_type(2)));
        PG8_LAS f32x2v* P = (PG8_LAS f32x2v*)lds;
        PG8_LAS f32x2v* S = (PG8_LAS f32x2v*)(lds + 8192);
        PG8_LAS unsigned* flag = (PG8_LAS unsigned*)(lds + 8192 + 2048);
#pragma unroll
        for (int ai = 0; ai < 2; ++ai)
#pragma unroll
            for (int m = 0; m < 4; ++m) {
                float s = 0.f;
#pragma unroll
                for (int bj = 0; bj < 2; ++bj)
#pragma unroll
                    for (int n = 0; n < 2; ++n) { const f32x4 x = v[ai][bj][m][n]; s += (x[0] + x[1]) + (x[2] + x[3]); }
                s += __shfl_xor(s, 16); s += __shfl_xor(s, 32);
                const float mw = s * (1.0f / 64.0f); float q = 0.f;
#pragma unroll
                for (int bj = 0; bj < 2; ++bj)
#pragma unroll
                    for (int n = 0; n < 2; ++n) { const f32x4 d = v[ai][bj][m][n] - mw; q += (d[0] * d[0] + d[1] * d[1]) + (d[2] * d[2] + d[3] * d[3]); }
                q += __shfl_xor(q, 16); q += __shfl_xor(q, 32);
                if (fq == 0) P[(ai * HALF + wr * 64 + m * 16 + fr) * 4 + wc] = (f32x2v){mw, q};
            }
        asm volatile("s_waitcnt lgkmcnt(0)" ::: "memory"); __builtin_amdgcn_s_barrier(); asm volatile("" ::: "memory");
#if defined(BROKEN_EXCHANGE_NO_WAIT)
#warning BROKEN CONTROL BUILD: the row-statistics exchange does not wait; results are wrong by design
        if (blockIdx.x >= 64) { const long long t0_ = clock64(); while (clock64() - t0_ < 60000) __builtin_amdgcn_s_sleep(8); }
#endif
        const int row = wid * 32 + (lane & 31);
        if (lane < 32) {
            const f32x2v a = P[row * 4 + 0], b = P[row * 4 + 1], c = P[row * 4 + 2], d = P[row * 4 + 3];
            const float mt = (a.x + b.x + c.x + d.x) * 0.25f;
            const float da = a.x - mt, db = b.x - mt, dc = c.x - mt, dd = d.x - mt;
            const float m2 = (a.y + b.y) + (c.y + d.y) + 64.0f * ((da * da + db * db) + (dc * dc + dd * dd));
            unsigned long long* slot = (unsigned long long*)xbuf + ((size_t)(u.pm * BM + row) * 4 + u.pn);
            __hip_atomic_store(slot, ((unsigned long long)__float_as_uint(m2) << 32) | __float_as_uint(mt), __ATOMIC_RELAXED, __HIP_MEMORY_SCOPE_AGENT);
        }
        asm volatile("s_waitcnt vmcnt(0)" ::: "memory");
        if (lane == 0) __hip_atomic_fetch_add(cnt + 64 * u.pm, 1u, __ATOMIC_RELAXED, __HIP_MEMORY_SCOPE_AGENT);
        if (wid == 0) {
            bool dead = false; const unsigned long long t0 = __builtin_amdgcn_s_memrealtime(); const unsigned want = 8u * (unsigned)ntn;
            for (;;) {
#if defined(BROKEN_EXCHANGE_NO_WAIT)
                break;
#endif
                if ((unsigned)__builtin_amdgcn_readfirstlane(__hip_atomic_load(cnt + 64 * u.pm, __ATOMIC_RELAXED, __HIP_MEMORY_SCOPE_AGENT)) >= want) break;
                if (__builtin_amdgcn_s_memrealtime() - t0 > 2000000ull) {
                    if (lane == 0) { unsigned expect = 0u; __hip_atomic_compare_exchange_strong(tmo + 1, &expect, code | (unsigned)(u.pm & 0xff), __ATOMIC_RELAXED, __ATOMIC_RELAXED, __HIP_MEMORY_SCOPE_AGENT);
                                     __hip_atomic_store(tmo, 1u, __ATOMIC_RELAXED, __HIP_MEMORY_SCOPE_AGENT); }
                    dead = true; break; }
                __builtin_amdgcn_s_sleep(2);
            }
            __builtin_amdgcn_fence(__ATOMIC_ACQUIRE, "agent");
            if (lane == 0) flag[0] = dead ? 1u : 0u;
        }
        asm volatile("s_waitcnt vmcnt(0) lgkmcnt(0)" ::: "memory"); __builtin_amdgcn_s_barrier(); asm volatile("" ::: "memory");
        const bool bad = flag[0] != 0u;
        if (lane < 32) {
            const unsigned long long* slot = (const unsigned long long*)xbuf + (size_t)(u.pm * BM + row) * 4; float mt[4], m2[4]; float ms = 0.f;
#pragma unroll
            for (int t = 0; t < 4; ++t) { if (t < ntn) { const unsigned long long w = __hip_atomic_load(slot + t, __ATOMIC_RELAXED, __HIP_MEMORY_SCOPE_AGENT); mt[t] = __uint_as_float((unsigned)w); m2[t] = __uint_as_float((unsigned)(w >> 32)); } else { mt[t] = 0.f; m2[t] = 0.f; } ms += mt[t]; }
            const float mean = ms / (float)ntn; float q = 0.f;
#pragma unroll
            for (int t = 0; t < 4; ++t) if (t < ntn) { const float dm = mt[t] - mean; q += m2[t] + 256.0f * dm * dm; }
            S[row] = (f32x2v){mean, 1.0f / sqrtf(q / (256.0f * (float)ntn) + eps)};
        }
        asm volatile("s_waitcnt lgkmcnt(0)" ::: "memory"); __builtin_amdgcn_s_barrier(); asm volatile("" ::: "memory");
        return bad;
    }
};
struct EpiLnRes {
    static constexpr bool PERM = false, AFTER_DRAIN = true, CHAIN = false;
    const float* base; float* out; int ldc; const float* bias; PanelStats st; unsigned poison;
    __device__ __forceinline__ void fused(f32x4 (&acc)[2][2][4][2], const Unit& u, int wr, int wc, int fr, int fq, PG8_LAS unsigned char* lds, int wid, int lane) const {
        typedef float f32x2v __attribute__((ext_vector_type(2)));
        const PG8_LAS f32x2v* S = (const PG8_LAS f32x2v*)(lds + 8192);
        const int col0 = u.pn * BM + wc * 32 + 4 * fq;
#pragma unroll
        for (int bj = 0; bj < 2; ++bj)
#pragma unroll
            for (int n = 0; n < 2; ++n) { const f32x4 bv = bias ? *(const f32x4*)(bias + col0 + bj * HALF + n * 16) : (f32x4){0.f, 0.f, 0.f, 0.f};
#pragma unroll
                for (int ai = 0; ai < 2; ++ai)
#pragma unroll
                    for (int m = 0; m < 4; ++m) acc[ai][bj][m][n] += bv; }
        f32x4 pre[4][2][2];
#pragma unroll
        for (int m = 0; m < 4; ++m) { const size_t off = (size_t)(u.pm * BM + wr * 64 + m * 16 + fr) * ldc + col0;
#pragma unroll
            for (int bj = 0; bj < 2; ++bj)
#pragma unroll
                for (int n = 0; n < 2; ++n) pre[m][bj][n] = *(const f32x4*)(base + off + bj * HALF + n * 16); }
        const bool bad = st.run(acc, u, wr, wc, fr, fq, lds, wid, lane) || poison != 0u;
        const float qnan = __builtin_nanf("");
#pragma unroll
        for (int ai = 0; ai < 2; ++ai)
#pragma unroll
            for (int m = 0; m < 4; ++m) { const int r = ai * HALF + wr * 64 + m * 16 + fr; const f32x2v sr = S[r]; const size_t off = (size_t)(u.pm * BM + r) * ldc + col0;
#pragma unroll
                for (int bj = 0; bj < 2; ++bj)
#pragma unroll
                    for (int n = 0; n < 2; ++n) { const f32x4 bs = ai == 0 ? pre[m][bj][n] : *(const f32x4*)(base + off + bj * HALF + n * 16); f32x4 o = bs + (acc[ai][bj][m][n] - sr.x) * sr.y;
                        if (bad) o = (f32x4){qnan, qnan, qnan, qnan}; *(f32x4*)(out + off + bj * HALF + n * 16) = o; }
                if (m & 1) asm volatile("" ::: "memory"); }
    }
};
struct EpiLnResLn {
    static constexpr bool PERM = false, AFTER_DRAIN = true, CHAIN = false;
    const float* base; float* out; bf16_t* xn; int ldc; const float* bias; PanelStats st1, st2; unsigned poison;
    __device__ __forceinline__ void fused(f32x4 (&acc)[2][2][4][2], const Unit& u, int wr, int wc, int fr, int fq, PG8_LAS unsigned char* lds, int wid, int lane) const {
        typedef float f32x2v __attribute__((ext_vector_type(2))); typedef unsigned u32x2v __attribute__((ext_vector_type(2)));
        const PG8_LAS f32x2v* S = (const PG8_LAS f32x2v*)(lds + 8192);
        const int col0 = u.pn * BM + wc * 32 + 4 * fq;
#pragma unroll
        for (int bj = 0; bj < 2; ++bj)
#pragma unroll
            for (int n = 0; n < 2; ++n) { const f32x4 bv = bias ? *(const f32x4*)(bias + col0 + bj * HALF + n * 16) : (f32x4){0.f, 0.f, 0.f, 0.f};
#pragma unroll
                for (int ai = 0; ai < 2; ++ai)
#pragma unroll
                    for (int m = 0; m < 4; ++m) acc[ai][bj][m][n] += bv; }
        bool bad = st1.run(acc, u, wr, wc, fr, fq, lds, wid, lane) || poison != 0u;
        const float qnan = __builtin_nanf("");
#pragma unroll
        for (int ai = 0; ai < 2; ++ai)
#pragma unroll
            for (int m = 0; m < 4; ++m) { const int r = ai * HALF + wr * 64 + m * 16 + fr; const f32x2v sr = S[r]; const size_t off = (size_t)(u.pm * BM + r) * ldc + col0;
#pragma unroll
                for (int bj = 0; bj < 2; ++bj)
#pragma unroll
                    for (int n = 0; n < 2; ++n) { const f32x4 bs = *(const f32x4*)(base + off + bj * HALF + n * 16); acc[ai][bj][m][n] = bs + (acc[ai][bj][m][n] - sr.x) * sr.y; }
                asm volatile("" : "+v"(acc[ai][0][m][0]), "+v"(acc[ai][0][m][1]), "+v"(acc[ai][1][m][0]), "+v"(acc[ai][1][m][1]));
                if (m & 1) asm volatile("" ::: "memory"); }
        const bool bad1 = bad;
        bad = st2.run(acc, u, wr, wc, fr, fq, lds, wid, lane) || bad;
#pragma unroll
        for (int ai = 0; ai < 2; ++ai)
#pragma unroll
            for (int m = 0; m < 4; ++m) { const int r = ai * HALF + wr * 64 + m * 16 + fr; const f32x2v sr = S[r]; const size_t off = (size_t)(u.pm * BM + r) * ldc + col0;
#pragma unroll
                for (int bj = 0; bj < 2; ++bj)
#pragma unroll
                    for (int n = 0; n < 2; ++n) { const f32x4 x1 = acc[ai][bj][m][n]; *(f32x4*)(out + off + bj * HALF + n * 16) = bad1 ? (f32x4){qnan, qnan, qnan, qnan} : x1;
                        const f32x4 o = (x1 - sr.x) * sr.y; u32x2v w; w.x = cvt_pk_bf16(o[0], o[1]); w.y = cvt_pk_bf16(o[2], o[3]);
                        if (bad) { w.x = 0x7fc07fc0u; w.y = 0x7fc07fc0u; } *(u32x2v*)(xn + off + bj * HALF + n * 16) = w; }
                asm volatile("" ::: "memory"); }
    }
};

template <class Epi, class Sched, bool ALIGN_EPI = false, bool SP2 = false>
__device__ __forceinline__ void gemm_phase(PG8_LAS unsigned char* lds, const Gemm g, const Sched& S, const Epi& E, const Gemm g1 = Gemm{nullptr, nullptr, 0, 0, 0}) {
    const int tid = threadIdx.x, wid = __builtin_amdgcn_readfirstlane(tid >> 6), lane = tid & 63, wr = wid >> 2, wc = wid & 3, fr = lane & 15, fq = lane >> 4;
    const int K = g.K, nt = K / BK;
    unsigned voffA[2], voffB[2];
#pragma unroll
    for (int i = 0; i < 2; ++i) { int R, C; stage_rc(tid * 16 + i * 8192, R, C); const int Rb = Epi::PERM ? ((R & ~31) + perm32(R & 31)) : R;
        voffA[i] = (unsigned)(R * K + C) * 2u; voffB[i] = (unsigned)(Rb * K + C) * 2u; }
    const size_t kstep = (size_t)(BK * 2);
    const size_t hstep = (size_t)HALF * K * 2;
    const size_t tstep = 2 * hstep;
    const unsigned ldsw = (unsigned)wid * 1024u;
    const int aoff = lds_byte(wr * 64 + fr, fq * 8), boff = lds_byte(wc * 32 + fr, fq * 8);
#define PG8_SA(b, h) (((b) * 2 + (h)) * HTB)
#define PG8_SB(b, h) ((4 + (b) * 2 + (h)) * HTB)
#define PG8_STAGE(bufoff, gbase, voff) do { _Pragma("unroll") for (int _i = 0; _i < 2; ++_i) \
        __builtin_amdgcn_global_load_lds((const unsigned*)((const char*)(gbase) + (voff)[_i]), (PG8_LAS unsigned*)(lds + (bufoff) + ldsw + _i * 8192), 16, 0, 0); } while (0)
#define PG8_LDA(dst, b, h) do { _Pragma("unroll") for (int m = 0; m < 4; ++m) _Pragma("unroll") for (int k = 0; k < 2; ++k) dst[m][k] = *(const PG8_LAS bf16x8*)(lds + PG8_SA(b, h) + aoff + m * 2048 + k * 1024); } while (0)
#define PG8_LDB(dst, b, h) do { _Pragma("unroll") for (int n = 0; n < 2; ++n) _Pragma("unroll") for (int k = 0; k < 2; ++k) dst[n][k] = *(const PG8_LAS bf16x8*)(lds + PG8_SB(b, h) + boff + n * 2048 + k * 1024); } while (0)
#define PG8_MMA(ai, bj, At, Bt) do { __builtin_amdgcn_s_setprio(1); _Pragma("unroll") for (int m = 0; m < 4; ++m) _Pragma("unroll") for (int n = 0; n < 2; ++n) _Pragma("unroll") for (int k = 0; k < 2; ++k) \
        acc[ai][bj][m][n] = __builtin_amdgcn_mfma_f32_16x16x32_bf16(Bt[n][k], At[m][k], acc[ai][bj][m][n], 0, 0, 0); __builtin_amdgcn_s_setprio(0); } while (0)
#define PG8_WAIT_V(n) asm volatile("s_waitcnt vmcnt(" #n ")" ::: "memory")
#define PG8_WAIT_L(n) asm volatile("s_waitcnt lgkmcnt(" #n ")" ::: "memory")
#define PG8_BAR __builtin_amdgcn_s_barrier()
#define PG8_SCHED __builtin_amdgcn_sched_barrier(0)
    Unit cur, nxt; int ui = 0;
    if (!S.next(0, cur)) return;
    f32x4 acc[2][2][4][2];
#pragma unroll
    for (int a = 0; a < 2; ++a)
#pragma unroll
        for (int b = 0; b < 2; ++b)
#pragma unroll
            for (int m = 0; m < 4; ++m)
#pragma unroll
                for (int n = 0; n < 2; ++n) acc[a][b][m][n] = (f32x4){0.f, 0.f, 0.f, 0.f};
    bf16x8 At[4][2], B0[2][2], B1[2][2];
    const char* cA = (const char*)(cur.sel ? g1.A : g.A) + (size_t)cur.pm * tstep; const char* cB = (const char*)(cur.sel ? g1.Bt : g.Bt) + (size_t)cur.pn * tstep;
    S.a_ready(cur);
    if constexpr (SP2) {
        PG8_STAGE(PG8_SB(0, 0), cB, voffB); PG8_STAGE(PG8_SB(0, 1), cB + hstep, voffB); PG8_STAGE(PG8_SA(0, 0), cA, voffA); PG8_STAGE(PG8_SA(0, 1), cA + hstep, voffA);
        if (wr == 1) PG8_BAR;
        PG8_WAIT_V(2); PG8_BAR;
        PG8_STAGE(PG8_SB(1, 0), cB + kstep, voffB); PG8_STAGE(PG8_SA(1, 0), cA + kstep, voffA); PG8_STAGE(PG8_SB(1, 1), cB + hstep + kstep, voffB);
        PG8_WAIT_V(6); PG8_BAR;
    } else {
        PG8_STAGE(PG8_SB(0, 0), cB, voffB); PG8_STAGE(PG8_SA(0, 0), cA, voffA); PG8_STAGE(PG8_SB(0, 1), cB + hstep, voffB); PG8_STAGE(PG8_SA(0, 1), cA + hstep, voffA);
        if (wr == 1) PG8_BAR;
        PG8_WAIT_V(4); PG8_BAR;
        PG8_STAGE(PG8_SB(1, 0), cB + kstep, voffB); PG8_STAGE(PG8_SA(1, 0), cA + kstep, voffA); PG8_STAGE(PG8_SB(1, 1), cB + hstep + kstep, voffB);
        PG8_WAIT_V(6); PG8_BAR;
    }
    for (;;) {
        const bool has_next = S.next(ui + 1, nxt);
        const char* nA = has_next ? (const char*)(nxt.sel ? g1.A : g.A) + (size_t)nxt.pm * tstep : cA; const char* nB = has_next ? (const char*)(nxt.sel ? g1.Bt : g.Bt) + (size_t)nxt.pn * tstep : cB;
        for (int t = 0; t < nt; t += 2) {
            const bool last = (t == nt - 2);
            const char* a1 = cA + (size_t)(t + 1) * kstep;
            const char* a2 = last ? nA : cA + (size_t)(t + 2) * kstep; const char* b2 = last ? nB : cB + (size_t)(t + 2) * kstep;
            const char* a3 = a2 + kstep; const char* b3 = b2 + kstep;
            if (last && has_next) S.a_ready(nxt);
            if constexpr (SP2) {
            PG8_LDB(B0, 0, 0); PG8_LDB(B1, 0, 1); PG8_SCHED; PG8_LDA(At, 0, 0); PG8_STAGE(PG8_SA(1, 1), a1 + hstep, voffA);
            PG8_WAIT_V(8); PG8_WAIT_L(0); PG8_BAR; PG8_MMA(0, 0, At, B0); PG8_MMA(0, 1, At, B1); PG8_BAR; PG8_SCHED;
            PG8_LDA(At, 0, 1); PG8_STAGE(PG8_SB(0, 0), b2, voffB); PG8_STAGE(PG8_SB(0, 1), b2 + hstep, voffB); PG8_STAGE(PG8_SA(0, 0), a2, voffA);
            PG8_WAIT_V(8); PG8_WAIT_L(0); PG8_BAR; PG8_MMA(1, 0, At, B0); PG8_MMA(1, 1, At, B1); PG8_BAR; PG8_SCHED;
            PG8_LDB(B0, 1, 0); PG8_LDB(B1, 1, 1); PG8_SCHED; PG8_LDA(At, 1, 0); PG8_STAGE(PG8_SA(0, 1), a2 + hstep, voffA);
            PG8_WAIT_V(8); PG8_WAIT_L(0); PG8_BAR; PG8_MMA(0, 0, At, B0); PG8_MMA(0, 1, At, B1); PG8_BAR; PG8_SCHED;
            PG8_LDA(At, 1, 1); PG8_STAGE(PG8_SB(1, 0), b3, voffB); PG8_STAGE(PG8_SB(1, 1), b3 + hstep, voffB); PG8_STAGE(PG8_SA(1, 0), a3, voffA);
            PG8_WAIT_V(8); PG8_WAIT_L(0); PG8_BAR; PG8_MMA(1, 0, At, B0); PG8_MMA(1, 1, At, B1); PG8_BAR; PG8_SCHED;
            } else {
            PG8_LDB(B0, 0, 0); PG8_SCHED; PG8_LDA(At, 0, 0); PG8_STAGE(PG8_SA(1, 1), a1 + hstep, voffA);
            PG8_WAIT_L(8); PG8_BAR; PG8_WAIT_L(0); PG8_MMA(0, 0, At, B0); PG8_BAR; PG8_SCHED;
            PG8_LDB(B1, 0, 1); PG8_STAGE(PG8_SB(0, 0), b2, voffB);
            PG8_BAR; PG8_WAIT_L(0); PG8_MMA(0, 1, At, B1); PG8_BAR;
            PG8_LDA(At, 0, 1); PG8_STAGE(PG8_SA(0, 0), a2, voffA);
            PG8_BAR; PG8_WAIT_L(0); PG8_MMA(1, 0, At, B0); PG8_BAR; PG8_SCHED;
            PG8_STAGE(PG8_SB(0, 1), b2 + hstep, voffB);
            PG8_WAIT_V(6); PG8_BAR; PG8_MMA(1, 1, At, B1); PG8_BAR;
            PG8_LDB(B0, 1, 0); PG8_SCHED; PG8_LDA(At, 1, 0); PG8_STAGE(PG8_SA(0, 1), a2 + hstep, voffA);
            PG8_WAIT_L(8); PG8_BAR; PG8_WAIT_L(0); PG8_MMA(0, 0, At, B0); PG8_BAR; PG8_SCHED;
            PG8_LDB(B1, 1, 1); PG8_STAGE(PG8_SB(1, 0), b3, voffB);
            PG8_BAR; PG8_WAIT_L(0); PG8_MMA(0, 1, At, B1); PG8_BAR;
            PG8_LDA(At, 1, 1); PG8_STAGE(PG8_SA(1, 0), a3, voffA);
            PG8_BAR; PG8_WAIT_L(0); PG8_MMA(1, 0, At, B0); PG8_BAR; PG8_SCHED;
            PG8_STAGE(PG8_SB(1, 1), b3 + hstep, voffB);
            PG8_WAIT_V(6); PG8_BAR; PG8_MMA(1, 1, At, B1); PG8_BAR;
            }
        }
        if constexpr (ALIGN_EPI) { if (wr == 0) PG8_BAR; }
        bool keep_acc = false;
        if constexpr (Epi::CHAIN) { keep_acc = E.chain(acc, cur, wr, wc, fr, fq); }
        if constexpr (!Epi::AFTER_DRAIN) { if (!keep_acc) { E(acc, cur, wr, wc, fr, fq); } S.done(cur); }
        if (!has_next) break;
        if (!keep_acc) {
#pragma unroll
        for (int a = 0; a < 2; ++a)
#pragma unroll
            for (int b = 0; b < 2; ++b)
#pragma unroll
                for (int m = 0; m < 4; ++m)
#pragma unroll
                    for (int n = 0; n < 2; ++n) acc[a][b][m][n] = (f32x4){0.f, 0.f, 0.f, 0.f};
        }
        cur = nxt; cA = nA; cB = nB; ++ui;
        if constexpr (ALIGN_EPI) { if (wr == 1) PG8_BAR; }
    }
    PG8_WAIT_V(0);
    if constexpr (!ALIGN_EPI) { if (wr == 0) PG8_BAR; }
    PG8_BAR;
    if constexpr (Epi::AFTER_DRAIN) { E.fused(acc, cur, wr, wc, fr, fq, lds, wid, lane); S.done(cur); }
#undef PG8_SA
#undef PG8_SB
#undef PG8_STAGE
#undef PG8_LDA
#undef PG8_LDB
#undef PG8_MMA
#undef PG8_WAIT_V
#undef PG8_WAIT_L
#undef PG8_BAR
#undef PG8_SCHED
}
}

#define GAS __attribute__((address_space(1)))
#define LAS __attribute__((address_space(3)))
typedef unsigned v4u __attribute__((ext_vector_type(4)));
typedef float f32x4 __attribute__((ext_vector_type(4)));
typedef short bf16x8 __attribute__((ext_vector_type(8)));
typedef GAS unsigned gu32;
typedef GAS unsigned long long gu64;
#define RLX_AGENT __ATOMIC_RELAXED, __HIP_MEMORY_SCOPE_AGENT
#define LDS_WAIT() asm volatile("s_waitcnt lgkmcnt(0)" ::: "memory")
#define VM_WAIT() asm volatile("s_waitcnt vmcnt(0)" ::: "memory")
__device__ __forceinline__ unsigned f2bf(float f) { unsigned u = __builtin_bit_cast(unsigned, f); return (u + 0x7fffu + ((u >> 16) & 1u)) >> 16; }
typedef float pk2_f32x2 __attribute__((ext_vector_type(2))); typedef __bf16 pk2_bf16x2 __attribute__((ext_vector_type(2)));
__device__ __forceinline__ unsigned pk2(float lo, float hi) {
  const pk2_f32x2 v = {lo, hi}; const pk2_bf16x2 b = __builtin_convertvector(v, pk2_bf16x2); return __builtin_bit_cast(unsigned, b);
}
__device__ __forceinline__ float wave_sum(float v) {
#pragma unroll
  for (int o = 1; o < 64; o <<= 1) v += __shfl_xor(v, o);
  return v;
}
__device__ __forceinline__ float wave_sum_dpp(float v) {
  v += __builtin_bit_cast(float, __builtin_amdgcn_update_dpp(0, __builtin_bit_cast(int, v), 0xB1, 0xF, 0xF, true));
  v += __builtin_bit_cast(float, __builtin_amdgcn_update_dpp(0, __builtin_bit_cast(int, v), 0x4E, 0xF, 0xF, true));
  v += __builtin_bit_cast(float, __builtin_amdgcn_update_dpp(0, __builtin_bit_cast(int, v), 0x141, 0xF, 0xF, true));
  v += __builtin_bit_cast(float, __builtin_amdgcn_update_dpp(0, __builtin_bit_cast(int, v), 0x140, 0xF, 0xF, true));
  v += __builtin_bit_cast(float, __builtin_amdgcn_update_dpp(0, __builtin_bit_cast(int, v), 0x142, 0xA, 0xF, true));
  v += __builtin_bit_cast(float, __builtin_amdgcn_update_dpp(0, __builtin_bit_cast(int, v), 0x143, 0xC, 0xF, true));
  return __builtin_bit_cast(float, __builtin_amdgcn_readlane(__builtin_bit_cast(int, v), 63));
}

#define XB_TMO      128
#define XB_XCNT(j)  (256  + 64 * (j))
#define XB_XSUB(j)  (1280 + 64 * (j))
#define XB_XGEN(j)  (2304 + 64 * (j))
#define XB_TOP      3328
#define XB_TOPGEN   3392
#define XCD_BAR_WORDS 3456
#define XB_SPIN_CAP (1u << 18)

__device__ __forceinline__ unsigned xb_ld(unsigned* p)              { return __hip_atomic_load(p, __ATOMIC_RELAXED, __HIP_MEMORY_SCOPE_AGENT); }
__device__ __forceinline__ unsigned xb_add(unsigned* p, unsigned v) { return __hip_atomic_fetch_add(p, v, __ATOMIC_RELAXED, __HIP_MEMORY_SCOPE_AGENT); }
__device__ __forceinline__ unsigned xb_xcc_id() { return (unsigned)__builtin_amdgcn_s_getreg((3 << 11) | 20) & 0xFu; }
#define XB_SPIN(cond, bar) do { unsigned _sp = 0; while (cond) { __builtin_amdgcn_s_sleep(1); \
    if ((++_sp & 255u) == 0u) { if (xb_ld(&(bar)[XB_TMO])) break; if (_sp > XB_SPIN_CAP) { atomicAdd(&(bar)[XB_TMO], 1u); break; } } } } while (0)

struct XcdBarrier {
    unsigned* bar; unsigned x;
    volatile LAS unsigned* st;
};

__device__ __forceinline__ XcdBarrier xcd_barrier_post(unsigned* bar, volatile LAS unsigned* st) {
    XcdBarrier b; b.bar = bar; b.x = xb_xcc_id(); b.st = st;
    if (threadIdx.x == 0) (void)xb_add(&bar[XB_XCNT(b.x)], 1u);
    return b;
}
__device__ __forceinline__ void xcd_barrier_complete(unsigned* bar, unsigned x, unsigned& nloc, unsigned& nx) {
    const unsigned G = gridDim.x * gridDim.y * gridDim.z;
    unsigned sum, cnt, mine, sp = 0u;
    for (;;) {
        sum = 0u; cnt = 0u; mine = 0u;
#pragma unroll
        for (unsigned j = 0; j < 16; ++j) { const unsigned c = xb_ld(&bar[XB_XCNT(j)]); sum += c; cnt += (c > 0u) ? 1u : 0u; mine = (j == x) ? c : mine; }
        if (sum == G) break;
        __builtin_amdgcn_s_sleep(1);
        if ((++sp & 255u) == 0u) { if (xb_ld(&bar[XB_TMO])) break; if (sp > XB_SPIN_CAP) { atomicAdd(&bar[XB_TMO], 1u); break; } }
    }
    nloc = mine > 0u ? mine : 1u; nx = cnt > 0u ? cnt : 1u;
}

__device__ __forceinline__ void xcd_barrier(const XcdBarrier& b) {
    asm volatile("s_waitcnt vmcnt(0)" ::: "memory");
    __syncthreads();
    if (threadIdx.x == 0) {
        unsigned* bar = b.bar;
        __builtin_amdgcn_s_waitcnt(0);
        unsigned nloc = b.st[0], nx = b.st[1];
        if (nloc == 0u) { xcd_barrier_complete(bar, b.x, nloc, nx); b.st[0] = nloc; b.st[1] = nx; }
        const unsigned old = xb_add(&bar[XB_XSUB(b.x)], 1u);
        const unsigned gen = old / nloc;
        if (old + 1u == (gen + 1u) * nloc) {
            __builtin_amdgcn_fence(__ATOMIC_RELEASE, "agent");
            asm volatile("s_waitcnt vmcnt(0)" ::: "memory");
            const unsigned og = xb_add(&bar[XB_TOP], 1u);
            const unsigned tg = og / nx;
            if (og + 1u == (tg + 1u) * nx) xb_add(&bar[XB_TOPGEN], 1u);
            else XB_SPIN(xb_ld(&bar[XB_TOPGEN]) == tg, bar);
            __builtin_amdgcn_fence(__ATOMIC_ACQUIRE, "agent");
            xb_add(&bar[XB_XGEN(b.x)], 1u);
            asm volatile("s_waitcnt vmcnt(0)" ::: "memory");
        } else {
            XB_SPIN(xb_ld(&bar[XB_XGEN(b.x)]) == gen, bar);
            __builtin_amdgcn_fence(__ATOMIC_ACQUIRE, "agent");
            asm volatile("s_waitcnt vmcnt(0)" ::: "memory");
        }
    }
    __syncthreads();
}


namespace sg {
typedef float f32x16 __attribute__((ext_vector_type(16)));
constexpr int BM = 128, BN = 256, BK = 64, RS = 144;
constexpr int A_BYTES = BM * RS;
__device__ __forceinline__ int crow(int r, int hi) { return (r & 3) + 8 * (r >> 2) + 4 * hi; }
template <class Epi>
__device__ __forceinline__ void tile(LAS unsigned char* lds, const us* const (&ap)[2], const us* bf0, const us* bf1, int K, const Epi& E, int tid) {
  const int lane = tid & 63, wave = __builtin_amdgcn_readfirstlane(tid >> 6), wm = wave >> 2, wn = wave & 3;
  const int r32 = lane & 31, hi = lane >> 5;
  f32x16 acc[2][2];
#pragma unroll
  for (int a = 0; a < 2; ++a)
#pragma unroll
    for (int b = 0; b < 2; ++b)
#pragma unroll
      for (int r = 0; r < 16; ++r) acc[a][b][r] = 0.f;
  v4u ra0[2], ra1[2];
  bf16x8 bq[2][4];
  unsigned wa[2];
#pragma unroll
  for (int i = 0; i < 2; ++i) { const int c = tid + 512 * i; wa[i] = (unsigned)((c >> 3) * RS + (c & 7) * 16); }
  const unsigned aoff = (unsigned)((wm * 64 + r32) * RS + hi * 16);
  const int nk = K / BK;
#define SG_LOADA(RA, kt_) do { const int kc_ = (kt_) < nk ? (kt_) : nk - 1; \
    _Pragma("unroll") for (int i = 0; i < 2; ++i) RA[i] = *(const v4u*)(ap[i] + kc_ * BK); } while (0)
#define SG_LOADB1(ks, kt_) do { const int kc_ = (kt_) < nk ? (kt_) : nk - 1; \
    bq[0][ks] = *(const bf16x8*)(bf0 + (size_t)(kc_ * 4 + (ks)) * 512); bq[1][ks] = *(const bf16x8*)(bf1 + (size_t)(kc_ * 4 + (ks)) * 512); } while (0)
#define SG_WRITEA(RA, bufoff) do { \
    _Pragma("unroll") for (int i = 0; i < 2; ++i) *(LAS v4u*)(lds + (bufoff) + wa[i]) = RA[i]; } while (0)
#define SG_COMPUTE(bufoff, ktn_) do { \
    _Pragma("unroll") for (int ks = 0; ks < 4; ++ks) { \
      bf16x8 af[2]; \
      _Pragma("unroll") for (int m = 0; m < 2; ++m) af[m] = *(const LAS bf16x8*)(lds + (bufoff) + aoff + m * 32 * RS + ks * 32); \
      _Pragma("unroll") for (int h = 0; h < 2; ++h) \
        _Pragma("unroll") for (int m = 0; m < 2; ++m) acc[h][m] = __builtin_amdgcn_mfma_f32_32x32x16_bf16(bq[h][ks], af[m], acc[h][m], 0, 0, 0); \
      SG_LOADB1(ks, ktn_); } } while (0)
  SG_LOADA(ra0, 0);
#pragma unroll
  for (int ks = 0; ks < 4; ++ks) SG_LOADB1(ks, 0);
  SG_LOADA(ra1, 1);
  SG_WRITEA(ra0, 0);
  __syncthreads();
  for (int kt = 0; kt < nk; kt += 2) {
    SG_LOADA(ra0, kt + 2);
    SG_COMPUTE(0, kt + 1);
    SG_WRITEA(ra1, A_BYTES);
    __syncthreads();
    SG_LOADA(ra1, kt + 3);
    SG_COMPUTE(A_BYTES, kt + 2);
    SG_WRITEA(ra0, 0);
    __syncthreads();
  }
#undef SG_LOADA
#undef SG_LOADB1
#undef SG_WRITEA
#undef SG_COMPUTE
  E(acc, wm, wn, r32, hi);
}
template <class Epi>
__device__ __forceinline__ void tile_wide(LAS unsigned char* lds, const us* const (&ap)[2], const us* bf0, const us* bf1, int K, const Epi& E, int tid) {
  const int lane = tid & 63, wave = __builtin_amdgcn_readfirstlane(tid >> 6);
  const int r32 = lane & 31, hi = lane >> 5;
  f32x16 acc[2][4];
#pragma unroll
  for (int a = 0; a < 2; ++a)
#pragma unroll
    for (int b = 0; b < 4; ++b)
#pragma unroll
      for (int r = 0; r < 16; ++r) acc[a][b][r] = 0.f;
  v4u ra0[2];
  bf16x8 bq[2][4];
  unsigned wa[2];
#pragma unroll
  for (int i = 0; i < 2; ++i) { const int c = tid + 512 * i; wa[i] = (unsigned)((c >> 3) * RS + (c & 7) * 16); }
  const unsigned aoff = (unsigned)(r32 * RS + hi * 16);
  const int nk = K / BK;
#define SGW_LOADA(RA, kt_) do { const int kc_ = (kt_) < nk ? (kt_) : nk - 1; \
    _Pragma("unroll") for (int i = 0; i < 2; ++i) RA[i] = *(const v4u*)(ap[i] + kc_ * BK); } while (0)
#define SGW_LOADB1(ks, kt_) do { const int kc_ = (kt_) < nk ? (kt_) : nk - 1; \
    bq[0][ks] = *(const bf16x8*)(bf0 + (size_t)(kc_ * 4 + (ks)) * 512); bq[1][ks] = *(const bf16x8*)(bf1 + (size_t)(kc_ * 4 + (ks)) * 512); } while (0)
#define SGW_WRITEA(RA, bufoff) do { \
    _Pragma("unroll") for (int i = 0; i < 2; ++i) *(LAS v4u*)(lds + (bufoff) + wa[i]) = RA[i]; } while (0)
#define SGW_LDA(dst, bufoff, ks) do { _Pragma("unroll") for (int m = 0; m < 4; ++m) dst[m] = *(const LAS bf16x8*)(lds + (bufoff) + aoff + m * 32 * RS + (ks) * 32); } while (0)
#define SGW_MMA(afr, ks, ktn_) do { \
      _Pragma("unroll") for (int h = 0; h < 2; ++h) \
        _Pragma("unroll") for (int m = 0; m < 4; ++m) acc[h][m] = __builtin_amdgcn_mfma_f32_32x32x16_bf16(bq[h][ks], afr[m], acc[h][m], 0, 0, 0); \
      SGW_LOADB1(ks, ktn_); __builtin_amdgcn_sched_barrier(0); } while (0)
#define SGW_COMPUTE(bufoff, ktn_) do { bf16x8 afA[4], afB[4]; \
    SGW_LDA(afA, bufoff, 0); \
    SGW_LDA(afB, bufoff, 1); SGW_MMA(afA, 0, ktn_); \
    SGW_LDA(afA, bufoff, 2); SGW_MMA(afB, 1, ktn_); \
    SGW_LDA(afB, bufoff, 3); SGW_MMA(afA, 2, ktn_); \
    SGW_MMA(afB, 3, ktn_); } while (0)
  SGW_LOADA(ra0, 0);
#pragma unroll
  for (int ks = 0; ks < 4; ++ks) SGW_LOADB1(ks, 0);
  SGW_WRITEA(ra0, 0);
  __syncthreads();
  for (int kt = 0; kt < nk; kt += 2) {
    SGW_LOADA(ra0, kt + 1); __builtin_amdgcn_sched_barrier(0);
    SGW_COMPUTE(0, kt + 1);
    SGW_WRITEA(ra0, A_BYTES);
    __syncthreads();
    SGW_LOADA(ra0, kt + 2); __builtin_amdgcn_sched_barrier(0);
    SGW_COMPUTE(A_BYTES, kt + 2);
    SGW_WRITEA(ra0, 0);
    __syncthreads();
  }
#undef SGW_LOADA
#undef SGW_LOADB1
#undef SGW_WRITEA
#undef SGW_COMPUTE
#undef SGW_LDA
#undef SGW_MMA
  E(acc, wave, r32, hi);
}
constexpr int ARS = 528;
template <class Epi>
__device__ __forceinline__ void tile_resident(LAS unsigned char* lds, const us* bf0, const us* bf1, const Epi& E, int tid) {
  const int lane = tid & 63, wave = __builtin_amdgcn_readfirstlane(tid >> 6), wm = wave >> 2, wn = wave & 3;
  const int r32 = lane & 31, hi = lane >> 5;
  f32x16 acc[2][2];
#pragma unroll
  for (int a = 0; a < 2; ++a)
#pragma unroll
    for (int b = 0; b < 2; ++b)
#pragma unroll
      for (int r = 0; r < 16; ++r) acc[a][b][r] = 0.f;
  bf16x8 bq[2][4];
  const unsigned aoff = (unsigned)((wm * 64 + r32) * ARS + hi * 16);
#define SGR_LOADB1(ks, kc_) do { bq[0][ks] = *(const bf16x8*)(bf0 + (size_t)((kc_) * 4 + (ks)) * 512); bq[1][ks] = *(const bf16x8*)(bf1 + (size_t)((kc_) * 4 + (ks)) * 512); } while (0)
#pragma unroll
  for (int ks = 0; ks < 4; ++ks) SGR_LOADB1(ks, 0);
  bf16x8 afA[2], afB[2];
#define SGR_LDA(dst, st_) do { _Pragma("unroll") for (int m = 0; m < 2; ++m) dst[m] = *(const LAS bf16x8*)(lds + aoff + m * 32 * ARS + (st_) * 32); } while (0)
#define SGR_MMA(afr, st_) do { \
      _Pragma("unroll") for (int h = 0; h < 2; ++h) \
        _Pragma("unroll") for (int m = 0; m < 2; ++m) acc[h][m] = __builtin_amdgcn_mfma_f32_32x32x16_bf16(bq[h][(st_) & 3], afr[m], acc[h][m], 0, 0, 0); \
      if ((st_) < 12) SGR_LOADB1((st_) & 3, ((st_) >> 2) + 1); \
      __builtin_amdgcn_sched_barrier(0); } while (0)
  SGR_LDA(afA, 0);
#pragma unroll
  for (int st = 0; st < 16; st += 2) {
    SGR_LDA(afB, st + 1); SGR_MMA(afA, st);
    if (st + 2 < 16) SGR_LDA(afA, st + 2);
    SGR_MMA(afB, st + 1);
  }
#undef SGR_LDA
#undef SGR_MMA
#undef SGR_LOADB1
  E(acc, wm, wn, r32, hi);
}
}

constexpr size_t MiB = 1u << 20;
constexpr size_t WS_CTL = 0, CTL_ZERO_BYTES = 64 * 1024;
constexpr int CW_BAR = 1024;
constexpr size_t WS_WIN = 1 * MiB;
constexpr size_t WS_WCO = 12 * MiB;
constexpr size_t WS_WAO = 13 * MiB;
constexpr size_t WS_WO = 14 * MiB;
constexpr size_t WS_CT = 16 * MiB, WS_ST = 18 * MiB;
constexpr size_t WS_KI = 20 * MiB;
constexpr size_t WS_WI = 22 * MiB;
constexpr size_t WS_HB = 24 * MiB;
constexpr size_t WS_G = 56 * MiB;
constexpr size_t WS_QI = 72 * MiB, WS_K = 88 * MiB, WS_V = 104 * MiB, WS_Q = 120 * MiB;
constexpr size_t WS_GC = 136 * MiB, WS_GA = 168 * MiB;
constexpr size_t WS_NA = 200 * MiB, WS_AO = 216 * MiB;
constexpr size_t WS_M1 = 56 * MiB;
constexpr int CW_ATTN = 512;
constexpr size_t WS_Y1 = 88 * MiB;
constexpr size_t WS_X1B = 168 * MiB;
constexpr size_t WS_END = 232 * MiB;

constexpr int LDS_BYTES = 148480;
constexpr int MISC_OFF = LDS_BYTES - 256;

constexpr bool AMP_ON = false;
struct Args {
  const float* in[20];
  float* out;
  unsigned char* ws;
  int ph_lo, ph_hi, li, dup;
};
enum { PH_PREP = 0, PH_INPROJ = 1, PH_CONV = 2, PH_TOPK = 3, PH_ATTN = 4, PH_MIX = 5, PH_WO = 6, PH_ROUTE = 7, PH_MOE1 = 8, PH_MOE2 = 9, PH_FINAL = 10, PH_END = 11 };

constexpr int CW_M1 = 576, CW_X1 = 640;
template <bool ACCUM> struct EpiGate {
  static constexpr bool PERM = true, AFTER_DRAIN = false, CHAIN = false;
  const us* gate; us* M1;
  __device__ __forceinline__ void operator()(const pg8::f32x4 (&acc)[2][2][4][2], const pg8::Unit& u, int wr, int wc, int fr, int fq) const {
    const int row0 = u.pm * 256 + wr * 64 + fr, col0 = u.pn * 256 + wc * 32 + 8 * fq;
    v4u gw[2][2][2][2];
#pragma unroll
    for (int ai = 0; ai < 2; ++ai)
#pragma unroll
      for (int mh = 0; mh < 2; ++mh)
#pragma unroll
        for (int mm = 0; mm < 2; ++mm)
#pragma unroll
          for (int bj = 0; bj < 2; ++bj)
            gw[ai][mh][mm][bj] = *(const v4u*)(gate + (size_t)(row0 + ai * 128 + (2 * mh + mm) * 16) * 1024 + col0 + bj * 128);
    __builtin_amdgcn_sched_barrier(0);
#pragma unroll
    for (int ai = 0; ai < 2; ++ai)
#pragma unroll
      for (int mh = 0; mh < 2; ++mh) {
#pragma unroll
        for (int mm = 0; mm < 2; ++mm)
#pragma unroll
          for (int bj = 0; bj < 2; ++bj) {
            const int m = 2 * mh + mm;
            const size_t off = (size_t)(row0 + ai * 128 + m * 16) * 1024 + col0 + bj * 128;
            const v4u g = gw[ai][mh][mm][bj];
            const f32x4 v0 = acc[ai][bj][m][0], v1 = acc[ai][bj][m][1];
            float o[8];
            o[0] = __uint_as_float(g.x << 16) * v0[0]; o[1] = __uint_as_float(g.x & 0xffff0000u) * v0[1];
            o[2] = __uint_as_float(g.y << 16) * v0[2]; o[3] = __uint_as_float(g.y & 0xffff0000u) * v0[3];
            o[4] = __uint_as_float(g.z << 16) * v1[0]; o[5] = __uint_as_float(g.z & 0xffff0000u) * v1[1];
            o[6] = __uint_as_float(g.w << 16) * v1[2]; o[7] = __uint_as_float(g.w & 0xffff0000u) * v1[3];
            if (ACCUM) {
              const v4u p = *(const v4u*)(M1 + off);
              o[0] += __uint_as_float(p.x << 16); o[1] += __uint_as_float(p.x & 0xffff0000u);
              o[2] += __uint_as_float(p.y << 16); o[3] += __uint_as_float(p.y & 0xffff0000u);
              o[4] += __uint_as_float(p.z << 16); o[5] += __uint_as_float(p.z & 0xffff0000u);
              o[6] += __uint_as_float(p.w << 16); o[7] += __uint_as_float(p.w & 0xffff0000u);
            }
            v4u w; w.x = pk2(o[0], o[1]); w.y = pk2(o[2], o[3]); w.z = pk2(o[4], o[5]); w.w = pk2(o[6], o[7]);
            *(v4u*)(M1 + off) = w;
          }
      }
  }
};
struct DualOrder : pg8::StaticOrder {
  const unsigned* ready;
  __device__ bool next(int i, pg8::Unit& u) const { if (i >= 2) return false; const bool ok = pg8::StaticOrder::next(0, u); u.sel = i; return ok; }
  __device__ __forceinline__ void a_ready(const pg8::Unit& u) const {
    if (u.sel == 0) return;
    if (threadIdx.x < 64) {
      unsigned sp = 0;
      while ((unsigned)__builtin_amdgcn_readfirstlane(__hip_atomic_load(ready + u.pm, __ATOMIC_RELAXED, __HIP_MEMORY_SCOPE_AGENT)) < 8u) { __builtin_amdgcn_s_sleep(2); if (++sp > (1u << 22)) break; }
      __builtin_amdgcn_fence(__ATOMIC_ACQUIRE, "agent");
      asm volatile("s_waitcnt vmcnt(0)" ::: "memory");
    }
    asm volatile("" ::: "memory"); __builtin_amdgcn_s_barrier(); asm volatile("" ::: "memory");
  }
};
struct EpiGate2 {
  static constexpr bool PERM = true, AFTER_DRAIN = false, CHAIN = true;
  const us *gc, *ga; us* M1;
  __device__ __forceinline__ bool chain(pg8::f32x4 (&acc)[2][2][4][2], const pg8::Unit& u, int wr, int wc, int fr, int fq) const {
    if (u.sel != 0) return false;
    const int row0 = u.pm * 256 + wr * 64 + fr, col0 = u.pn * 256 + wc * 32 + 8 * fq;
    v4u gw[2][2][2][2];
#pragma unroll
    for (int ai = 0; ai < 2; ++ai)
#pragma unroll
      for (int mh = 0; mh < 2; ++mh)
#pragma unroll
        for (int mm = 0; mm < 2; ++mm)
#pragma unroll
          for (int bj = 0; bj < 2; ++bj)
            gw[ai][mh][mm][bj] = *(const v4u*)(gc + (size_t)(row0 + ai * 128 + (2 * mh + mm) * 16) * 1024 + col0 + bj * 128);
    __builtin_amdgcn_sched_barrier(0);
#pragma unroll
    for (int ai = 0; ai < 2; ++ai)
#pragma unroll
      for (int mh = 0; mh < 2; ++mh)
#pragma unroll
        for (int mm = 0; mm < 2; ++mm)
#pragma unroll
          for (int bj = 0; bj < 2; ++bj) {
            const int m = 2 * mh + mm;
            const v4u g = gw[ai][mh][mm][bj];
            f32x4& v0 = acc[ai][bj][m][0]; f32x4& v1 = acc[ai][bj][m][1];
            v0[0] *= __uint_as_float(g.x << 16); v0[1] *= __uint_as_float(g.x & 0xffff0000u);
            v0[2] *= __uint_as_float(g.y << 16); v0[3] *= __uint_as_float(g.y & 0xffff0000u);
            v1[0] *= __uint_as_float(g.z << 16); v1[1] *= __uint_as_float(g.z & 0xffff0000u);
            v1[2] *= __uint_as_float(g.w << 16); v1[3] *= __uint_as_float(g.w & 0xffff0000u);
          }
    __builtin_amdgcn_sched_barrier(0);
    return true;
  }
  __device__ __forceinline__ void operator()(const pg8::f32x4 (&acc)[2][2][4][2], const pg8::Unit& u, int wr, int wc, int fr, int fq) const {
    EpiGate<false> E; E.gate = ga; E.M1 = M1; E(acc, u, wr, wc, fr, fq);
  }
};
struct EpiRes {
  static constexpr bool PERM = true, AFTER_DRAIN = false, CHAIN = false;
  const float* base; us* x1b;
  __device__ __forceinline__ void operator()(const pg8::f32x4 (&acc)[2][2][4][2], const pg8::Unit& u, int wr, int wc, int fr, int fq) const {
    const int row0 = u.pm * 256 + wr * 64 + fr, col0 = u.pn * 256 + wc * 32 + 8 * fq;
#pragma unroll
    for (int ai = 0; ai < 2; ++ai)
#pragma unroll
      for (int mh = 0; mh < 2; ++mh) {
        f32x4 b[2][2][2];
#pragma unroll
        for (int mm = 0; mm < 2; ++mm)
#pragma unroll
          for (int bj = 0; bj < 2; ++bj)
#pragma unroll
            for (int n = 0; n < 2; ++n) b[mm][bj][n] = *(const f32x4*)(base + (size_t)(row0 + ai * 128 + (2 * mh + mm) * 16) * 1024 + col0 + bj * 128 + n * 4);
        __builtin_amdgcn_sched_barrier(0);
#pragma unroll
        for (int mm = 0; mm < 2; ++mm)
#pragma unroll
          for (int bj = 0; bj < 2; ++bj) {
            const f32x4 o0 = b[mm][bj][0] + acc[ai][bj][2 * mh + mm][0], o1 = b[mm][bj][1] + acc[ai][bj][2 * mh + mm][1];
            v4u w; w.x = pk2(o0[0], o0[1]); w.y = pk2(o0[2], o0[3]); w.z = pk2(o1[0], o1[1]); w.w = pk2(o1[2], o1[3]);
            *(v4u*)(x1b + (size_t)(row0 + ai * 128 + (2 * mh + mm) * 16) * 1024 + col0 + bj * 128) = w;
          }
        __builtin_amdgcn_sched_barrier(0);
      }
  }
};

__device__ __forceinline__ void p0_transpose_item(const float* __restrict__ W, int ldw, int k0, int n_src, us* __restrict__ WT, int ldt, int dst_row0,
                                                  LAS float* scr, int lane) {
  if (n_src >= 0) {
#pragma unroll 8
    for (int i = 0; i < 32; ++i) { const int kk = 2 * i + (lane >> 5); scr[kk * 33 + (lane & 31)] = W[(size_t)(k0 + kk) * ldw + n_src + (lane & 31)]; }
  } else {
#pragma unroll 8
    for (int i = 0; i < 32; ++i) { const int kk = 2 * i + (lane >> 5); scr[kk * 33 + (lane & 31)] = 0.f; }
  }
  LDS_WAIT(); asm volatile("" ::: "memory");
  const int c = lane & 7;
#pragma unroll
  for (int j = 0; j < 4; ++j) {
    const int n = (lane >> 3) + 8 * j;
    const LAS float* s = scr + (8 * c) * 33 + n;
    v4u o;
    o.x = pk2(s[0 * 33], s[1 * 33]); o.y = pk2(s[2 * 33], s[3 * 33]); o.z = pk2(s[4 * 33], s[5 * 33]); o.w = pk2(s[6 * 33], s[7 * 33]);
    *(v4u*)(WT + (size_t)(dst_row0 + n) * ldt + k0 + 8 * c) = o;
  }
  LDS_WAIT(); asm volatile("" ::: "memory");
}
__device__ __forceinline__ void p0_transpose_item64(const float* __restrict__ W, int ldw, int k0, int n_src, us* __restrict__ WT, int ldt, int dst_a, int dst_b, bool zero_b,
                                                    LAS float* scr, int lane) {
  const float* src_ = W + (size_t)k0 * ldw + n_src + lane;
#pragma unroll
  for (int b = 0; b < 4; ++b) {
    float v_[16];
#pragma unroll
    for (int i = 0; i < 16; ++i) v_[i] = src_[(size_t)(16 * b + i) * ldw];
    __builtin_amdgcn_sched_barrier(0);
#pragma unroll
    for (int i = 0; i < 16; ++i) scr[(16 * b + i) * 65 + lane] = (zero_b && lane >= 32) ? 0.f : v_[i];
  }
  LDS_WAIT(); asm volatile("" ::: "memory");
  const int c = lane & 7;
#pragma unroll
  for (int j = 0; j < 8; ++j) {
    const int n = (lane >> 3) + 8 * j;
    const LAS float* s = scr + (8 * c) * 65 + n;
    v4u o;
    o.x = pk2(s[0 * 65], s[1 * 65]); o.y = pk2(s[2 * 65], s[3 * 65]); o.z = pk2(s[4 * 65], s[5 * 65]); o.w = pk2(s[6 * 65], s[7 * 65]);
    const int drow = j < 4 ? dst_a + n : dst_b + (n - 32);
    *(v4u*)(WT + (size_t)drow * ldt + k0 + 8 * c) = o;
  }
  LDS_WAIT(); asm volatile("" ::: "memory");
}
__device__ __forceinline__ void p0_transpose_item_fm(const float* __restrict__ W, int ldw, int k0, int n_src, us* __restrict__ WT, int K, int g,
                                                     LAS float* scr, int lane, const float* __restrict__ kscale = nullptr) {
#pragma unroll 8
  for (int i = 0; i < 32; ++i) { const int kk = 2 * i + (lane >> 5); scr[kk * 33 + (lane & 31)] = W[(size_t)(k0 + kk) * ldw + n_src + (lane & 31)]; }
  LDS_WAIT(); asm volatile("" ::: "memory");
  const int c = lane & 7;
#pragma unroll
  for (int j = 0; j < 4; ++j) {
    const int n = (lane >> 3) + 8 * j;
    const LAS float* s = scr + (8 * c) * 33 + n;
    v4u o;
    f32x4 g0 = (f32x4){1.f, 1.f, 1.f, 1.f}, g1 = g0;
    if (kscale) { g0 = *(const f32x4*)(kscale + k0 + 8 * c); g1 = *(const f32x4*)(kscale + k0 + 8 * c + 4); }
    o.x = pk2(s[0 * 33] * g0[0], s[1 * 33] * g0[1]); o.y = pk2(s[2 * 33] * g0[2], s[3 * 33] * g0[3]); o.z = pk2(s[4 * 33] * g1[0], s[5 * 33] * g1[1]); o.w = pk2(s[6 * 33] * g1[2], s[7 * 33] * g1[3]);
    *(v4u*)(WT + ((((size_t)g * (K >> 4) + (k0 >> 4) + (c >> 1)) * 2 + (c & 1)) * 32 + n) * 8) = o;
  }
  LDS_WAIT(); asm volatile("" ::: "memory");
}
__device__ __forceinline__ int inproj_src(int g) {
  const int pn = g >> 3, bj = (g >> 2) & 1, wc = g & 3;
  if (pn < 4) return (bj ? 512 : 0) + pn * 128 + wc * 32;
  if (pn < 12) { const int type = (pn - 4) >> 1, head = ((pn - 4) & 1) * 4 + wc; return OFF_Q + type * 512 + head * 64 + bj * 32; }
  if (pn < 20) return (bj ? OFF_GA : OFF_GC) + (pn - 12) * 128 + wc * 32;
  if (wc == 0) return OFF_KI + bj * 32;
  if (wc == 1 && bj == 0) return OFF_WI;
  return -1;
}
__device__ __forceinline__ void rms_row_to_bf16(const float* __restrict__ xrow, const float* __restrict__ g, us* __restrict__ orow, int lane) {
  const f32x4* xr = (const f32x4*)xrow + lane;
  f32x4 v[4]; float s = 0.f;
#pragma unroll
  for (int j = 0; j < 4; ++j) { v[j] = xr[64 * j]; s += (v[j].x * v[j].x + v[j].y * v[j].y) + (v[j].z * v[j].z + v[j].w * v[j].w); }
  const float rstd = 1.0f / sqrtf(wave_sum(s) * (1.0f / D) + EPS);
#pragma unroll
  for (int j = 0; j < 4; ++j) {
    const f32x4 gg = ((const f32x4*)g)[lane + 64 * j];
    unsigned long long o = (unsigned long long)pk2(v[j].x * rstd * gg.x, v[j].y * rstd * gg.y) |
                           ((unsigned long long)pk2(v[j].z * rstd * gg.z, v[j].w * rstd * gg.w) << 32);
    ((unsigned long long*)orow)[lane + 64 * j] = o;
  }
}

__device__ __forceinline__ void rms_rows4_to_bf16(const float* __restrict__ x0, const float* __restrict__ g, us* __restrict__ o0, int lane) {
  f32x4 v[4][4];
#pragma unroll
  for (int r = 0; r < 4; ++r)
#pragma unroll
    for (int j = 0; j < 4; ++j) v[r][j] = ((const f32x4*)(x0 + (size_t)r * D))[lane + 64 * j];
  __builtin_amdgcn_sched_barrier(0);
#pragma unroll
  for (int r = 0; r < 4; ++r) {
    float s = 0.f;
#pragma unroll
    for (int j = 0; j < 4; ++j) s += (v[r][j].x * v[r][j].x + v[r][j].y * v[r][j].y) + (v[r][j].z * v[r][j].z + v[r][j].w * v[r][j].w);
    const float rstd = 1.0f / sqrtf(wave_sum_dpp(s) * (1.0f / D) + EPS);
#pragma unroll
    for (int j = 0; j < 4; ++j) {
      const f32x4 gg = ((const f32x4*)g)[lane + 64 * j];
      unsigned long long o = (unsigned long long)pk2(v[r][j].x * rstd * gg.x, v[r][j].y * rstd * gg.y) |
                             ((unsigned long long)pk2(v[r][j].z * rstd * gg.z, v[r][j].w * rstd * gg.w) << 32);
      ((unsigned long long*)(o0 + (size_t)r * D))[lane + 64 * j] = o;
    }
  }
}

constexpr int CW_DEP = 104;
constexpr unsigned DEP_TARGET = 7u * 64u * 8u;
constexpr int CW_TQ = 100;
struct InProjOrder : pg8::StaticOrder {
  unsigned* dep;
  __device__ __forceinline__ static int perm(int r) { return r == 0 ? 20 : (r < 3 ? r + 9 : (r < 13 ? r - 3 : r - 1)); }
  __device__ __forceinline__ static bool is_dep(int pn) { return pn < 4 || pn == 10 || pn == 11 || pn == 20; }
  __device__ bool next(int i, pg8::Unit& u) const { const bool ok = pg8::StaticOrder::next(i, u); u.pn = perm(u.pn); return ok; }
  __device__ __forceinline__ void done(const pg8::Unit& u) const {
    if (is_dep(u.pn)) {
      asm volatile("s_waitcnt vmcnt(0)" ::: "memory");
      if ((threadIdx.x & 63) == 0) __hip_atomic_fetch_add(dep, 1u, __ATOMIC_RELAXED, __HIP_MEMORY_SCOPE_AGENT);
    }
  }
};
__device__ __forceinline__ void st16_wt_g(void* ptr, v4u v) { asm volatile("global_store_dwordx4 %0, %1, off sc1\n\ts_nop 1" :: "v"(ptr), "v"(v) : "memory"); }

struct EpiInProj {
  static constexpr bool PERM = true, AFTER_DRAIN = false, CHAIN = false;
  us *G, *Q, *K, *V, *QI, *KI, *GC, *GA; float* WI; const float *CT, *ST;
  __device__ __forceinline__ void operator()(const pg8::f32x4 (&acc)[2][2][4][2], const pg8::Unit& u, int wr, int wc, int fr, int fq) const {
    const int pn = u.pn;
    const int row0 = u.pm * 256 + wr * 64 + fr;
    if (pn < 4) {
#pragma unroll
      for (int ai = 0; ai < 2; ++ai)
#pragma unroll
        for (int m = 0; m < 4; ++m) {
          const int row = row0 + ai * 128 + m * 16;
          const f32x4 a0 = acc[ai][0][m][0], a1 = acc[ai][0][m][1], b0 = acc[ai][1][m][0], b1 = acc[ai][1][m][1];
          v4u w;
          w.x = pk2(a0[0] * fsigmoid(b0[0]), a0[1] * fsigmoid(b0[1])); w.y = pk2(a0[2] * fsigmoid(b0[2]), a0[3] * fsigmoid(b0[3]));
          w.z = pk2(a1[0] * fsigmoid(b1[0]), a1[1] * fsigmoid(b1[1])); w.w = pk2(a1[2] * fsigmoid(b1[2]), a1[3] * fsigmoid(b1[3]));
          st16_wt_g(G + (size_t)row * 512 + pn * 128 + wc * 32 + 8 * fq, w);
        }
    } else if (pn < 12) {
      const int type = (pn - 4) >> 1, head = ((pn - 4) & 1) * 4 + wc;
      us* dst = type == 0 ? Q : (type == 1 ? K : (type == 2 ? V : QI));
      const float sc = type == 0 ? QSCALE : 1.0f;
#pragma unroll
      for (int ai = 0; ai < 2; ++ai)
#pragma unroll
        for (int m = 0; m < 4; ++m) {
          const int row = row0 + ai * 128 + m * 16;
          const f32x4 x10 = acc[ai][0][m][0], x11 = acc[ai][0][m][1], x20 = acc[ai][1][m][0], x21 = acc[ai][1][m][1];
          f32x4 o10, o11, o20, o21;
          if (type == 2) { o10 = x10; o11 = x11; o20 = x20; o21 = x21; }
          else {
            const f32x4 c0 = *(const f32x4*)(CT + (size_t)row * 32 + 8 * fq), c1 = *(const f32x4*)(CT + (size_t)row * 32 + 8 * fq + 4);
            const f32x4 s0 = *(const f32x4*)(ST + (size_t)row * 32 + 8 * fq), s1 = *(const f32x4*)(ST + (size_t)row * 32 + 8 * fq + 4);
            o10 = (x10 * c0 - x20 * s0) * sc; o11 = (x11 * c1 - x21 * s1) * sc;
            o20 = (x20 * c0 + x10 * s0) * sc; o21 = (x21 * c1 + x11 * s1) * sc;
          }
          v4u w1, w2;
          w1.x = pk2(o10[0], o10[1]); w1.y = pk2(o10[2], o10[3]); w1.z = pk2(o11[0], o11[1]); w1.w = pk2(o11[2], o11[3]);
          w2.x = pk2(o20[0], o20[1]); w2.y = pk2(o20[2], o20[3]); w2.z = pk2(o21[0], o21[1]); w2.w = pk2(o21[2], o21[3]);
          us* p = dst + (size_t)row * 512 + head * 64 + 8 * fq;
          if (type == 3) { st16_wt_g(p, w1); st16_wt_g(p + 32, w2); } else { *(v4u*)p = w1; *(v4u*)(p + 32) = w2; }
        }
    } else if (pn < 20) {
      const int cb = (pn - 12) * 128 + wc * 32 + 8 * fq;
#pragma unroll
      for (int ai = 0; ai < 2; ++ai)
#pragma unroll
        for (int m = 0; m < 4; ++m) {
          const int row = row0 + ai * 128 + m * 16;
          float rr[8], gg[8];
#pragma unroll
          for (int n = 0; n < 2; ++n)
#pragma unroll
            for (int i = 0; i < 4; ++i) {
              const float gcv = fsigmoid(acc[ai][0][m][n][i]), gav = fmaxf(fsigmoid(acc[ai][1][m][n][i]), 1e-30f);
              gg[4 * n + i] = gav; rr[4 * n + i] = gcv * __builtin_amdgcn_rcpf(gav);
            }
          v4u w, w2;
          w.x = pk2(rr[0], rr[1]); w.y = pk2(rr[2], rr[3]); w.z = pk2(rr[4], rr[5]); w.w = pk2(rr[6], rr[7]);
          w2.x = pk2(gg[0], gg[1]); w2.y = pk2(gg[2], gg[3]); w2.z = pk2(gg[4], gg[5]); w2.w = pk2(gg[6], gg[7]);
          *(v4u*)(GC + (size_t)row * 1024 + cb) = w;
          *(v4u*)(GA + (size_t)row * 1024 + cb) = w2;
        }
    } else {
      if (wc == 0) {
#pragma unroll
        for (int ai = 0; ai < 2; ++ai)
#pragma unroll
          for (int m = 0; m < 4; ++m) {
            const int row = row0 + ai * 128 + m * 16;
            const f32x4 x10 = acc[ai][0][m][0], x11 = acc[ai][0][m][1], x20 = acc[ai][1][m][0], x21 = acc[ai][1][m][1];
            const f32x4 c0 = *(const f32x4*)(CT + (size_t)row * 32 + 8 * fq), c1 = *(const f32x4*)(CT + (size_t)row * 32 + 8 * fq + 4);
            const f32x4 s0 = *(const f32x4*)(ST + (size_t)row * 32 + 8 * fq), s1 = *(const f32x4*)(ST + (size_t)row * 32 + 8 * fq + 4);
            const f32x4 o10 = x10 * c0 - x20 * s0, o11 = x11 * c1 - x21 * s1, o20 = x20 * c0 + x10 * s0, o21 = x21 * c1 + x11 * s1;
            v4u w1, w2;
            w1.x = pk2(o10[0], o10[1]); w1.y = pk2(o10[2], o10[3]); w1.z = pk2(o11[0], o11[1]); w1.w = pk2(o11[2], o11[3]);
            w2.x = pk2(o20[0], o20[1]); w2.y = pk2(o20[2], o20[3]); w2.z = pk2(o21[0], o21[1]); w2.w = pk2(o21[2], o21[3]);
            us* p = KI + ((size_t)(row >> 5) * 8 * 32 + (row & 31)) * 8;
            st16_wt_g(p + (size_t)fq * 256, w1); st16_wt_g(p + (size_t)(4 + fq) * 256, w2);
          }
      } else if (wc == 1 && fq == 0) {
#pragma unroll
        for (int ai = 0; ai < 2; ++ai)
#pragma unroll
          for (int m = 0; m < 4; ++m) {
            const int row = row0 + ai * 128 + m * 16;
            const f32x4 wa_ = acc[ai][0][m][0] * IDX_SCALE, wb_ = acc[ai][0][m][1] * IDX_SCALE;
            st16_wt_g(WI + (size_t)row * 8, (v4u){__float_as_uint(wa_[0]), __float_as_uint(wa_[1]), __float_as_uint(wa_[2]), __float_as_uint(wa_[3])});
            st16_wt_g(WI + (size_t)row * 8 + 4, (v4u){__float_as_uint(wb_[0]), __float_as_uint(wb_[1]), __float_as_uint(wb_[2]), __float_as_uint(wb_[3])});
          }
      }
    }
  }
};


constexpr size_t WS_WGU = 232 * MiB;
constexpr size_t WS_WD = 248 * MiB;
constexpr size_t WS_YS = 72 * MiB;
constexpr size_t WS_HID = 136 * MiB;
constexpr size_t WS_LIST = 160 * MiB;
constexpr size_t WS_COMB = 162 * MiB;
constexpr size_t WS_RSTD = 163 * MiB;
constexpr int CW_CNT = 64;
constexpr int LIST_CAP = 16384;

__device__ __forceinline__ void moe_offsets(const unsigned* cnt, int (&rb_start)[17], int (&row_off)[17]) {
  int a = 0, b = 0;
#pragma unroll
  for (int e = 0; e < 16; ++e) { rb_start[e] = a; row_off[e] = b; const int n = (int)__hip_atomic_load(cnt + e, RLX_AGENT); const int nb = (n + 127) >> 7; a += nb; b += nb * 128; }
  rb_start[16] = a; row_off[16] = b;
}

constexpr size_t WS_WR = 11 * MiB + 512 * 1024;
__device__ __forceinline__ void route_weights_item(us* __restrict__ WR, const float* __restrict__ g_ffn, const float* __restrict__ w_rg, const float* __restrict__ w_re, int i) {
  const int l = i & 63, nt = (i >> 6) & 3, ks = i >> 8;
  const int o = 16 * (nt & 1) + (l & 15), k0 = 32 * ks + 8 * (l >> 4);
  unsigned w[4];
#pragma unroll
  for (int jj = 0; jj < 4; ++jj) {
    unsigned h2[2];
#pragma unroll
    for (int j2 = 0; j2 < 2; ++j2) {
      const int k = k0 + 2 * jj + j2;
      float v = 0.f;
      if (o < 4) v = w_rg[k * 4 + o]; else if (o < 20) v = w_re[k * 16 + (o - 4)];
      v *= g_ffn[k];
      const unsigned hi = f2bf_(v);
      h2[j2] = (nt < 2) ? hi : f2bf_(v - __uint_as_float(hi << 16));
    }
    w[jj] = h2[0] | (h2[1] << 16);
  }
  *(v4u*)(WR + (size_t)i * 8) = (v4u){w[0], w[1], w[2], w[3]};
}

__device__ __forceinline__ void route_phase(LAS unsigned char* lds, unsigned char* ws, const us* x1b, const float* b_rg, const float* b_re, int tid, int lane, int wave, int mode) {
  LAS float* LG = (LAS float*)lds;
  LAS float* SS = (LAS float*)(lds + 16896);
  LAS int* cnt_l = (LAS int*)(lds + 20480);
  LAS int* base_l = cnt_l + 16;
  LAS int* tok_e = base_l + 16;
  LAS int* tok_p = tok_e + 128;
  unsigned* cnt = (unsigned*)(ws + WS_CTL) + CW_CNT;
  int* LIST = (int*)(ws + WS_LIST);
  float* COMB = (float*)(ws + WS_COMB);
  float* RSTD = (float*)(ws + WS_RSTD);
  const us* WR = (const us*)(ws + WS_WR);
  if (tid < 16) cnt_l[tid] = 0;
  const int t0 = blockIdx.x * 64;
  {
    const int mblk = wave & 3, kh = wave >> 2;
    const us* arow = x1b + (size_t)(t0 + 16 * mblk + (lane & 15)) * D + kh * 512 + 8 * (lane >> 4);
    bf16x8 a[16];
#pragma unroll
    for (int ks = 0; ks < 16; ++ks) a[ks] = *(const bf16x8*)(arow + 32 * ks);
    const us* bbase = WR + ((size_t)(kh * 16) * 4 * 64 + lane) * 8;
    f32x4 acc0 = (f32x4){0.f, 0.f, 0.f, 0.f}, acc1 = acc0;
    float ssq = 0.f;
#pragma unroll
    for (int c = 0; c < 4; ++c) {
      bf16x8 bfr[4][4];
#pragma unroll
      for (int k4 = 0; k4 < 4; ++k4)
#pragma unroll
        for (int nt = 0; nt < 4; ++nt) bfr[k4][nt] = *(const bf16x8*)(bbase + (size_t)((c * 4 + k4) * 4 + nt) * 512);
      __builtin_amdgcn_sched_barrier(0);
#pragma unroll
      for (int k4 = 0; k4 < 4; ++k4) {
        const bf16x8 av = a[c * 4 + k4];
        acc0 = __builtin_amdgcn_mfma_f32_16x16x32_bf16(av, bfr[k4][0], acc0, 0, 0, 0);
        acc1 = __builtin_amdgcn_mfma_f32_16x16x32_bf16(av, bfr[k4][1], acc1, 0, 0, 0);
        acc0 = __builtin_amdgcn_mfma_f32_16x16x32_bf16(av, bfr[k4][2], acc0, 0, 0, 0);
        acc1 = __builtin_amdgcn_mfma_f32_16x16x32_bf16(av, bfr[k4][3], acc1, 0, 0, 0);
        const v4u au = __builtin_bit_cast(v4u, av);
#pragma unroll
        for (int d = 0; d < 4; ++d) { const float lo_ = __uint_as_float(au[d] << 16), hi_ = __uint_as_float(au[d] & 0xffff0000u); ssq = __builtin_fmaf(lo_, lo_, ssq); ssq = __builtin_fmaf(hi_, hi_, ssq); }
      }
    }
    ssq += __shfl_xor(ssq, 16); ssq += __shfl_xor(ssq, 32);
    LAS float* lg = LG + (kh * 64 + 16 * mblk + 4 * (lane >> 4)) * 33 + (lane & 15);
#pragma unroll
    for (int i = 0; i < 4; ++i) { lg[i * 33] = acc0[i]; lg[i * 33 + 16] = acc1[i]; }
    if (lane < 16) SS[kh * 64 + 16 * mblk + lane] = ssq;
  }
  __syncthreads();
  if (wave == 0) {
    const int t = t0 + lane;
    const LAS float* l0 = LG + lane * 33, *l1 = LG + (64 + lane) * 33;
    const float rstd = 1.0f / sqrtf((SS[lane] + SS[64 + lane]) * (1.0f / D) + EPS);
    RSTD[t] = rstd;
    const float g0 = (l0[0] + l1[0]) * rstd + b_rg[0], g1 = (l0[1] + l1[1]) * rstd + b_rg[1], g2 = (l0[2] + l1[2]) * rstd + b_rg[2], g3 = (l0[3] + l1[3]) * rstd + b_rg[3];
    int gi = 0; float gm = g0;
    if (g1 > gm) { gm = g1; gi = 1; }
    if (g2 > gm) { gm = g2; gi = 2; }
    if (g3 > gm) { gm = g3; gi = 3; }
    const float pg = 1.0f / (expf(g0 - gm) + expf(g1 - gm) + expf(g2 - gm) + expf(g3 - gm));
    const f32x4 be = *(const f32x4*)(b_re + gi * 4);
    const LAS float* e0p = l0 + 4 + gi * 4, *e1p = l1 + 4 + gi * 4;
    const float e0 = (e0p[0] + e1p[0]) * rstd + be[0], e1 = (e0p[1] + e1p[1]) * rstd + be[1], e2 = (e0p[2] + e1p[2]) * rstd + be[2], e3 = (e0p[3] + e1p[3]) * rstd + be[3];
    int i0 = 0; float m0 = e0;
    if (e1 > m0) { m0 = e1; i0 = 1; }
    if (e2 > m0) { m0 = e2; i0 = 2; }
    if (e3 > m0) { m0 = e3; i0 = 3; }
    int i1 = -1; float m1 = -INFINITY;
    if (i0 != 0 && e0 > m1) { m1 = e0; i1 = 0; }
    if (i0 != 1 && e1 > m1) { m1 = e1; i1 = 1; }
    if (i0 != 2 && e2 > m1) { m1 = e2; i1 = 2; }
    if (i0 != 3 && e3 > m1) { m1 = e3; i1 = 3; }
    const float r = expf(m1 - m0);
    const float c0 = pg / (1.0f + r), c1 = pg * r / (1.0f + r);
    const int ea = gi * 4 + i0, eb = gi * 4 + i1;
    tok_e[lane * 2] = ea; tok_e[lane * 2 + 1] = eb;
    tok_p[lane * 2] = atomicAdd((int*)(cnt_l + ea), 1);
    tok_p[lane * 2 + 1] = atomicAdd((int*)(cnt_l + eb), 1);
    *(unsigned long long*)(COMB + t * 2) = (unsigned long long)__float_as_uint(c0) | ((unsigned long long)__float_as_uint(c1) << 32);
  }
  __syncthreads();
  if (mode & 1) return;
  if (tid < 16) base_l[tid] = (int)__hip_atomic_fetch_add(cnt + tid, (unsigned)cnt_l[tid], RLX_AGENT);
  __syncthreads();
  if (tid < 128) {
    const int e = tok_e[tid], p = base_l[e] + tok_p[tid];
    LIST[e * LIST_CAP + p] = (blockIdx.x * 64 + (tid >> 1)) * 2 + (tid & 1);
  }
}

constexpr int SG_EPI_STAGE = 9216;
__device__ __forceinline__ void st16_wt(us* p, v4u v) { asm volatile("global_store_dwordx4 %0, %1, off sc1\n\ts_nop 1" :: "v"(p), "v"(v) : "memory"); }
struct EpiMoe1 {
  us* HID; int hid_row0, nvalid; LAS unsigned char* stage;
  const LAS float* rstd_l;
  __device__ __forceinline__ void operator()(const sg::f32x16 (&acc)[2][4], int wave, int r32, int hi) const {
    const int lane = r32 + 32 * hi;
    LAS unsigned char* st = stage + wave * SG_EPI_STAGE;
#pragma unroll
    for (int m = 0; m < 4; ++m) {
      const float rs = rstd_l[32 * m + r32];
#pragma unroll
      for (int q = 0; q < 4; ++q) {
        float h[4];
#pragma unroll
        for (int i = 0; i < 4; ++i) { const float g = acc[0][m][4 * q + i] * rs, u = acc[1][m][4 * q + i] * rs; h[i] = g * fsigmoid(g) * u; }
        *(LAS unsigned long long*)(st + (m * 32 + r32) * 72 + (8 * q + 4 * hi) * 2) = (unsigned long long)pk2(h[0], h[1]) | ((unsigned long long)pk2(h[2], h[3]) << 32);
      }
    }
    LDS_WAIT();
#pragma unroll
    for (int i = 0; i < 8; ++i) {
      const int rr = i * 16 + (lane >> 2), c = lane & 3;
      const unsigned long long lo = *(const LAS unsigned long long*)(st + rr * 72 + c * 16), hi2 = *(const LAS unsigned long long*)(st + rr * 72 + c * 16 + 8);
      const v4u v = (v4u){(unsigned)lo, (unsigned)(lo >> 32), (unsigned)hi2, (unsigned)(hi2 >> 32)};
      if (rr < nvalid) st16_wt(HID + (size_t)(hid_row0 + rr) * 256 + wave * 32 + c * 8, v);
      asm volatile("" ::: "memory");
    }
    LDS_WAIT();
  }
};
struct EpiMoe2 {
  us* YS; const LAS int* slots; int ct, nvalid; LAS unsigned char* stage;
  __device__ __forceinline__ void operator()(const sg::f32x16 (&acc)[2][2], int wm, int wn, int r32, int hi) const {
    const int lane = r32 + 32 * hi;
    LAS unsigned char* st = stage + (wm * 4 + wn) * SG_EPI_STAGE;
#pragma unroll
    for (int m = 0; m < 2; ++m) {
#pragma unroll
      for (int h = 0; h < 2; ++h)
#pragma unroll
        for (int q = 0; q < 4; ++q)
          *(LAS unsigned long long*)(st + r32 * 144 + (h * 32 + 8 * q + 4 * hi) * 2) =
              (unsigned long long)pk2(acc[h][m][4 * q], acc[h][m][4 * q + 1]) | ((unsigned long long)pk2(acc[h][m][4 * q + 2], acc[h][m][4 * q + 3]) << 32);
      LDS_WAIT();
#pragma unroll
      for (int i = 0; i < 4; ++i) {
        const int rr = i * 8 + (lane >> 3), c = lane & 7, grow = wm * 64 + m * 32 + rr;
        const v4u v = *(const LAS v4u*)(st + rr * 144 + c * 16);
        if (grow < nvalid) { const int slot = slots[grow]; *(v4u*)(YS + (size_t)slot * 1024 + ct * 256 + (c >> 2) * 128 + wn * 32 + (c & 3) * 8) = v; }
        asm volatile("" ::: "memory");
      }
      LDS_WAIT();
    }
  }
};

constexpr int CW_Q = 96;
constexpr int CW_READY = 128;
constexpr int MOE_SLOTS = LDS_BYTES - 1024;
constexpr int MOE_TAB = LDS_BYTES - 512;
constexpr int MOE_STG1 = 40960, MOE_STG2 = 67584;
template <int PART> __device__ __forceinline__ void moe_phase(LAS unsigned char* lds, unsigned char* ws, volatile LAS unsigned* MISC, int tid0, int mode) {
  int tid = tid0;
  unsigned* ctl = (unsigned*)(ws + WS_CTL);
  const unsigned* cnt = ctl + CW_CNT;
  LAS int* tab = (LAS int*)(lds + MOE_TAB);
  if (tid < 64) {
    const int n = tid < 16 ? (int)__hip_atomic_load(cnt + (tid & 15), RLX_AGENT) : 0;
    const int nb = (n + 127) >> 7;
    int incl = nb;
#pragma unroll
    for (int d = 1; d < 16; d <<= 1) { const int o = __shfl_up(incl, d); if ((tid & 63) >= d) incl += o; }
    if (tid < 16) { tab[tid] = incl - nb; tab[17 + tid] = (incl - nb) * 128; tab[34 + tid] = n; }
    if (tid == 15) { tab[16] = incl; tab[33] = incl * 128; }
  }
  __syncthreads();
  const int nrb = __builtin_amdgcn_readfirstlane(tab[16]);
  const int* LIST = (const int*)(ws + WS_LIST);
  const us* X1B = (const us*)(ws + WS_X1B);
  const float* RSTD = (const float*)(ws + WS_RSTD);
  const us* WguT = (const us*)(ws + WS_WGU);
  const us* WdT = (const us*)(ws + WS_WD);
  us* HID = (us*)(ws + WS_HID);
  const int wave_ = __builtin_amdgcn_readfirstlane(tid0 >> 6);
  unsigned long long tp_acc = 0ull, tp_0 = 0ull; const int tprobe = AMP_ON ? mode >> 8 : 0;
  if (tprobe == 3) tp_0 = __builtin_amdgcn_s_memrealtime();
  for (;;) {
    if (wave_ == 0) {   const int lane_ = tid0 & 63;
      unsigned v_ = 0u;
      if (lane_ == 0) v_ = __hip_atomic_fetch_add(ctl + CW_Q + (PART == 2 ? 1 : 0), 1u, RLX_AGENT) + (PART == 2 ? (unsigned)nrb : 0u);
      MISC[16] = (unsigned)__builtin_amdgcn_readfirstlane((int)v_);
    }
    __syncthreads();
    asm volatile("" : "+v"(tid));
    const int lane_ = tid & 63, wn_ = (tid >> 6) & 3;
    const int q = __builtin_amdgcn_readfirstlane((int)MISC[16]);
    if (q >= (PART == 1 ? 1 : 3) * nrb) break;
    const bool down = q >= nrb;
    if (tprobe == (down ? 2 : 1)) tp_0 = __builtin_amdgcn_s_memrealtime();
    const int rb = down ? (q - nrb) >> 1 : q;
    int e = 0;
#pragma unroll
    for (int k = 1; k < 16; ++k) if (rb >= tab[k]) e = k;
    const int n_e = tab[34 + e], row0 = tab[17 + e];
    const int r0 = (rb - tab[e]) * 128, nvalid = min(128, n_e - r0);
    if (!down) {
      const us* ap[2];
#pragma unroll
      for (int i = 0; i < 2; ++i) { const int c = tid + 512 * i; int r = c >> 3; if (r >= nvalid) r = 0; const int tok = LIST[e * LIST_CAP + r0 + r] >> 1; ap[i] = X1B + (size_t)tok * D + (c & 7) * 8; }
      if (tid < 128) ((LAS float*)(lds + MOE_SLOTS))[tid] = RSTD[LIST[e * LIST_CAP + r0 + (tid < nvalid ? tid : 0)] >> 1];
      const us* bf0 = WguT + ((size_t)(e * 16 + (wave_ >> 2) * 8 + (wave_ & 3)) * 64 * 2 + (lane_ >> 5)) * 256 + (lane_ & 31) * 8;
      const us* bf1 = bf0 + (size_t)4 * 64 * 512;
      EpiMoe1 E; E.HID = HID; E.hid_row0 = row0 + r0; E.nvalid = nvalid; E.stage = lds + MOE_STG1; E.rstd_l = (const LAS float*)(lds + MOE_SLOTS);
      sg::tile_wide(lds, ap, bf0, bf1, 1024, E, tid);
      asm volatile("s_waitcnt vmcnt(0)" ::: "memory");
      __syncthreads();
      if (wave_ == 1) { if (lane_ == 0) __hip_atomic_fetch_add(ctl + CW_READY + rb, 1u, RLX_AGENT); }
    } else {
      if (PART == 0 && wave_ == 2) { if (lane_ == 0) {
        unsigned sp = 0;
        while (__hip_atomic_load(ctl + CW_READY + rb, RLX_AGENT) < 1u) { __builtin_amdgcn_s_sleep(2); if (++sp > (1u << 22)) break; }
        __builtin_amdgcn_fence(__ATOMIC_ACQUIRE, "agent");
        asm volatile("s_waitcnt vmcnt(0)" ::: "memory");
      } }
      __syncthreads();
      if (tid < 128) ((LAS int*)(lds + MOE_SLOTS))[tid] = LIST[e * LIST_CAP + r0 + (tid < nvalid ? tid : 0)];
      {
        const us* hrow = HID + (size_t)(row0 + r0) * 256;
#pragma unroll
        for (int i = 0; i < 8; ++i) { const int c = tid + 512 * i; const int r = c >> 5, ch = c & 31;
          const v4u v = *(const v4u*)(hrow + (size_t)r * 256 + ch * 8);
          *(LAS v4u*)(lds + r * sg::ARS + ch * 16) = v; }
      }
      __syncthreads();
#pragma unroll 1
      for (int ct = 2 * ((q - nrb) & 1); ct < 2 * ((q - nrb) & 1) + 2; ++ct) {
        const us* bf0 = WdT + ((size_t)(e * 32 + ct * 8 + wn_) * 16 * 2 + (lane_ >> 5)) * 256 + (lane_ & 31) * 8;
        const us* bf1 = bf0 + (size_t)4 * 16 * 512;
        EpiMoe2 E; E.YS = (us*)(ws + WS_YS); E.slots = (const LAS int*)(lds + MOE_SLOTS); E.ct = ct; E.nvalid = nvalid; E.stage = lds + MOE_STG2;
        sg::tile_resident(lds, bf0, bf1, E, tid);
      }
      __syncthreads();
    }
    if (tprobe == (down ? 2 : 1)) tp_acc += __builtin_amdgcn_s_memrealtime() - tp_0;
  }
  if (tprobe == 3) tp_acc = __builtin_amdgcn_s_memrealtime() - tp_0;
  if (tprobe && blockIdx.x == 0) { const unsigned long long t1 = __builtin_amdgcn_s_memrealtime(); while (__builtin_amdgcn_s_memrealtime() - t1 < 9ull * tp_acc) __builtin_amdgcn_s_sleep(8); }
}
__device__ __forceinline__ void final_phase(unsigned char* ws, const us* x1b, float* out, const float* g_final, int lane, int wave, int mode) {
  const us* YS = (const us*)(ws + WS_YS);
  const float* COMB = (const float*)(ws + WS_COMB);
  for (int t = blockIdx.x * 8 + wave; t < T; t += gridDim.x * 8) {
    const unsigned long long* xr = (const unsigned long long*)(x1b + (size_t)t * D) + lane;
    const float c0 = COMB[t * 2], c1 = COMB[t * 2 + 1];
    const unsigned long long* y0 = (const unsigned long long*)(YS + (size_t)(2 * t) * D) + lane;
    const unsigned long long* y1 = (const unsigned long long*)(YS + (size_t)(2 * t + 1) * D) + lane;
    f32x4 v[4]; float s = 0.f;
#pragma unroll
    for (int j = 0; j < 4; ++j) {
      const unsigned long long xx = xr[64 * j];
      const unsigned long long a = y0[64 * j], b = y1[64 * j];
      v[j].x = __uint_as_float((unsigned)xx << 16) + (c0 * __uint_as_float((unsigned)a << 16) + c1 * __uint_as_float((unsigned)b << 16));
      v[j].y = __uint_as_float((unsigned)xx & 0xffff0000u) + (c0 * __uint_as_float((unsigned)a & 0xffff0000u) + c1 * __uint_as_float((unsigned)b & 0xffff0000u));
      v[j].z = __uint_as_float((unsigned)(xx >> 32) << 16) + (c0 * __uint_as_float((unsigned)(a >> 32) << 16) + c1 * __uint_as_float((unsigned)(b >> 32) << 16));
      v[j].w = __uint_as_float((unsigned)(xx >> 32) & 0xffff0000u) + (c0 * __uint_as_float((unsigned)(a >> 32) & 0xffff0000u) + c1 * __uint_as_float((unsigned)(b >> 32) & 0xffff0000u));
      s += (v[j].x * v[j].x + v[j].y * v[j].y) + (v[j].z * v[j].z + v[j].w * v[j].w);
    }
    const float rstd = 1.0f / sqrtf(wave_sum_dpp(s) * (1.0f / D) + EPS);
    f32x4* orow = (mode & 1) ? (f32x4*)((float*)(ws + WS_G) + (size_t)(t & 4095) * D) + lane : (f32x4*)(out + (size_t)t * D) + lane;
#pragma unroll
    for (int j = 0; j < 4; ++j) { const f32x4 gg = ((const f32x4*)g_final)[lane + 64 * j]; orow[64 * j] = v[j] * rstd * gg; }
  }
}

__device__ __forceinline__ void conv_unit(LAS unsigned char* lds, unsigned char* ws, const float* __restrict__ w_dw, const float* __restrict__ b_dw,
                                          const float* __restrict__ ln_g, const float* __restrict__ ln_b, int tid, int lane, int wave, int unit) {
  const us* G = (const us*)(ws + WS_G);
  us* NA = (us*)(ws + WS_NA);
  LAS us* gl = (LAS us*)lds;
  LAS float* ctile = (LAS float*)(lds + 96256);
  float w[31];
#pragma unroll
  for (int j = 0; j < 31; ++j) w[j] = w_dw[j * 512 + tid];
  const float bias = b_dw[tid];
  const f32x4 ga = *(const f32x4*)(ln_g + 4 * lane), gb = *(const f32x4*)(ln_g + 256 + 4 * lane);
  const f32x4 ba = *(const f32x4*)(ln_b + 4 * lane), bb = *(const f32x4*)(ln_b + 256 + 4 * lane);
  {
    const int t0 = unit * 64, tt0 = t0 & (S - 1);
    for (int c = tid; c < 94 * 64; c += 512) {
      const int r = c >> 6, ch = c & 63;
      v4u v = (v4u){0u, 0u, 0u, 0u};
      if (tt0 - 30 + r >= 0) v = *(const v4u*)(G + (size_t)(t0 - 30 + r) * 512 + ch * 8);
      *(LAS v4u*)(gl + r * 512 + ch * 8) = v;
    }
    __syncthreads();
#pragma unroll 1
    for (int q4 = 0; q4 < 4; ++q4) {
#pragma unroll 1
      for (int ph = 0; ph < 2; ++ph) {
        const int p = 2 * q4 + ph;
        float acc[8];
#pragma unroll
        for (int o = 0; o < 8; ++o) acc[o] = bias;
#pragma unroll
        for (int rr = 0; rr < 38; ++rr) {
          const float gv = __uint_as_float(((unsigned)gl[(p * 8 + rr) * 512 + tid]) << 16);
#pragma unroll
          for (int o = 0; o < 8; ++o) { const int j = rr - o; if (j >= 0 && j < 31) acc[o] += w[j] * gv; }
        }
#pragma unroll
        for (int o = 0; o < 8; ++o) ctile[(ph * 8 + o) * 512 + tid] = acc[o];
      }
      __syncthreads();
#pragma unroll
      for (int q = 0; q < 2; ++q) {
        const int tok = wave * 2 + q;
        const f32x4 a = *(const LAS f32x4*)(ctile + tok * 512 + 4 * lane), b = *(const LAS f32x4*)(ctile + tok * 512 + 256 + 4 * lane);
        const float mu = wave_sum_dpp((a.x + a.y) + (a.z + a.w) + (b.x + b.y) + (b.z + b.w)) * (1.0f / 512);
        const f32x4 da = a - mu, db = b - mu;
        const float var = wave_sum_dpp((da.x * da.x + da.y * da.y) + (da.z * da.z + da.w * da.w) + (db.x * db.x + db.y * db.y) + (db.z * db.z + db.w * db.w)) * (1.0f / 512);
        const float rs = 1.0f / sqrtf(var + EPS);
        f32x4 na = da * rs * ga + ba, nb = db * rs * gb + bb;
        na.x *= fsigmoid(na.x); na.y *= fsigmoid(na.y); na.z *= fsigmoid(na.z); na.w *= fsigmoid(na.w);
        nb.x *= fsigmoid(nb.x); nb.y *= fsigmoid(nb.y); nb.z *= fsigmoid(nb.z); nb.w *= fsigmoid(nb.w);
        us* dst = NA + (size_t)(t0 + q4 * 16 + tok) * 512;
        *(unsigned long long*)(dst + 4 * lane) = (unsigned long long)pk2(na.x, na.y) | ((unsigned long long)pk2(na.z, na.w) << 32);
        *(unsigned long long*)(dst + 256 + 4 * lane) = (unsigned long long)pk2(nb.x, nb.y) | ((unsigned long long)pk2(nb.z, nb.w) << 32);
      }
      __syncthreads();
    }
  }
}

__device__ __forceinline__ unsigned pk_sub_sat_u16(unsigned a, unsigned b) { unsigned r; asm("v_pk_sub_u16 %0, %1, %2 clamp" : "=v"(r) : "v"(a), "v"(b)); return r; }
__device__ __forceinline__ unsigned pk_min_u16(unsigned a, unsigned b) { unsigned r; asm("v_pk_min_u16 %0, %1, %2" : "=v"(r) : "v"(a), "v"(b)); return r; }
__device__ __forceinline__ unsigned pk_add_u16(unsigned a, unsigned b) { unsigned r; asm("v_pk_add_u16 %0, %1, %2" : "=v"(r) : "v"(a), "v"(b)); return r; }
__device__ __forceinline__ int wave_isum(int v) {
#pragma unroll
  for (int o = 1; o < 64; o <<= 1) v += __shfl_xor(v, o);
  return v;
}
__device__ __forceinline__ unsigned f16key(float sc) {
  sc += 0.0f;
  const _Float16 h = (_Float16)sc;
  const unsigned b = (unsigned)__builtin_bit_cast(unsigned short, h);
  const unsigned m = (unsigned)((int)(b << 16) >> 31);
  return (b ^ (m | 0x8000u)) & 0xFFFFu;
}
__device__ __forceinline__ unsigned f16key_raw(float sc) {
  const _Float16 h = (_Float16)sc;
  const unsigned b = (unsigned)__builtin_bit_cast(unsigned short, h);
  const unsigned m = (unsigned)__builtin_amdgcn_sbfe((int)b, 15, 1);
  return b ^ (m | 0x8000u);
}
__device__ __forceinline__ int wave_isum_dpp(int v) {
  v += __builtin_amdgcn_update_dpp(0, v, 0xB1, 0xF, 0xF, true);
  v += __builtin_amdgcn_update_dpp(0, v, 0x4E, 0xF, 0xF, true);
  v += __builtin_amdgcn_update_dpp(0, v, 0x141, 0xF, 0xF, true);
  v += __builtin_amdgcn_update_dpp(0, v, 0x140, 0xF, 0xF, true);
  v += __builtin_amdgcn_update_dpp(0, v, 0x142, 0xA, 0xF, true);
  v += __builtin_amdgcn_update_dpp(0, v, 0x143, 0xC, 0xF, true);
  return __builtin_amdgcn_readlane(v, 63);
}
__device__ __forceinline__ void tk_count4(unsigned& acc, const v4u k, unsigned cm1p, unsigned one2) {
  unsigned t0, t1, t2, t3;
  asm("v_pk_sub_u16 %1, %5, %9 clamp\n\tv_pk_sub_u16 %2, %6, %9 clamp\n\tv_pk_sub_u16 %3, %7, %9 clamp\n\tv_pk_sub_u16 %4, %8, %9 clamp\n\t"
      "v_pk_min_u16 %1, %1, %10\n\tv_pk_min_u16 %2, %2, %10\n\tv_pk_min_u16 %3, %3, %10\n\tv_pk_min_u16 %4, %4, %10\n\t"
      "v_pk_add_u16 %1, %1, %2\n\tv_pk_add_u16 %3, %3, %4\n\tv_pk_add_u16 %0, %0, %1\n\tv_pk_add_u16 %0, %0, %3"
      : "+v"(acc), "=&v"(t0), "=&v"(t1), "=&v"(t2), "=&v"(t3)
      : "v"(k.x), "v"(k.y), "v"(k.z), "v"(k.w), "v"(cm1p), "v"(one2));
}
template <int NQ> __device__ __forceinline__ int tk_count(const v4u (&kq)[NQ], unsigned cm1p, unsigned one2) {
  unsigned a0 = 0u, a1 = 0u;
#pragma unroll
  for (int q = 0; q < NQ; ++q) { if (q & 1) tk_count4(a1, kq[q], cm1p, one2); else tk_count4(a0, kq[q], cm1p, one2); }
  const unsigned a = a0 + a1;
  return wave_isum_dpp((int)((a & 0xffffu) + (a >> 16)));
}
template <int NQ> __device__ __forceinline__ void tk_select(const LAS us* KEYS, const LAS unsigned* HIST, unsigned char* MWB, int T0, int N_unit, int nkw, int wave, int lane) {
  const unsigned one2 = 0x00010001u;
#pragma unroll 1
  for (int jj = 0; jj < 2; ++jj) {
    const int j = 2 * wave + jj;
    v4u kq[NQ];
#pragma unroll
    for (int q = 0; q < NQ; ++q) {
      const int ci = lane + 64 * q;
      kq[q] = (v4u){0u, 0u, 0u, 0u};
      if (ci * 8 < N_unit) kq[q] = *(const LAS v4u*)(KEYS + j * 4096 + ci * 8);
    }
    unsigned prefix = 0u; int cge = 0, bit0 = 15;
    {
      const v4u h4 = *(const LAS v4u*)(HIST + j * 256 + 4 * lane);
      const int c0 = (int)h4.x, c1 = (int)h4.y, c2 = (int)h4.z, c3 = (int)h4.w;
      const int t4 = (c0 + c1) + (c2 + c3);
      int p = t4;
      p += __builtin_amdgcn_update_dpp(0, p, 0x111, 0xF, 0xF, true);
      p += __builtin_amdgcn_update_dpp(0, p, 0x112, 0xF, 0xF, true);
      p += __builtin_amdgcn_update_dpp(0, p, 0x114, 0xF, 0xF, true);
      p += __builtin_amdgcn_update_dpp(0, p, 0x118, 0xF, 0xF, true);
      p += __builtin_amdgcn_update_dpp(0, p, 0x142, 0xA, 0xF, true);
      p += __builtin_amdgcn_update_dpp(0, p, 0x143, 0xC, 0xF, true);
      const int total = __builtin_amdgcn_readlane(p, 63);
      const int suf = total - p + t4;
      const unsigned long long okm = __ballot(suf >= TOPK);
      if (okm != 0ull) {
        const int ls = 63 - __builtin_clzll(okm);
        const int above = __builtin_amdgcn_readlane(suf - t4, ls);
        const int d3 = __builtin_amdgcn_readlane(c3, ls), d2 = __builtin_amdgcn_readlane(c2, ls), d1 = __builtin_amdgcn_readlane(c1, ls), d0 = __builtin_amdgcn_readlane(c0, ls);
        int bsel, cnt_ge;
        if (above + d3 >= TOPK) { bsel = 3; cnt_ge = above + d3; }
        else if (above + d3 + d2 >= TOPK) { bsel = 2; cnt_ge = above + d3 + d2; }
        else if (above + d3 + d2 + d1 >= TOPK) { bsel = 1; cnt_ge = above + d3 + d2 + d1; }
        else { bsel = 0; cnt_ge = above + d3 + d2 + d1 + d0; }
        prefix = (unsigned)(4 * ls + bsel) << 8; cge = cnt_ge; bit0 = 7;
      }
    }
#pragma unroll 1
    for (int bit = (cge == TOPK ? -1 : bit0); bit >= 0; --bit) {
      const unsigned cand = prefix | (1u << bit), cm1 = cand - 1u, cp = cm1 | (cm1 << 16);
      const int cnt = tk_count<NQ>(kq, cp, one2);
      if (cnt >= TOPK) { prefix = cand; cge = cnt; if (cnt == TOPK) break; }
    }
    const unsigned tau = prefix, tp = tau | (tau << 16);
    unsigned char* mrow = MWB + (size_t)(T0 + j) * 512;
#define TK_STORE(q_, f0, f1, f2, f3) do { const unsigned by_ = ((f0) & 1u) | (((f0) >> 16) << 1) | (((f1) & 1u) << 2) | (((f1) >> 16) << 3) | (((f2) & 1u) << 4) | (((f2) >> 16) << 5) | \
        (((f3) & 1u) << 6) | (((f3) >> 16) << 7); const int ci_ = lane + 64 * (q_); if (ci_ * 8 < nkw) mrow[ci_] = (unsigned char)by_; } while (0)
    if (tau == 0u) {
#pragma unroll
      for (int q = 0; q < NQ; ++q) {
        TK_STORE(q, pk_min_u16(kq[q].x, one2), pk_min_u16(kq[q].y, one2), pk_min_u16(kq[q].z, one2), pk_min_u16(kq[q].w, one2)); }
    } else if (cge == TOPK) {
      const unsigned cm1 = tau - 1u, cp = cm1 | (cm1 << 16);
#pragma unroll
      for (int q = 0; q < NQ; ++q) {
        TK_STORE(q, pk_min_u16(pk_sub_sat_u16(kq[q].x, cp), one2), pk_min_u16(pk_sub_sat_u16(kq[q].y, cp), one2),
                 pk_min_u16(pk_sub_sat_u16(kq[q].z, cp), one2), pk_min_u16(pk_sub_sat_u16(kq[q].w, cp), one2)); }
    } else {
      const int cgt = tk_count<NQ>(kq, tp, one2);
      const int need = TOPK - cgt;
      int base = 0;
#pragma unroll
      for (int q = 0; q < NQ; ++q) {
        unsigned gt[4], eq[4];
        gt[0] = pk_min_u16(pk_sub_sat_u16(kq[q].x, tp), one2); gt[1] = pk_min_u16(pk_sub_sat_u16(kq[q].y, tp), one2);
        gt[2] = pk_min_u16(pk_sub_sat_u16(kq[q].z, tp), one2); gt[3] = pk_min_u16(pk_sub_sat_u16(kq[q].w, tp), one2);
        eq[0] = pk_min_u16(kq[q].x ^ tp, one2) ^ one2; eq[1] = pk_min_u16(kq[q].y ^ tp, one2) ^ one2;
        eq[2] = pk_min_u16(kq[q].z ^ tp, one2) ^ one2; eq[3] = pk_min_u16(kq[q].w ^ tp, one2) ^ one2;
        const unsigned es = (eq[0] + eq[1]) + (eq[2] + eq[3]);
        const int ecnt = (int)((es & 0xffffu) + (es >> 16));
        if (__ballot(ecnt != 0) != 0ull) {
          int pre = 0, tot = 0;
#pragma unroll
          for (int bb = 0; bb < 4; ++bb) {
            const unsigned long long bal = __ballot((ecnt >> bb) & 1);
            pre += (int)__builtin_amdgcn_mbcnt_hi((unsigned)(bal >> 32), __builtin_amdgcn_mbcnt_lo((unsigned)bal, 0u)) << bb;
            tot += __popcll(bal) << bb;
          }
          int rk = base + pre;
#pragma unroll
          for (int d = 0; d < 4; ++d) {
            const unsigned e_lo = eq[d] & 1u, e_hi = eq[d] >> 16;
            const unsigned s_lo = (e_lo && rk < need) ? 1u : 0u; rk += (int)e_lo;
            const unsigned s_hi = (e_hi && rk < need) ? 1u : 0u; rk += (int)e_hi;
            gt[d] |= s_lo | (s_hi << 16);
          }
          base += tot;
        }
        TK_STORE(q, gt[0], gt[1], gt[2], gt[3]);
      }
    }
#undef TK_STORE
  }
}

__device__ __forceinline__ void topk_phase(LAS unsigned char* lds, unsigned char* ws, unsigned char* mw, int tid0, int mode, unsigned long long& amp_acc,
                                           volatile LAS unsigned* MISC, int mword, unsigned* qhead,
                                           const float* __restrict__ cw_dw, const float* __restrict__ cb_dw, const float* __restrict__ cln_g, const float* __restrict__ cln_b) {
  const int ampk = AMP_ON ? (mode >> 16) & 15 : 0;
  typedef float f32x16 __attribute__((ext_vector_type(16)));
  const us* QI = (const us*)(ws + WS_QI);
  const us* KI = (const us*)(ws + WS_KI);
  const float* WI = (const float*)(ws + WS_WI);
  unsigned char* MWB = mw;
  LAS us* KEYS = (LAS us*)lds;
  LAS unsigned* HIST = (LAS unsigned*)(lds + 131072);
  const int wave_u = __builtin_amdgcn_readfirstlane(tid0 >> 6);
  int tid = tid0;
  for (;;) {
    if (wave_u == 0) {
      unsigned v_ = 0u;
      if ((tid0 & 63) == 0) v_ = __hip_atomic_fetch_add(qhead, 1u, __ATOMIC_RELAXED, __HIP_MEMORY_SCOPE_AGENT);
      MISC[mword] = (unsigned)__builtin_amdgcn_readfirstlane((int)v_);
    }
    __syncthreads();
    const int uq = __builtin_amdgcn_readfirstlane((int)MISC[mword]);
    if (uq >= 1280) break;
    asm volatile("" : "+v"(tid));
    const int lane = tid & 63, wave = tid >> 6;
    if (uq >= 768 && uq < 1024) { conv_unit(lds, ws, cw_dw, cb_dw, cln_g, cln_b, tid, lane, wave_u, uq - 768); continue; }
    const int u = uq < 768 ? uq : uq - 1024, blk_hi = uq < 768 ? 255 : 63;
    const int r = lane & 31, hh = lane >> 5;
    const int a_tok = ((r >> 3) >> 1) + 2 * ((r >> 2) & 1), a_head = (r & 3) + 4 * ((r >> 3) & 1);
    const int rp = wave_u & 1, kg = wave_u >> 1;
    const int b = u & 3, blk = blk_hi - (u >> 2);
    const int tt0 = blk * 16, T0 = b * S + tt0, tmax = tt0 + 15, nkt = (tmax >> 5) + 1;
    ((LAS v4u*)HIST)[tid] = (v4u){0u, 0u, 0u, 0u}; ((LAS v4u*)HIST)[tid + 512] = (v4u){0u, 0u, 0u, 0u};
    __syncthreads();
    const unsigned long long ta_ = AMP_ON ? __builtin_amdgcn_s_memrealtime() : 0ull;
    if (!(mode & 2)) {
      bf16x8 afr[2][4];
#pragma unroll
      for (int mt = 0; mt < 2; ++mt)
#pragma unroll
        for (int ks = 0; ks < 4; ++ks) afr[mt][ks] = *(const bf16x8*)(QI + (size_t)(T0 + 8 * rp + 4 * mt + a_tok) * 512 + a_head * 64 + 16 * ks + 8 * hh);
      float wv[2][16];
#pragma unroll
      for (int mt = 0; mt < 2; ++mt)
#pragma unroll
        for (int tl = 0; tl < 2; ++tl) {
          const float* wp = WI + (size_t)(T0 + 8 * rp + 4 * mt + tl + 2 * hh) * 8;
          const f32x4 w0 = *(const f32x4*)wp, w1 = *(const f32x4*)(wp + 4);
          wv[mt][8 * tl + 0] = w0.x; wv[mt][8 * tl + 1] = w0.y; wv[mt][8 * tl + 2] = w0.z; wv[mt][8 * tl + 3] = w0.w;
          wv[mt][8 * tl + 4] = w1.x; wv[mt][8 * tl + 5] = w1.y; wv[mt][8 * tl + 6] = w1.z; wv[mt][8 * tl + 7] = w1.w;
        }
      const us* kbase = KI + ((size_t)(b * (S / 32)) * 8 * 32 + hh * 32 + r) * 8;
      bf16x8 bA[4], bB[4];
      const int klast = nkt - 1;
#define TK_LOADB(dst, kt_) do { const int kc_ = (kt_) < klast ? (kt_) : klast; _Pragma("unroll") for (int ks = 0; ks < 4; ++ks) dst[ks] = *(const bf16x8*)(kbase + (size_t)kc_ * 2048 + 512 * ks); } while (0)
      LAS unsigned* hbp[2][2];
#pragma unroll
      for (int mt = 0; mt < 2; ++mt)
#pragma unroll
        for (int tl = 0; tl < 2; ++tl) hbp[mt][tl] = HIST + (8 * rp + 4 * mt + tl + 2 * hh) * 256;
#define TK_TILE(bfr, kt_, DIAG) do { \
        f32x16 acc[2]; \
        _Pragma("unroll") for (int mt = 0; mt < 2; ++mt) { \
          _Pragma("unroll") for (int i = 0; i < 16; ++i) acc[mt][i] = 0.f; \
          _Pragma("unroll") for (int ks = 0; ks < 4; ++ks) acc[mt] = __builtin_amdgcn_mfma_f32_32x32x16_bf16(afr[mt][ks], bfr[ks], acc[mt], 0, 0, 0); } \
        const int s = (kt_) * 32 + r; \
        _Pragma("unroll") for (int mt = 0; mt < 2; ++mt) \
          _Pragma("unroll") for (int tl = 0; tl < 2; ++tl) { \
            float sc = 0.f; \
            _Pragma("unroll") for (int h8 = 0; h8 < 8; ++h8) { const float rl_ = __int_as_float(max(__float_as_int(acc[mt][8 * tl + h8]), 0));   \
              asm("v_fmac_f32_e32 %0, %1, %2" : "+v"(sc) : "v"(wv[mt][8 * tl + h8]), "v"(rl_)); }     \
            const int tokl = 8 * rp + 4 * mt + tl + 2 * hh; \
            if (DIAG) { \
              const unsigned key = (s <= tt0 + tokl) ? f16key(sc) : 0u; \
              KEYS[tokl * 4096 + s] = (us)key; \
              if (key) __hip_atomic_fetch_add(hbp[mt][tl] + (key >> 8), 1u, __ATOMIC_RELAXED, __HIP_MEMORY_SCOPE_WORKGROUP);     \
            } else { \
              const unsigned key = f16key_raw(sc); \
              KEYS[tokl * 4096 + s] = (us)key; \
              __hip_atomic_fetch_add(hbp[mt][tl] + __builtin_amdgcn_ubfe(key, 8, 8), 1u, __ATOMIC_RELAXED, __HIP_MEMORY_SCOPE_WORKGROUP); \
            } \
          } } while (0)
      if (kg < nkt) {
        TK_LOADB(bA, kg);
        for (int kt = kg; kt < nkt; kt += 8) {
          TK_LOADB(bB, kt + 4);
          __builtin_amdgcn_sched_barrier(0);
          if (kt * 32 + 31 <= tt0) TK_TILE(bA, kt, false); else TK_TILE(bA, kt, true);
          if (kt + 4 < nkt) {
            TK_LOADB(bA, kt + 8);
            __builtin_amdgcn_sched_barrier(0);
            if ((kt + 4) * 32 + 31 <= tt0) TK_TILE(bB, kt + 4, false); else TK_TILE(bB, kt + 4, true);
          }
        }
      }
#undef TK_LOADB
#undef TK_TILE
    }
    __syncthreads();
    const unsigned long long tb_ = AMP_ON ? __builtin_amdgcn_s_memrealtime() : 0ull;
    if (ampk == 2) amp_acc += tb_ - ta_;
    {
      const int N_unit = nkt * 32;
      const int nkw = ((tt0 >> 8) + 1) * 256;
      const int nq = (nkw + 511) >> 9;
      if (mode & 1) continue;
      switch (nq) {
        case 1: tk_select<1>(KEYS, HIST, MWB, T0, N_unit, nkw, wave, lane); break;
        case 2: tk_select<2>(KEYS, HIST, MWB, T0, N_unit, nkw, wave, lane); break;
        case 3: tk_select<3>(KEYS, HIST, MWB, T0, N_unit, nkw, wave, lane); break;
        case 4: tk_select<4>(KEYS, HIST, MWB, T0, N_unit, nkw, wave, lane); break;
        case 5: tk_select<5>(KEYS, HIST, MWB, T0, N_unit, nkw, wave, lane); break;
        case 6: tk_select<6>(KEYS, HIST, MWB, T0, N_unit, nkw, wave, lane); break;
        case 7: tk_select<7>(KEYS, HIST, MWB, T0, N_unit, nkw, wave, lane); break;
        default: tk_select<8>(KEYS, HIST, MWB, T0, N_unit, nkw, wave, lane); break;
      }
      if (ampk == 3) amp_acc += __builtin_amdgcn_s_memrealtime() - tb_;
    }
  }
}

namespace attn_body {
using bf16=__hip_bfloat16;
using bf16x8=__attribute__((ext_vector_type(8)))short;
using s16x4=__attribute__((ext_vector_type(4)))short;
using f32x16=__attribute__((ext_vector_type(16)))float;
using u32x4=__attribute__((ext_vector_type(4)))unsigned;
constexpr int BATCH=4,NHEAD=8,SEQ=4096,D=64,DM=NHEAD*D;
constexpr int NW=8,QBLK=32,QB=QBLK*NW,KVBLK=64,NQB=SEQ/QB;
constexpr int ATTN_PITCH=DM, ATTN_UNIT_ROWS=QB;
__device__ __forceinline__ int crow(int r,int hi){return (r&3)+8*(r>>2)+4*hi;}
#define SBAR() __builtin_amdgcn_sched_barrier(0)
__device__ __forceinline__ void cmask(f32x16&p0,f32x16&p1,int jb,int qrel,int hi){
  const float NEG=-INFINITY; int kb=64*jb+4*hi;
  #pragma unroll
  for(int r=0;r<16;++r){int kv=kb+(r&3)+8*(r>>2); if(kv>qrel)p0[r]=NEG; if(kv+32>qrel)p1[r]=NEG;}
}

constexpr int NSLOT=3, SLOTB=8192;
constexpr int LDS_K=0, LDS_V=NSLOT*SLOTB, LDS_WS=2*NSLOT*SLOTB, LDS_OST=LDS_WS+NW*64*4, LDS_MK=LDS_OST+NW*4096, LDS_BYTES=LDS_MK+NW*2048;
constexpr float C2=0.125f*1.4426950408889634f;
__device__ __forceinline__ void glds16(const void*gsrc,unsigned lds_dst){unsigned keep;
  asm volatile("s_mov_b32 %0, m0\n\ts_mov_b32 m0, %2\n\ts_nop 0\n\tglobal_load_lds_dwordx4 %1, off\n\ts_mov_b32 m0, %0":"=&s"(keep):"v"(gsrc),"s"(lds_dst):"memory");}
__device__ __forceinline__ void glds16s(const void*sbase,unsigned voff,unsigned lds_dst){unsigned keep;
  asm volatile("s_mov_b32 %0, m0\n\ts_mov_b32 m0, %3\n\ts_nop 0\n\tglobal_load_lds_dwordx4 %1, %2\n\ts_mov_b32 m0, %0":"=&s"(keep):"v"(voff),"s"(sbase),"s"(lds_dst):"memory");}
__device__ __forceinline__ float max3f(float a,float b,float c){float r;asm("v_max3_f32 %0, %1, %2, %3":"=v"(r):"v"(a),"v"(b),"v"(c));return r;}
__device__ __forceinline__ float max2f(float a,float b){float r;asm("v_max_f32_e32 %0, %1, %2":"=v"(r):"v"(a),"v"(b));return r;}
__device__ __forceinline__ float fadd_s(float a,float b){float r;asm("v_add_f32_e32 %0, %1, %2":"=v"(r):"v"(a),"v"(b));return r;}
__device__ __forceinline__ float fsub_s(float a,float b){float r;asm("v_sub_f32_e32 %0, %1, %2":"=v"(r):"v"(a),"v"(b));return r;}
typedef float f32x2_t __attribute__((ext_vector_type(2))); typedef __bf16 bf16x2_t __attribute__((ext_vector_type(2)));
__device__ __forceinline__ unsigned cvtpk_s(float lo,float hi){f32x2_t v={lo,hi};bf16x2_t b=__builtin_convertvector(v,bf16x2_t);return __builtin_bit_cast(unsigned,b);}
#define WAIT_BAR(N) asm volatile("s_waitcnt vmcnt(" #N ") lgkmcnt(0)\n\ts_barrier":::"memory")

__device__ __forceinline__ void qkt(f32x16&p0,f32x16&p1,const char*Kslot,const bf16x8*qr,const f32x16&negm,int r32,int hi){
  const char*kb=Kslot+hi*1024+r32*16;
  #pragma unroll
  for(int d0=0;d0<4;++d0){
    const bf16x8 b0=*reinterpret_cast<const bf16x8*>(kb+d0*2048);
    const bf16x8 b1=*reinterpret_cast<const bf16x8*>(kb+d0*2048+512);
    if(d0==0){p0=__builtin_amdgcn_mfma_f32_32x32x16_bf16(b0,qr[0],negm,0,0,0);p1=__builtin_amdgcn_mfma_f32_32x32x16_bf16(b1,qr[0],negm,0,0,0);}
    else{p0=__builtin_amdgcn_mfma_f32_32x32x16_bf16(b0,qr[d0],p0,0,0,0);p1=__builtin_amdgcn_mfma_f32_32x32x16_bf16(b1,qr[d0],p1,0,0,0);}}
}
typedef __attribute__((address_space(3))) const char* lds_cptr;
typedef short v4i16_t __attribute__((ext_vector_type(4)));
__device__ __forceinline__ void kload8(bf16x8*kf,lds_cptr kp){
  kf[0]=*(const __attribute__((address_space(3))) bf16x8*)(kp);      kf[1]=*(const __attribute__((address_space(3))) bf16x8*)(kp+512);
  kf[2]=*(const __attribute__((address_space(3))) bf16x8*)(kp+2048); kf[3]=*(const __attribute__((address_space(3))) bf16x8*)(kp+2560);
  kf[4]=*(const __attribute__((address_space(3))) bf16x8*)(kp+4096); kf[5]=*(const __attribute__((address_space(3))) bf16x8*)(kp+4608);
  kf[6]=*(const __attribute__((address_space(3))) bf16x8*)(kp+6144); kf[7]=*(const __attribute__((address_space(3))) bf16x8*)(kp+6656);
}
__device__ __forceinline__ void kload2(bf16x8*kf,lds_cptr kp,int j){ kf[2*j]=*(const __attribute__((address_space(3))) bf16x8*)(kp+j*2048); kf[2*j+1]=*(const __attribute__((address_space(3))) bf16x8*)(kp+j*2048+512); }
__device__ __forceinline__ s16x4 vtr(lds_cptr p){ return __builtin_bit_cast(s16x4,__builtin_amdgcn_ds_read_tr16_b64_v4i16((__attribute__((address_space(3))) v4i16_t*)p)); }
__device__ __forceinline__ float rowmax(const f32x16&p0,const f32x16&p1){
  float a=max3f(p0[0],p0[1],p1[0]),b=max3f(p0[2],p0[3],p1[1]);a=max3f(a,p1[2],p1[3]);
  #pragma unroll
  for(int r=4;r<16;r+=4){a=max3f(a,p0[r],p0[r+1]);b=max3f(b,p0[r+2],p0[r+3]);a=max3f(a,p1[r],p1[r+1]);b=max3f(b,p1[r+2],p1[r+3]);}
  const float m=max2f(a,b);
  auto rr=__builtin_amdgcn_permlane32_swap(__float_as_uint(m),__float_as_uint(m),false,false);
  return max2f(__uint_as_float(rr[0]),__uint_as_float(rr[1]));
}
__device__ __forceinline__ void pv(f32x16*o,int vb,bf16x8 pa0,bf16x8 pa1,bf16x8 pa2,bf16x8 pa3){
  #pragma unroll
  for(int d0=0;d0<2;++d0){s16x4 lo[4],hi[4];
    #pragma unroll
    for(int ks=0;ks<4;++ks){
      asm volatile("ds_read_b64_tr_b16 %0,%1 offset:%c2":"=&v"(lo[ks]):"v"(vb),"i"(d0*4096+ks*1024):"memory");
      asm volatile("ds_read_b64_tr_b16 %0,%1 offset:%c2":"=&v"(hi[ks]):"v"(vb),"i"(d0*4096+ks*1024+512):"memory");}
    asm volatile("s_waitcnt lgkmcnt(0)":::"memory");SBAR();
    #define PK(k) (bf16x8){lo[k][0],lo[k][1],lo[k][2],lo[k][3],hi[k][0],hi[k][1],hi[k][2],hi[k][3]}
    o[d0]=__builtin_amdgcn_mfma_f32_32x32x16_bf16(pa0,PK(0),o[d0],0,0,0);
    o[d0]=__builtin_amdgcn_mfma_f32_32x32x16_bf16(pa1,PK(1),o[d0],0,0,0);
    o[d0]=__builtin_amdgcn_mfma_f32_32x32x16_bf16(pa2,PK(2),o[d0],0,0,0);
    o[d0]=__builtin_amdgcn_mfma_f32_32x32x16_bf16(pa3,PK(3),o[d0],0,0,0);
    #undef PK
  }
}

#ifndef ATTN_STORE16
#define ATTN_STORE16(p,v) asm volatile("global_store_dwordx4 %0, %1, off sc1\n\ts_nop 1"::"v"(p),"v"(v):"memory")
#endif
template<int THRL> __device__ __forceinline__ void attn_unit(int b,int h,int qb,const bf16*Q,const bf16*__restrict__ K,const bf16*__restrict__ V,bf16*O,const unsigned char*MW,unsigned*done,char*shm){
  const int tid=threadIdx.x,lane=tid&63,r32=lane&31,hi=lane>>5; const int wid=__builtin_amdgcn_readfirstlane(tid>>6);
  const long rowbase=(long)b*SEQ; const int q0=qb*QB;
  const bf16*Qw=Q+(rowbase+q0+wid*QBLK)*DM+h*D;
  const bf16*Kh=K+rowbase*DM+h*D,*Vh=V+rowbase*DM+h*D;
  const unsigned lds0=(unsigned)(uintptr_t)shm;
  __attribute__((address_space(3))) float*wsf=(__attribute__((address_space(3))) float*)((__attribute__((address_space(3))) char*)shm+LDS_WS)+wid*64;
  const unsigned koff=(unsigned)((lane*DM+wid*8)*2);
  const unsigned voff=(unsigned)(((16*(wid&3)+(lane>>2))*DM+(wid>>2)*32+(lane&3)*8)*2);
  const unsigned kdst=lds0+LDS_K+wid*1024, vdst=lds0+LDS_V+wid*1024;
  #define DMA_K(t,slot) glds16s(Kh+(long)(t)*KVBLK*DM,koff,(unsigned)__builtin_amdgcn_readfirstlane(kdst+(slot)))
  #define DMA_V(t,slot) glds16s(Vh+(long)(t)*KVBLK*DM,voff,(unsigned)__builtin_amdgcn_readfirstlane(vdst+(slot)))
  const int vb0=(int)(lds0+LDS_V)+((lane>>4)&1)*32+(lane&3)*8+(4*hi+((lane&15)>>2))*64;
  const char*Kbase=shm+LDS_K; bf16x8 kf[8];
  const lds_cptr shm3=(lds_cptr)shm; const lds_cptr kp0=shm3+LDS_K+hi*1024+r32*16; const lds_cptr vp0=shm3+LDS_V+((lane>>4)&1)*32+(lane&3)*8+(4*hi+((lane&15)>>2))*64;
  const int NT=(q0+QB)/KVBLK;
  const unsigned char*mbase=MW+((size_t)(rowbase+q0+wid*QBLK))*512; const unsigned moff=(unsigned)((lane>>1)*512+(lane&1)*16);
  const unsigned mdst=lds0+LDS_MK+wid*2048;
  #define MDMA(g) glds16s(mbase+(g)*32,moff,(unsigned)__builtin_amdgcn_readfirstlane(mdst+((g)&1)*1024))
  const lds_cptr mkp=(lds_cptr)shm+LDS_MK+wid*2048+r32*32;
  #define MWORD(t) (*(const __attribute__((address_space(3))) unsigned long long*)(mkp+(((t)>>2)&1)*1024+(((t)>>1)&1)*16+((t)&1)*8))
  #define MAPPLY(X,B,w) do{ X[B]=__uint_as_float(__float_as_uint(X[B])&(unsigned)__builtin_amdgcn_sbfe((int)(w),((B)&3)+8*((B)>>2),1)); }while(0)
  #define MAPPLYC(X,B,w) do{ int m_; asm("v_bfe_i32 %0, %1, %2, 1":"=v"(m_):"v"(w),"I"(((B)&3)+8*((B)>>2))); X[B]=__uint_as_float(__float_as_uint(X[B])&(unsigned)m_); }while(0)
  MDMA(0); if(q0+QB>4*KVBLK){MDMA(1);}
  DMA_K(0,0);DMA_V(0,0);DMA_K(1,SLOTB);
  bf16x8 qr[4];
  #pragma unroll
  for(int d0=0;d0<4;++d0)qr[d0]=*reinterpret_cast<const bf16x8*>(&Qw[(long)r32*DM+d0*16+hi*8]);
  float mhat=0.f;f32x16 o[2];o[0]=f32x16{};o[1]=f32x16{};f32x16 negm=f32x16{};asm volatile("":"+v"(negm));
  typedef float f32x4l __attribute__((ext_vector_type(4)));
  f32x4l lsum={0.f,0.f,0.f,0.f};
  bf16x8 SELA; { const short o1_=(lane==0||lane==32||lane==17||lane==49)?(short)0x3F80:(short)0; SELA=(bf16x8){o1_,o1_,o1_,o1_,o1_,o1_,o1_,o1_}; asm volatile("":"+v"(SELA)); }
  const int qrel=wid*QBLK+r32;
  #define CMASK(P0,P1,t) do{int jb_=(t)-(NT-4); if(jb_>=0)cmask(P0,P1,jb_,qrel,hi);}while(0)
  bool resc=false;
  #define START(P0,P1) do{ const float rm=rowmax(P0,P1); resc=false; \
    { const float dl=rm; mhat=fadd_s(mhat,dl); \
      _Pragma("unroll") for(int r=0;r<16;++r){P0[r]=fsub_s(P0[r],dl);P1[r]=fsub_s(P1[r],dl);} \
      _Pragma("unroll") for(int r=0;r<16;++r)negm[r]=-mhat; asm volatile("":"+v"(negm)); } \
    _Pragma("unroll") for(int r=0;r<16;++r)P0[r]=__builtin_amdgcn_exp2f(P0[r]); }while(0)
  #define RESC() do{ if(resc){ asm volatile("s_waitcnt lgkmcnt(0)":::"memory"); \
      _Pragma("unroll") for(int d_=0;d_<2;++d_) _Pragma("unroll") for(int r=0;r<16;++r)o[d_][r]*=wsf[crow(r,hi)]; \
      lsum[0]*=wsf[lane&15]; lsum[1]*=wsf[(lane&15)+16]; } }while(0)
  f32x16 pA0,pA1,pB0,pB1;
  int sl_prev=0,sl_cur=0,sl_next=SLOTB;
  #define ROT() do{sl_prev=sl_cur;sl_cur=sl_next;sl_next=(sl_next==(NSLOT-1)*SLOTB)?0:sl_next+SLOTB;}while(0)
  DMA_K(2,2*SLOTB);
  WAIT_BAR(3);
  qkt(pA0,pA1,Kbase,qr,negm,r32,hi);asm volatile("s_nop 15\n\ts_nop 7":"+v"(pA0),"+v"(pA1));
  START(pA0,pA1);
  _Pragma("unroll") for(int r=0;r<16;++r)pA1[r]=__builtin_amdgcn_exp2f(pA1[r]);
  unsigned mwl,mwh; { const unsigned long long mw_=MWORD(0); mwl=(unsigned)mw_>>(4*hi); mwh=(unsigned)(mw_>>32)>>(4*hi); }
  WAIT_BAR(0);
  DMA_K(3,0);DMA_V(1,SLOTB);
  ROT();
  kload8(kf,kp0+sl_cur);
  WAIT_BAR(2);
  s16x4 vlo[8],vhi[8]; u32x4 pw0,pw1,pw2,pw3;
  #define PKW(P,B) cvtpk_s(P[B],P[B+1])
  #define PAF(k) __builtin_bit_cast(bf16x8,pw##k)
  #define VFR(i) (bf16x8){vlo[i][0],vlo[i][1],vlo[i][2],vlo[i][3],vhi[i][0],vhi[i][1],vhi[i][2],vhi[i][3]}
  #define PIN(x) asm volatile("":"+v"(x))
  #define MX3(a,b,c) __builtin_fmaxf(__builtin_fmaxf((a),(b)),(c))
  #define GAPA(MF,PX,B0,WORD,PW,I0) do{ MF; MAPPLYC(PX,B0,WORD); MAPPLYC(PX,(B0)+1,WORD); MAPPLYC(PX,(B0)+2,WORD); MAPPLYC(PX,(B0)+3,WORD); PW[I0]=PKW(PX,B0); PW[(I0)+1]=PKW(PX,(B0)+2); PIN(PW); SBAR(); }while(0)
  #define EX(v) __builtin_amdgcn_exp2f(v)
  #define GAPB(MF,X,B,w) do{ MF; X[B]=EX(X[B]); X[B+1]=EX(X[B+1]); X[B+2]=EX(X[B+2]); X[B+3]=EX(X[B+3]); PIN(X); SBAR(); }while(0)
  #define VRD(i) do{ vlo[i]=vtr(vp_+(((i)>>2)*4096+((i)&3)*1024)); vhi[i]=vtr(vp_+(((i)>>2)*4096+((i)&3)*1024+512)); }while(0)
  #define KRD(G,j) do{ if(G){ kload2(kf,kp0+sl_next,j); SBAR(); } }while(0)
  #define STEP(C0,C1,P0,P1,t,GK,GV,GL) do{ SBAR(); \
    const lds_cptr vp_=vp0+sl_prev; \
    VRD(0); SBAR(); \
    GAPA(C0=__builtin_amdgcn_mfma_f32_32x32x16_bf16(kf[0],qr[0],negm,0,0,0), P0,0,mwl,pw0,0); \
    VRD(4); SBAR(); GAPA(C1=__builtin_amdgcn_mfma_f32_32x32x16_bf16(kf[1],qr[0],negm,0,0,0), P0,4,mwl,pw0,2); \
    VRD(1); SBAR(); GAPA(C0=__builtin_amdgcn_mfma_f32_32x32x16_bf16(kf[2],qr[1],C0,0,0,0),   P0,8,mwl,pw1,0); \
    VRD(5); SBAR(); GAPA(C1=__builtin_amdgcn_mfma_f32_32x32x16_bf16(kf[3],qr[1],C1,0,0,0),   P0,12,mwl,pw1,2); \
    VRD(2); SBAR(); GAPA(C0=__builtin_amdgcn_mfma_f32_32x32x16_bf16(kf[4],qr[2],C0,0,0,0),   P1,0,mwh,pw2,0); \
    VRD(6); SBAR(); GAPA(C1=__builtin_amdgcn_mfma_f32_32x32x16_bf16(kf[5],qr[2],C1,0,0,0),   P1,4,mwh,pw2,2); \
    VRD(3); SBAR(); GAPA(C0=__builtin_amdgcn_mfma_f32_32x32x16_bf16(kf[6],qr[3],C0,0,0,0),   P1,8,mwh,pw3,0); \
    VRD(7); SBAR(); GAPA(C1=__builtin_amdgcn_mfma_f32_32x32x16_bf16(kf[7],qr[3],C1,0,0,0),   P1,12,mwh,pw3,2); \
    if((((t)&3)==0)&&((t)+4<NT)){MDMA(((t)>>2)+1);} \
    if(GK){DMA_K((t)+3,sl_cur);} if(GV){DMA_V((t)+1,sl_next);} \
    { const unsigned long long mw_=MWORD(t); mwl=(unsigned)mw_>>(4*hi); mwh=(unsigned)(mw_>>32)>>(4*hi); }     \
    { float a=MX3(C0[0],C0[1],C1[0]),b=MX3(C0[2],C0[3],C1[1]); a=MX3(a,C1[2],C1[3]); \
      _Pragma("unroll") for(int r=4;r<16;r+=4){a=MX3(a,C0[r],C0[r+1]);b=MX3(b,C0[r+2],C0[r+3]);a=MX3(a,C1[r],C1[r+1]);b=MX3(b,C1[r+2],C1[r+3]);} \
      float rm; asm("v_max_f32 %0, %1, %2":"=v"(rm):"v"(a),"v"(b));   \
      { auto rr=__builtin_amdgcn_permlane32_swap(__float_as_uint(rm),__float_as_uint(rm),false,false); asm("v_max_f32 %0, %1, %2":"=v"(rm):"v"(rr[0]),"v"(rr[1])); } \
      resc=false; \
      if(__builtin_expect(__any(rm>(float)THRL),0)){ const float dl=__builtin_fmaxf(rm,0.f); mhat+=dl; \
        _Pragma("unroll") for(int r=0;r<16;++r){C0[r]-=dl;C1[r]-=dl;} \
        _Pragma("unroll") for(int r=0;r<16;++r)negm[r]=-mhat; asm volatile("":"+v"(negm)); \
        const float f=__builtin_amdgcn_exp2f(-dl); if(hi==0)wsf[r32]=f; resc=true; } } \
    SBAR(); \
    GAPB(o[0]=__builtin_amdgcn_mfma_f32_32x32x16_bf16(PAF(0),VFR(0),o[0],0,0,0), C0,0,0); \
    GAPB(o[1]=__builtin_amdgcn_mfma_f32_32x32x16_bf16(PAF(0),VFR(4),o[1],0,0,0); lsum=__builtin_amdgcn_mfma_f32_16x16x32_bf16(SELA,PAF(0),lsum,0,0,0), C0,4,0); \
    KRD(GL,0); GAPB(o[0]=__builtin_amdgcn_mfma_f32_32x32x16_bf16(PAF(1),VFR(1),o[0],0,0,0), C0,8,0); \
    KRD(GL,1); GAPB(o[1]=__builtin_amdgcn_mfma_f32_32x32x16_bf16(PAF(1),VFR(5),o[1],0,0,0); lsum=__builtin_amdgcn_mfma_f32_16x16x32_bf16(SELA,PAF(1),lsum,0,0,0), C0,12,0); \
    KRD(GL,2); GAPB(o[0]=__builtin_amdgcn_mfma_f32_32x32x16_bf16(PAF(2),VFR(2),o[0],0,0,0), C1,0,0); \
    KRD(GL,3); GAPB(o[1]=__builtin_amdgcn_mfma_f32_32x32x16_bf16(PAF(2),VFR(6),o[1],0,0,0); lsum=__builtin_amdgcn_mfma_f32_16x16x32_bf16(SELA,PAF(2),lsum,0,0,0), C1,4,0); \
    GAPB(o[0]=__builtin_amdgcn_mfma_f32_32x32x16_bf16(PAF(3),VFR(3),o[0],0,0,0), C1,8,0); \
    GAPB(o[1]=__builtin_amdgcn_mfma_f32_32x32x16_bf16(PAF(3),VFR(7),o[1],0,0,0); lsum=__builtin_amdgcn_mfma_f32_16x16x32_bf16(SELA,PAF(3),lsum,0,0,0), C1,12,0); \
    }while(0)
  int t=1;
  #undef CMASK
  #define CMASK(P0,P1,t) do{}while(0)
  for(;t+5<NT;t+=2){
    STEP(pB0,pB1,pA0,pA1,t,true,true,true);     WAIT_BAR(2); RESC(); ROT();
    STEP(pA0,pA1,pB0,pB1,t+1,true,true,true);   WAIT_BAR(2); RESC(); ROT();
  }
  #undef CMASK
  #define CMASK(P0,P1,t) do{int jb_=(t)-(NT-4); if(jb_>=0)cmask(P0,P1,jb_,qrel,hi);}while(0)
  #define ENDW(tt) do{ if((tt)+3<NT){WAIT_BAR(2);} else if((tt)+2<NT){WAIT_BAR(1);} else {WAIT_BAR(0);} }while(0)
  for(;t+1<NT;t+=2){
    STEP(pB0,pB1,pA0,pA1,t,(t+3<NT),(t+1<NT),(t+1<NT));       ENDW(t);   RESC(); ROT();
    STEP(pA0,pA1,pB0,pB1,t+1,(t+4<NT),(t+2<NT),(t+2<NT));     ENDW(t+1); RESC(); ROT();
  }
  STEP(pB0,pB1,pA0,pA1,NT-1,false,false,false); RESC();
  { _Pragma("unroll") for(int r=0;r<16;++r){ MAPPLY(pB0,r,mwl); MAPPLY(pB1,r,mwh); }
    pw0=(u32x4){PKW(pB0,0),PKW(pB0,2),PKW(pB0,4),PKW(pB0,6)};pw1=(u32x4){PKW(pB0,8),PKW(pB0,10),PKW(pB0,12),PKW(pB0,14)};pw2=(u32x4){PKW(pB1,0),PKW(pB1,2),PKW(pB1,4),PKW(pB1,6)};pw3=(u32x4){PKW(pB1,8),PKW(pB1,10),PKW(pB1,12),PKW(pB1,14)};
    SBAR(); pv(o,vb0+sl_cur,PAF(0),PAF(1),PAF(2),PAF(3));
    lsum=__builtin_amdgcn_mfma_f32_16x16x32_bf16(SELA,PAF(0),lsum,0,0,0); lsum=__builtin_amdgcn_mfma_f32_16x16x32_bf16(SELA,PAF(1),lsum,0,0,0);
    lsum=__builtin_amdgcn_mfma_f32_16x16x32_bf16(SELA,PAF(2),lsum,0,0,0); lsum=__builtin_amdgcn_mfma_f32_16x16x32_bf16(SELA,PAF(3),lsum,0,0,0); }
  #undef PKW
  #undef PAF
  #undef VFR
  #undef PIN
  #undef MX3
  #undef GAPA
  #undef GAPB
  #undef EX
  #undef VRD
  #undef KRD
  #undef STEP
  #undef ENDW
  if(lane<16){wsf[32+lane]=lsum[0];wsf[48+lane]=lsum[1];}asm volatile("s_waitcnt lgkmcnt(0)":::"memory");
  float rli[16];
  #pragma unroll
  for(int r=0;r<16;++r)rli[r]=__builtin_amdgcn_rcpf(wsf[32+crow(r,hi)]);
  bf16*Ow=O+(rowbase+q0+wid*QBLK)*DM+h*D;
  { bf16*stg=(bf16*)(shm+LDS_OST)+wid*2048;
    #pragma unroll
    for(int r=0;r<16;++r){const int orow=crow(r,hi);
      #pragma unroll
      for(int d0=0;d0<2;++d0)stg[orow*64+d0*32+r32]=__float2bfloat16(o[d0][r]*rli[r]);}
    asm volatile("s_waitcnt lgkmcnt(0)":::"memory");
    #pragma unroll
    for(int i=0;i<4;++i){const int row=i*8+(lane>>3),ch=lane&7; const u32x4 v=*(const u32x4*)(stg+row*64+ch*8); ATTN_STORE16(Ow+(long)row*DM+ch*8,v);} }
  asm volatile("s_waitcnt vmcnt(0) lgkmcnt(0)\n\ts_barrier":::"memory");
  if(wid==1){ if(lane==0) __hip_atomic_fetch_add(done+b*16+qb,1u,__ATOMIC_RELAXED,__HIP_MEMORY_SCOPE_AGENT); }
  #undef DMA_K
  #undef DMA_V
  #undef CMASK
  #undef MDMA
  #undef MWORD
  #undef MAPPLY
  #undef MAPPLYC
  #undef START
  #undef RESC
  #undef ROT
}
constexpr int ATTN_LDS_BYTES=LDS_BYTES;
struct AttnTensors { const bf16* Q; const bf16* K; const bf16* V; bf16* O; const unsigned char* MW; unsigned* done; };
template<int THRL=8> __device__ __forceinline__ void attn_phase(char*lds,const AttnTensors&T,int grid,int block){
  for(int v0=block;v0<256;v0+=grid){
    const int vcu=(grid==256)?((v0%8)*32+v0/8):v0; const int bh=vcu>>3,s=vcu&7;
    attn_unit<THRL>(bh/NHEAD,bh%NHEAD,s,T.Q,T.K,T.V,T.O,T.MW,T.done,lds);
    attn_unit<THRL>(bh/NHEAD,bh%NHEAD,15-s,T.Q,T.K,T.V,T.O,T.MW,T.done,lds);
  }
}
#undef SBAR
#undef WAIT_BAR
}

__global__ void __launch_bounds__(512, 2) mk_fwd(Args args) {
  extern __shared__ __attribute__((aligned(16))) unsigned char lds_raw[];
  LAS unsigned char* lds = (LAS unsigned char*)lds_raw;
  volatile LAS unsigned* MISC = (volatile LAS unsigned*)(lds + MISC_OFF);
  const int tid = threadIdx.x, lane = tid & 63;
  const int wave = __builtin_amdgcn_readfirstlane(tid >> 6);
  const int G_ = gridDim.x;
  unsigned char* ws = args.ws;
  if (tid < 32) MISC[tid] = 0u;
  __syncthreads();
  XcdBarrier bar = xcd_barrier_post((unsigned*)(ws + WS_CTL) + CW_BAR + args.li * XCD_BAR_WORDS, MISC + 8);
  const int lo = args.ph_lo, hi = args.ph_hi;
#define IN(k) (lo <= (k) && (k) < hi)
  unsigned long long amp_acc = 0ull, t_lastexit = AMP_ON ? __builtin_amdgcn_s_memrealtime() : 0ull;
#define SEAM(k) do { if (IN(k) && (k) + 1 < hi) { if (!AMP_ON) { xcd_barrier(bar); } else { const unsigned long long tb_ = __builtin_amdgcn_s_memrealtime(); xcd_barrier(bar); const unsigned long long te_ = __builtin_amdgcn_s_memrealtime(); \
    if (((args.dup >> 16) & 15) == 1) amp_acc += te_ - tb_; \
    if (((args.dup >> 16) & 15) == 14 && (((unsigned)args.dup >> 28) & 15u) == (unsigned)(k)) amp_acc += te_ - t_lastexit; t_lastexit = te_; } } } while (0)

#define PHASE_IDS() int tid_p = tid; asm volatile("" : "+v"(tid_p)); const int lane_p = tid_p & 63; const int wave_p = __builtin_amdgcn_readfirstlane(tid_p >> 6)
#define AMP_T0() const unsigned long long tph_ = AMP_ON ? __builtin_amdgcn_s_memrealtime() : 0ull
#define AMP_T1(k) do { if (AMP_ON && ((args.dup >> 16) & 15) == 15 && (((unsigned)args.dup >> 28) & 15u) == (unsigned)(k)) amp_acc += __builtin_amdgcn_s_memrealtime() - tph_; } while (0)
  const float* x = args.in[0];
  const int* pos = (const int*)args.in[1];
  const float* g_mix = args.in[2];
  const float* w_in = args.in[3];
  us* WinT = (us*)(ws + WS_WIN); us* WcoT = (us*)(ws + WS_WCO); us* WaoT = (us*)(ws + WS_WAO); us* WoT = (us*)(ws + WS_WO);
  float* CT = (float*)(ws + WS_CT); float* ST = (float*)(ws + WS_ST);
  us* Hb = (us*)(ws + WS_HB);

  { AMP_T0(); if (IN(PH_PREP)) {
    LAS float* scr = (LAS float*)(lds + wave * 16384);
    const int gw = blockIdx.x * 8 + wave, NGW = G_ * 8;
    constexpr int I_IN = 16 * 84, I_CO = 8 * 16, I_AO = 8 * 16, I_O = 16 * 16;
    constexpr int NITEMS = I_IN + I_CO + I_AO + I_O;
    LAS float* scr64 = (LAS float*)(lds + wave * 16640);
    for (int it = gw; it < NITEMS; it += NGW) {
      int r = it;
      if (r < I_IN) {
        const int p = r % 84, kb = r / 84, pn = p >> 2, q = p & 3;
        int ga, gb;
        if (pn >= 4 && pn < 12) { ga = pn * 8 + q; gb = ga + 4; }
        else if (pn == 20) { ga = 160 + q; gb = 164 + q; }
        else { ga = pn * 8 + (q >> 1) * 4 + 2 * (q & 1); gb = ga + 1; }
        const int sa = inproj_src(ga), sb = inproj_src(gb);
        if (sa < 0) { p0_transpose_item(w_in, INC, 64 * kb, -1, WinT, 1024, 32 * ga, scr64, lane); p0_transpose_item(w_in, INC, 64 * kb, -1, WinT, 1024, 32 * gb, scr64, lane); }
        else p0_transpose_item64(w_in, INC, 64 * kb, sa, WinT, 1024, 32 * ga, 32 * gb, sb < 0, scr64, lane);
        continue;
      }
      r -= I_IN;
      if (r < I_CO) { const int nb = r % 16, kb = r / 16; p0_transpose_item64(args.in[8], 1024, 64 * kb, 64 * nb, WcoT, 512, 64 * nb, 64 * nb + 32, false, scr64, lane); continue; }
      r -= I_CO;
      if (r < I_AO) { const int nb = r % 16, kb = r / 16; p0_transpose_item64(args.in[9], 1024, 64 * kb, 64 * nb, WaoT, 512, 64 * nb, 64 * nb + 32, false, scr64, lane); continue; }
      r -= I_AO;
      { const int nb = r % 16, kb = r / 16; p0_transpose_item64(args.in[10], 1024, 64 * kb, 64 * nb, WoT, 1024, 64 * nb, 64 * nb + 32, false, scr64, lane); }
    }
    for (int row = gw * 4; row < T; row += NGW * 4) rms_rows4_to_bf16(x + (size_t)row * D, g_mix, Hb + (size_t)row * D, lane);
    const float inv = 1.0f / powf(10000.0f, (float)(2 * (tid & 31)) / 64.0f);
    for (int i = blockIdx.x * 512 + tid; i < T * 32; i += G_ * 512) {
      const int t = i >> 5;
      const float ang = (float)pos[t] * inv;
      const float n_ = rintf(ang * 0.15915494309189535f);
      float rr = __builtin_fmaf(-n_, 6.28125f, ang); rr = __builtin_fmaf(-n_, 1.9353071795864769e-3f, rr);
      const float rev = rr * 0.15915494309189535f;
      CT[i] = __builtin_amdgcn_cosf(rev); ST[i] = __builtin_amdgcn_sinf(rev);
    }
    for (int i = blockIdx.x * 512 + tid; i < 8192; i += G_ * 512) route_weights_item((us*)(ws + WS_WR), args.in[11], args.in[12], args.in[14], i);
  }
  AMP_T1(PH_PREP); }
  SEAM(PH_PREP);
  { AMP_T0(); if (IN(PH_INPROJ)) {
    pg8::Gemm g{Hb, WinT, T, NIN, D};
    InProjOrder So; So.init(T, NIN, G_, (int)blockIdx.x); So.dep = (unsigned*)(ws + WS_CTL) + CW_DEP;
    EpiInProj E;
    E.G = (us*)(ws + WS_G); E.Q = (us*)(ws + WS_Q); E.K = (us*)(ws + WS_K); E.V = (us*)(ws + WS_V); E.QI = (us*)(ws + WS_QI);
    E.KI = (us*)(ws + WS_KI); E.GC = (us*)(ws + WS_GC); E.GA = (us*)(ws + WS_GA); E.WI = (float*)(ws + WS_WI); E.CT = CT; E.ST = ST;
    pg8::gemm_phase<EpiInProj, InProjOrder, true, true>(lds, g, So, E);
    {
      const int nwg_ = (T / 256) * (NIN / 256); int n6 = nwg_ - 5 * G_; n6 = n6 < 0 ? 0 : (n6 > G_ ? G_ : n6);
      const bool all_ = (n6 == 0 || n6 == G_);
      const bool six = !all_ && (int)blockIdx.x < n6;
      const int nfree = all_ ? G_ : G_ - n6, myidx = all_ ? (int)blockIdx.x : (int)blockIdx.x - n6;
      if (!six && nfree > 0) {
        LAS float* scr = (LAS float*)(lds + wave * 16384);
        constexpr int I_GU = 16 * 16 * 16, I_DN = 16 * 4 * 32;
        for (int it = myidx * 8 + wave; it < I_GU + I_DN; it += nfree * 8) {
          int r = it;
      if (r < I_GU) {
        const int g16 = r & 15, kb = (r >> 4) & 15, e = r >> 8; const int ct = g16 >> 3, half = (g16 >> 2) & 1, q = g16 & 3;
        p0_transpose_item_fm((half ? args.in[17] : args.in[16]) + (size_t)e * 1024 * 256, 256, 64 * kb, 128 * ct + 32 * q, (us*)(ws + WS_WGU), 1024,
                             e * 16 + ct * 8 + half * 4 + q, scr, lane, args.in[11]);
        continue; }
      r -= I_GU;
      { const int g = r & 31, kb = (r >> 5) & 3, e = r >> 7;
        p0_transpose_item_fm(args.in[18] + (size_t)e * 256 * 1024, 1024, 64 * kb, 32 * g, (us*)(ws + WS_WD), 256, e * 32 + g, scr, lane); }
        }
      }
    }
  }
  AMP_T1(PH_INPROJ); }
  { AMP_T0(); if (IN(PH_TOPK)) { PHASE_IDS();
    unsigned* ctl_ = (unsigned*)(ws + WS_CTL);
    if (threadIdx.x < 64) {
      unsigned sp = 0;
      while ((unsigned)__builtin_amdgcn_readfirstlane(__hip_atomic_load(ctl_ + CW_DEP, __ATOMIC_RELAXED, __HIP_MEMORY_SCOPE_AGENT)) < DEP_TARGET) { __builtin_amdgcn_s_sleep(2); if (++sp > (1u << 22)) break; }
      __builtin_amdgcn_fence(__ATOMIC_ACQUIRE, "agent");
      asm volatile("s_waitcnt vmcnt(0)" ::: "memory");
    }
    __syncthreads();
    topk_phase(lds, ws, (unsigned char*)args.out, tid_p, args.dup, amp_acc, MISC, 20, ctl_ + CW_TQ, args.in[4], args.in[5], args.in[6], args.in[7]);
  }
  AMP_T1(PH_TOPK); }
  SEAM(PH_TOPK);
  { AMP_T0(); if (IN(PH_ATTN)) {
    attn_body::AttnTensors Tn{(const attn_body::bf16*)(ws + WS_Q), (const attn_body::bf16*)(ws + WS_K), (const attn_body::bf16*)(ws + WS_V),
                              (attn_body::bf16*)(ws + WS_AO), (const unsigned char*)args.out, (unsigned*)(ws + WS_CTL) + CW_ATTN};
    attn_body::attn_phase<8>((char*)lds_raw, Tn, G_, (int)blockIdx.x);
  }
  AMP_T1(PH_ATTN); }
  { AMP_T0(); if (IN(PH_MIX)) {
    us* M1 = (us*)(ws + WS_M1);
    DualOrder So; So.init(T, 1024, G_, (int)blockIdx.x); So.ready = (const unsigned*)(ws + WS_CTL) + CW_ATTN;
    pg8::Gemm g0{(const us*)(ws + WS_NA), WcoT, T, 1024, 512}, g1{(const us*)(ws + WS_AO), WaoT, T, 1024, 512};
    EpiGate2 E; E.gc = (const us*)(ws + WS_GC); E.ga = (const us*)(ws + WS_GA); E.M1 = M1;
    pg8::gemm_phase<EpiGate2, DualOrder, true, true>(lds, g0, So, E, g1);
  }
  AMP_T1(PH_MIX); }
  SEAM(PH_MIX);
  { AMP_T0(); if (IN(PH_WO)) {
    pg8::Gemm g{(const us*)(ws + WS_M1), WoT, T, 1024, 1024};
    pg8::StaticOrder So; So.init(T, 1024, G_, (int)blockIdx.x);
    EpiRes E; E.base = x; E.x1b = (us*)(ws + WS_X1B);
    pg8::gemm_phase<EpiRes, pg8::StaticOrder, true, true>(lds, g, So, E);
  }
  AMP_T1(PH_WO); }
  SEAM(PH_WO);
  const unsigned long long tr0_ = AMP_ON ? __builtin_amdgcn_s_memrealtime() : 0ull;
  if (IN(PH_ROUTE)) { PHASE_IDS(); route_phase(lds, ws, (const us*)(ws + WS_X1B), args.in[13], args.in[15], tid_p, lane_p, wave_p, args.dup); }
  if (AMP_ON && ((args.dup >> 16) & 15) == 4) amp_acc += __builtin_amdgcn_s_memrealtime() - tr0_;
  SEAM(PH_ROUTE);
  { AMP_T0(); if (IN(PH_MOE1)) { PHASE_IDS(); moe_phase<0>(lds, ws, MISC, tid_p, args.dup); }
  AMP_T1(PH_MOE1); }
  SEAM(PH_MOE1);
  if (AMP_ON && ((args.dup >> 16) & 15) == 5) { for (int i_ = 0; i_ < 10; ++i_) xcd_barrier(bar); }
  { AMP_T0(); if (IN(PH_FINAL)) { PHASE_IDS(); final_phase(ws, (const us*)(ws + WS_X1B), args.out, args.in[19], lane_p, wave_p, args.dup); }
  AMP_T1(PH_FINAL); }
  if (AMP_ON && ((args.dup >> 16) & 15) && (int)blockIdx.x == ((args.dup >> 20) & 255)) { const unsigned long long t1 = __builtin_amdgcn_s_memrealtime(); while (__builtin_amdgcn_s_memrealtime() - t1 < 9ull * amp_acc) __builtin_amdgcn_s_sleep(8); }
}

constexpr int SHIP_MODE = 0;
constexpr int PROBE_MODE = 0;
constexpr int PROBE_K = -1;
extern "C" void kernel_launch(void* const* d_in, const int* in_sizes, int n_in, void* d_out, int out_size, void* d_ws, size_t ws_size,
                              hipStream_t stream) {
  static int grid = 0;
  if (grid == 0) {
    int dev = 0, cus = 0, per_cu = 0;
    hipGetDevice(&dev);
    hipDeviceGetAttribute(&cus, hipDeviceAttributeMultiprocessorCount, dev);
    hipFuncSetAttribute((const void*)mk_fwd, hipFuncAttributeMaxDynamicSharedMemorySize, LDS_BYTES);
    hipOccupancyMaxActiveBlocksPerMultiprocessor(&per_cu, (const void*)mk_fwd, 512, LDS_BYTES);
    if (per_cu < 1) { fprintf(stderr, "kernel_launch: occupancy query says %d blocks/CU\n", per_cu); per_cu = 1; }
    grid = cus;
  }
  hipMemsetAsync((char*)d_ws + WS_CTL, 0, CTL_ZERO_BYTES, stream);
  Args a{};
  for (int i = 0; i < 20; ++i) a.in[i] = (const float*)d_in[i];
  a.out = (float*)d_out; a.ws = (unsigned char*)d_ws;
  auto launch = [&](int lo, int hi, int li, int mode = 0) {
    a.ph_lo = lo; a.ph_hi = hi; a.li = li; a.dup = mode;
    void* kargs[] = {&a};
    hipError_t e = hipLaunchCooperativeKernel((const void*)mk_fwd, dim3(grid), dim3(512), kargs, LDS_BYTES, stream);
    if (e != hipSuccess) fprintf(stderr, "cooperative launch failed: %s (grid %d)\n", hipGetErrorString(e), grid);
  };
  if (PROBE_K == -1) launch(PH_PREP, PH_END, 0, SHIP_MODE);
  else if (PROBE_K == -2) { launch(PH_PREP, PH_ATTN, 0); launch(PH_ATTN, PH_MIX, 1); launch(PH_MIX, PH_END, 2); }
  else { int li = 0; if (PROBE_K > 0) launch(PH_PREP, PROBE_K, li++); launch(PROBE_K, PROBE_K + 1, li++, PROBE_MODE); if (PROBE_K == PH_MOE1) hipMemsetAsync((char*)d_ws + WS_CTL + 96 * 4, 0, (512 - 96) * 4, stream); launch(PROBE_K, PROBE_K + 1, li++); if (PROBE_K + 1 < PH_END) launch(PROBE_K + 1, PH_END, li++); }

}
```
